# Optimizing an MI355X kernel written in HIP

```python
import jax
import jax.numpy as jnp
from jax import lax
import numpy as np

D_MODEL = 2048
BATCH = 1
SEQ = 8192
DEPTH = 1

MLA_HEADS = 8
QK_NOPE = 128
QK_ROPE = 64
V_HEAD = 128
Q_LORA = 512
KV_LORA = 256
MLA_WIDTH = MLA_HEADS * V_HEAD
MOBA_HEADS = 8
MOBA_HEAD_DIM = 128
MOBA_WIDTH = MOBA_HEADS * MOBA_HEAD_DIM
MOBA_BLOCK = 256
MOBA_TOPK = 3
MOBA_QCHUNK = 32
MIX_WIDTH = MLA_WIDTH + MOBA_WIDTH
IN_COLS = Q_LORA + KV_LORA + QK_ROPE + 3 * MOBA_WIDTH
ROPE_THETA = 10000.0
ATTN_QBLOCK = 128
N_EXPERTS = 32
TOP_K = 4
D_FF = D_MODEL
SWIGLU_LIMIT = 7.0
SWIGLU_ALPHA = 1.702
MOE_BLOCK = 256
DEEPNORM_ALPHA = float((2 * DEPTH) ** 0.25)
DEEPNORM_BETA = float((8 * DEPTH) ** -0.25)
RMS_EPS = 1e-6
LN_EPS = 1e-5

kernel_name = "hybrid_mla_moba_moe_deepnorm"


def rms_norm(x, g):
    xf = x.astype(jnp.float32)
    y = xf * lax.rsqrt(jnp.mean(xf * xf, axis=-1, keepdims=True) + RMS_EPS)
    return (y * g.astype(jnp.float32)).astype(x.dtype)


def layer_norm(x, g, b):
    xf = x.astype(jnp.float32)
    mu = jnp.mean(xf, axis=-1, keepdims=True)
    var = jnp.mean(jnp.square(xf - mu), axis=-1, keepdims=True)
    y = (xf - mu) * lax.rsqrt(var + LN_EPS)
    return (y * g.astype(jnp.float32) + b.astype(jnp.float32)).astype(x.dtype)


def rope(x, pos):
    d = x.shape[-1]
    half = d // 2
    inv_freq = ROPE_THETA ** (-jnp.arange(half, dtype=jnp.float32) * 2.0 / d)
    ang = pos.astype(jnp.float32)[:, :, None] * inv_freq
    cos = jnp.cos(ang)[:, :, None, :]
    sin = jnp.sin(ang)[:, :, None, :]
    xf = x.astype(jnp.float32)
    x1, x2 = xf[..., :half], xf[..., half:]
    return jnp.concatenate([x1 * cos - x2 * sin, x2 * cos + x1 * sin], axis=-1).astype(x.dtype)


def causal_dense_attention(q, k, v, scale):
    B, S, H, Dq = q.shape
    nq = S // ATTN_QBLOCK
    qb = q.reshape(B, nq, ATTN_QBLOCK, H, Dq).transpose(1, 0, 2, 3, 4)
    k_pos = jnp.arange(S)

    def step(args):
        qc, i = args
        s = jnp.einsum('bqhd,bkhd->bhqk', qc, k).astype(jnp.float32) * scale
        q_pos = i * ATTN_QBLOCK + jnp.arange(ATTN_QBLOCK)
        s = jnp.where(k_pos[None, :] <= q_pos[:, None], s, -jnp.inf)
        p = jax.nn.softmax(s, axis=-1).astype(v.dtype)
        return jnp.einsum('bhqk,bkhd->bqhd', p, v)

    o = lax.map(step, (qb, jnp.arange(nq)))
    return o.transpose(1, 0, 2, 3, 4).reshape(B, S, H, v.shape[-1])


def mla_attention(h_q, h_kv, h_kr, positions, g_q_a, w_q_b, g_kv_a, w_kv_b):
    B, S, _ = h_q.shape
    q = (rms_norm(h_q, g_q_a) @ w_q_b).reshape(B, S, MLA_HEADS, QK_NOPE + QK_ROPE)
    q = jnp.concatenate([q[..., :QK_NOPE], rope(q[..., QK_NOPE:], positions)], axis=-1)
    kv = (rms_norm(h_kv, g_kv_a) @ w_kv_b).reshape(B, S, MLA_HEADS, QK_NOPE + V_HEAD)
    k_pe = rope(h_kr[:, :, None, :], positions)
    k = jnp.concatenate([kv[..., :QK_NOPE],
                         jnp.broadcast_to(k_pe, (B, S, MLA_HEADS, QK_ROPE))], axis=-1)
    v = kv[..., QK_NOPE:]
    o = causal_dense_attention(q, k, v, (QK_NOPE + QK_ROPE) ** -0.5)
    return o.reshape(B, S, MLA_WIDTH)


def moba_attention(q, k, v):
    B, S, H, D = q.shape
    nb = -(-S // MOBA_BLOCK)
    s_pad = nb * MOBA_BLOCK
    pad = ((0, 0), (0, s_pad - S), (0, 0), (0, 0))
    qp, kp, vp = jnp.pad(q, pad), jnp.pad(k, pad), jnp.pad(v, pad)
    kb = kp.reshape(B, nb, MOBA_BLOCK, H, D).transpose(0, 3, 1, 2, 4)
    vb = vp.reshape(B, nb, MOBA_BLOCK, H, D).transpose(0, 3, 1, 2, 4)
    kbar = jnp.mean(kb.astype(jnp.float32), axis=3)
    gate = jnp.einsum('bshd,bhnd->bshn', qp.astype(jnp.float32), kbar)
    q_blk = jnp.arange(s_pad) // MOBA_BLOCK
    past = jnp.arange(nb)[None, :] < q_blk[:, None]
    gate = jnp.where(past[None, :, None, :], gate, -jnp.inf)
    kt = min(MOBA_TOPK, nb)
    _, sel = lax.top_k(gate, kt)

    nc = s_pad // MOBA_QCHUNK
    qc_all = qp.reshape(B, nc, MOBA_QCHUNK, H, D).transpose(1, 0, 2, 3, 4)
    sel_all = sel.reshape(B, nc, MOBA_QCHUNK, H, kt).transpose(1, 0, 2, 3, 4)
    bi = jnp.arange(B)[:, None, None, None]
    hi = jnp.arange(H)[None, None, :, None]
    scale = D ** -0.5
    chunks_per_block = MOBA_BLOCK // MOBA_QCHUNK

    def step(args):
        qc, ic, c = args
        blk = c // chunks_per_block
        kg = kb[bi, hi, ic]
        vg = vb[bi, hi, ic]
        s_sel = jnp.einsum('bqhd,bqhjkd->bqhjk', qc, kg).astype(jnp.float32) * scale
        valid = jnp.arange(kt) < blk
        s_sel = jnp.where(valid[:, None], s_sel, -jnp.inf)
        k_own = lax.dynamic_index_in_dim(kb, blk, axis=2, keepdims=False)
        v_own = lax.dynamic_index_in_dim(vb, blk, axis=2, keepdims=False)
        s_own = jnp.einsum('bqhd,bhkd->bqhk', qc, k_own).astype(jnp.float32) * scale
        q_pos = c * MOBA_QCHUNK + jnp.arange(MOBA_QCHUNK)
        k_pos = blk * MOBA_BLOCK + jnp.arange(MOBA_BLOCK)
        causal = k_pos[None, :] <= q_pos[:, None]
        s_own = jnp.where(causal[None, :, None, :], s_own, -jnp.inf)
        s = jnp.concatenate([s_sel.reshape(B, MOBA_QCHUNK, H, kt * MOBA_BLOCK), s_own], axis=-1)
        p = jax.nn.softmax(s, axis=-1).astype(v.dtype)
        p_sel = p[..., :kt * MOBA_BLOCK].reshape(B, MOBA_QCHUNK, H, kt, MOBA_BLOCK)
        p_own = p[..., kt * MOBA_BLOCK:]
        return (jnp.einsum('bqhjk,bqhjkd->bqhd', p_sel, vg)
                + jnp.einsum('bqhk,bhkd->bqhd', p_own, v_own))

    o = lax.map(step, (qc_all, sel_all, jnp.arange(nc)))
    o = o.transpose(1, 0, 2, 3, 4).reshape(B, s_pad, H, D)[:, :S]
    return o.reshape(B, S, MOBA_WIDTH)


def moe_ffn(x, w_router, b_router, w_gate_up, b_gate_up, w_down, b_down):
    T, D = x.shape
    logits = x.astype(jnp.float32) @ w_router.astype(jnp.float32) + b_router.astype(jnp.float32)
    top_vals, top_idx = lax.top_k(logits, TOP_K)
    gates = jax.nn.softmax(top_vals, axis=-1)
    n_assign = T * TOP_K
    flat_e = top_idx.reshape(n_assign)
    flat_tok = jnp.repeat(jnp.arange(T, dtype=jnp.int32), TOP_K)
    flat_g = gates.reshape(n_assign)
    order = jnp.argsort(flat_e, stable=True)
    sorted_e = flat_e[order]
    counts = jnp.bincount(flat_e, length=N_EXPERTS)
    padded = (counts + MOE_BLOCK - 1) // MOE_BLOCK * MOE_BLOCK
    pad_end = jnp.cumsum(padded)
    pad_start = pad_end - padded
    start = jnp.cumsum(counts) - counts
    dest = pad_start[sorted_e] + jnp.arange(n_assign) - start[sorted_e]
    n_blocks = -(-n_assign // MOE_BLOCK) + N_EXPERTS
    n_rows = n_blocks * MOE_BLOCK
    row_tok = jnp.full((n_rows,), T, jnp.int32).at[dest].set(flat_tok[order])
    row_gate = jnp.zeros((n_rows,), jnp.float32).at[dest].set(flat_g[order])
    block_e = jnp.minimum(
        jnp.searchsorted(pad_end, jnp.arange(n_blocks) * MOE_BLOCK, side="right"), N_EXPERTS - 1)
    x_pad = jnp.concatenate([x, jnp.zeros((1, D), x.dtype)], axis=0)
    xb = x_pad[row_tok].reshape(n_blocks, MOE_BLOCK, D)

    def expert_block(args):
        xe, e = args
        gu = xe @ w_gate_up[e] + b_gate_up[e]
        g = jnp.minimum(gu[:, :D_FF], SWIGLU_LIMIT)
        u = jnp.clip(gu[:, D_FF:], -SWIGLU_LIMIT, SWIGLU_LIMIT)
        act = (u + 1.0) * (g * jax.nn.sigmoid(g * SWIGLU_ALPHA))
        return act @ w_down[e] + b_down[e]

    y = lax.map(expert_block, (xb, block_e)).reshape(n_rows, D)
    y = (y.astype(jnp.float32) * row_gate[:, None]).astype(x.dtype)
    return jnp.zeros((T + 1, D), x.dtype).at[row_tok].add(y)[:T]


def hybrid_layer(x, positions, w_in, g_q_a, w_q_b, g_kv_a, w_kv_b, g_out_mla, g_out_moba, w_o,
                 ln1_g, ln1_b, w_router, b_router, w_gate_up, b_gate_up, w_down, b_down,
                 ln2_g, ln2_b):
    B, S, D = x.shape
    h = x @ w_in
    o1 = Q_LORA
    o2 = o1 + KV_LORA
    o3 = o2 + QK_ROPE
    o4 = o3 + MOBA_WIDTH
    o5 = o4 + MOBA_WIDTH
    mla = mla_attention(h[..., :o1], h[..., o1:o2], h[..., o2:o3], positions,
                        g_q_a, w_q_b, g_kv_a, w_kv_b)
    mq = rope(h[..., o3:o4].reshape(B, S, MOBA_HEADS, MOBA_HEAD_DIM), positions)
    mk = rope(h[..., o4:o5].reshape(B, S, MOBA_HEADS, MOBA_HEAD_DIM), positions)
    mv = h[..., o5:].reshape(B, S, MOBA_HEADS, MOBA_HEAD_DIM)
    moba = moba_attention(mq, mk, mv)
    mixed = jnp.concatenate([rms_norm(mla, g_out_mla), rms_norm(moba, g_out_moba)], axis=-1) @ w_o
    x1 = layer_norm(DEEPNORM_ALPHA * x + mixed, ln1_g, ln1_b)
    ffn = moe_ffn(x1.reshape(B * S, D), w_router, b_router, w_gate_up, b_gate_up,
                  w_down, b_down).reshape(B, S, D)
    return layer_norm(DEEPNORM_ALPHA * x1 + ffn, ln2_g, ln2_b)


def setup_inputs(seed: int = 0) -> dict:
    key = jax.random.key(seed)
    ks = jax.random.split(key, 21)
    f32 = jnp.float32
    L = DEPTH

    def nrm(k, shape, scale):
        return jax.random.normal(k, shape, f32) * scale

    return {
        "x": jax.random.normal(ks[0], (BATCH, SEQ, D_MODEL), f32),
        "positions": jnp.broadcast_to(jnp.arange(SEQ, dtype=jnp.int32), (BATCH, SEQ)),
        "w_in": nrm(ks[1], (L, D_MODEL, IN_COLS), D_MODEL ** -0.5),
        "g_q_a": 1.0 + nrm(ks[2], (L, Q_LORA), 0.01),
        "w_q_b": nrm(ks[3], (L, Q_LORA, MLA_HEADS * (QK_NOPE + QK_ROPE)), Q_LORA ** -0.5),
        "g_kv_a": 1.0 + nrm(ks[4], (L, KV_LORA), 0.01),
        "w_kv_b": nrm(ks[5], (L, KV_LORA, MLA_HEADS * (QK_NOPE + V_HEAD)), KV_LORA ** -0.5),
        "g_out_mla": 1.0 + nrm(ks[6], (L, MLA_WIDTH), 0.01),
        "g_out_moba": 1.0 + nrm(ks[7], (L, MOBA_WIDTH), 0.01),
        "w_o": nrm(ks[8], (L, MIX_WIDTH, D_MODEL), DEEPNORM_BETA * MIX_WIDTH ** -0.5),
        "ln1_g": 1.0 + nrm(ks[9], (L, D_MODEL), 0.01),
        "ln1_b": nrm(ks[10], (L, D_MODEL), 0.01),
        "w_router": nrm(ks[11], (L, D_MODEL, N_EXPERTS), D_MODEL ** -0.5),
        "b_router": nrm(ks[12], (L, N_EXPERTS), 0.01),
        "w_gate_up": nrm(ks[13], (L, N_EXPERTS, D_MODEL, 2 * D_FF), D_MODEL ** -0.5),
        "b_gate_up": nrm(ks[14], (L, N_EXPERTS, 2 * D_FF), 0.01),
        "w_down": nrm(ks[15], (L, N_EXPERTS, D_FF, D_MODEL), DEEPNORM_BETA * D_FF ** -0.5),
        "b_down": nrm(ks[16], (L, N_EXPERTS, D_MODEL), 0.01),
        "ln2_g": 1.0 + nrm(ks[17], (L, D_MODEL), 0.01),
        "ln2_b": nrm(ks[18], (L, D_MODEL), 0.01),
    }


def reference(x, positions, w_in, g_q_a, w_q_b, g_kv_a, w_kv_b, g_out_mla, g_out_moba, w_o,
              ln1_g, ln1_b, w_router, b_router, w_gate_up, b_gate_up, w_down, b_down,
              ln2_g, ln2_b):
    h = x
    for l in range(DEPTH):
        h = hybrid_layer(h, positions, w_in[l], g_q_a[l], w_q_b[l], g_kv_a[l], w_kv_b[l],
                         g_out_mla[l], g_out_moba[l], w_o[l], ln1_g[l], ln1_b[l],
                         w_router[l], b_router[l], w_gate_up[l], b_gate_up[l],
                         w_down[l], b_down[l], ln2_g[l], ln2_b[l])
    return h
```

```cpp
#include <hip/hip_runtime.h>
#include <cstdio>
#include <cstdint>

#ifndef MK_N_LAUNCHES
#define MK_N_LAUNCHES 1
#endif

constexpr int T = 8192, DM = 2048, NH = 8;
constexpr int QLORA = 512, KVLORA = 256, ROPE = 64, NOPE = 128, VH = 128, QKH = NOPE + ROPE;
constexpr int MW = 1024;
constexpr int INC = 3904, INP = 4096;
constexpr int NE = 32, TOPK = 4, DFF = 2048;
constexpr int MAXROWS = T * TOPK + NE * 256;
constexpr int MAXRT = MAXROWS / 256;
constexpr float ALPHA = 1.189207115002721f;
constexpr float RMS_EPS = 1e-6f, LN_EPS = 1e-5f;

#define GAS __attribute__((address_space(1)))
#define LAS __attribute__((address_space(3)))
typedef unsigned short bf16;
typedef unsigned v4u __attribute__((ext_vector_type(4)));
typedef unsigned v2u __attribute__((ext_vector_type(2)));
typedef float f32x4 __attribute__((ext_vector_type(4)));
typedef float f32x2 __attribute__((ext_vector_type(2)));
typedef float f32x16 __attribute__((ext_vector_type(16)));
typedef short bf16x8 __attribute__((ext_vector_type(8)));
typedef short s16x4 __attribute__((ext_vector_type(4)));
typedef GAS unsigned gu32;
#define RLX_AGENT __ATOMIC_RELAXED, __HIP_MEMORY_SCOPE_AGENT
#define LDS_WAIT() asm volatile("s_waitcnt lgkmcnt(0)" ::: "memory")
#define VM_WAIT() asm volatile("s_waitcnt vmcnt(0)" ::: "memory")
#define SBAR() __builtin_amdgcn_sched_barrier(0)

__device__ __forceinline__ unsigned cvt_pk_bf16(float lo, float hi) { unsigned r; asm volatile("v_cvt_pk_bf16_f32 %0, %1, %2" : "=v"(r) : "v"(lo), "v"(hi)); return r; }
__device__ __forceinline__ float bf2f(unsigned short b) { return __uint_as_float(((unsigned)b) << 16); }
__device__ __forceinline__ float bflo(unsigned w) { return __uint_as_float(w << 16); }
__device__ __forceinline__ float bfhi(unsigned w) { return __uint_as_float(w & 0xffff0000u); }
__device__ __forceinline__ unsigned short f2bf(float f) { return (unsigned short)(cvt_pk_bf16(f, f) & 0xffffu); }
__device__ __forceinline__ float wave_sum(float v) {
#pragma unroll
    for (int o = 1; o < 64; o <<= 1) v += __shfl_xor(v, o);
    return v;
}

constexpr size_t MiB = 1u << 20;
constexpr size_t WS_CTL = 0, CTL_ZERO_BYTES = 1 * MiB;
constexpr size_t WS_XB    = 2 * MiB;
constexpr size_t WS_WIN   = WS_XB + 32 * MiB;
constexpr size_t WS_WQB   = WS_WIN + 16 * MiB;
constexpr size_t WS_WKVB  = WS_WQB + 2 * MiB;
constexpr size_t WS_WO    = WS_WKVB + 1 * MiB;
constexpr size_t WS_C128  = WS_WO + 8 * MiB;
constexpr size_t WS_S128  = WS_C128 + 2 * MiB;
constexpr size_t WS_C64   = WS_S128 + 2 * MiB;
constexpr size_t WS_S64   = WS_C64 + 1 * MiB;
constexpr size_t WS_HQ    = WS_S64 + 1 * MiB;
constexpr size_t WS_HKV   = WS_HQ + 8 * MiB;
constexpr size_t WS_HR    = WS_HKV + 4 * MiB;
constexpr size_t WS_KPE   = WS_HR + 4 * MiB;
constexpr size_t WS_MQ    = WS_KPE + 1 * MiB;
constexpr size_t WS_MK    = WS_MQ + 16 * MiB;
constexpr size_t WS_MV    = WS_MK + 16 * MiB;
constexpr size_t WS_RSQ   = WS_MV + 16 * MiB;
constexpr size_t WS_RSKV  = WS_RSQ + 1 * MiB;
constexpr size_t WS_QM    = WS_RSKV + 1 * MiB;
constexpr size_t WS_KVM   = WS_QM + 24 * MiB;
constexpr size_t WS_KBAR  = WS_KVM + 32 * MiB;
constexpr size_t WS_SEL   = WS_KBAR + 1 * MiB;
constexpr size_t WS_OMIX  = WS_SEL + 1 * MiB;
constexpr size_t WS_X1P   = WS_OMIX + 32 * MiB;
constexpr size_t WS_X1N   = WS_X1P + 64 * MiB;
constexpr size_t WS_X1B   = WS_X1N + 64 * MiB;
constexpr size_t WS_TOPE  = WS_X1B + 32 * MiB;
constexpr size_t WS_TOPR  = WS_TOPE + 1 * MiB;
constexpr size_t WS_TOPG  = WS_TOPR + 1 * MiB;
constexpr size_t WS_TOPROW= WS_TOPG + 1 * MiB;
constexpr size_t WS_RGATE = WS_TOPROW + 1 * MiB;
constexpr size_t WS_XG    = WS_RGATE + 1 * MiB;
constexpr size_t WS_ACT   = WS_XG + 160 * MiB;
constexpr size_t WS_WGU   = WS_ACT + 160 * MiB;
constexpr size_t WS_WD    = WS_WGU + 512 * MiB;
constexpr size_t WS_END   = WS_WD + 256 * MiB;
constexpr int CW_BAR = 4096;
constexpr int CW_COUNT = 16384;
constexpr int CW_TILEE = 16384 + 64;
constexpr int CW_NRT = 16384 + 64 + 192;

constexpr int LDS_BYTES = 159744;
constexpr int LDSCTL_OFF = 158720;

namespace pg8 {
constexpr int BM = 256, BK = 64, HALF = 128, HTB = HALF * BK * 2, STAGE_BYTES = 8 * HTB, NXCD = 8, WGM = 8;
__host__ __device__ __forceinline__ int lds_byte(int r, int c) { const int st = (r >> 4) * 2 + (c >> 5), rr = r & 15, cc = c & 31, ob = rr * 64 + cc * 2; return st * 1024 + (ob ^ (((ob >> 9) & 1) << 5)); }
__host__ __device__ __forceinline__ void stage_rc(int b, int& R, int& C) { const int st = b / 1024, sb = b % 1024, swz = sb ^ (((sb >> 9) & 1) << 5); R = (st >> 1) * 16 + swz / 64; C = (st & 1) * 32 + (swz % 64) / 2; }
__host__ __device__ __forceinline__ int perm32(int rho) { const int n = rho >> 4, i = rho & 15; return 8 * (i >> 2) + 4 * n + (i & 3); }

struct Unit { int pm, pn, e; };
struct Gemm { const bf16* A; const bf16* Bt; int K, lda, ldb; size_t bes; };

struct StaticOrder {
    int nM, nN, nwg, G, c;
    __device__ void init(int M, int N, int G_, int c_) { nM = M / BM; nN = N / BM; nwg = nM * nN; G = G_; c = c_; }
    __device__ bool next(int i, Unit& u) const {
        const long L = (long)i * G + c; if (L >= nwg) return false;
        int wgid = (int)L; { const int q = nwg / NXCD, r = nwg % NXCD, xcd = wgid % NXCD, off = wgid / NXCD; wgid = (xcd < r ? xcd * (q + 1) : r * (q + 1) + (xcd - r) * q) + off; }
        const int nig = WGM * nN, gid = wgid / nig, fm = gid * WGM, gsz = (nM - fm) < WGM ? (nM - fm) : WGM;
        u.pm = fm + ((wgid % nig) % gsz); u.pn = (wgid % nig) / gsz; u.e = 0; return true;
    }
};
struct MoeOrder {
    const unsigned* tile_e; int n_rt, npn, G, c;
    __device__ bool next(int i, Unit& u) const {
        const long L = (long)i * G + c; if (L >= (long)n_rt * npn) return false;
        const int rt = (int)(L / npn); u.pm = rt; u.pn = (int)(L - (long)rt * npn);
        u.e = (int)__builtin_amdgcn_readfirstlane((int)__hip_atomic_load(tile_e + rt, RLX_AGENT)); return true;
    }
};

typedef f32x4 Acc[2][2][4][2];

struct EpiInProj {
    static constexpr bool PERM = true;
    unsigned char* ws;
    __device__ __forceinline__ void operator()(const Acc& acc, const Unit& u, int wr, int wc, int fr, int fq) const {
        const int pn = u.pn; size_t off; int ldc, colt;
        if (pn < 4) { off = WS_HQ + (size_t)(pn >> 1) * (8u << 20) + (size_t)(pn == 3 ? 1 : 0) * (4u << 20); ldc = 512 - (pn >> 1) * 256; colt = (pn >> 1) ? 0 : pn * 256; }
        else { off = WS_MQ + (size_t)((pn - 4) >> 2) * (16u << 20); ldc = 1024; colt = ((pn - 4) & 3) * 256; }
        bf16* base = (bf16*)(ws + off);
        const int row0 = u.pm * BM + wr * 64 + fr, col0 = colt + wc * 32 + 8 * fq;
#pragma unroll
        for (int ai = 0; ai < 2; ++ai)
#pragma unroll
            for (int m = 0; m < 4; ++m) { bf16* rowp = base + (size_t)(row0 + ai * HALF + m * 16) * ldc + col0;
#pragma unroll
                for (int bj = 0; bj < 2; ++bj) { const f32x4 v0 = acc[ai][bj][m][0], v1 = acc[ai][bj][m][1];
                    v4u w; w.x = cvt_pk_bf16(v0[0], v0[1]); w.y = cvt_pk_bf16(v0[2], v0[3]); w.z = cvt_pk_bf16(v1[0], v1[1]); w.w = cvt_pk_bf16(v1[2], v1[3]);
                    *(v4u*)(rowp + bj * HALF) = w; } }
    }
};
struct EpiRowScale {
    static constexpr bool PERM = true;
    bf16* O; int ldc; const float* rs;
    __device__ __forceinline__ void operator()(const Acc& acc, const Unit& u, int wr, int wc, int fr, int fq) const {
        const int row0 = u.pm * BM + wr * 64 + fr, col0 = u.pn * BM + wc * 32 + 8 * fq;
#pragma unroll
        for (int ai = 0; ai < 2; ++ai)
#pragma unroll
            for (int m = 0; m < 4; ++m) { const int row = row0 + ai * HALF + m * 16; const float s = rs[row]; bf16* rowp = O + (size_t)row * ldc + col0;
#pragma unroll
                for (int bj = 0; bj < 2; ++bj) { const f32x4 v0 = acc[ai][bj][m][0] * s, v1 = acc[ai][bj][m][1] * s;
                    v4u w; w.x = cvt_pk_bf16(v0[0], v0[1]); w.y = cvt_pk_bf16(v0[2], v0[3]); w.z = cvt_pk_bf16(v1[0], v1[1]); w.w = cvt_pk_bf16(v1[2], v1[3]);
                    *(v4u*)(rowp + bj * HALF) = w; } }
    }
};
struct EpiResF32 {
    static constexpr bool PERM = false;
    const float* X; float* O; int ldc;
    __device__ __forceinline__ void operator()(const Acc& acc, const Unit& u, int wr, int wc, int fr, int fq) const {
        const int row0 = u.pm * BM + wr * 64 + fr, col0 = u.pn * BM + wc * 32 + 4 * fq;
#pragma unroll
        for (int ai = 0; ai < 2; ++ai)
#pragma unroll
            for (int m = 0; m < 4; ++m) { const size_t off = (size_t)(row0 + ai * HALF + m * 16) * ldc + col0;
#pragma unroll
                for (int bj = 0; bj < 2; ++bj)
#pragma unroll
                    for (int n = 0; n < 2; ++n) { const f32x4 xv = *(const f32x4*)(X + off + bj * HALF + n * 16); *(f32x4*)(O + off + bj * HALF + n * 16) = xv * ALPHA + acc[ai][bj][m][n]; }
                asm volatile("" ::: "memory"); }
    }
};
struct EpiSwiglu {
    static constexpr bool PERM = true;
    bf16* ACT; const float* bgu;
    __device__ __forceinline__ void operator()(const Acc& acc, const Unit& u, int wr, int wc, int fr, int fq) const {
        const int row0 = u.pm * BM + wr * 64 + fr, j0 = u.pn * HALF + wc * 32 + 8 * fq;
        const float* bg = bgu + (size_t)u.e * (2 * DFF) + j0; const float* bu = bg + DFF;
        const f32x4 bg0 = *(const f32x4*)bg, bg1 = *(const f32x4*)(bg + 4), bu0 = *(const f32x4*)bu, bu1 = *(const f32x4*)(bu + 4);
#pragma unroll
        for (int ai = 0; ai < 2; ++ai)
#pragma unroll
            for (int m = 0; m < 4; ++m) { bf16* rowp = ACT + (size_t)(row0 + ai * HALF + m * 16) * DFF + j0;
                float a[8];
#pragma unroll
                for (int n = 0; n < 2; ++n) { const f32x4 gv = acc[ai][0][m][n] + (n ? bg1 : bg0), uv = acc[ai][1][m][n] + (n ? bu1 : bu0);
#pragma unroll
                    for (int j = 0; j < 4; ++j) { const float g = fminf(gv[j], 7.0f), uu = fminf(fmaxf(uv[j], -7.0f), 7.0f);
                        const float sg = __builtin_amdgcn_rcpf(1.0f + __builtin_amdgcn_exp2f(g * (-1.702f * 1.4426950408889634f)));
                        a[n * 4 + j] = (uu + 1.0f) * g * sg; } }
                v4u w; w.x = cvt_pk_bf16(a[0], a[1]); w.y = cvt_pk_bf16(a[2], a[3]); w.z = cvt_pk_bf16(a[4], a[5]); w.w = cvt_pk_bf16(a[6], a[7]);
                *(v4u*)rowp = w; }
    }
};
struct EpiDown {
    static constexpr bool PERM = true;
    bf16* Y; const float* bd; const float* rgate;
    __device__ __forceinline__ void operator()(const Acc& acc, const Unit& u, int wr, int wc, int fr, int fq) const {
        const int row0 = u.pm * BM + wr * 64 + fr, col0 = u.pn * BM + wc * 32 + 8 * fq;
        const float* bp = bd + (size_t)u.e * DM + col0;
        f32x4 bv[2][2];
#pragma unroll
        for (int bj = 0; bj < 2; ++bj)
#pragma unroll
            for (int n = 0; n < 2; ++n) bv[bj][n] = *(const f32x4*)(bp + bj * HALF + 4 * n);
#pragma unroll
        for (int ai = 0; ai < 2; ++ai)
#pragma unroll
            for (int m = 0; m < 4; ++m) { const int row = row0 + ai * HALF + m * 16; const float s = rgate[row]; bf16* rowp = Y + (size_t)row * DM + col0;
#pragma unroll
                for (int bj = 0; bj < 2; ++bj) { const f32x4 v0 = (acc[ai][bj][m][0] + bv[bj][0]) * s, v1 = (acc[ai][bj][m][1] + bv[bj][1]) * s;
                    v4u w; w.x = cvt_pk_bf16(v0[0], v0[1]); w.y = cvt_pk_bf16(v0[2], v0[3]); w.z = cvt_pk_bf16(v1[0], v1[1]); w.w = cvt_pk_bf16(v1[2], v1[3]);
                    *(v4u*)(rowp + bj * HALF) = w; } }
    }
};

template <class Epi, class Sched, bool ALIGN_EPI = true, bool SP2 = true>
__device__ __forceinline__ void gemm_phase(LAS unsigned char* lds, const Gemm g, const Sched& S, const Epi& E) {
    const int tid = threadIdx.x, wid = __builtin_amdgcn_readfirstlane(tid >> 6), lane = tid & 63, wr = wid >> 2, wc = wid & 3, fr = lane & 15, fq = lane >> 4;
    const int K = g.K, nt = K / BK;
    unsigned voffA[2], voffB[2];
#pragma unroll
    for (int i = 0; i < 2; ++i) { int R, C; stage_rc(tid * 16 + i * 8192, R, C); const int Rb = Epi::PERM ? ((R & ~31) + perm32(R & 31)) : R;
        voffA[i] = (unsigned)(R * g.lda + C) * 2u; voffB[i] = (unsigned)(Rb * g.ldb + C) * 2u; }
    const size_t kstep = (size_t)(BK * 2);
    const size_t hstepA = (size_t)HALF * g.lda * 2, hstepB = (size_t)HALF * g.ldb * 2;
    const size_t tstepA = 2 * hstepA, tstepB = 2 * hstepB;
    const unsigned ldsw = (unsigned)wid * 1024u;
    const int aoff = lds_byte(wr * 64 + fr, fq * 8), boff = lds_byte(wc * 32 + fr, fq * 8);
#define PG8_SA(b, h) (((b) * 2 + (h)) * HTB)
#define PG8_SB(b, h) ((4 + (b) * 2 + (h)) * HTB)
#define PG8_STAGE(bufoff, gbase, voff) do { _Pragma("unroll") for (int _i = 0; _i < 2; ++_i) \
        __builtin_amdgcn_global_load_lds((const unsigned*)((const char*)(gbase) + (voff)[_i]), (LAS unsigned*)(lds + (bufoff) + ldsw + _i * 8192), 16, 0, 0); } while (0)
#define PG8_LDA(dst, b, h) do { _Pragma("unroll") for (int m = 0; m < 4; ++m) _Pragma("unroll") for (int k = 0; k < 2; ++k) dst[m][k] = *(const LAS bf16x8*)(lds + PG8_SA(b, h) + aoff + m * 2048 + k * 1024); } while (0)
#define PG8_LDB(dst, b, h) do { _Pragma("unroll") for (int n = 0; n < 2; ++n) _Pragma("unroll") for (int k = 0; k < 2; ++k) dst[n][k] = *(const LAS bf16x8*)(lds + PG8_SB(b, h) + boff + n * 2048 + k * 1024); } while (0)
#define PG8_MMA(ai, bj, At, Bt) do { __builtin_amdgcn_s_setprio(1); _Pragma("unroll") for (int m = 0; m < 4; ++m) _Pragma("unroll") for (int n = 0; n < 2; ++n) _Pragma("unroll") for (int k = 0; k < 2; ++k) \
        acc[ai][bj][m][n] = __builtin_amdgcn_mfma_f32_16x16x32_bf16(Bt[n][k], At[m][k], acc[ai][bj][m][n], 0, 0, 0); __builtin_amdgcn_s_setprio(0); } while (0)
#define PG8_WAIT_V(n) asm volatile("s_waitcnt vmcnt(" #n ")" ::: "memory")
#define PG8_WAIT_L(n) asm volatile("s_waitcnt lgkmcnt(" #n ")" ::: "memory")
#define PG8_BAR __builtin_amdgcn_s_barrier()
#define PG8_SCHED __builtin_amdgcn_sched_barrier(0)
    Unit cur, nxt; int ui = 0;
    if (!S.next(0, cur)) return;
    Acc acc;
#pragma unroll
    for (int a = 0; a < 2; ++a)
#pragma unroll
        for (int b = 0; b < 2; ++b)
#pragma unroll
            for (int m = 0; m < 4; ++m)
#pragma unroll
                for (int n = 0; n < 2; ++n) acc[a][b][m][n] = (f32x4){0.f, 0.f, 0.f, 0.f};
    bf16x8 At[4][2], B0[2][2], B1[2][2];
    const char* cA = (const char*)g.A + (size_t)cur.pm * tstepA; const char* cB = (const char*)g.Bt + (size_t)cur.e * g.bes + (size_t)cur.pn * tstepB;
    if constexpr (SP2) {
        PG8_STAGE(PG8_SB(0, 0), cB, voffB); PG8_STAGE(PG8_SB(0, 1), cB + hstepB, voffB); PG8_STAGE(PG8_SA(0, 0), cA, voffA); PG8_STAGE(PG8_SA(0, 1), cA + hstepA, voffA);
        if (wr == 1) PG8_BAR;
        PG8_WAIT_V(2); PG8_BAR;
        PG8_STAGE(PG8_SB(1, 0), cB + kstep, voffB); PG8_STAGE(PG8_SA(1, 0), cA + kstep, voffA); PG8_STAGE(PG8_SB(1, 1), cB + hstepB + kstep, voffB);
        PG8_WAIT_V(6); PG8_BAR;
    } else {
        PG8_STAGE(PG8_SB(0, 0), cB, voffB); PG8_STAGE(PG8_SA(0, 0), cA, voffA); PG8_STAGE(PG8_SB(0, 1), cB + hstepB, voffB); PG8_STAGE(PG8_SA(0, 1), cA + hstepA, voffA);
        if (wr == 1) PG8_BAR;
        PG8_WAIT_V(4); PG8_BAR;
        PG8_STAGE(PG8_SB(1, 0), cB + kstep, voffB); PG8_STAGE(PG8_SA(1, 0), cA + kstep, voffA); PG8_STAGE(PG8_SB(1, 1), cB + hstepB + kstep, voffB);
        PG8_WAIT_V(6); PG8_BAR;
    }
    for (;;) {
        const bool has_next = S.next(ui + 1, nxt);
        const char* nA = has_next ? (const char*)g.A + (size_t)nxt.pm * tstepA : cA; const char* nB = has_next ? (const char*)g.Bt + (size_t)nxt.e * g.bes + (size_t)nxt.pn * tstepB : cB;
        for (int t = 0; t < nt; t += 2) {
            const bool last = (t == nt - 2);
            const char* a1 = cA + (size_t)(t + 1) * kstep;
            const char* a2 = last ? nA : cA + (size_t)(t + 2) * kstep; const char* b2 = last ? nB : cB + (size_t)(t + 2) * kstep;
            const char* a3 = a2 + kstep; const char* b3 = b2 + kstep;
            if constexpr (SP2) {
            PG8_LDB(B0, 0, 0); PG8_LDB(B1, 0, 1); PG8_SCHED; PG8_LDA(At, 0, 0); PG8_STAGE(PG8_SA(1, 1), a1 + hstepA, voffA);
            PG8_WAIT_V(8); PG8_WAIT_L(0); PG8_BAR; PG8_MMA(0, 0, At, B0); PG8_MMA(0, 1, At, B1); PG8_BAR; PG8_SCHED;
            PG8_LDA(At, 0, 1); PG8_STAGE(PG8_SB(0, 0), b2, voffB); PG8_STAGE(PG8_SB(0, 1), b2 + hstepB, voffB); PG8_STAGE(PG8_SA(0, 0), a2, voffA);
            PG8_WAIT_V(8); PG8_WAIT_L(0); PG8_BAR; PG8_MMA(1, 0, At, B0); PG8_MMA(1, 1, At, B1); PG8_BAR; PG8_SCHED;
            PG8_LDB(B0, 1, 0); PG8_LDB(B1, 1, 1); PG8_SCHED; PG8_LDA(At, 1, 0); PG8_STAGE(PG8_SA(0, 1), a2 + hstepA, voffA);
            PG8_WAIT_V(8); PG8_WAIT_L(0); PG8_BAR; PG8_MMA(0, 0, At, B0); PG8_MMA(0, 1, At, B1); PG8_BAR; PG8_SCHED;
            PG8_LDA(At, 1, 1); PG8_STAGE(PG8_SB(1, 0), b3, voffB); PG8_STAGE(PG8_SB(1, 1), b3 + hstepB, voffB); PG8_STAGE(PG8_SA(1, 0), a3, voffA);
            PG8_WAIT_V(8); PG8_WAIT_L(0); PG8_BAR; PG8_MMA(1, 0, At, B0); PG8_MMA(1, 1, At, B1); PG8_BAR; PG8_SCHED;
            } else {
            PG8_LDB(B0, 0, 0); PG8_SCHED; PG8_LDA(At, 0, 0); PG8_STAGE(PG8_SA(1, 1), a1 + hstepA, voffA);
            PG8_WAIT_L(8); PG8_BAR; PG8_WAIT_L(0); PG8_MMA(0, 0, At, B0); PG8_BAR; PG8_SCHED;
            PG8_LDB(B1, 0, 1); PG8_STAGE(PG8_SB(0, 0), b2, voffB);
            PG8_BAR; PG8_WAIT_L(0); PG8_MMA(0, 1, At, B1); PG8_BAR;
            PG8_LDA(At, 0, 1); PG8_STAGE(PG8_SA(0, 0), a2, voffA);
            PG8_BAR; PG8_WAIT_L(0); PG8_MMA(1, 0, At, B0); PG8_BAR; PG8_SCHED;
            PG8_STAGE(PG8_SB(0, 1), b2 + hstepB, voffB);
            PG8_WAIT_V(6); PG8_BAR; PG8_MMA(1, 1, At, B1); PG8_BAR;
            PG8_LDB(B0, 1, 0); PG8_SCHED; PG8_LDA(At, 1, 0); PG8_STAGE(PG8_SA(0, 1), a2 + hstepA, voffA);
            PG8_WAIT_L(8); PG8_BAR; PG8_WAIT_L(0); PG8_MMA(0, 0, At, B0); PG8_BAR; PG8_SCHED;
            PG8_LDB(B1, 1, 1); PG8_STAGE(PG8_SB(1, 0), b3, voffB);
            PG8_BAR; PG8_WAIT_L(0); PG8_MMA(0, 1, At, B1); PG8_BAR;
            PG8_LDA(At, 1, 1); PG8_STAGE(PG8_SA(1, 0), a3, voffA);
            PG8_BAR; PG8_WAIT_L(0); PG8_MMA(1, 0, At, B0); PG8_BAR; PG8_SCHED;
            PG8_STAGE(PG8_SB(1, 1), b3 + hstepB, voffB);
            PG8_WAIT_V(6); PG8_BAR; PG8_MMA(1, 1, At, B1); PG8_BAR;
            }
        }
        if constexpr (ALIGN_EPI) { if (wr == 0) PG8_BAR; }
        E(acc, cur, wr, wc, fr, fq);
        if (!has_next) break;
#pragma unroll
        for (int a = 0; a < 2; ++a)
#pragma unroll
            for (int b = 0; b < 2; ++b)
#pragma unroll
                for (int m = 0; m < 4; ++m)
#pragma unroll
                    for (int n = 0; n < 2; ++n) acc[a][b][m][n] = (f32x4){0.f, 0.f, 0.f, 0.f};
        cur = nxt; cA = nA; cB = nB; ++ui;
        if constexpr (ALIGN_EPI) { if (wr == 1) PG8_BAR; }
    }
    PG8_WAIT_V(0);
    if constexpr (!ALIGN_EPI) { if (wr == 0) PG8_BAR; }
    PG8_BAR;
#undef PG8_SA
#undef PG8_SB
#undef PG8_STAGE
#undef PG8_LDA
#undef PG8_LDB
#undef PG8_MMA
#undef PG8_WAIT_V
#undef PG8_WAIT_L
#undef PG8_BAR
#undef PG8_SCHED
}
}

namespace at {
constexpr int SHM_V = 16384, SHM_K = 16384, SHM_K2 = 8192;
constexpr int OFF_V = 0, OFF_K = 2 * SHM_V, OFF_K2 = OFF_K + 2 * SHM_K, OFF_WS = OFF_K2 + 2 * SHM_K2, ATTN_LDS = OFF_WS + 8 * 64 * 4;
#define KSWZ(row, colB) ((row) * 256 + ((colB) ^ (((row) & 7) << 4)))
#define K2SWZ(row, colB) ((row) * 128 + ((colB) ^ ((((row) >> 1) & 7) << 4)))
__device__ __forceinline__ int v_st(int k, int c) { const int kk = (k & ~0xC) | ((k & 4) << 1) | ((k & 8) >> 1); return ((kk >> 3) * 4 + (c >> 5)) * 512 + ((kk & 7) * 32 + (c & 31)) * 2; }
__device__ __forceinline__ int v_rd_base(int lane) { return ((lane & 3) << 3) | (((lane >> 2) & 3) << 6) | (((lane >> 4) & 1) << 5) | (((lane >> 5) & 1) << 8); }
constexpr int v_rd_off(int d0, int ks, int half) { return d0 * 512 + ks * 4096 + half * 2048; }
__device__ __forceinline__ int crow(int r, int hi) { return (r & 3) + 8 * (r >> 2) + 4 * hi; }

template <int VB>
__device__ __forceinline__ void pv_tile(f32x16* o, int vb0, bf16x8 pa0, bf16x8 pa1, bf16x8 pa2, bf16x8 pa3) {
#define TRRD(dst, off) asm volatile("ds_read_b64_tr_b16 %0, %1 offset:%2" : "=&v"(dst) : "v"(vb0), "i"(off) : "memory")
#define PV_D0(d0) do { s16x4 l0, l1, l2, l3, h0, h1, h2, h3; constexpr int b_ = VB * SHM_V + v_rd_off(d0, 0, 0); \
        TRRD(l0, b_); TRRD(h0, b_ + 2048); TRRD(l1, b_ + 4096); TRRD(h1, b_ + 6144); TRRD(l2, b_ + 8192); TRRD(h2, b_ + 10240); TRRD(l3, b_ + 12288); TRRD(h3, b_ + 14336); \
        asm volatile("s_waitcnt lgkmcnt(0)" ::: "memory"); SBAR(); \
        o[d0] = __builtin_amdgcn_mfma_f32_32x32x16_bf16(pa0, (bf16x8){l0[0], l0[1], l0[2], l0[3], h0[0], h0[1], h0[2], h0[3]}, o[d0], 0, 0, 0); \
        o[d0] = __builtin_amdgcn_mfma_f32_32x32x16_bf16(pa1, (bf16x8){l1[0], l1[1], l1[2], l1[3], h1[0], h1[1], h1[2], h1[3]}, o[d0], 0, 0, 0); \
        o[d0] = __builtin_amdgcn_mfma_f32_32x32x16_bf16(pa2, (bf16x8){l2[0], l2[1], l2[2], l2[3], h2[0], h2[1], h2[2], h2[3]}, o[d0], 0, 0, 0); \
        o[d0] = __builtin_amdgcn_mfma_f32_32x32x16_bf16(pa3, (bf16x8){l3[0], l3[1], l3[2], l3[3], h3[0], h3[1], h3[2], h3[3]}, o[d0], 0, 0, 0); } while (0)
    PV_D0(0); PV_D0(1); PV_D0(2); PV_D0(3);
#undef PV_D0
#undef TRRD
}

struct St { bf16x8 k0, k1, v0, v1, k2; };

template <bool MLA>
__device__ __forceinline__ void attn_unit(const bf16* Qp, int ldq, const bf16* Kp, const bf16* Vp, int ldk, const bf16* K2p, bf16* Op, int ldo, int qb, const unsigned* selp, char* lds) {
    constexpr float SCALE = MLA ? 0.07216878364870322f : 0.08838834764831845f;
    constexpr float C2 = 1.4426950408889634f * SCALE, THR = 8.f;
    const int tid = threadIdx.x, wid = __builtin_amdgcn_readfirstlane(tid >> 6), lane = tid & 63, r32 = lane & 31, hi = lane >> 5;
    const int q0 = qb * 256, qlo = q0 + wid * 32, qrow = qlo + r32, qm = qrow - 4 * hi;
    char* V_lds = lds + OFF_V; char* K_lds = lds + OFF_K; char* K2_lds = lds + OFF_K2;
    float* ws = (float*)(lds + OFF_WS) + wid * 64; float* li_l = ws; float* al_l = ws + 32;
    bf16x8 qr[8], qr2[4];
    { const bf16* Qw = Qp + (size_t)qrow * ldq + hi * 8;
#pragma unroll
      for (int d0 = 0; d0 < 8; ++d0) qr[d0] = *(const bf16x8*)(Qw + d0 * 16);
      if constexpr (MLA) {
#pragma unroll
          for (int d0 = 0; d0 < 4; ++d0) qr2[d0] = *(const bf16x8*)(Qw + 128 + d0 * 16); } }
    unsigned sel = 0u; if constexpr (!MLA) sel = selp[(size_t)qrow * NH];
    const int sr = tid >> 4, sc = (tid & 15) * 8, vst0 = v_st(sr, sc), vst1 = v_st(32 + sr, sc), kws = KSWZ(sr, sc * 2);
    const int k2r = tid >> 3, k2c = (tid & 7) * 8, k2ws = K2SWZ(k2r, k2c * 2);
    const int vb0 = (int)(uintptr_t)V_lds + v_rd_base(lane);
    float m_reg = -1e30f, l_reg = 0.f; f32x16 o[4];
#pragma unroll
    for (int d = 0; d < 4; ++d) o[d] = f32x16{};
    St S;
#define SLOAD(k0_) do { S.v0 = *(const bf16x8*)(Vp + (size_t)((k0_) + sr) * ldk + sc); S.v1 = *(const bf16x8*)(Vp + (size_t)((k0_) + 32 + sr) * ldk + sc); \
        S.k0 = *(const bf16x8*)(Kp + (size_t)((k0_) + sr) * ldk + sc); S.k1 = *(const bf16x8*)(Kp + (size_t)((k0_) + 32 + sr) * ldk + sc); \
        if constexpr (MLA) S.k2 = *(const bf16x8*)(K2p + (size_t)((k0_) + k2r) * ROPE + k2c); } while (0)
#define SWRITE(bf) do { *(bf16x8*)(V_lds + (bf) * SHM_V + vst0) = S.v0; *(bf16x8*)(V_lds + (bf) * SHM_V + vst1) = S.v1; \
        *(bf16x8*)(K_lds + (bf) * SHM_K + kws) = S.k0; *(bf16x8*)(K_lds + (bf) * SHM_K + kws + 32 * 256) = S.k1; \
        if constexpr (MLA) *(bf16x8*)(K2_lds + (bf) * SHM_K2 + k2ws) = S.k2; } while (0)
    const int NT = 4 * (qb + 1);
    SLOAD(0); VM_WAIT(); SWRITE(0); __syncthreads();
#define TILE_STEP(BF, t_) do { const int t = (t_); const int kb = t * 64; \
        if (t + 1 < NT) SLOAD(kb + 64); \
        bool act = kb <= qlo + 31; const int jblk = t >> 2; \
        if constexpr (!MLA) { if (jblk < qb) act = __any((int)((sel >> jblk) & 1u)) != 0; } \
        if (act) { \
            f32x16 p0 = f32x16{}, p1 = f32x16{}; \
            { const char* kbs[4]; _Pragma("unroll") for (int dd = 0; dd < 4; ++dd) kbs[dd] = K_lds + (BF) * SHM_K + KSWZ(r32, (dd * 16 + hi * 8) * 2); \
              _Pragma("unroll") for (int d0 = 0; d0 < 8; ++d0) { const char* a = kbs[d0 & 3] + (d0 >> 2) * 128; \
                const bf16x8 b0 = *(const bf16x8*)a; const bf16x8 b1 = *(const bf16x8*)(a + 32 * 256); \
                p0 = __builtin_amdgcn_mfma_f32_32x32x16_bf16(b0, qr[d0], p0, 0, 0, 0); p1 = __builtin_amdgcn_mfma_f32_32x32x16_bf16(b1, qr[d0], p1, 0, 0, 0); } } \
            if constexpr (MLA) { _Pragma("unroll") for (int d0 = 0; d0 < 4; ++d0) { const char* a = K2_lds + (BF) * SHM_K2 + K2SWZ(r32, (d0 * 16 + hi * 8) * 2); \
                const bf16x8 b0 = *(const bf16x8*)a; const bf16x8 b1 = *(const bf16x8*)(a + 32 * 128); \
                p0 = __builtin_amdgcn_mfma_f32_32x32x16_bf16(b0, qr2[d0], p0, 0, 0, 0); p1 = __builtin_amdgcn_mfma_f32_32x32x16_bf16(b1, qr2[d0], p1, 0, 0, 0); } } \
            const float NEG = -__builtin_inff(); \
            if (kb + 63 > qlo) { const int dq = qm - kb; \
                _Pragma("unroll") for (int r = 0; r < 16; ++r) { const int c = (r & 3) + 8 * (r >> 2); if (dq - c < 0) p0[r] = NEG; if (dq - c - 32 < 0) p1[r] = NEG; } } \
            if constexpr (!MLA) { if (jblk < qb) { if (((sel >> jblk) & 1u) == 0u) { _Pragma("unroll") for (int r = 0; r < 16; ++r) { p0[r] = NEG; p1[r] = NEG; } } } } \
            float pmax = p0[0]; _Pragma("unroll") for (int r = 1; r < 16; ++r) pmax = fmaxf(pmax, p0[r]); _Pragma("unroll") for (int r = 0; r < 16; ++r) pmax = fmaxf(pmax, p1[r]); \
            { auto rr = __builtin_amdgcn_permlane32_swap(__float_as_uint(pmax), __float_as_uint(pmax), false, false); pmax = fmaxf(__uint_as_float(rr[0]), __uint_as_float(rr[1])); } \
            float mn, alpha; \
            if (__builtin_expect(__all((pmax - m_reg) * SCALE <= THR), 1)) { mn = m_reg; alpha = 1.f; } \
            else { mn = fmaxf(m_reg, pmax); alpha = __builtin_amdgcn_exp2f((m_reg - mn) * C2); m_reg = mn; } \
            const float mnL = -mn * C2; \
            _Pragma("unroll") for (int r = 0; r < 16; ++r) { p0[r] = __builtin_amdgcn_exp2f(fmaf(p0[r], C2, mnL)); p1[r] = __builtin_amdgcn_exp2f(fmaf(p1[r], C2, mnL)); } \
            float ps = 0.f; _Pragma("unroll") for (int r = 0; r < 16; ++r) ps += p0[r]; _Pragma("unroll") for (int r = 0; r < 16; ++r) ps += p1[r]; \
            { auto rr = __builtin_amdgcn_permlane32_swap(__float_as_uint(ps), __float_as_uint(ps), false, false); ps = __uint_as_float(rr[0]) + __uint_as_float(rr[1]); } \
            l_reg = l_reg * alpha + ps; \
            if (__any(alpha < 1.f)) { if (hi == 0) al_l[r32] = alpha; LDS_WAIT(); \
                _Pragma("unroll") for (int d_ = 0; d_ < 4; ++d_) _Pragma("unroll") for (int r = 0; r < 16; ++r) o[d_][r] *= al_l[crow(r, hi)]; } \
            bf16x8 pa0, pa1, pa2, pa3; \
            PK4(p0, 0, pa0); PK4(p0, 8, pa1); PK4(p1, 0, pa2); PK4(p1, 8, pa3); \
            SBAR(); pv_tile<BF>(o, vb0, pa0, pa1, pa2, pa3); \
        } \
        if (t + 1 < NT) { VM_WAIT(); SWRITE((BF) ^ 1); } \
        __syncthreads(); } while (0)
#define PK4(P, B_, OUT) do { const unsigned a0 = cvt_pk_bf16(P[B_+0], P[B_+1]), a1 = cvt_pk_bf16(P[B_+2], P[B_+3]); \
        const unsigned b0_ = cvt_pk_bf16(P[B_+4], P[B_+5]), b1_ = cvt_pk_bf16(P[B_+6], P[B_+7]); \
        auto r0 = __builtin_amdgcn_permlane32_swap(a0, b0_, false, false); auto r1 = __builtin_amdgcn_permlane32_swap(a1, b1_, false, false); \
        v4u w = {r0[0], r1[0], r0[1], r1[1]}; OUT = *reinterpret_cast<bf16x8*>(&w); } while (0)
    for (int t2 = 0; t2 < NT; t2 += 2) { TILE_STEP(0, t2); TILE_STEP(1, t2 + 1); }
#undef PK4
#undef TILE_STEP
#undef SLOAD
#undef SWRITE
    if (hi == 0) li_l[r32] = l_reg; LDS_WAIT();
    float rli[16];
#pragma unroll
    for (int r = 0; r < 16; ++r) rli[r] = __builtin_amdgcn_rcpf(li_l[crow(r, hi)]);
    bf16* Ow = Op + (size_t)qlo * ldo;
#pragma unroll
    for (int r = 0; r < 16; ++r) { const int orow = crow(r, hi);
#pragma unroll
        for (int d0 = 0; d0 < 4; ++d0) { const float v = o[d0][r] * rli[r]; const float vn = __shfl_xor(v, 1);
            if ((r32 & 1) == 0) *(unsigned*)(Ow + (size_t)orow * ldo + d0 * 32 + r32) = cvt_pk_bf16(v, vn); } }
    __syncthreads();
}
}

#define XB_TMO      128
#define XB_XCNT(j)  (256  + 64 * (j))
#define XB_XSUB(j)  (1280 + 64 * (j))
#define XB_XGEN(j)  (2304 + 64 * (j))
#define XB_TOP      3328
#define XB_TOPGEN   3392
#define XCD_BAR_WORDS 3456
#define XB_SPIN_CAP (1u << 18)
__device__ __forceinline__ unsigned xb_ld(unsigned* p)              { return __hip_atomic_load(p, __ATOMIC_RELAXED, __HIP_MEMORY_SCOPE_AGENT); }
__device__ __forceinline__ unsigned xb_add(unsigned* p, unsigned v) { return __hip_atomic_fetch_add(p, v, __ATOMIC_RELAXED, __HIP_MEMORY_SCOPE_AGENT); }
__device__ __forceinline__ unsigned xb_xcc_id() { return (unsigned)__builtin_amdgcn_s_getreg((3 << 11) | 20) & 0xFu; }
#define XB_SPIN(cond, bar) do { unsigned _sp = 0; while (cond) { __builtin_amdgcn_s_sleep(1); \
    if ((++_sp & 255u) == 0u) { if (xb_ld(&(bar)[XB_TMO])) break; if (_sp > XB_SPIN_CAP) { atomicAdd(&(bar)[XB_TMO], 1u); break; } } } } while (0)
struct XcdBarrier { unsigned* bar; unsigned x; volatile LAS unsigned* st; };
__device__ __forceinline__ XcdBarrier xcd_barrier_post(unsigned* bar, volatile LAS unsigned* st) {
    XcdBarrier b; b.bar = bar; b.x = xb_xcc_id(); b.st = st;
    if (threadIdx.x == 0) (void)xb_add(&bar[XB_XCNT(b.x)], 1u);
    return b;
}
__device__ __forceinline__ void xcd_barrier_complete(unsigned* bar, unsigned x, unsigned& nloc, unsigned& nx) {
    const unsigned G = gridDim.x * gridDim.y * gridDim.z;
    unsigned sum, cnt, mine, sp = 0u;
    for (;;) {
        sum = 0u; cnt = 0u; mine = 0u;
#pragma unroll
        for (unsigned j = 0; j < 16; ++j) { const unsigned c = xb_ld(&bar[XB_XCNT(j)]); sum += c; cnt += (c > 0u) ? 1u : 0u; mine = (j == x) ? c : mine; }
        if (sum == G) break;
        __builtin_amdgcn_s_sleep(1);
        if ((++sp & 255u) == 0u) { if (xb_ld(&bar[XB_TMO])) break; if (sp > XB_SPIN_CAP) { atomicAdd(&bar[XB_TMO], 1u); break; } }
    }
    nloc = mine > 0u ? mine : 1u; nx = cnt > 0u ? cnt : 1u;
}
__device__ __forceinline__ void xcd_barrier(const XcdBarrier& b) {
    asm volatile("s_waitcnt vmcnt(0)" ::: "memory");
    __syncthreads();
    if (threadIdx.x == 0) {
        unsigned* bar = b.bar;
        __builtin_amdgcn_s_waitcnt(0);
        unsigned nloc = b.st[0], nx = b.st[1];
        if (nloc == 0u) { xcd_barrier_complete(bar, b.x, nloc, nx); b.st[0] = nloc; b.st[1] = nx; }
        const unsigned old = xb_add(&bar[XB_XSUB(b.x)], 1u);
        const unsigned gen = old / nloc;
        if (old + 1u == (gen + 1u) * nloc) {
            __builtin_amdgcn_fence(__ATOMIC_RELEASE, "agent");
            asm volatile("s_waitcnt vmcnt(0)" ::: "memory");
            const unsigned og = xb_add(&bar[XB_TOP], 1u);
            const unsigned tg = og / nx;
            if (og + 1u == (tg + 1u) * nx) xb_add(&bar[XB_TOPGEN], 1u);
            else XB_SPIN(xb_ld(&bar[XB_TOPGEN]) == tg, bar);
            __builtin_amdgcn_fence(__ATOMIC_ACQUIRE, "agent");
            xb_add(&bar[XB_XGEN(b.x)], 1u);
            asm volatile("s_waitcnt vmcnt(0)" ::: "memory");
        } else {
            XB_SPIN(xb_ld(&bar[XB_XGEN(b.x)]) == gen, bar);
            __builtin_amdgcn_fence(__ATOMIC_ACQUIRE, "agent");
            asm volatile("s_waitcnt vmcnt(0)" ::: "memory");
        }
    }
    __syncthreads();
}

struct Args {
    const float* x; const int* pos; const float* w_in; const float* g_q_a; const float* w_q_b; const float* g_kv_a; const float* w_kv_b;
    const float* g_out_mla; const float* g_out_moba; const float* w_o; const float* ln1_g; const float* ln1_b; const float* w_router; const float* b_router;
    const float* w_gate_up; const float* b_gate_up; const float* w_down; const float* b_down; const float* ln2_g; const float* ln2_b;
    float* out; unsigned char* ws; int ph_lo, ph_hi;
};
constexpr int NPHASES = 14;

__device__ __forceinline__ void tr_item(const float* W, int N, bf16* WT, int K, LAS float* scr, int k0, int n0, int prow0, const float* sc, int lane) {
#pragma unroll 8
    for (int i = 0; i < 64; ++i) scr[i * 65 + lane] = W[(size_t)(k0 + i) * N + n0 + lane];
    LDS_WAIT(); asm volatile("" ::: "memory");
    const int c = lane & 7;
    float s8[8];
#pragma unroll
    for (int i = 0; i < 8; ++i) s8[i] = sc ? sc[k0 + 8 * c + i] : 1.0f;
#pragma unroll
    for (int j = 0; j < 8; ++j) { const int n = j * 8 + (lane >> 3); const LAS float* s = scr + (8 * c) * 65 + n;
        v4u o; o.x = cvt_pk_bf16(s[0] * s8[0], s[65] * s8[1]); o.y = cvt_pk_bf16(s[2 * 65] * s8[2], s[3 * 65] * s8[3]);
        o.z = cvt_pk_bf16(s[4 * 65] * s8[4], s[5 * 65] * s8[5]); o.w = cvt_pk_bf16(s[6 * 65] * s8[6], s[7 * 65] * s8[7]);
        *(v4u*)(WT + (size_t)(prow0 + n) * K + k0 + 8 * c) = o; }
    LDS_WAIT(); asm volatile("" ::: "memory");
}
__device__ __forceinline__ void sincos_d(double x, float& sn, float& cs) {
    const double inv2pi = 0.15915494309189533577, pi2hi = 6.283185307179586232, pi2lo = 2.4492935982947064e-16;
    const double n = rint(x * inv2pi); double r = fma(-n, pi2hi, x); r = fma(-n, pi2lo, r);
    const double r2 = r * r; double s = 1.0, c = 1.0;
    double ts = 0.0, tc = 0.0;
#pragma unroll
    for (int k = 14; k >= 1; --k) { ts = (ts + 1.0) * (-r2 * (1.0 / (double)((2 * k) * (2 * k + 1)))); tc = (tc + 1.0) * (-r2 * (1.0 / (double)((2 * k - 1) * (2 * k)))); }
    s = r * (1.0 + ts); c = 1.0 + tc; sn = (float)s; cs = (float)c;
}

__global__ void __launch_bounds__(512, 2) fwd(Args a) {
    extern __shared__ __attribute__((aligned(16))) unsigned char lds[];
    LAS unsigned char* L = (LAS unsigned char*)lds;
    const int tid = threadIdx.x, lane = tid & 63, wave = __builtin_amdgcn_readfirstlane(tid >> 6);
    const int G = gridDim.x, bid = blockIdx.x;
    const int gw = bid * 8 + wave, NGW = G * 8;
    const int gt = bid * 512 + tid, NGT = G * 512;
    unsigned char* ws = a.ws;
    gu32* ctl = (gu32*)(ws + WS_CTL);
    for (int u = tid; u < (LDS_BYTES - LDSCTL_OFF) / 4; u += 512) ((LAS unsigned*)(L + LDSCTL_OFF))[u] = 0u;
    __syncthreads();
    XcdBarrier bar; bar.bar = (unsigned*)(ctl + CW_BAR); bar.x = 0; bar.st = nullptr;
    if (MK_N_LAUNCHES == 1) bar = xcd_barrier_post((unsigned*)(ctl + CW_BAR), (volatile LAS unsigned*)(L + LDSCTL_OFF));
    const int lo = a.ph_lo, hi = a.ph_hi;
#define IN(k) (lo <= (k) && (k) < hi)
#define SEAM(k) do { if (IN(k) && IN((k) + 1)) xcd_barrier(bar); } while (0)

    bf16* XB = (bf16*)(ws + WS_XB); bf16* WIN = (bf16*)(ws + WS_WIN); bf16* WQB = (bf16*)(ws + WS_WQB); bf16* WKVB = (bf16*)(ws + WS_WKVB); bf16* WO = (bf16*)(ws + WS_WO);
    float* C128 = (float*)(ws + WS_C128); float* S128 = (float*)(ws + WS_S128); float* C64 = (float*)(ws + WS_C64); float* S64 = (float*)(ws + WS_S64);
    bf16* HQ = (bf16*)(ws + WS_HQ); bf16* HKV = (bf16*)(ws + WS_HKV); bf16* HR = (bf16*)(ws + WS_HR); bf16* KPE = (bf16*)(ws + WS_KPE);
    bf16* MQ = (bf16*)(ws + WS_MQ); bf16* MK = (bf16*)(ws + WS_MK); bf16* MV = (bf16*)(ws + WS_MV);
    float* RSQ = (float*)(ws + WS_RSQ); float* RSKV = (float*)(ws + WS_RSKV);
    bf16* QM = (bf16*)(ws + WS_QM); bf16* KVM = (bf16*)(ws + WS_KVM);
    float* KBAR = (float*)(ws + WS_KBAR); unsigned* SEL = (unsigned*)(ws + WS_SEL);
    bf16* OMIX = (bf16*)(ws + WS_OMIX);
    float* X1P = (float*)(ws + WS_X1P); float* X1N = (float*)(ws + WS_X1N); bf16* X1B = (bf16*)(ws + WS_X1B);
    int* TOPE = (int*)(ws + WS_TOPE); int* TOPR = (int*)(ws + WS_TOPR); float* TOPG = (float*)(ws + WS_TOPG); int* TOPROW = (int*)(ws + WS_TOPROW);
    float* RGATE = (float*)(ws + WS_RGATE);
    bf16* XG = (bf16*)(ws + WS_XG); bf16* ACT = (bf16*)(ws + WS_ACT); bf16* YB = XG;
    bf16* WGU = (bf16*)(ws + WS_WGU); bf16* WD = (bf16*)(ws + WS_WD);

    if (IN(0)) {
        LAS float* scr = (LAS float*)(L + wave * 16640);
        constexpr int I0 = 32 * 61, I1 = 8 * 24, I2 = 4 * 32, I3 = 32 * 32, I4 = NE * 32 * 64, I5 = NE * 32 * 32;
        constexpr int NIT = I0 + I1 + I2 + I3 + I4 + I5;
        for (int it = gw; it < NIT; it += NGW) {
            int r = it;
            if (r < I0) { const int kb = r / 61, nb = r % 61, n0 = nb * 64; tr_item(a.w_in, INC, WIN, DM, scr, kb * 64, n0, n0 < 832 ? n0 : n0 + 192, nullptr, lane); continue; } r -= I0;
            if (r < I1) { const int kb = r / 24, nb = r % 24; tr_item(a.w_q_b, 1536, WQB, QLORA, scr, kb * 64, nb * 64, nb * 64, a.g_q_a, lane); continue; } r -= I1;
            if (r < I2) { const int kb = r / 32, nb = r % 32; tr_item(a.w_kv_b, 2048, WKVB, KVLORA, scr, kb * 64, nb * 64, nb * 64, a.g_kv_a, lane); continue; } r -= I2;
            if (r < I3) { const int kb = r / 32, nb = r % 32; tr_item(a.w_o, DM, WO, DM, scr, kb * 64, nb * 64, nb * 64, kb < 16 ? a.g_out_mla : a.g_out_moba - MW, lane); continue; } r -= I3;
            if (r < I4) { const int e = r / 2048, q = r % 2048, kb = q / 64, nb = q % 64, n0 = nb * 64;
                const int prow = n0 < DFF ? (n0 >> 7) * 256 + (n0 & 127) : ((n0 - DFF) >> 7) * 256 + 128 + ((n0 - DFF) & 127);
                tr_item(a.w_gate_up + (size_t)e * DM * 2 * DFF, 2 * DFF, WGU + (size_t)e * 2 * DFF * DM, DM, scr, kb * 64, n0, prow, nullptr, lane); continue; } r -= I4;
            { const int e = r / 1024, q = r % 1024, kb = q / 32, nb = q % 32;
              tr_item(a.w_down + (size_t)e * DFF * DM, DM, WD + (size_t)e * DM * DFF, DFF, scr, kb * 64, nb * 64, nb * 64, nullptr, lane); }
        }
        for (int i = gt; i < 192 * DM / 8; i += NGT) *(v4u*)(WIN + (size_t)832 * DM + (size_t)i * 8) = (v4u){0u, 0u, 0u, 0u};
        for (int i = gt; i < T * DM / 8; i += NGT) { const f32x4 v0 = *(const f32x4*)(a.x + (size_t)i * 8), v1 = *(const f32x4*)(a.x + (size_t)i * 8 + 4);
            v4u w; w.x = cvt_pk_bf16(v0[0], v0[1]); w.y = cvt_pk_bf16(v0[2], v0[3]); w.z = cvt_pk_bf16(v1[0], v1[1]); w.w = cvt_pk_bf16(v1[2], v1[3]); *(v4u*)(XB + (size_t)i * 8) = w; }
        for (int i = gt; i < T * 96; i += NGT) { const int t = i / 96, j = i % 96; const float p = (float)a.pos[t];
            if (j < 64) { const float inv = (float)exp2(-(double)j * (2.0 / 128.0) * 13.287712379549449); float sn, cs; sincos_d((double)(p * inv), sn, cs); C128[t * 64 + j] = cs; S128[t * 64 + j] = sn; }
            else { const int jj = j - 64; const float inv = (float)exp2(-(double)jj * (2.0 / 64.0) * 13.287712379549449); float sn, cs; sincos_d((double)(p * inv), sn, cs); C64[t * 32 + jj] = cs; S64[t * 32 + jj] = sn; } }
    }
    SEAM(0);

    if (IN(1)) {
        pg8::Gemm g{XB, WIN, DM, DM, DM, 0}; pg8::StaticOrder S; S.init(T, INP, G, bid);
        pg8::EpiInProj E{ws};
        pg8::gemm_phase<pg8::EpiInProj, pg8::StaticOrder>(L, g, S, E);
    }
    SEAM(1);

    if (IN(2)) {
        for (int r = gw; r < T; r += NGW) {
            { const v4u w = *(const v4u*)(HQ + (size_t)r * QLORA + lane * 8); float s = 0.f;
              s += bflo(w.x) * bflo(w.x) + bfhi(w.x) * bfhi(w.x) + bflo(w.y) * bflo(w.y) + bfhi(w.y) * bfhi(w.y) + bflo(w.z) * bflo(w.z) + bfhi(w.z) * bfhi(w.z) + bflo(w.w) * bflo(w.w) + bfhi(w.w) * bfhi(w.w);
              s = wave_sum(s); if (lane == 0) RSQ[r] = 1.0f / sqrtf(s * (1.0f / QLORA) + RMS_EPS); }
            { const v2u w = *(const v2u*)(HKV + (size_t)r * KVLORA + lane * 4); float s = 0.f;
              s += bflo(w.x) * bflo(w.x) + bfhi(w.x) * bfhi(w.x) + bflo(w.y) * bflo(w.y) + bfhi(w.y) * bfhi(w.y);
              s = wave_sum(s); if (lane == 0) RSKV[r] = 1.0f / sqrtf(s * (1.0f / KVLORA) + RMS_EPS); }
            if (lane < 32) { const float x1 = bf2f(HR[(size_t)r * 256 + lane]), x2 = bf2f(HR[(size_t)r * 256 + 32 + lane]); const float c = C64[r * 32 + lane], s = S64[r * 32 + lane];
                KPE[(size_t)r * ROPE + lane] = f2bf(x1 * c - x2 * s); KPE[(size_t)r * ROPE + 32 + lane] = f2bf(x2 * c + x1 * s); }
            const float c = C128[r * 64 + lane], s = S128[r * 64 + lane];
#pragma unroll
            for (int h = 0; h < NH; ++h) {
                bf16* q = MQ + (size_t)r * MW + h * 128; const float q1 = bf2f(q[lane]), q2 = bf2f(q[64 + lane]); q[lane] = f2bf(q1 * c - q2 * s); q[64 + lane] = f2bf(q2 * c + q1 * s);
                bf16* k = MK + (size_t)r * MW + h * 128; const float k1 = bf2f(k[lane]), k2 = bf2f(k[64 + lane]); k[lane] = f2bf(k1 * c - k2 * s); k[64 + lane] = f2bf(k2 * c + k1 * s); }
        }
    }
    SEAM(2);

    if (IN(3)) {
        { pg8::Gemm g{HQ, WQB, QLORA, QLORA, QLORA, 0}; pg8::StaticOrder S; S.init(T, 1536, G, bid); pg8::EpiRowScale E{QM, 1536, RSQ};
          pg8::gemm_phase<pg8::EpiRowScale, pg8::StaticOrder>(L, g, S, E); }
        { pg8::Gemm g{HKV, WKVB, KVLORA, KVLORA, KVLORA, 0}; pg8::StaticOrder S; S.init(T, 2048, G, bid); pg8::EpiRowScale E{KVM, 2048, RSKV};
          pg8::gemm_phase<pg8::EpiRowScale, pg8::StaticOrder>(L, g, S, E); }
    }
    SEAM(3);

    if (IN(4)) {
        for (int r = gw; r < T; r += NGW) {
#pragma unroll
            for (int j = 0; j < 4; ++j) { const int idx = lane + 64 * j, h = idx >> 5, i = idx & 31; bf16* q = QM + (size_t)r * 1536 + h * QKH + NOPE;
                const float c = C64[r * 32 + i], s = S64[r * 32 + i]; const float x1 = bf2f(q[i]), x2 = bf2f(q[32 + i]); q[i] = f2bf(x1 * c - x2 * s); q[32 + i] = f2bf(x2 * c + x1 * s); }
        }
        for (int it = gw; it < NH * 32; it += NGW) { const int h = it >> 5, blk = it & 31; float s0 = 0.f, s1 = 0.f;
            const bf16* p = MK + (size_t)blk * 256 * MW + h * 128 + 2 * lane;
            for (int rr = 0; rr < 256; ++rr) { const unsigned w = *(const unsigned*)(p + (size_t)rr * MW); s0 += bflo(w); s1 += bfhi(w); }
            KBAR[(h * 32 + blk) * 128 + 2 * lane] = s0 * (1.0f / 256.0f); KBAR[(h * 32 + blk) * 128 + 2 * lane + 1] = s1 * (1.0f / 256.0f); }
    }
    SEAM(4);

    if (IN(5)) {
        LAS float* kb = (LAS float*)L;
        for (int i = tid; i < NH * 32 * 128; i += 512) kb[(i >> 7) * 129 + (i & 127)] = KBAR[i];
        LAS unsigned* qs = (LAS unsigned*)(L + 132096 + wave * 2048);
        __syncthreads();
        for (int t = gw; t < T; t += NGW) {
            const int blk = t >> 8;
            { const v4u w0 = *(const v4u*)(MQ + (size_t)t * MW + lane * 8), w1 = *(const v4u*)(MQ + (size_t)t * MW + 512 + lane * 8);
              *(LAS v4u*)(qs + lane * 4) = w0; *(LAS v4u*)(qs + 256 + lane * 4) = w1; }
            LDS_WAIT(); asm volatile("" ::: "memory");
            const int n = lane & 31;
#pragma unroll 1
            for (int hp = 0; hp < 4; ++hp) { const int h = 2 * hp + (lane >> 5);
                const LAS float* kr = kb + (h * 32 + n) * 129; const LAS unsigned* qh = qs + h * 64; float dot = 0.f;
#pragma unroll 8
                for (int d = 0; d < 64; ++d) { const unsigned w = qh[d]; dot = fmaf(bflo(w), kr[2 * d], dot); dot = fmaf(bfhi(w), kr[2 * d + 1], dot); }
                float gate = n < blk ? dot : -__builtin_inff(); unsigned bits = 0u;
#pragma unroll
                for (int k = 0; k < 3; ++k) { float v = gate; int idx = n;
#pragma unroll
                    for (int off = 16; off >= 1; off >>= 1) { const float ov = __shfl_xor(v, off); const int oi = __shfl_xor(idx, off); if (ov > v || (ov == v && oi < idx)) { v = ov; idx = oi; } }
                    if (k < blk) bits |= 1u << idx;
                    if (n == idx) gate = -__builtin_inff(); }
                if (n == 0) SEL[(size_t)t * NH + h] = bits; }
            LDS_WAIT(); asm volatile("" ::: "memory");
        }
        __syncthreads();
    }
    SEAM(5);

    if (IN(6)) {
        for (int it = bid; it < 256; it += G) { const int h = it & 7, s = it >> 3;
            at::attn_unit<true>((const bf16*)QM + h * QKH, 1536, (const bf16*)KVM + h * 256, (const bf16*)KVM + h * 256 + 128, 2048, (const bf16*)KPE, OMIX + h * 128, DM, s, nullptr, (char*)lds);
            at::attn_unit<false>((const bf16*)MQ + h * 128, MW, (const bf16*)MK + h * 128, (const bf16*)MV + h * 128, MW, nullptr, OMIX + MW + h * 128, DM, 31 - s, SEL + h, (char*)lds);
        }
    }
    SEAM(6);

    if (IN(7)) {
        for (int r = gw; r < T; r += NGW) { v4u w[4]; float ss[2] = {0.f, 0.f};
#pragma unroll
            for (int j = 0; j < 4; ++j) { w[j] = *(const v4u*)(OMIX + (size_t)r * DM + j * 512 + lane * 8); float s = 0.f;
                s += bflo(w[j].x) * bflo(w[j].x) + bfhi(w[j].x) * bfhi(w[j].x) + bflo(w[j].y) * bflo(w[j].y) + bfhi(w[j].y) * bfhi(w[j].y) + bflo(w[j].z) * bflo(w[j].z) + bfhi(w[j].z) * bfhi(w[j].z) + bflo(w[j].w) * bflo(w[j].w) + bfhi(w[j].w) * bfhi(w[j].w);
                ss[j >> 1] += s; }
            const float r0 = 1.0f / sqrtf(wave_sum(ss[0]) * (1.0f / MW) + RMS_EPS), r1 = 1.0f / sqrtf(wave_sum(ss[1]) * (1.0f / MW) + RMS_EPS);
#pragma unroll
            for (int j = 0; j < 4; ++j) { const float sc = j < 2 ? r0 : r1; v4u o;
                o.x = cvt_pk_bf16(bflo(w[j].x) * sc, bfhi(w[j].x) * sc); o.y = cvt_pk_bf16(bflo(w[j].y) * sc, bfhi(w[j].y) * sc); o.z = cvt_pk_bf16(bflo(w[j].z) * sc, bfhi(w[j].z) * sc); o.w = cvt_pk_bf16(bflo(w[j].w) * sc, bfhi(w[j].w) * sc);
                *(v4u*)(OMIX + (size_t)r * DM + j * 512 + lane * 8) = o; } }
    }
    SEAM(7);

    if (IN(8)) {
        pg8::Gemm g{OMIX, WO, DM, DM, DM, 0}; pg8::StaticOrder S; S.init(T, DM, G, bid); pg8::EpiResF32 E{a.x, X1P, DM};
        pg8::gemm_phase<pg8::EpiResF32, pg8::StaticOrder>(L, g, S, E);
    }
    SEAM(8);

    if (IN(9)) {
        LAS float* part = (LAS float*)L;
        LAS float* lg = (LAS float*)(L + 32768);
        for (int rg = bid; rg < T / 32; rg += G) { const int R0 = rg * 32;
            for (int rr = 0; rr < 4; ++rr) { const int r = R0 + wave * 4 + rr; f32x4 v[8]; float s = 0.f;
#pragma unroll
                for (int j = 0; j < 8; ++j) { v[j] = *(const f32x4*)(X1P + (size_t)r * DM + j * 256 + lane * 4); s += (v[j][0] + v[j][1]) + (v[j][2] + v[j][3]); }
                const float mean = wave_sum(s) * (1.0f / DM); float q = 0.f;
#pragma unroll
                for (int j = 0; j < 8; ++j) { v[j] = v[j] - mean; q += (v[j][0] * v[j][0] + v[j][1] * v[j][1]) + (v[j][2] * v[j][2] + v[j][3] * v[j][3]); }
                const float rstd = 1.0f / sqrtf(wave_sum(q) * (1.0f / DM) + LN_EPS);
#pragma unroll
                for (int j = 0; j < 8; ++j) { const int c = j * 256 + lane * 4; const f32x4 gg = *(const f32x4*)(a.ln1_g + c), bb = *(const f32x4*)(a.ln1_b + c);
                    const f32x4 y = v[j] * rstd * gg + bb; *(f32x4*)(X1N + (size_t)r * DM + c) = y;
                    v2u w; w.x = cvt_pk_bf16(y[0], y[1]); w.y = cvt_pk_bf16(y[2], y[3]); *(v2u*)(X1B + (size_t)r * DM + c) = w; } }
            VM_WAIT(); __syncthreads();
            { f32x16 acc = f32x16{}; const int hh = lane >> 5, li = lane & 31;
              const float* ap = X1N + (size_t)(R0 + li) * DM + wave * 256 + 4 * hh; const float* bp = a.w_router + (size_t)(wave * 256 + 4 * hh) * NE + li;
#pragma unroll 4
              for (int kk = 0; kk < 32; ++kk) { const f32x4 av = *(const f32x4*)(ap + kk * 8); const float* b = bp + (size_t)kk * 8 * NE;
                  acc = __builtin_amdgcn_mfma_f32_32x32x2f32(av[0], b[0], acc, 0, 0, 0); acc = __builtin_amdgcn_mfma_f32_32x32x2f32(av[1], b[NE], acc, 0, 0, 0);
                  acc = __builtin_amdgcn_mfma_f32_32x32x2f32(av[2], b[2 * NE], acc, 0, 0, 0); acc = __builtin_amdgcn_mfma_f32_32x32x2f32(av[3], b[3 * NE], acc, 0, 0, 0); }
#pragma unroll
              for (int r = 0; r < 16; ++r) part[(wave * 32 + at::crow(r, hh)) * 32 + li] = acc[r]; }
            __syncthreads();
            for (int i = tid; i < 1024; i += 512) { float s = a.b_router[i & 31];
#pragma unroll
                for (int w = 0; w < 8; ++w) s += part[w * 1024 + i];
                lg[(i >> 5) * 33 + (i & 31)] = s; }
            __syncthreads();
            if (tid < 32) { float v[32];
#pragma unroll
                for (int e = 0; e < 32; ++e) v[e] = lg[tid * 33 + e];
                float tv[4]; int ti[4];
#pragma unroll
                for (int k = 0; k < 4; ++k) { float best = -__builtin_inff(); int bi = 0;
#pragma unroll
                    for (int e = 0; e < 32; ++e) { if (v[e] > best) { best = v[e]; bi = e; } }
                    tv[k] = best; ti[k] = bi;
#pragma unroll
                    for (int e = 0; e < 32; ++e) if (e == bi) v[e] = -__builtin_inff(); }
                const float e1 = __expf(tv[1] - tv[0]), e2 = __expf(tv[2] - tv[0]), e3 = __expf(tv[3] - tv[0]); const float inv = 1.0f / (1.0f + e1 + e2 + e3);
                const float gk[4] = {inv, e1 * inv, e2 * inv, e3 * inv}; const int r = R0 + tid;
#pragma unroll
                for (int k = 0; k < 4; ++k) { const unsigned rank = __hip_atomic_fetch_add((unsigned*)(ctl + CW_COUNT + ti[k]), 1u, RLX_AGENT);
                    TOPE[r * 4 + k] = ti[k]; TOPR[r * 4 + k] = (int)rank; TOPG[r * 4 + k] = gk[k]; } }
            __syncthreads();
        }
    }
    SEAM(9);

    if (IN(10)) {
        LAS int* ps = (LAS int*)L;
        if (tid == 0) { int acc_ = 0; for (int e = 0; e < NE; ++e) { const int c = (int)__hip_atomic_load((unsigned*)(ctl + CW_COUNT + e), RLX_AGENT); const int p = (c + 255) & ~255; ps[e] = acc_; ps[32 + e] = c; ps[64 + e] = p; acc_ += p; } ps[96] = acc_; }
        __syncthreads();
        if (bid == 0) { if (tid == 0) __hip_atomic_store((unsigned*)(ctl + CW_NRT), (unsigned)(ps[96] >> 8), RLX_AGENT);
            if (tid < NE) { const int e = tid; for (int rt = ps[e] >> 8; rt < (ps[e] + ps[64 + e]) >> 8; ++rt) __hip_atomic_store((unsigned*)(ctl + CW_TILEE + rt), (unsigned)e, RLX_AGENT); } }
        for (int it = gw; it < T * TOPK; it += NGW) { const int t = it >> 2; const int e = TOPE[it], rk = TOPR[it]; const int row = ps[e] + rk;
            const v4u* src = (const v4u*)(X1B + (size_t)t * DM); v4u* dst = (v4u*)(XG + (size_t)row * DM);
#pragma unroll
            for (int j = 0; j < 4; ++j) dst[j * 64 + lane] = src[j * 64 + lane];
            if (lane == 0) { RGATE[row] = TOPG[it]; TOPROW[it] = row; } }
        for (int it = gw; it < NE * 256; it += NGW) { const int e = it >> 8, i = it & 255; const int rk = ps[32 + e] + i;
            if (rk < ps[64 + e]) { const int row = ps[e] + rk; v4u* dst = (v4u*)(XG + (size_t)row * DM);
#pragma unroll
                for (int j = 0; j < 4; ++j) dst[j * 64 + lane] = (v4u){0u, 0u, 0u, 0u};
                if (lane == 0) RGATE[row] = 0.f; } }
        __syncthreads();
    }
    SEAM(10);

    if (IN(11)) {
        const int n_rt = (int)__builtin_amdgcn_readfirstlane((int)__hip_atomic_load((unsigned*)(ctl + CW_NRT), RLX_AGENT));
        pg8::Gemm g{XG, WGU, DM, DM, DM, (size_t)2 * DFF * DM * 2}; pg8::MoeOrder S{(const unsigned*)(ctl + CW_TILEE), n_rt, 16, G, bid};
        pg8::EpiSwiglu E{ACT, a.b_gate_up};
        pg8::gemm_phase<pg8::EpiSwiglu, pg8::MoeOrder>(L, g, S, E);
    }
    SEAM(11);

    if (IN(12)) {
        const int n_rt = (int)__builtin_amdgcn_readfirstlane((int)__hip_atomic_load((unsigned*)(ctl + CW_NRT), RLX_AGENT));
        pg8::Gemm g{ACT, WD, DFF, DFF, DFF, (size_t)DM * DFF * 2}; pg8::MoeOrder S{(const unsigned*)(ctl + CW_TILEE), n_rt, 8, G, bid};
        pg8::EpiDown E{YB, a.b_down, RGATE};
        pg8::gemm_phase<pg8::EpiDown, pg8::MoeOrder>(L, g, S, E);
    }
    SEAM(12);

    if (IN(13)) {
        for (int t = gw; t < T; t += NGW) { int rows[4];
#pragma unroll
            for (int k = 0; k < 4; ++k) rows[k] = TOPROW[t * 4 + k];
            f32x4 v[8]; float s = 0.f;
#pragma unroll
            for (int j = 0; j < 8; ++j) { const int c = j * 256 + lane * 4; f32x4 y = *(const f32x4*)(X1N + (size_t)t * DM + c) * ALPHA;
#pragma unroll
                for (int k = 0; k < 4; ++k) { const v2u w = *(const v2u*)(YB + (size_t)rows[k] * DM + c); y[0] += bflo(w.x); y[1] += bfhi(w.x); y[2] += bflo(w.y); y[3] += bfhi(w.y); }
                v[j] = y; s += (y[0] + y[1]) + (y[2] + y[3]); }
            const float mean = wave_sum(s) * (1.0f / DM); float q = 0.f;
#pragma unroll
            for (int j = 0; j < 8; ++j) { v[j] = v[j] - mean; q += (v[j][0] * v[j][0] + v[j][1] * v[j][1]) + (v[j][2] * v[j][2] + v[j][3] * v[j][3]); }
            const float rstd = 1.0f / sqrtf(wave_sum(q) * (1.0f / DM) + LN_EPS);
#pragma unroll
            for (int j = 0; j < 8; ++j) { const int c = j * 256 + lane * 4; const f32x4 gg = *(const f32x4*)(a.ln2_g + c), bb = *(const f32x4*)(a.ln2_b + c);
                *(f32x4*)(a.out + (size_t)t * DM + c) = v[j] * rstd * gg + bb; } }
    }
#undef IN
#undef SEAM
}

extern "C" void kernel_launch(void* const* d_in, const int* in_sizes, int n_in, void* d_out, int out_size, void* d_ws, size_t ws_size, hipStream_t stream) {
    static int grid = 0;
    if (grid == 0) {
        if (n_in != 20 || in_sizes[0] != T * DM || out_size != T * DM || ws_size < WS_END) { fprintf(stderr, "kernel_launch: unexpected shapes (n_in %d, in0 %d, out %d, ws %zu < %zu)\n", n_in, n_in > 0 ? in_sizes[0] : -1, out_size, ws_size, (size_t)WS_END); grid = -1; return; }
        int dev = 0, cus = 0, per_cu = 0;
        if (hipGetDevice(&dev) != hipSuccess || hipDeviceGetAttribute(&cus, hipDeviceAttributeMultiprocessorCount, dev) != hipSuccess) { grid = -1; return; }
        if (hipFuncSetAttribute((const void*)fwd, hipFuncAttributeMaxDynamicSharedMemorySize, LDS_BYTES) != hipSuccess) { fprintf(stderr, "kernel_launch: hipFuncSetAttribute failed\n"); grid = -1; return; }
        if (hipOccupancyMaxActiveBlocksPerMultiprocessor(&per_cu, (const void*)fwd, 512, LDS_BYTES) != hipSuccess || per_cu < 1) fprintf(stderr, "kernel_launch: occupancy query says %d\n", per_cu);
        (void)hipGetLastError();
        grid = cus;
    }
    if (grid < 0) return;
    (void)hipMemsetAsync((char*)d_ws + WS_CTL, 0, CTL_ZERO_BYTES, stream);
    Args a{};
    a.x = (const float*)d_in[0]; a.pos = (const int*)d_in[1]; a.w_in = (const float*)d_in[2]; a.g_q_a = (const float*)d_in[3]; a.w_q_b = (const float*)d_in[4];
    a.g_kv_a = (const float*)d_in[5]; a.w_kv_b = (const float*)d_in[6]; a.g_out_mla = (const float*)d_in[7]; a.g_out_moba = (const float*)d_in[8]; a.w_o = (const float*)d_in[9];
    a.ln1_g = (const float*)d_in[10]; a.ln1_b = (const float*)d_in[11]; a.w_router = (const float*)d_in[12]; a.b_router = (const float*)d_in[13];
    a.w_gate_up = (const float*)d_in[14]; a.b_gate_up = (const float*)d_in[15]; a.w_down = (const float*)d_in[16]; a.b_down = (const float*)d_in[17];
    a.ln2_g = (const float*)d_in[18]; a.ln2_b = (const float*)d_in[19];
    a.out = (float*)d_out; a.ws = (unsigned char*)d_ws;
    if (MK_N_LAUNCHES == 1) { a.ph_lo = 0; a.ph_hi = NPHASES; hipLaunchKernelGGL(fwd, dim3(grid), dim3(512), LDS_BYTES, stream, a); }
    else { for (int p = 0; p < NPHASES; ++p) { a.ph_lo = p; a.ph_hi = p + 1; hipLaunchKernelGGL(fwd, dim3(grid), dim3(512), LDS_BYTES, stream, a); } }
    const hipError_t le = hipPeekAtLastError();
    if (le != hipSuccess) fprintf(stderr, "kernel_launch: launch failed: %s\n", hipGetErrorName(le));
}
```

```cpp
#include <hip/hip_runtime.h>
#include <cstdio>
#include <cstdint>

#ifndef PROBE_REP_MASK
#define PROBE_REP_MASK 0
#endif
#ifndef MK_N_LAUNCHES
#define MK_N_LAUNCHES 1
#endif

constexpr int T = 8192, DM = 2048, NH = 8;
constexpr int QLORA = 512, KVLORA = 256, ROPE = 64, NOPE = 128, VH = 128, QKH = NOPE + ROPE;
constexpr int MW = 1024;
constexpr int INC = 3904, INP = 4096;
constexpr int NE = 32, TOPK = 4, DFF = 2048;
constexpr int MAXROWS = T * TOPK + NE * 256;
constexpr int MAXRT = MAXROWS / 256;
constexpr float ALPHA = 1.189207115002721f;
constexpr float RMS_EPS = 1e-6f, LN_EPS = 1e-5f;

#define GAS __attribute__((address_space(1)))
#define LAS __attribute__((address_space(3)))
typedef unsigned short bf16;
typedef unsigned v4u __attribute__((ext_vector_type(4)));
typedef unsigned v2u __attribute__((ext_vector_type(2)));
typedef float f32x4 __attribute__((ext_vector_type(4)));
typedef float f32x2 __attribute__((ext_vector_type(2)));
typedef float f32x16 __attribute__((ext_vector_type(16)));
typedef short bf16x8 __attribute__((ext_vector_type(8)));
typedef short s16x4 __attribute__((ext_vector_type(4)));
typedef GAS unsigned gu32;
#define RLX_AGENT __ATOMIC_RELAXED, __HIP_MEMORY_SCOPE_AGENT
#define LDS_WAIT() asm volatile("s_waitcnt lgkmcnt(0)" ::: "memory")
#define VM_WAIT() asm volatile("s_waitcnt vmcnt(0)" ::: "memory")
#define SBAR() __builtin_amdgcn_sched_barrier(0)

__device__ __forceinline__ unsigned cvt_pk_bf16(float lo, float hi) { unsigned r; asm volatile("v_cvt_pk_bf16_f32 %0, %1, %2" : "=v"(r) : "v"(lo), "v"(hi)); return r; }
__device__ __forceinline__ float bf2f(unsigned short b) { return __uint_as_float(((unsigned)b) << 16); }
__device__ __forceinline__ float bflo(unsigned w) { return __uint_as_float(w << 16); }
__device__ __forceinline__ float bfhi(unsigned w) { return __uint_as_float(w & 0xffff0000u); }
__device__ __forceinline__ unsigned short f2bf(float f) { return (unsigned short)(cvt_pk_bf16(f, f) & 0xffffu); }
__device__ __forceinline__ unsigned pk4_fp8(float a, float b, float c, float d) { int w = 0; w = __builtin_amdgcn_cvt_pk_fp8_f32(a, b, w, false); w = __builtin_amdgcn_cvt_pk_fp8_f32(c, d, w, true); return (unsigned)w; }
typedef int v4i __attribute__((ext_vector_type(4)));
typedef int v8i __attribute__((ext_vector_type(8)));
__device__ __forceinline__ v8i cat8(bf16x8 a, bf16x8 b) { const v4i x = __builtin_bit_cast(v4i, a), y = __builtin_bit_cast(v4i, b); return __builtin_shufflevector(x, y, 0, 1, 2, 3, 4, 5, 6, 7); }
__device__ __forceinline__ int lane_id() { int l = (int)__builtin_amdgcn_mbcnt_hi(~0u, __builtin_amdgcn_mbcnt_lo(~0u, 0u)); asm volatile("" : "+v"(l)); return l; }
__device__ __forceinline__ float wave_sum(float v) {
#pragma unroll
    for (int o = 1; o < 64; o <<= 1) v += __shfl_xor(v, o);
    return v;
}

constexpr size_t MiB = 1u << 20;
constexpr size_t WS_CTL = 0, CTL_ZERO_BYTES = 1 * MiB;
constexpr size_t WS_XB    = 2 * MiB;
constexpr size_t WS_WIN   = WS_XB + 32 * MiB;
constexpr size_t WS_WQB   = WS_WIN + 16 * MiB;
constexpr size_t WS_WKVB  = WS_WQB + 2 * MiB;
constexpr size_t WS_WO    = WS_WKVB + 1 * MiB;
constexpr size_t WS_C128  = WS_WO + 8 * MiB;
constexpr size_t WS_S128  = WS_C128 + 2 * MiB;
constexpr size_t WS_C64   = WS_S128 + 2 * MiB;
constexpr size_t WS_S64   = WS_C64 + 1 * MiB;
constexpr size_t WS_HQ    = WS_S64 + 1 * MiB;
constexpr size_t WS_HKV   = WS_HQ + 8 * MiB;
constexpr size_t WS_HR    = WS_HKV + 4 * MiB;
constexpr size_t WS_KPE   = WS_HR + 4 * MiB;
constexpr size_t WS_MQ    = WS_KPE + 1 * MiB;
constexpr size_t WS_MK    = WS_MQ + 16 * MiB;
constexpr size_t WS_MV    = WS_MK + 16 * MiB;
constexpr size_t WS_RSQ   = WS_MV + 16 * MiB;
constexpr size_t WS_RSKV  = WS_RSQ + 1 * MiB;
constexpr size_t WS_QM    = WS_RSKV + 1 * MiB;
constexpr size_t WS_KVM   = WS_QM + 24 * MiB;
constexpr size_t WS_KBAR  = WS_KVM + 32 * MiB;
constexpr size_t WS_SEL   = WS_KBAR + 1 * MiB;
constexpr size_t WS_OMIX  = WS_SEL + 1 * MiB;
constexpr size_t WS_X1P   = WS_OMIX + 32 * MiB;
constexpr size_t WS_X1N   = WS_X1P + 64 * MiB;
constexpr size_t WS_X1B   = WS_X1N + 64 * MiB;
constexpr size_t WS_TOPE  = WS_X1B + 32 * MiB;
constexpr size_t WS_TOPR  = WS_TOPE + 1 * MiB;
constexpr size_t WS_TOPG  = WS_TOPR + 1 * MiB;
constexpr size_t WS_TOPROW= WS_TOPG + 1 * MiB;
constexpr size_t WS_RGATE = WS_TOPROW + 1 * MiB;
constexpr size_t WS_XG    = WS_RGATE + 1 * MiB;
constexpr size_t WS_ACT   = WS_XG + 80 * MiB;
constexpr size_t WS_Y     = WS_ACT + 80 * MiB;
constexpr size_t WS_WGU   = WS_Y + 160 * MiB;
constexpr size_t WS_WD    = WS_WGU + 256 * MiB;
constexpr size_t WS_END   = WS_WD + 128 * MiB;
constexpr float SC_X = 16.0f, SC_WGU = 512.0f, SC_ACT = 4.0f, SC_WD = 1024.0f;
constexpr int CW_BAR = 4096;
constexpr int CW_COUNT = 16384;
constexpr int CW_TILEE = 16384 + 64;
constexpr int CW_NRT = 16384 + 64 + 192;

constexpr int LDS_BYTES = 159744;
constexpr int LDSCTL_OFF = 158720;

namespace pg8 {
constexpr int BM = 256, BK = 64, HALF = 128, HTB = HALF * BK * 2, STAGE_BYTES = 8 * HTB, NXCD = 8, WGM = 8;
__host__ __device__ __forceinline__ int lds_byte(int r, int c) { const int st = (r >> 4) * 2 + (c >> 5), rr = r & 15, cc = c & 31, ob = rr * 64 + cc * 2; return st * 1024 + (ob ^ (((ob >> 9) & 1) << 5)); }
__host__ __device__ __forceinline__ void stage_rc(int b, int& R, int& C) { const int st = b / 1024, sb = b % 1024, swz = sb ^ (((sb >> 9) & 1) << 5); R = (st >> 1) * 16 + swz / 64; C = (st & 1) * 32 + (swz % 64) / 2; }
__host__ __device__ __forceinline__ int perm32(int rho) { const int n = rho >> 4, i = rho & 15; return 8 * (i >> 2) + 4 * n + (i & 3); }

struct Unit { int pm, pn, e; };
struct Gemm { const void* A; const void* Bt; int Kb, lda, ldb; size_t bes; };

struct StaticOrder {
    int nM, nN, nwg, G, c;
    __device__ void init(int M, int N, int G_, int c_) { nM = M / BM; nN = N / BM; nwg = nM * nN; G = G_; c = c_; }
    __device__ bool next(int i, Unit& u) const {
        const long L = (long)i * G + c; if (L >= nwg) return false;
        int wgid = (int)L; { const int q = nwg / NXCD, r = nwg % NXCD, xcd = wgid % NXCD, off = wgid / NXCD; wgid = (xcd < r ? xcd * (q + 1) : r * (q + 1) + (xcd - r) * q) + off; }
        const int nig = WGM * nN, gid = wgid / nig, fm = gid * WGM, gsz = (nM - fm) < WGM ? (nM - fm) : WGM;
        u.pm = fm + ((wgid % nig) % gsz); u.pn = (wgid % nig) / gsz; u.e = 0; return true;
    }
};
struct MoeOrder {
    const LAS unsigned* tile_e; int n_rt, lnpn, G, c;
    __device__ bool next(int i, Unit& u) const {
        const int L = i * G + c; if (L >= (n_rt << lnpn)) return false;
        const int rt = L >> lnpn; u.pm = rt; u.pn = L - (rt << lnpn);
        u.e = (int)__builtin_amdgcn_readfirstlane((int)tile_e[rt]); return true;
    }
};

typedef f32x4 Acc[2][2][4][2];

struct EpiInProj {
    static constexpr bool PERM = true;
    unsigned char* ws;
    __device__ __forceinline__ void operator()(const Acc& acc, const Unit& u, int wr, int wc, int fr, int fq) const {
        const int pn = u.pn; size_t off; int ldc, colt;
        if (pn < 4) { off = WS_HQ + (size_t)(pn >> 1) * (8u << 20) + (size_t)(pn == 3 ? 1 : 0) * (4u << 20); ldc = 512 - (pn >> 1) * 256; colt = (pn >> 1) ? 0 : pn * 256; }
        else { off = WS_MQ + (size_t)((pn - 4) >> 2) * (16u << 20); ldc = 1024; colt = ((pn - 4) & 3) * 256; }
        bf16* base = (bf16*)(ws + off);
        const int row0 = u.pm * BM + wr * 64 + fr, col0 = colt + wc * 32 + 8 * fq;
#pragma unroll
        for (int ai = 0; ai < 2; ++ai)
#pragma unroll
            for (int m = 0; m < 4; ++m) { bf16* rowp = base + (size_t)(row0 + ai * HALF + m * 16) * ldc + col0;
#pragma unroll
                for (int bj = 0; bj < 2; ++bj) { const f32x4 v0 = acc[ai][bj][m][0], v1 = acc[ai][bj][m][1];
                    v4u w; w.x = cvt_pk_bf16(v0[0], v0[1]); w.y = cvt_pk_bf16(v0[2], v0[3]); w.z = cvt_pk_bf16(v1[0], v1[1]); w.w = cvt_pk_bf16(v1[2], v1[3]);
                    *(v4u*)(rowp + bj * HALF) = w; } }
    }
};
struct EpiRowScale {
    static constexpr bool PERM = true;
    bf16* O; int ldc; const float* rs;
    __device__ __forceinline__ void operator()(const Acc& acc, const Unit& u, int wr, int wc, int fr, int fq) const {
        const int row0 = u.pm * BM + wr * 64 + fr, col0 = u.pn * BM + wc * 32 + 8 * fq;
#pragma unroll
        for (int ai = 0; ai < 2; ++ai)
#pragma unroll
            for (int m = 0; m < 4; ++m) { const int row = row0 + ai * HALF + m * 16; const float s = rs[row]; bf16* rowp = O + (size_t)row * ldc + col0;
#pragma unroll
                for (int bj = 0; bj < 2; ++bj) { const f32x4 v0 = acc[ai][bj][m][0] * s, v1 = acc[ai][bj][m][1] * s;
                    v4u w; w.x = cvt_pk_bf16(v0[0], v0[1]); w.y = cvt_pk_bf16(v0[2], v0[3]); w.z = cvt_pk_bf16(v1[0], v1[1]); w.w = cvt_pk_bf16(v1[2], v1[3]);
                    *(v4u*)(rowp + bj * HALF) = w; } }
    }
};
struct EpiResF32 {
    static constexpr bool PERM = false;
    const float* X; float* O; int ldc;
    __device__ __forceinline__ void operator()(const Acc& acc, const Unit& u, int wr, int wc, int fr, int fq) const {
        const int row0 = u.pm * BM + wr * 64 + fr, col0 = u.pn * BM + wc * 32 + 4 * fq;
#pragma unroll
        for (int ai = 0; ai < 2; ++ai)
#pragma unroll
            for (int m = 0; m < 4; ++m) { const size_t off = (size_t)(row0 + ai * HALF + m * 16) * ldc + col0;
#pragma unroll
                for (int bj = 0; bj < 2; ++bj)
#pragma unroll
                    for (int n = 0; n < 2; ++n) { const f32x4 xv = *(const f32x4*)(X + off + bj * HALF + n * 16); *(f32x4*)(O + off + bj * HALF + n * 16) = xv * ALPHA + acc[ai][bj][m][n]; }
                asm volatile("" ::: "memory"); }
    }
};
struct EpiSwiglu {
    static constexpr bool PERM = true;
    unsigned char* ACT; const float* bgu;
    __device__ __forceinline__ void operator()(const Acc& acc, const Unit& u, int wr, int wc, int fr, int fq) const {
        const int row0 = u.pm * BM + wr * 64 + fr, j0 = u.pn * HALF + wc * 32 + 8 * fq;
        const float* bg = bgu + (size_t)u.e * (2 * DFF) + j0; const float* bu = bg + DFF;
        const f32x4 bg0 = *(const f32x4*)bg, bg1 = *(const f32x4*)(bg + 4), bu0 = *(const f32x4*)bu, bu1 = *(const f32x4*)(bu + 4);
#pragma unroll
        for (int ai = 0; ai < 2; ++ai)
#pragma unroll
            for (int m = 0; m < 4; ++m) { unsigned char* rowp = ACT + (size_t)(row0 + ai * HALF + m * 16) * DFF + j0;
                float a[8];
#pragma unroll
                for (int n = 0; n < 2; ++n) { const f32x4 gv = acc[ai][0][m][n] * (1.0f / (SC_X * SC_WGU)) + (n ? bg1 : bg0), uv = acc[ai][1][m][n] * (1.0f / (SC_X * SC_WGU)) + (n ? bu1 : bu0);
#pragma unroll
                    for (int j = 0; j < 4; ++j) { const float g = fminf(gv[j], 7.0f), uu = fminf(fmaxf(uv[j], -7.0f), 7.0f);
                        const float sg = __builtin_amdgcn_rcpf(1.0f + __builtin_amdgcn_exp2f(g * (-1.702f * 1.4426950408889634f)));
                        a[n * 4 + j] = (uu + 1.0f) * g * sg * SC_ACT; } }
                v2u w; w.x = pk4_fp8(a[0], a[1], a[2], a[3]); w.y = pk4_fp8(a[4], a[5], a[6], a[7]);
                *(v2u*)rowp = w; }
    }
};
struct EpiDown {
    static constexpr bool PERM = true;
    bf16* Y; const float* bd; const float* rgate;
    __device__ __forceinline__ void operator()(const Acc& acc, const Unit& u, int wr, int wc, int fr, int fq) const {
        const int row0 = u.pm * BM + wr * 64 + fr, col0 = u.pn * BM + wc * 32 + 8 * fq;
        const float* bp = bd + (size_t)u.e * DM + col0;
        f32x4 bv[2][2];
#pragma unroll
        for (int bj = 0; bj < 2; ++bj)
#pragma unroll
            for (int n = 0; n < 2; ++n) bv[bj][n] = *(const f32x4*)(bp + bj * HALF + 4 * n);
#pragma unroll
        for (int ai = 0; ai < 2; ++ai)
#pragma unroll
            for (int m = 0; m < 4; ++m) { const int row = row0 + ai * HALF + m * 16; const float s = rgate[row]; bf16* rowp = Y + (size_t)row * DM + col0;
#pragma unroll
                for (int bj = 0; bj < 2; ++bj) { const f32x4 v0 = (acc[ai][bj][m][0] * (1.0f / (SC_ACT * SC_WD)) + bv[bj][0]) * s, v1 = (acc[ai][bj][m][1] * (1.0f / (SC_ACT * SC_WD)) + bv[bj][1]) * s;
                    v4u w; w.x = cvt_pk_bf16(v0[0], v0[1]); w.y = cvt_pk_bf16(v0[2], v0[3]); w.z = cvt_pk_bf16(v1[0], v1[1]); w.w = cvt_pk_bf16(v1[2], v1[3]);
                    *(v4u*)(rowp + bj * HALF) = w; } }
    }
};

template <class Epi, class Sched, bool F8 = false, bool ALIGN_EPI = true, bool SP2 = true>
__device__ __forceinline__ void gemm_phase(LAS unsigned char* lds, const Gemm g, const Sched& S, const Epi& E, const int wid  ) {
    const int lane = lane_id(), tid = wid * 64 + lane, wr = wid >> 2, wc = wid & 3, fr = lane & 15, fq = lane >> 4;
    const int nt = g.Kb / 128;
    const __amdgpu_buffer_rsrc_t rA = __builtin_amdgcn_make_buffer_rsrc((void*)g.A, 0, -1, 0x00020000);
    const __amdgpu_buffer_rsrc_t rB = __builtin_amdgcn_make_buffer_rsrc((void*)g.Bt, 0, -1, 0x00020000);
    unsigned voffA[2], voffB[2];
#pragma unroll
    for (int i = 0; i < 2; ++i) { int R, C; stage_rc(tid * 16 + i * 8192, R, C); const int Rb = Epi::PERM ? ((R & ~31) + perm32(R & 31)) : R;
        voffA[i] = (unsigned)(R * g.lda + C * 2); voffB[i] = (unsigned)(Rb * g.ldb + C * 2); }
    const unsigned kstep = 128u;
    const unsigned hstepA = (unsigned)HALF * g.lda, hstepB = (unsigned)HALF * g.ldb;
    const unsigned tstepA = 2 * hstepA, tstepB = 2 * hstepB;
    const unsigned ldsw = (unsigned)wid * 1024u;
    const int aoff = lds_byte(wr * 64 + fr, fq * 8), boff = lds_byte(wc * 32 + fr, fq * 8);
#define PG8_SA(b, h) (((b) * 2 + (h)) * HTB)
#define PG8_SB(b, h) ((4 + (b) * 2 + (h)) * HTB)
#define PG8_STAGE(bufoff, rsrc, soff, voff) do { _Pragma("unroll") for (int _i = 0; _i < 2; ++_i) \
        __builtin_amdgcn_raw_ptr_buffer_load_lds(rsrc, (LAS unsigned*)(lds + (bufoff) + ldsw + _i * 8192), 16, (voff)[_i], (soff), 0, 0); } while (0)
#define PG8_LDA(dst, b, h) do { _Pragma("unroll") for (int m = 0; m < 4; ++m) _Pragma("unroll") for (int k = 0; k < 2; ++k) dst[m][k] = *(const LAS bf16x8*)(lds + PG8_SA(b, h) + aoff + m * 2048 + k * 1024); } while (0)
#define PG8_LDB(dst, b, h) do { _Pragma("unroll") for (int n = 0; n < 2; ++n) _Pragma("unroll") for (int k = 0; k < 2; ++k) dst[n][k] = *(const LAS bf16x8*)(lds + PG8_SB(b, h) + boff + n * 2048 + k * 1024); } while (0)
#define PG8_MMA(ai, bj, At, Bt) do { __builtin_amdgcn_s_setprio(1); if constexpr (F8) { _Pragma("unroll") for (int m = 0; m < 4; ++m) _Pragma("unroll") for (int n = 0; n < 2; ++n) \
        acc[ai][bj][m][n] = __builtin_amdgcn_mfma_scale_f32_16x16x128_f8f6f4(cat8(Bt[n][0], Bt[n][1]), cat8(At[m][0], At[m][1]), acc[ai][bj][m][n], 0, 0, 0, 0, 0, 0); } \
        else { _Pragma("unroll") for (int m = 0; m < 4; ++m) _Pragma("unroll") for (int n = 0; n < 2; ++n) _Pragma("unroll") for (int k = 0; k < 2; ++k) \
        acc[ai][bj][m][n] = __builtin_amdgcn_mfma_f32_16x16x32_bf16(Bt[n][k], At[m][k], acc[ai][bj][m][n], 0, 0, 0); } __builtin_amdgcn_s_setprio(0); } while (0)
#define PG8_WAIT_V(n) asm volatile("s_waitcnt vmcnt(" #n ")" ::: "memory")
#define PG8_WAIT_L(n) asm volatile("s_waitcnt lgkmcnt(" #n ")" ::: "memory")
#define PG8_BAR __builtin_amdgcn_s_barrier()
#define PG8_SCHED __builtin_amdgcn_sched_barrier(0)
    Unit cur, nxt; int ui = 0;
    if (!S.next(0, cur)) return;
    Acc acc;
#pragma unroll
    for (int a = 0; a < 2; ++a)
#pragma unroll
        for (int b = 0; b < 2; ++b)
#pragma unroll
            for (int m = 0; m < 4; ++m)
#pragma unroll
                for (int n = 0; n < 2; ++n) acc[a][b][m][n] = (f32x4){0.f, 0.f, 0.f, 0.f};
    bf16x8 At[4][2], B0[2][2], B1[2][2];
    unsigned cA = (unsigned)cur.pm * tstepA, cB = (unsigned)((size_t)cur.e * g.bes) + (unsigned)cur.pn * tstepB;
    if constexpr (SP2) {
        PG8_STAGE(PG8_SB(0, 0), rB, cB, voffB); PG8_STAGE(PG8_SB(0, 1), rB, cB + hstepB, voffB); PG8_STAGE(PG8_SA(0, 0), rA, cA, voffA); PG8_STAGE(PG8_SA(0, 1), rA, cA + hstepA, voffA);
        if (wr == 1) PG8_BAR;
        PG8_WAIT_V(2); PG8_BAR;
        PG8_STAGE(PG8_SB(1, 0), rB, cB + kstep, voffB); PG8_STAGE(PG8_SA(1, 0), rA, cA + kstep, voffA); PG8_STAGE(PG8_SB(1, 1), rB, cB + hstepB + kstep, voffB);
        PG8_WAIT_V(6); PG8_BAR;
    } else {
        PG8_STAGE(PG8_SB(0, 0), rB, cB, voffB); PG8_STAGE(PG8_SA(0, 0), rA, cA, voffA); PG8_STAGE(PG8_SB(0, 1), rB, cB + hstepB, voffB); PG8_STAGE(PG8_SA(0, 1), rA, cA + hstepA, voffA);
        if (wr == 1) PG8_BAR;
        PG8_WAIT_V(4); PG8_BAR;
        PG8_STAGE(PG8_SB(1, 0), rB, cB + kstep, voffB); PG8_STAGE(PG8_SA(1, 0), rA, cA + kstep, voffA); PG8_STAGE(PG8_SB(1, 1), rB, cB + hstepB + kstep, voffB);
        PG8_WAIT_V(6); PG8_BAR;
    }
    for (;;) {
        const bool has_next = S.next(ui + 1, nxt);
        const unsigned nA = has_next ? (unsigned)nxt.pm * tstepA : cA; const unsigned nB = has_next ? (unsigned)((size_t)nxt.e * g.bes) + (unsigned)nxt.pn * tstepB : cB;
        for (int t = 0; t < nt; t += 2) {
            const bool last = (t == nt - 2);
            const unsigned a1 = cA + (unsigned)(t + 1) * kstep;
            const unsigned a2 = last ? nA : cA + (unsigned)(t + 2) * kstep; const unsigned b2 = last ? nB : cB + (unsigned)(t + 2) * kstep;
            const unsigned a3 = a2 + kstep; const unsigned b3 = b2 + kstep;
            if constexpr (SP2) {
            PG8_LDB(B0, 0, 0); PG8_LDB(B1, 0, 1); PG8_SCHED; PG8_LDA(At, 0, 0); PG8_STAGE(PG8_SA(1, 1), rA, a1 + hstepA, voffA);
            PG8_WAIT_V(8); PG8_WAIT_L(0); PG8_BAR; PG8_MMA(0, 0, At, B0); PG8_MMA(0, 1, At, B1); PG8_BAR; PG8_SCHED;
            PG8_LDA(At, 0, 1); PG8_STAGE(PG8_SB(0, 0), rB, b2, voffB); PG8_STAGE(PG8_SB(0, 1), rB, b2 + hstepB, voffB); PG8_STAGE(PG8_SA(0, 0), rA, a2, voffA);
            PG8_WAIT_V(8); PG8_WAIT_L(0); PG8_BAR; PG8_MMA(1, 0, At, B0); PG8_MMA(1, 1, At, B1); PG8_BAR; PG8_SCHED;
            PG8_LDB(B0, 1, 0); PG8_LDB(B1, 1, 1); PG8_SCHED; PG8_LDA(At, 1, 0); PG8_STAGE(PG8_SA(0, 1), rA, a2 + hstepA, voffA);
            PG8_WAIT_V(8); PG8_WAIT_L(0); PG8_BAR; PG8_MMA(0, 0, At, B0); PG8_MMA(0, 1, At, B1); PG8_BAR; PG8_SCHED;
            PG8_LDA(At, 1, 1); PG8_STAGE(PG8_SB(1, 0), rB, b3, voffB); PG8_STAGE(PG8_SB(1, 1), rB, b3 + hstepB, voffB); PG8_STAGE(PG8_SA(1, 0), rA, a3, voffA);
            PG8_WAIT_V(8); PG8_WAIT_L(0); PG8_BAR; PG8_MMA(1, 0, At, B0); PG8_MMA(1, 1, At, B1); PG8_BAR; PG8_SCHED;
            } else {
            PG8_LDB(B0, 0, 0); PG8_SCHED; PG8_LDA(At, 0, 0); PG8_STAGE(PG8_SA(1, 1), rA, a1 + hstepA, voffA);
            PG8_WAIT_L(8); PG8_BAR; PG8_WAIT_L(0); PG8_MMA(0, 0, At, B0); PG8_BAR; PG8_SCHED;
            PG8_LDB(B1, 0, 1); PG8_STAGE(PG8_SB(0, 0), rB, b2, voffB);
            PG8_BAR; PG8_WAIT_L(0); PG8_MMA(0, 1, At, B1); PG8_BAR;
            PG8_LDA(At, 0, 1); PG8_STAGE(PG8_SA(0, 0), rA, a2, voffA);
            PG8_BAR; PG8_WAIT_L(0); PG8_MMA(1, 0, At, B0); PG8_BAR; PG8_SCHED;
            PG8_STAGE(PG8_SB(0, 1), rB, b2 + hstepB, voffB);
            PG8_WAIT_V(6); PG8_BAR; PG8_MMA(1, 1, At, B1); PG8_BAR;
            PG8_LDB(B0, 1, 0); PG8_SCHED; PG8_LDA(At, 1, 0); PG8_STAGE(PG8_SA(0, 1), rA, a2 + hstepA, voffA);
            PG8_WAIT_L(8); PG8_BAR; PG8_WAIT_L(0); PG8_MMA(0, 0, At, B0); PG8_BAR; PG8_SCHED;
            PG8_LDB(B1, 1, 1); PG8_STAGE(PG8_SB(1, 0), rB, b3, voffB);
            PG8_BAR; PG8_WAIT_L(0); PG8_MMA(0, 1, At, B1); PG8_BAR;
            PG8_LDA(At, 1, 1); PG8_STAGE(PG8_SA(1, 0), rA, a3, voffA);
            PG8_BAR; PG8_WAIT_L(0); PG8_MMA(1, 0, At, B0); PG8_BAR; PG8_SCHED;
            PG8_STAGE(PG8_SB(1, 1), rB, b3 + hstepB, voffB);
            PG8_WAIT_V(6); PG8_BAR; PG8_MMA(1, 1, At, B1); PG8_BAR;
            }
        }
        if constexpr (ALIGN_EPI) { if (wr == 0) PG8_BAR; }
        { const int l2 = lane_id(); E(acc, cur, wr, wc, l2 & 15, l2 >> 4); }
        if (!has_next) break;
#pragma unroll
        for (int a = 0; a < 2; ++a)
#pragma unroll
            for (int b = 0; b < 2; ++b)
#pragma unroll
                for (int m = 0; m < 4; ++m)
#pragma unroll
                    for (int n = 0; n < 2; ++n) acc[a][b][m][n] = (f32x4){0.f, 0.f, 0.f, 0.f};
        cur = nxt; cA = nA; cB = nB; ++ui;
        if constexpr (ALIGN_EPI) { if (wr == 1) PG8_BAR; }
    }
    PG8_WAIT_V(0);
    if constexpr (!ALIGN_EPI) { if (wr == 0) PG8_BAR; }
    PG8_BAR;
#undef PG8_SA
#undef PG8_SB
#undef PG8_STAGE
#undef PG8_LDA
#undef PG8_LDB
#undef PG8_MMA
#undef PG8_WAIT_V
#undef PG8_WAIT_L
#undef PG8_BAR
#undef PG8_SCHED
}
}

namespace at {
constexpr int SHM_V = 16384, SHM_K = 16384, SHM_K2 = 8192;
constexpr int OFF_V = 0, OFF_K = 2 * SHM_V, OFF_K2 = OFF_K + 2 * SHM_K, OFF_WS = OFF_K2 + 2 * SHM_K2, ATTN_LDS = OFF_WS + 8 * 64 * 4;
#define KSWZ(row, colB) ((row) * 256 + ((colB) ^ (((row) & 7) << 4)))
#define K2SWZ(row, colB) ((row) * 128 + ((colB) ^ ((((row) >> 1) & 7) << 4)))
__device__ __forceinline__ int v_st(int k, int c) { const int kk = (k & ~0xC) | ((k & 4) << 1) | ((k & 8) >> 1); return ((kk >> 3) * 4 + (c >> 5)) * 512 + ((kk & 7) * 32 + (c & 31)) * 2; }
__device__ __forceinline__ int v_rd_base(int lane) { return ((lane & 3) << 3) | (((lane >> 2) & 3) << 6) | (((lane >> 4) & 1) << 5) | (((lane >> 5) & 1) << 8); }
constexpr int v_rd_off(int d0, int ks, int half) { return d0 * 512 + ks * 4096 + half * 2048; }
__device__ __forceinline__ int crow(int r, int hi) { return (r & 3) + 8 * (r >> 2) + 4 * hi; }

template <int VB>
__device__ __forceinline__ void pv_tile(f32x16* o, int vb0, bf16x8 pa0, bf16x8 pa1, bf16x8 pa2, bf16x8 pa3) {
#define TRRD(dst, off) asm volatile("ds_read_b64_tr_b16 %0, %1 offset:%2" : "=&v"(dst) : "v"(vb0), "i"(off) : "memory")
#define PV_D0(d0) do { s16x4 l0, l1, l2, l3, h0, h1, h2, h3; constexpr int b_ = VB * SHM_V + v_rd_off(d0, 0, 0); \
        TRRD(l0, b_); TRRD(h0, b_ + 2048); TRRD(l1, b_ + 4096); TRRD(h1, b_ + 6144); TRRD(l2, b_ + 8192); TRRD(h2, b_ + 10240); TRRD(l3, b_ + 12288); TRRD(h3, b_ + 14336); \
        asm volatile("s_waitcnt lgkmcnt(0)" ::: "memory"); SBAR(); \
        o[d0] = __builtin_amdgcn_mfma_f32_32x32x16_bf16(pa0, (bf16x8){l0[0], l0[1], l0[2], l0[3], h0[0], h0[1], h0[2], h0[3]}, o[d0], 0, 0, 0); \
        o[d0] = __builtin_amdgcn_mfma_f32_32x32x16_bf16(pa1, (bf16x8){l1[0], l1[1], l1[2], l1[3], h1[0], h1[1], h1[2], h1[3]}, o[d0], 0, 0, 0); \
        o[d0] = __builtin_amdgcn_mfma_f32_32x32x16_bf16(pa2, (bf16x8){l2[0], l2[1], l2[2], l2[3], h2[0], h2[1], h2[2], h2[3]}, o[d0], 0, 0, 0); \
        o[d0] = __builtin_amdgcn_mfma_f32_32x32x16_bf16(pa3, (bf16x8){l3[0], l3[1], l3[2], l3[3], h3[0], h3[1], h3[2], h3[3]}, o[d0], 0, 0, 0); } while (0)
    PV_D0(0); PV_D0(1); PV_D0(2); PV_D0(3);
#undef PV_D0
#undef TRRD
}

struct St { bf16x8 k0, k1, v0, v1, k2; };

template <bool MLA>
__device__ __forceinline__ void attn_unit(const bf16* Qp, int ldq, const bf16* Kp, const bf16* Vp, int ldk, const bf16* K2p, bf16* Op, int ldo, int qb, const unsigned* selp, char* lds, const int wid) {
    constexpr float SCALE = MLA ? 0.07216878364870322f : 0.08838834764831845f;
    constexpr float C2 = 1.4426950408889634f * SCALE, THR = 8.f;
    const int lane = lane_id(), tid = wid * 64 + lane, r32 = lane & 31, hi = lane >> 5;
    const int q0 = qb * 256, qlo = q0 + wid * 32, qrow = qlo + r32, qm = qrow - 4 * hi;
    char* V_lds = lds + OFF_V; char* K_lds = lds + OFF_K; char* K2_lds = lds + OFF_K2;
    float* ws = (float*)(lds + OFF_WS) + wid * 64; float* li_l = ws; float* al_l = ws + 32;
    bf16x8 qr[8], qr2[4];
    { const bf16* Qw = Qp + (size_t)qrow * ldq + hi * 8;
#pragma unroll
      for (int d0 = 0; d0 < 8; ++d0) qr[d0] = *(const bf16x8*)(Qw + d0 * 16);
      if constexpr (MLA) {
#pragma unroll
          for (int d0 = 0; d0 < 4; ++d0) qr2[d0] = *(const bf16x8*)(Qw + 128 + d0 * 16); } }
    unsigned sel = 0u; if constexpr (!MLA) sel = selp[(size_t)qrow * NH];
    const int sr = tid >> 4, sc = (tid & 15) * 8, vst0 = v_st(sr, sc), vst1 = v_st(32 + sr, sc), kws = KSWZ(sr, sc * 2);
    const int k2r = tid >> 3, k2c = (tid & 7) * 8, k2ws = K2SWZ(k2r, k2c * 2);
    const int vb0 = (int)(uintptr_t)V_lds + v_rd_base(lane);
    float m_reg = -1e30f, l_reg = 0.f; f32x16 o[4];
#pragma unroll
    for (int d = 0; d < 4; ++d) o[d] = f32x16{};
    St S;
#define SLOAD(k0_) do { S.v0 = *(const bf16x8*)(Vp + (size_t)((k0_) + sr) * ldk + sc); S.v1 = *(const bf16x8*)(Vp + (size_t)((k0_) + 32 + sr) * ldk + sc); \
        S.k0 = *(const bf16x8*)(Kp + (size_t)((k0_) + sr) * ldk + sc); S.k1 = *(const bf16x8*)(Kp + (size_t)((k0_) + 32 + sr) * ldk + sc); \
        if constexpr (MLA) S.k2 = *(const bf16x8*)(K2p + (size_t)((k0_) + k2r) * ROPE + k2c); } while (0)
#define SWRITE(bf) do { *(bf16x8*)(V_lds + (bf) * SHM_V + vst0) = S.v0; *(bf16x8*)(V_lds + (bf) * SHM_V + vst1) = S.v1; \
        *(bf16x8*)(K_lds + (bf) * SHM_K + kws) = S.k0; *(bf16x8*)(K_lds + (bf) * SHM_K + kws + 32 * 256) = S.k1; \
        if constexpr (MLA) *(bf16x8*)(K2_lds + (bf) * SHM_K2 + k2ws) = S.k2; } while (0)
    const int NT = 4 * (qb + 1);
    SLOAD(0); VM_WAIT(); SWRITE(0); __syncthreads();
#define TILE_STEP(BF, t_) do { const int t = (t_); const int kb = t * 64; \
        if (t + 1 < NT) SLOAD(kb + 64); \
        bool act = kb <= qlo + 31; const int jblk = t >> 2; \
        if constexpr (!MLA) { if (jblk < qb) act = __any((int)((sel >> jblk) & 1u)) != 0; } \
        if (act) { \
            f32x16 p0 = f32x16{}, p1 = f32x16{}; \
            { const char* kbs[4]; _Pragma("unroll") for (int dd = 0; dd < 4; ++dd) kbs[dd] = K_lds + (BF) * SHM_K + KSWZ(r32, (dd * 16 + hi * 8) * 2); \
              _Pragma("unroll") for (int d0 = 0; d0 < 8; ++d0) { const char* a = kbs[d0 & 3] + (d0 >> 2) * 128; \
                const bf16x8 b0 = *(const bf16x8*)a; const bf16x8 b1 = *(const bf16x8*)(a + 32 * 256); \
                p0 = __builtin_amdgcn_mfma_f32_32x32x16_bf16(b0, qr[d0], p0, 0, 0, 0); p1 = __builtin_amdgcn_mfma_f32_32x32x16_bf16(b1, qr[d0], p1, 0, 0, 0); } } \
            if constexpr (MLA) { _Pragma("unroll") for (int d0 = 0; d0 < 4; ++d0) { const char* a = K2_lds + (BF) * SHM_K2 + K2SWZ(r32, (d0 * 16 + hi * 8) * 2); \
                const bf16x8 b0 = *(const bf16x8*)a; const bf16x8 b1 = *(const bf16x8*)(a + 32 * 128); \
                p0 = __builtin_amdgcn_mfma_f32_32x32x16_bf16(b0, qr2[d0], p0, 0, 0, 0); p1 = __builtin_amdgcn_mfma_f32_32x32x16_bf16(b1, qr2[d0], p1, 0, 0, 0); } } \
            const float NEG = -__builtin_inff(); \
            if (kb + 63 > qlo) { const int dq = qm - kb; \
                _Pragma("unroll") for (int r = 0; r < 16; ++r) { const int c = (r & 3) + 8 * (r >> 2); if (dq - c < 0) p0[r] = NEG; if (dq - c - 32 < 0) p1[r] = NEG; } } \
            if constexpr (!MLA) { if (jblk < qb) { if (((sel >> jblk) & 1u) == 0u) { _Pragma("unroll") for (int r = 0; r < 16; ++r) { p0[r] = NEG; p1[r] = NEG; } } } } \
            float pmax = p0[0]; _Pragma("unroll") for (int r = 1; r < 16; ++r) pmax = fmaxf(pmax, p0[r]); _Pragma("unroll") for (int r = 0; r < 16; ++r) pmax = fmaxf(pmax, p1[r]); \
            { auto rr = __builtin_amdgcn_permlane32_swap(__float_as_uint(pmax), __float_as_uint(pmax), false, false); pmax = fmaxf(__uint_as_float(rr[0]), __uint_as_float(rr[1])); } \
            float mn, alpha; \
            if (__builtin_expect(__all((pmax - m_reg) * SCALE <= THR), 1)) { mn = m_reg; alpha = 1.f; } \
            else { mn = fmaxf(m_reg, pmax); alpha = __builtin_amdgcn_exp2f((m_reg - mn) * C2); m_reg = mn; } \
            const float mnL = -mn * C2; \
            _Pragma("unroll") for (int r = 0; r < 16; ++r) { p0[r] = __builtin_amdgcn_exp2f(fmaf(p0[r], C2, mnL)); p1[r] = __builtin_amdgcn_exp2f(fmaf(p1[r], C2, mnL)); } \
            float ps = 0.f; _Pragma("unroll") for (int r = 0; r < 16; ++r) ps += p0[r]; _Pragma("unroll") for (int r = 0; r < 16; ++r) ps += p1[r]; \
            { auto rr = __builtin_amdgcn_permlane32_swap(__float_as_uint(ps), __float_as_uint(ps), false, false); ps = __uint_as_float(rr[0]) + __uint_as_float(rr[1]); } \
            l_reg = l_reg * alpha + ps; \
            if (__any(alpha < 1.f)) { if (hi == 0) al_l[r32] = alpha; LDS_WAIT(); \
                _Pragma("unroll") for (int d_ = 0; d_ < 4; ++d_) _Pragma("unroll") for (int r = 0; r < 16; ++r) o[d_][r] *= al_l[crow(r, hi)]; } \
            bf16x8 pa0, pa1, pa2, pa3; \
            PK4(p0, 0, pa0); PK4(p0, 8, pa1); PK4(p1, 0, pa2); PK4(p1, 8, pa3); \
            SBAR(); pv_tile<BF>(o, vb0, pa0, pa1, pa2, pa3); \
        } \
        if (t + 1 < NT) { VM_WAIT(); SWRITE((BF) ^ 1); } \
        __syncthreads(); } while (0)
#define PK4(P, B_, OUT) do { const unsigned a0 = cvt_pk_bf16(P[B_+0], P[B_+1]), a1 = cvt_pk_bf16(P[B_+2], P[B_+3]); \
        const unsigned b0_ = cvt_pk_bf16(P[B_+4], P[B_+5]), b1_ = cvt_pk_bf16(P[B_+6], P[B_+7]); \
        auto r0 = __builtin_amdgcn_permlane32_swap(a0, b0_, false, false); auto r1 = __builtin_amdgcn_permlane32_swap(a1, b1_, false, false); \
        v4u w = {r0[0], r1[0], r0[1], r1[1]}; OUT = *reinterpret_cast<bf16x8*>(&w); } while (0)
    for (int t2 = 0; t2 < NT; t2 += 2) { TILE_STEP(0, t2); TILE_STEP(1, t2 + 1); }
#undef PK4
#undef TILE_STEP
#undef SLOAD
#undef SWRITE
    if (hi == 0) li_l[r32] = l_reg; LDS_WAIT();
    float rli[16];
#pragma unroll
    for (int r = 0; r < 16; ++r) rli[r] = __builtin_amdgcn_rcpf(li_l[crow(r, hi)]);
    bf16* Ow = Op + (size_t)qlo * ldo;
#pragma unroll
    for (int r = 0; r < 16; ++r) { const int orow = crow(r, hi);
#pragma unroll
        for (int d0 = 0; d0 < 4; ++d0) { const float v = o[d0][r] * rli[r]; const float vn = __shfl_xor(v, 1);
            if ((r32 & 1) == 0) *(unsigned*)(Ow + (size_t)orow * ldo + d0 * 32 + r32) = cvt_pk_bf16(v, vn); } }
    __syncthreads();
}
}

#define XB_TMO      128
#define XB_XCNT(j)  (256  + 64 * (j))
#define XB_XSUB(j)  (1280 + 64 * (j))
#define XB_XGEN(j)  (2304 + 64 * (j))
#define XB_TOP      3328
#define XB_TOPGEN   3392
#define XCD_BAR_WORDS 3456
#define XB_SPIN_CAP (1u << 18)
__device__ __forceinline__ unsigned xb_ld(unsigned* p)              { return __hip_atomic_load(p, __ATOMIC_RELAXED, __HIP_MEMORY_SCOPE_AGENT); }
__device__ __forceinline__ unsigned xb_add(unsigned* p, unsigned v) { return __hip_atomic_fetch_add(p, v, __ATOMIC_RELAXED, __HIP_MEMORY_SCOPE_AGENT); }
__device__ __forceinline__ unsigned xb_xcc_id() { return (unsigned)__builtin_amdgcn_s_getreg((3 << 11) | 20) & 0xFu; }
#define XB_SPIN(cond, bar) do { unsigned _sp = 0; while (cond) { __builtin_amdgcn_s_sleep(1); \
    if ((++_sp & 255u) == 0u) { if (xb_ld(&(bar)[XB_TMO])) break; if (_sp > XB_SPIN_CAP) { atomicAdd(&(bar)[XB_TMO], 1u); break; } } } } while (0)
struct XcdBarrier { unsigned* bar; unsigned x; volatile LAS unsigned* st; };
__device__ __forceinline__ XcdBarrier xcd_barrier_post(unsigned* bar, volatile LAS unsigned* st, bool t0  ) {
    XcdBarrier b; b.bar = bar; b.x = xb_xcc_id(); b.st = st;
    if (t0) (void)xb_add(&bar[XB_XCNT(b.x)], 1u);
    return b;
}
__device__ __forceinline__ void xcd_barrier_complete(unsigned* bar, unsigned x, unsigned& nloc, unsigned& nx) {
    const unsigned G = gridDim.x * gridDim.y * gridDim.z;
    unsigned sum, cnt, mine, sp = 0u;
    for (;;) {
        sum = 0u; cnt = 0u; mine = 0u;
#pragma unroll
        for (unsigned j = 0; j < 16; ++j) { const unsigned c = xb_ld(&bar[XB_XCNT(j)]); sum += c; cnt += (c > 0u) ? 1u : 0u; mine = (j == x) ? c : mine; }
        if (sum == G) break;
        __builtin_amdgcn_s_sleep(1);
        if ((++sp & 255u) == 0u) { if (xb_ld(&bar[XB_TMO])) break; if (sp > XB_SPIN_CAP) { atomicAdd(&bar[XB_TMO], 1u); break; } }
    }
    nloc = mine > 0u ? mine : 1u; nx = cnt > 0u ? cnt : 1u;
}
__device__ __forceinline__ void xcd_barrier(const XcdBarrier& b, bool t0  ) {
    asm volatile("s_waitcnt vmcnt(0)" ::: "memory");
    __syncthreads();
    if (t0) {
        unsigned* bar = b.bar;
        __builtin_amdgcn_s_waitcnt(0);
        unsigned nloc = b.st[0], nx = b.st[1];
        if (nloc == 0u) { xcd_barrier_complete(bar, b.x, nloc, nx); b.st[0] = nloc; b.st[1] = nx; }
        const unsigned old = xb_add(&bar[XB_XSUB(b.x)], 1u);
        const unsigned gen = old / nloc;
        if (old + 1u == (gen + 1u) * nloc) {
            __builtin_amdgcn_fence(__ATOMIC_RELEASE, "agent");
            asm volatile("s_waitcnt vmcnt(0)" ::: "memory");
            const unsigned og = xb_add(&bar[XB_TOP], 1u);
            const unsigned tg = og / nx;
            if (og + 1u == (tg + 1u) * nx) xb_add(&bar[XB_TOPGEN], 1u);
            else XB_SPIN(xb_ld(&bar[XB_TOPGEN]) == tg, bar);
            __builtin_amdgcn_fence(__ATOMIC_ACQUIRE, "agent");
            xb_add(&bar[XB_XGEN(b.x)], 1u);
            asm volatile("s_waitcnt vmcnt(0)" ::: "memory");
        } else {
            XB_SPIN(xb_ld(&bar[XB_XGEN(b.x)]) == gen, bar);
            __builtin_amdgcn_fence(__ATOMIC_ACQUIRE, "agent");
            asm volatile("s_waitcnt vmcnt(0)" ::: "memory");
        }
    }
    __syncthreads();
}

struct Args {
    const float* x; const int* pos; const float* w_in; const float* g_q_a; const float* w_q_b; const float* g_kv_a; const float* w_kv_b;
    const float* g_out_mla; const float* g_out_moba; const float* w_o; const float* ln1_g; const float* ln1_b; const float* w_router; const float* b_router;
    const float* w_gate_up; const float* b_gate_up; const float* w_down; const float* b_down; const float* ln2_g; const float* ln2_b;
    float* out; unsigned char* ws; int ph_lo, ph_hi;
};
constexpr int NPHASES = 14;

__device__ __forceinline__ void tr_item(const float* W, int N, bf16* WT, int K, LAS float* scr, int k0, int n0, int prow0, const float* sc, int lane) {
    { float tv[64]; const float* wp = W + (size_t)k0 * N + n0 + lane;
#pragma unroll
      for (int i = 0; i < 64; ++i) tv[i] = wp[(size_t)i * N];
#pragma unroll
      for (int i = 0; i < 64; ++i) scr[i * 65 + lane] = tv[i]; }
    LDS_WAIT(); asm volatile("" ::: "memory");
    const int c = lane & 7;
    float s8[8];
#pragma unroll
    for (int i = 0; i < 8; ++i) s8[i] = sc ? sc[k0 + 8 * c + i] : 1.0f;
#pragma unroll
    for (int j = 0; j < 8; ++j) { const int n = j * 8 + (lane >> 3); const LAS float* s = scr + (8 * c) * 65 + n;
        v4u o; o.x = cvt_pk_bf16(s[0] * s8[0], s[65] * s8[1]); o.y = cvt_pk_bf16(s[2 * 65] * s8[2], s[3 * 65] * s8[3]);
        o.z = cvt_pk_bf16(s[4 * 65] * s8[4], s[5 * 65] * s8[5]); o.w = cvt_pk_bf16(s[6 * 65] * s8[6], s[7 * 65] * s8[7]);
        *(v4u*)(WT + (size_t)(prow0 + n) * K + k0 + 8 * c) = o; }
    LDS_WAIT(); asm volatile("" ::: "memory");
}
__device__ __forceinline__ void tr_item_f8(const float* W, int N, unsigned char* WT, int K, LAS float* scr, int k0, int n0, int prow0, float cs, int lane) {
    { float tv[64]; const float* wp = W + (size_t)k0 * N + n0 + lane;
#pragma unroll
      for (int i = 0; i < 64; ++i) tv[i] = wp[(size_t)i * N];
#pragma unroll
      for (int i = 0; i < 64; ++i) scr[i * 65 + lane] = tv[i]; }
    LDS_WAIT(); asm volatile("" ::: "memory");
    const int c = lane & 3;
#pragma unroll
    for (int j = 0; j < 4; ++j) { const int n = j * 16 + (lane >> 2); const LAS float* s = scr + (16 * c) * 65 + n;
        v4u o; o.x = pk4_fp8(s[0] * cs, s[65] * cs, s[2 * 65] * cs, s[3 * 65] * cs); o.y = pk4_fp8(s[4 * 65] * cs, s[5 * 65] * cs, s[6 * 65] * cs, s[7 * 65] * cs);
        o.z = pk4_fp8(s[8 * 65] * cs, s[9 * 65] * cs, s[10 * 65] * cs, s[11 * 65] * cs); o.w = pk4_fp8(s[12 * 65] * cs, s[13 * 65] * cs, s[14 * 65] * cs, s[15 * 65] * cs);
        *(v4u*)(WT + (size_t)(prow0 + n) * K + k0 + 16 * c) = o; }
    LDS_WAIT(); asm volatile("" ::: "memory");
}
__device__ __forceinline__ void sincos_d(double x, float& sn, float& cs) {
    const double inv2pi = 0.15915494309189533577, pi2hi = 6.283185307179586232, pi2lo = 2.4492935982947064e-16;
    const double n = rint(x * inv2pi); double r = fma(-n, pi2hi, x); r = fma(-n, pi2lo, r);
    const double r2 = r * r; double s = 1.0, c = 1.0;
    double ts = 0.0, tc = 0.0;
#pragma unroll
    for (int k = 14; k >= 1; --k) { ts = (ts + 1.0) * (-r2 * (1.0 / (double)((2 * k) * (2 * k + 1)))); tc = (tc + 1.0) * (-r2 * (1.0 / (double)((2 * k - 1) * (2 * k)))); }
    s = r * (1.0 + ts); c = 1.0 + tc; sn = (float)s; cs = (float)c;
}

#define XB   ((bf16*)(ws + WS_XB))
#define WIN  ((bf16*)(ws + WS_WIN))
#define WQB  ((bf16*)(ws + WS_WQB))
#define WKVB ((bf16*)(ws + WS_WKVB))
#define WO   ((bf16*)(ws + WS_WO))
#define C128 ((float*)(ws + WS_C128))
#define S128 ((float*)(ws + WS_S128))
#define C64  ((float*)(ws + WS_C64))
#define S64  ((float*)(ws + WS_S64))
#define HQ   ((bf16*)(ws + WS_HQ))
#define HKV  ((bf16*)(ws + WS_HKV))
#define HR   ((bf16*)(ws + WS_HR))
#define KPE  ((bf16*)(ws + WS_KPE))
#define MQ   ((bf16*)(ws + WS_MQ))
#define MK   ((bf16*)(ws + WS_MK))
#define MV   ((bf16*)(ws + WS_MV))
#define RSQ  ((float*)(ws + WS_RSQ))
#define RSKV ((float*)(ws + WS_RSKV))
#define QM   ((bf16*)(ws + WS_QM))
#define KVM  ((bf16*)(ws + WS_KVM))
#define KBAR ((float*)(ws + WS_KBAR))
#define SEL  ((unsigned*)(ws + WS_SEL))
#define OMIX ((bf16*)(ws + WS_OMIX))
#define X1P  ((float*)(ws + WS_X1P))
#define X1N  ((float*)(ws + WS_X1N))
#define X1B  ((unsigned char*)(ws + WS_X1B))
#define TOPE ((int*)(ws + WS_TOPE))
#define TOPR ((int*)(ws + WS_TOPR))
#define TOPG ((float*)(ws + WS_TOPG))
#define TOPROW ((int*)(ws + WS_TOPROW))
#define RGATE ((float*)(ws + WS_RGATE))
#define XG   ((unsigned char*)(ws + WS_XG))
#define ACT  ((unsigned char*)(ws + WS_ACT))
#define YB   ((bf16*)(ws + WS_Y))
#define WGU  ((unsigned char*)(ws + WS_WGU))
#define WD   ((unsigned char*)(ws + WS_WD))
__device__ __forceinline__ GAS unsigned char* opq(const void* p) { GAS unsigned char* q = (GAS unsigned char*)p; asm volatile("" : "+s"(q)); return q; }
typedef const __attribute__((address_space(4))) struct Args* KArgs;
__device__ __forceinline__ KArgs kargs() { auto p = __builtin_amdgcn_kernarg_segment_ptr(); asm volatile("" : "+s"(p)); return (KArgs)p; }

__global__ void __launch_bounds__(512, 2) fwd(Args a) {
    extern __shared__ __attribute__((aligned(16))) unsigned char lds[];
    LAS unsigned char* L = (LAS unsigned char*)lds;
    const int wave = __builtin_amdgcn_readfirstlane((int)threadIdx.x >> 6);
    const int G = gridDim.x, bid = blockIdx.x;
    const int gw = bid * 8 + wave, NGW = G * 8;
    const int NGT = G * 512;
    gu32* ctl = (gu32*)(a.ws + WS_CTL);
    for (int u = wave * 64 + lane_id(); u < (LDS_BYTES - LDSCTL_OFF) / 4; u += 512) ((LAS unsigned*)(L + LDSCTL_OFF))[u] = 0u;
    __syncthreads();
    XcdBarrier bar; bar.bar = (unsigned*)(ctl + CW_BAR); bar.x = 0; bar.st = nullptr;
    if (MK_N_LAUNCHES == 1) bar = xcd_barrier_post((unsigned*)(ctl + CW_BAR), (volatile LAS unsigned*)(L + LDSCTL_OFF), wave == 0 && lane_id() == 0);
    const int lo = a.ph_lo, hi = a.ph_hi;
#define IN(k) (lo <= (k) && (k) < hi)
#define REPS(k) ((((PROBE_REP_MASK) >> (k)) & 1) + 1)
#define SEAM(k) do { if (IN(k) && IN((k) + 1)) { XcdBarrier b2_ = bar; b2_.bar = (unsigned*)(opq(kargs()->ws) + WS_CTL + (size_t)CW_BAR * 4); xcd_barrier(b2_, wave == 0 && lane_id() == 0); } } while (0)

    if (IN(0)) for (int rep_ = 0; rep_ < REPS(0); ++rep_) { KArgs ka = kargs(); GAS unsigned char* ws = opq(ka->ws); const int lane = lane_id(), tid = wave * 64 + lane, gt = bid * 512 + tid; (void)gt;
        LAS float* scr = (LAS float*)(L + wave * 16640);
        constexpr int I0 = 32 * 61, I1 = 8 * 24, I2 = 4 * 32, I3 = 32 * 32, I4 = NE * 32 * 64, I5 = NE * 32 * 32;
        constexpr int NIT = I0 + I1 + I2 + I3 + I4 + I5;
        for (int it = gw; it < NIT; it += NGW) {
            int r = it;
            if (r < I0) { const int kb = r / 61, nb = r % 61, n0 = nb * 64; tr_item(((const float*)(GAS const float*)ka->w_in), INC, WIN, DM, scr, kb * 64, n0, n0 < 832 ? n0 : n0 + 192, nullptr, lane); continue; } r -= I0;
            if (r < I1) { const int kb = r / 24, nb = r % 24; tr_item(((const float*)(GAS const float*)ka->w_q_b), 1536, WQB, QLORA, scr, kb * 64, nb * 64, nb * 64, ((const float*)(GAS const float*)ka->g_q_a), lane); continue; } r -= I1;
            if (r < I2) { const int kb = r / 32, nb = r % 32; tr_item(((const float*)(GAS const float*)ka->w_kv_b), 2048, WKVB, KVLORA, scr, kb * 64, nb * 64, nb * 64, ((const float*)(GAS const float*)ka->g_kv_a), lane); continue; } r -= I2;
            if (r < I3) { const int kb = r / 32, nb = r % 32; tr_item(((const float*)(GAS const float*)ka->w_o), DM, WO, DM, scr, kb * 64, nb * 64, nb * 64, kb < 16 ? ((const float*)(GAS const float*)ka->g_out_mla) : ((const float*)(GAS const float*)ka->g_out_moba) - MW, lane); continue; } r -= I3;
            if (r < I4) { const int e = r / 2048, q = r % 2048, kb = q / 64, nb = q % 64, n0 = nb * 64;
                const int prow = n0 < DFF ? (n0 >> 7) * 256 + (n0 & 127) : ((n0 - DFF) >> 7) * 256 + 128 + ((n0 - DFF) & 127);
                tr_item_f8(((const float*)(GAS const float*)ka->w_gate_up) + (size_t)e * DM * 2 * DFF, 2 * DFF, WGU + (size_t)e * 2 * DFF * DM, DM, scr, kb * 64, n0, prow, SC_WGU, lane); continue; } r -= I4;
            { const int e = r / 1024, q = r % 1024, kb = q / 32, nb = q % 32;
              tr_item_f8(((const float*)(GAS const float*)ka->w_down) + (size_t)e * DFF * DM, DM, WD + (size_t)e * DM * DFF, DFF, scr, kb * 64, nb * 64, nb * 64, SC_WD, lane); }
        }
        for (int i = gt; i < 192 * DM / 8; i += NGT) *(v4u*)(WIN + (size_t)832 * DM + (size_t)i * 8) = (v4u){0u, 0u, 0u, 0u};
        for (int i = gt; i < T * DM / 8; i += NGT) { const f32x4 v0 = *(const f32x4*)(((const float*)(GAS const float*)ka->x) + (size_t)i * 8), v1 = *(const f32x4*)(((const float*)(GAS const float*)ka->x) + (size_t)i * 8 + 4);
            v4u w; w.x = cvt_pk_bf16(v0[0], v0[1]); w.y = cvt_pk_bf16(v0[2], v0[3]); w.z = cvt_pk_bf16(v1[0], v1[1]); w.w = cvt_pk_bf16(v1[2], v1[3]); *(v4u*)(XB + (size_t)i * 8) = w; }
        for (int i = gt; i < T * 96; i += NGT) { const int t = i / 96, j = i % 96; const float p = (float)((const int*)(GAS const int*)ka->pos)[t];
            if (j < 64) { const float inv = (float)exp2(-(double)j * (2.0 / 128.0) * 13.287712379549449); float sn, cs; sincos_d((double)(p * inv), sn, cs); C128[t * 64 + j] = cs; S128[t * 64 + j] = sn; }
            else { const int jj = j - 64; const float inv = (float)exp2(-(double)jj * (2.0 / 64.0) * 13.287712379549449); float sn, cs; sincos_d((double)(p * inv), sn, cs); C64[t * 32 + jj] = cs; S64[t * 32 + jj] = sn; } }
    }
    SEAM(0);

    if (IN(1)) for (int rep_ = 0; rep_ < REPS(1); ++rep_) { KArgs ka = kargs(); GAS unsigned char* ws = opq(ka->ws);
        pg8::Gemm g{XB, WIN, DM * 2, DM * 2, DM * 2, 0}; pg8::StaticOrder S; S.init(T, INP, G, bid);
        pg8::EpiInProj E{(unsigned char*)ws};
        pg8::gemm_phase<pg8::EpiInProj, pg8::StaticOrder>(L, g, S, E, wave);
    }
    SEAM(1);

    if (IN(2)) for (int rep_ = 0; rep_ < REPS(2); ++rep_) { KArgs ka = kargs(); GAS unsigned char* ws = opq(ka->ws); const int lane = lane_id(), tid = wave * 64 + lane, gt = bid * 512 + tid; (void)gt;
        for (int r = gw; r < T; r += NGW) {
            { const v4u w = *(const v4u*)(HQ + (size_t)r * QLORA + lane * 8); float s = 0.f;
              s += bflo(w.x) * bflo(w.x) + bfhi(w.x) * bfhi(w.x) + bflo(w.y) * bflo(w.y) + bfhi(w.y) * bfhi(w.y) + bflo(w.z) * bflo(w.z) + bfhi(w.z) * bfhi(w.z) + bflo(w.w) * bflo(w.w) + bfhi(w.w) * bfhi(w.w);
              s = wave_sum(s); if (lane == 0) RSQ[r] = 1.0f / sqrtf(s * (1.0f / QLORA) + RMS_EPS); }
            { const v2u w = *(const v2u*)(HKV + (size_t)r * KVLORA + lane * 4); float s = 0.f;
              s += bflo(w.x) * bflo(w.x) + bfhi(w.x) * bfhi(w.x) + bflo(w.y) * bflo(w.y) + bfhi(w.y) * bfhi(w.y);
              s = wave_sum(s); if (lane == 0) RSKV[r] = 1.0f / sqrtf(s * (1.0f / KVLORA) + RMS_EPS); }
            if (lane < 32) { const float x1 = bf2f(HR[(size_t)r * 256 + lane]), x2 = bf2f(HR[(size_t)r * 256 + 32 + lane]); const float c = C64[r * 32 + lane], s = S64[r * 32 + lane];
                KPE[(size_t)r * ROPE + lane] = f2bf(x1 * c - x2 * s); KPE[(size_t)r * ROPE + 32 + lane] = f2bf(x2 * c + x1 * s); }
            const float c = C128[r * 64 + lane], s = S128[r * 64 + lane];
#pragma unroll
            for (int h = 0; h < NH; ++h) {
                bf16* q = MQ + (size_t)r * MW + h * 128; const float q1 = bf2f(q[lane]), q2 = bf2f(q[64 + lane]); q[lane] = f2bf(q1 * c - q2 * s); q[64 + lane] = f2bf(q2 * c + q1 * s);
                bf16* k = MK + (size_t)r * MW + h * 128; const float k1 = bf2f(k[lane]), k2 = bf2f(k[64 + lane]); k[lane] = f2bf(k1 * c - k2 * s); k[64 + lane] = f2bf(k2 * c + k1 * s); }
        }
    }
    SEAM(2);

    if (IN(3)) for (int rep_ = 0; rep_ < REPS(3); ++rep_) { KArgs ka = kargs(); GAS unsigned char* ws = opq(ka->ws);
        { pg8::Gemm g{HQ, WQB, QLORA * 2, QLORA * 2, QLORA * 2, 0}; pg8::StaticOrder S; S.init(T, 1536, G, bid); pg8::EpiRowScale E{QM, 1536, RSQ};
          pg8::gemm_phase<pg8::EpiRowScale, pg8::StaticOrder>(L, g, S, E, wave); }
        { pg8::Gemm g{HKV, WKVB, KVLORA * 2, KVLORA * 2, KVLORA * 2, 0}; pg8::StaticOrder S; S.init(T, 2048, G, bid); pg8::EpiRowScale E{KVM, 2048, RSKV};
          pg8::gemm_phase<pg8::EpiRowScale, pg8::StaticOrder>(L, g, S, E, wave); }
    }
    SEAM(3);

    if (IN(4)) for (int rep_ = 0; rep_ < REPS(4); ++rep_) { KArgs ka = kargs(); GAS unsigned char* ws = opq(ka->ws); const int lane = lane_id(), tid = wave * 64 + lane, gt = bid * 512 + tid; (void)gt;
        for (int r = gw; r < T; r += NGW) {
#pragma unroll
            for (int j = 0; j < 4; ++j) { const int idx = lane + 64 * j, h = idx >> 5, i = idx & 31; bf16* q = QM + (size_t)r * 1536 + h * QKH + NOPE;
                const float c = C64[r * 32 + i], s = S64[r * 32 + i]; const float x1 = bf2f(q[i]), x2 = bf2f(q[32 + i]); q[i] = f2bf(x1 * c - x2 * s); q[32 + i] = f2bf(x2 * c + x1 * s); }
        }
        for (int it = gw; it < NH * 32; it += NGW) { const int h = it >> 5, blk = it & 31; float s0 = 0.f, s1 = 0.f;
            const bf16* p = MK + (size_t)blk * 256 * MW + h * 128 + 2 * lane;
            for (int rr = 0; rr < 256; ++rr) { const unsigned w = *(const unsigned*)(p + (size_t)rr * MW); s0 += bflo(w); s1 += bfhi(w); }
            KBAR[(h * 32 + blk) * 128 + 2 * lane] = s0 * (1.0f / 256.0f); KBAR[(h * 32 + blk) * 128 + 2 * lane + 1] = s1 * (1.0f / 256.0f); }
    }
    SEAM(4);

    if (IN(5)) for (int rep_ = 0; rep_ < REPS(5); ++rep_) { KArgs ka = kargs(); GAS unsigned char* ws = opq(ka->ws); const int lane = lane_id(), tid = wave * 64 + lane, gt = bid * 512 + tid; (void)gt;
        LAS float* kb = (LAS float*)L;
        for (int i = tid; i < NH * 32 * 128; i += 512) kb[(i >> 7) * 129 + (i & 127)] = KBAR[i];
        LAS unsigned* qs = (LAS unsigned*)(L + 132096 + wave * 2048);
        __syncthreads();
        for (int t = gw; t < T; t += NGW) {
            const int blk = t >> 8;
            { const v4u w0 = *(const v4u*)(MQ + (size_t)t * MW + lane * 8), w1 = *(const v4u*)(MQ + (size_t)t * MW + 512 + lane * 8);
              *(LAS v4u*)(qs + lane * 4) = w0; *(LAS v4u*)(qs + 256 + lane * 4) = w1; }
            LDS_WAIT(); asm volatile("" ::: "memory");
            const int n = lane & 31;
#pragma unroll 1
            for (int hp = 0; hp < 4; ++hp) { const int h = 2 * hp + (lane >> 5);
                const LAS float* kr = kb + (h * 32 + n) * 129; const LAS unsigned* qh = qs + h * 64; float dot = 0.f;
#pragma unroll 8
                for (int d = 0; d < 64; ++d) { const unsigned w = qh[d]; dot = fmaf(bflo(w), kr[2 * d], dot); dot = fmaf(bfhi(w), kr[2 * d + 1], dot); }
                float gate = n < blk ? dot : -__builtin_inff(); unsigned bits = 0u;
#pragma unroll
                for (int k = 0; k < 3; ++k) { float v = gate; int idx = n;
#pragma unroll
                    for (int off = 16; off >= 1; off >>= 1) { const float ov = __shfl_xor(v, off); const int oi = __shfl_xor(idx, off); if (ov > v || (ov == v && oi < idx)) { v = ov; idx = oi; } }
                    if (k < blk) bits |= 1u << idx;
                    if (n == idx) gate = -__builtin_inff(); }
                if (n == 0) SEL[(size_t)t * NH + h] = bits; }
            LDS_WAIT(); asm volatile("" ::: "memory");
        }
        __syncthreads();
    }
    SEAM(5);

    if (IN(6)) for (int rep_ = 0; rep_ < REPS(6); ++rep_) { KArgs ka = kargs(); GAS unsigned char* ws = opq(ka->ws);
        for (int it = bid; it < 256; it += G) { const int h = it & 7, s = it >> 3;
            at::attn_unit<true>((const bf16*)QM + h * QKH, 1536, (const bf16*)KVM + h * 256, (const bf16*)KVM + h * 256 + 128, 2048, (const bf16*)KPE, OMIX + h * 128, DM, s, nullptr, (char*)lds, wave);
            at::attn_unit<false>((const bf16*)MQ + h * 128, MW, (const bf16*)MK + h * 128, (const bf16*)MV + h * 128, MW, nullptr, OMIX + MW + h * 128, DM, 31 - s, SEL + h, (char*)lds, wave);
        }
    }
    SEAM(6);

    if (IN(7)) for (int rep_ = 0; rep_ < REPS(7); ++rep_) { KArgs ka = kargs(); GAS unsigned char* ws = opq(ka->ws); const int lane = lane_id(), tid = wave * 64 + lane, gt = bid * 512 + tid; (void)gt;
        for (int r = gw; r < T; r += NGW) { v4u w[4]; float ss[2] = {0.f, 0.f};
#pragma unroll
            for (int j = 0; j < 4; ++j) { w[j] = *(const v4u*)(OMIX + (size_t)r * DM + j * 512 + lane * 8); float s = 0.f;
                s += bflo(w[j].x) * bflo(w[j].x) + bfhi(w[j].x) * bfhi(w[j].x) + bflo(w[j].y) * bflo(w[j].y) + bfhi(w[j].y) * bfhi(w[j].y) + bflo(w[j].z) * bflo(w[j].z) + bfhi(w[j].z) * bfhi(w[j].z) + bflo(w[j].w) * bflo(w[j].w) + bfhi(w[j].w) * bfhi(w[j].w);
                ss[j >> 1] += s; }
            const float r0 = 1.0f / sqrtf(wave_sum(ss[0]) * (1.0f / MW) + RMS_EPS), r1 = 1.0f / sqrtf(wave_sum(ss[1]) * (1.0f / MW) + RMS_EPS);
#pragma unroll
            for (int j = 0; j < 4; ++j) { const float sc = j < 2 ? r0 : r1; v4u o;
                o.x = cvt_pk_bf16(bflo(w[j].x) * sc, bfhi(w[j].x) * sc); o.y = cvt_pk_bf16(bflo(w[j].y) * sc, bfhi(w[j].y) * sc); o.z = cvt_pk_bf16(bflo(w[j].z) * sc, bfhi(w[j].z) * sc); o.w = cvt_pk_bf16(bflo(w[j].w) * sc, bfhi(w[j].w) * sc);
                *(v4u*)(OMIX + (size_t)r * DM + j * 512 + lane * 8) = o; } }
    }
    SEAM(7);

    if (IN(8)) for (int rep_ = 0; rep_ < REPS(8); ++rep_) { KArgs ka = kargs(); GAS unsigned char* ws = opq(ka->ws);
        pg8::Gemm g{OMIX, WO, DM * 2, DM * 2, DM * 2, 0}; pg8::StaticOrder S; S.init(T, DM, G, bid); pg8::EpiResF32 E{((const float*)(GAS const float*)ka->x), X1P, DM};
        pg8::gemm_phase<pg8::EpiResF32, pg8::StaticOrder>(L, g, S, E, wave);
    }
    SEAM(8);

    if (IN(9)) for (int rep_ = 0; rep_ < REPS(9); ++rep_) { KArgs ka = kargs(); GAS unsigned char* ws = opq(ka->ws); const int lane = lane_id(), tid = wave * 64 + lane, gt = bid * 512 + tid; (void)gt;
        LAS float* part = (LAS float*)L;
        LAS float* lg = (LAS float*)(L + 32768);
        for (int rg = bid; rg < T / 32; rg += G) { const int R0 = rg * 32;
            for (int rr = 0; rr < 4; ++rr) { const int r = R0 + wave * 4 + rr; f32x4 v[8]; float s = 0.f;
#pragma unroll
                for (int j = 0; j < 8; ++j) { v[j] = *(const f32x4*)(X1P + (size_t)r * DM + j * 256 + lane * 4); s += (v[j][0] + v[j][1]) + (v[j][2] + v[j][3]); }
                const float mean = wave_sum(s) * (1.0f / DM); float q = 0.f;
#pragma unroll
                for (int j = 0; j < 8; ++j) { v[j] = v[j] - mean; q += (v[j][0] * v[j][0] + v[j][1] * v[j][1]) + (v[j][2] * v[j][2] + v[j][3] * v[j][3]); }
                const float rstd = 1.0f / sqrtf(wave_sum(q) * (1.0f / DM) + LN_EPS);
#pragma unroll
                for (int j = 0; j < 8; ++j) { const int c = j * 256 + lane * 4; const f32x4 gg = *(const f32x4*)(((const float*)(GAS const float*)ka->ln1_g) + c), bb = *(const f32x4*)(((const float*)(GAS const float*)ka->ln1_b) + c);
                    const f32x4 y = v[j] * rstd * gg + bb; *(f32x4*)(X1N + (size_t)r * DM + c) = y;
                    *(unsigned*)(X1B + (size_t)r * DM + c) = pk4_fp8(y[0] * SC_X, y[1] * SC_X, y[2] * SC_X, y[3] * SC_X); } }
            VM_WAIT(); __syncthreads();
            { f32x16 acc = f32x16{}; const int hh = lane >> 5, li = lane & 31;
              const float* ap = X1N + (size_t)(R0 + li) * DM + wave * 256 + 4 * hh; const float* bp = ((const float*)(GAS const float*)ka->w_router) + (size_t)(wave * 256 + 4 * hh) * NE + li;
#pragma unroll 4
              for (int kk = 0; kk < 32; ++kk) { const f32x4 av = *(const f32x4*)(ap + kk * 8); const float* b = bp + (size_t)kk * 8 * NE;
                  acc = __builtin_amdgcn_mfma_f32_32x32x2f32(av[0], b[0], acc, 0, 0, 0); acc = __builtin_amdgcn_mfma_f32_32x32x2f32(av[1], b[NE], acc, 0, 0, 0);
                  acc = __builtin_amdgcn_mfma_f32_32x32x2f32(av[2], b[2 * NE], acc, 0, 0, 0); acc = __builtin_amdgcn_mfma_f32_32x32x2f32(av[3], b[3 * NE], acc, 0, 0, 0); }
#pragma unroll
              for (int r = 0; r < 16; ++r) part[(wave * 32 + at::crow(r, hh)) * 32 + li] = acc[r]; }
            __syncthreads();
            for (int i = tid; i < 1024; i += 512) { float s = ((const float*)(GAS const float*)ka->b_router)[i & 31];
#pragma unroll
                for (int w = 0; w < 8; ++w) s += part[w * 1024 + i];
                lg[(i >> 5) * 33 + (i & 31)] = s; }
            __syncthreads();
            if (tid < 32) { float v[32];
#pragma unroll
                for (int e = 0; e < 32; ++e) v[e] = lg[tid * 33 + e];
                float tv[4]; int ti[4];
#pragma unroll
                for (int k = 0; k < 4; ++k) { float best = -__builtin_inff(); int bi = 0;
#pragma unroll
                    for (int e = 0; e < 32; ++e) { if (v[e] > best) { best = v[e]; bi = e; } }
                    tv[k] = best; ti[k] = bi;
#pragma unroll
                    for (int e = 0; e < 32; ++e) if (e == bi) v[e] = -__builtin_inff(); }
                const float e1 = __expf(tv[1] - tv[0]), e2 = __expf(tv[2] - tv[0]), e3 = __expf(tv[3] - tv[0]); const float inv = 1.0f / (1.0f + e1 + e2 + e3);
                const float gk[4] = {inv, e1 * inv, e2 * inv, e3 * inv}; const int r = R0 + tid;
#pragma unroll
                for (int k = 0; k < 4; ++k) { const unsigned rank = __hip_atomic_fetch_add((unsigned*)(ctl + CW_COUNT + ti[k]), 1u, RLX_AGENT);
                    TOPE[r * 4 + k] = ti[k]; TOPR[r * 4 + k] = (int)rank; TOPG[r * 4 + k] = gk[k]; } }
            __syncthreads();
        }
    }
    SEAM(9);

    if (IN(10)) for (int rep_ = 0; rep_ < REPS(10); ++rep_) { KArgs ka = kargs(); GAS unsigned char* ws = opq(ka->ws); const int lane = lane_id(), tid = wave * 64 + lane, gt = bid * 512 + tid; (void)gt;
        LAS int* ps = (LAS int*)L;
        if (tid == 0) { int acc_ = 0; for (int e = 0; e < NE; ++e) { const int c = (int)__hip_atomic_load((unsigned*)(ctl + CW_COUNT + e), RLX_AGENT); const int p = (c + 255) & ~255; ps[e] = acc_; ps[32 + e] = c; ps[64 + e] = p; acc_ += p; } ps[96] = acc_; }
        __syncthreads();
        if (bid == 0) { if (tid == 0) __hip_atomic_store((unsigned*)(ctl + CW_NRT), (unsigned)(ps[96] >> 8), RLX_AGENT);
            if (tid < NE) { const int e = tid; for (int rt = ps[e] >> 8; rt < (ps[e] + ps[64 + e]) >> 8; ++rt) __hip_atomic_store((unsigned*)(ctl + CW_TILEE + rt), (unsigned)e, RLX_AGENT); } }
        for (int it = gw; it < T * TOPK; it += NGW) { const int t = it >> 2; const int e = TOPE[it], rk = TOPR[it]; const int row = ps[e] + rk;
            const v4u* src = (const v4u*)(X1B + (size_t)t * DM); v4u* dst = (v4u*)(XG + (size_t)row * DM);
#pragma unroll
            for (int j = 0; j < 2; ++j) dst[j * 64 + lane] = src[j * 64 + lane];
            if (lane == 0) { RGATE[row] = TOPG[it]; TOPROW[it] = row; } }
        for (int it = gw; it < NE * 256; it += NGW) { const int e = it >> 8, i = it & 255; const int rk = ps[32 + e] + i;
            if (rk < ps[64 + e]) { const int row = ps[e] + rk; v4u* dst = (v4u*)(XG + (size_t)row * DM);
#pragma unroll
                for (int j = 0; j < 2; ++j) dst[j * 64 + lane] = (v4u){0u, 0u, 0u, 0u};
                if (lane == 0) RGATE[row] = 0.f; } }
        __syncthreads();
    }
    SEAM(10);

    if (IN(11)) for (int rep_ = 0; rep_ < REPS(11); ++rep_) { KArgs ka = kargs(); GAS unsigned char* ws = opq(ka->ws);
        const int n_rt = (int)__builtin_amdgcn_readfirstlane((int)__hip_atomic_load((unsigned*)(ctl + CW_NRT), RLX_AGENT));
        LAS unsigned* te = (LAS unsigned*)(L + LDSCTL_OFF + 64);
        { const int i_ = wave * 64 + lane_id(); if (i_ < MAXRT) te[i_] = i_ < n_rt ? __hip_atomic_load((unsigned*)(ctl + CW_TILEE + i_), RLX_AGENT) : 0u; }
        __syncthreads();
        pg8::Gemm g{XG, WGU, DM, DM, DM, (size_t)2 * DFF * DM}; pg8::MoeOrder S{te, n_rt, 4, G, bid};
        pg8::EpiSwiglu E{ACT, ((const float*)(GAS const float*)ka->b_gate_up)};
        pg8::gemm_phase<pg8::EpiSwiglu, pg8::MoeOrder, true>(L, g, S, E, wave);
    }
    SEAM(11);

    if (IN(12)) for (int rep_ = 0; rep_ < REPS(12); ++rep_) { KArgs ka = kargs(); GAS unsigned char* ws = opq(ka->ws);
        const int n_rt = (int)__builtin_amdgcn_readfirstlane((int)__hip_atomic_load((unsigned*)(ctl + CW_NRT), RLX_AGENT));
        LAS unsigned* te = (LAS unsigned*)(L + LDSCTL_OFF + 64);
        { const int i_ = wave * 64 + lane_id(); if (i_ < MAXRT) te[i_] = i_ < n_rt ? __hip_atomic_load((unsigned*)(ctl + CW_TILEE + i_), RLX_AGENT) : 0u; }
        __syncthreads();
        pg8::Gemm g{ACT, WD, DFF, DFF, DFF, (size_t)DM * DFF}; pg8::MoeOrder S{te, n_rt, 3, G, bid};
        pg8::EpiDown E{YB, ((const float*)(GAS const float*)ka->b_down), RGATE};
        pg8::gemm_phase<pg8::EpiDown, pg8::MoeOrder, true>(L, g, S, E, wave);
    }
    SEAM(12);

    if (IN(13)) for (int rep_ = 0; rep_ < REPS(13); ++rep_) { KArgs ka = kargs(); GAS unsigned char* ws = opq(ka->ws); const int lane = lane_id(), tid = wave * 64 + lane, gt = bid * 512 + tid; (void)gt;
        for (int t = gw; t < T; t += NGW) { int rows[4];
#pragma unroll
            for (int k = 0; k < 4; ++k) rows[k] = TOPROW[t * 4 + k];
            f32x4 v[8]; float s = 0.f;
#pragma unroll
            for (int j = 0; j < 8; ++j) { const int c = j * 256 + lane * 4; f32x4 y = *(const f32x4*)(X1N + (size_t)t * DM + c) * ALPHA;
#pragma unroll
                for (int k = 0; k < 4; ++k) { const v2u w = *(const v2u*)(YB + (size_t)rows[k] * DM + c); y[0] += bflo(w.x); y[1] += bfhi(w.x); y[2] += bflo(w.y); y[3] += bfhi(w.y); }
                v[j] = y; s += (y[0] + y[1]) + (y[2] + y[3]); }
            const float mean = wave_sum(s) * (1.0f / DM); float q = 0.f;
#pragma unroll
            for (int j = 0; j < 8; ++j) { v[j] = v[j] - mean; q += (v[j][0] * v[j][0] + v[j][1] * v[j][1]) + (v[j][2] * v[j][2] + v[j][3] * v[j][3]); }
            const float rstd = 1.0f / sqrtf(wave_sum(q) * (1.0f / DM) + LN_EPS);
#pragma unroll
            for (int j = 0; j < 8; ++j) { const int c = j * 256 + lane * 4; const f32x4 gg = *(const f32x4*)(((const float*)(GAS const float*)ka->ln2_g) + c), bb = *(const f32x4*)(((const float*)(GAS const float*)ka->ln2_b) + c);
                *(f32x4*)(((float*)(GAS float*)ka->out) + (size_t)t * DM + c) = v[j] * rstd * gg + bb; } }
    }
#undef IN
#undef SEAM
}

extern "C" void kernel_launch(void* const* d_in, const int* in_sizes, int n_in, void* d_out, int out_size, void* d_ws, size_t ws_size, hipStream_t stream) {
    static int grid = 0;
    if (grid == 0) {
        if (n_in != 20 || in_sizes[0] != T * DM || out_size != T * DM || ws_size < WS_END) { fprintf(stderr, "kernel_launch: unexpected shapes (n_in %d, in0 %d, out %d, ws %zu < %zu)\n", n_in, n_in > 0 ? in_sizes[0] : -1, out_size, ws_size, (size_t)WS_END); grid = -1; return; }
        int dev = 0, cus = 0, per_cu = 0;
        if (hipGetDevice(&dev) != hipSuccess || hipDeviceGetAttribute(&cus, hipDeviceAttributeMultiprocessorCount, dev) != hipSuccess) { grid = -1; return; }
        if (hipFuncSetAttribute((const void*)fwd, hipFuncAttributeMaxDynamicSharedMemorySize, LDS_BYTES) != hipSuccess) { fprintf(stderr, "kernel_launch: hipFuncSetAttribute failed\n"); grid = -1; return; }
        if (hipOccupancyMaxActiveBlocksPerMultiprocessor(&per_cu, (const void*)fwd, 512, LDS_BYTES) != hipSuccess || per_cu < 1) fprintf(stderr, "kernel_launch: occupancy query says %d\n", per_cu);
        (void)hipGetLastError();
        grid = cus;
    }
    if (grid < 0) return;
    (void)hipMemsetAsync((char*)d_ws + WS_CTL, 0, CTL_ZERO_BYTES, stream);
    Args a{};
    a.x = (const float*)d_in[0]; a.pos = (const int*)d_in[1]; a.w_in = (const float*)d_in[2]; a.g_q_a = (const float*)d_in[3]; a.w_q_b = (const float*)d_in[4];
    a.g_kv_a = (const float*)d_in[5]; a.w_kv_b = (const float*)d_in[6]; a.g_out_mla = (const float*)d_in[7]; a.g_out_moba = (const float*)d_in[8]; a.w_o = (const float*)d_in[9];
    a.ln1_g = (const float*)d_in[10]; a.ln1_b = (const float*)d_in[11]; a.w_router = (const float*)d_in[12]; a.b_router = (const float*)d_in[13];
    a.w_gate_up = (const float*)d_in[14]; a.b_gate_up = (const float*)d_in[15]; a.w_down = (const float*)d_in[16]; a.b_down = (const float*)d_in[17];
    a.ln2_g = (const float*)d_in[18]; a.ln2_b = (const float*)d_in[19];
    a.out = (float*)d_out; a.ws = (unsigned char*)d_ws;
    if (MK_N_LAUNCHES == 1) { a.ph_lo = 0; a.ph_hi = NPHASES; hipLaunchKernelGGL(fwd, dim3(grid), dim3(512), LDS_BYTES, stream, a); }
    else { for (int p = 0; p < NPHASES; ++p) { a.ph_lo = p; a.ph_hi = p + 1; hipLaunchKernelGGL(fwd, dim3(grid), dim3(512), LDS_BYTES, stream, a); } }
    const hipError_t le = hipPeekAtLastError();
    if (le != hipSuccess) fprintf(stderr, "kernel_launch: launch failed: %s\n", hipGetErrorName(le));
}
```

```cpp
#include <hip/hip_runtime.h>
#include <cstdio>
#include <cstdint>

#ifndef PROBE_REP_MASK
#define PROBE_REP_MASK 0
#endif
#ifndef MK_N_LAUNCHES
#define MK_N_LAUNCHES 1
#endif

constexpr int T = 8192, DM = 2048, NH = 8;
constexpr int QLORA = 512, KVLORA = 256, ROPE = 64, NOPE = 128, VH = 128, QKH = NOPE + ROPE;
constexpr int MW = 1024;
constexpr int INC = 3904, INP = 4096;
constexpr int NE = 32, TOPK = 4, DFF = 2048;
constexpr int MAXROWS = T * TOPK + NE * 256;
constexpr int MAXRT = MAXROWS / 256;
constexpr float ALPHA = 1.189207115002721f;
constexpr float RMS_EPS = 1e-6f, LN_EPS = 1e-5f;

#define GAS __attribute__((address_space(1)))
#define LAS __attribute__((address_space(3)))
typedef unsigned short bf16;
typedef unsigned v4u __attribute__((ext_vector_type(4)));
typedef unsigned v2u __attribute__((ext_vector_type(2)));
typedef float f32x4 __attribute__((ext_vector_type(4)));
typedef float f32x2 __attribute__((ext_vector_type(2)));
typedef float f32x16 __attribute__((ext_vector_type(16)));
typedef short bf16x8 __attribute__((ext_vector_type(8)));
typedef short s16x4 __attribute__((ext_vector_type(4)));
typedef GAS unsigned gu32;
#define RLX_AGENT __ATOMIC_RELAXED, __HIP_MEMORY_SCOPE_AGENT
#define LDS_WAIT() asm volatile("s_waitcnt lgkmcnt(0)" ::: "memory")
#define VM_WAIT() asm volatile("s_waitcnt vmcnt(0)" ::: "memory")
#define SBAR() __builtin_amdgcn_sched_barrier(0)

__device__ __forceinline__ unsigned cvt_pk_bf16(float lo, float hi) { unsigned r; asm volatile("v_cvt_pk_bf16_f32 %0, %1, %2" : "=v"(r) : "v"(lo), "v"(hi)); return r; }
__device__ __forceinline__ float bf2f(unsigned short b) { return __uint_as_float(((unsigned)b) << 16); }
__device__ __forceinline__ float bflo(unsigned w) { return __uint_as_float(w << 16); }
__device__ __forceinline__ float bfhi(unsigned w) { return __uint_as_float(w & 0xffff0000u); }
__device__ __forceinline__ unsigned short f2bf(float f) { return (unsigned short)(cvt_pk_bf16(f, f) & 0xffffu); }
__device__ __forceinline__ unsigned pk4_fp8(float a, float b, float c, float d) { int w = 0; w = __builtin_amdgcn_cvt_pk_fp8_f32(a, b, w, false); w = __builtin_amdgcn_cvt_pk_fp8_f32(c, d, w, true); return (unsigned)w; }
typedef int v4i __attribute__((ext_vector_type(4)));
typedef int v8i __attribute__((ext_vector_type(8)));
__device__ __forceinline__ v8i cat8(bf16x8 a, bf16x8 b) { const v4i x = __builtin_bit_cast(v4i, a), y = __builtin_bit_cast(v4i, b); return __builtin_shufflevector(x, y, 0, 1, 2, 3, 4, 5, 6, 7); }
__device__ __forceinline__ int lane_id() { int l = (int)__builtin_amdgcn_mbcnt_hi(~0u, __builtin_amdgcn_mbcnt_lo(~0u, 0u)); asm volatile("" : "+v"(l)); return l; }
__device__ __forceinline__ float wave_sum(float v) {
#pragma unroll
    for (int o = 1; o < 64; o <<= 1) v += __shfl_xor(v, o);
    return v;
}

constexpr size_t MiB = 1u << 20;
constexpr size_t WS_CTL = 0, CTL_ZERO_BYTES = 1 * MiB;
constexpr size_t WS_XB    = 2 * MiB;
constexpr size_t WS_WIN   = WS_XB + 32 * MiB;
constexpr size_t WS_WQB   = WS_WIN + 16 * MiB;
constexpr size_t WS_WKVB  = WS_WQB + 2 * MiB;
constexpr size_t WS_WO    = WS_WKVB + 1 * MiB;
constexpr size_t WS_C128  = WS_WO + 8 * MiB;
constexpr size_t WS_S128  = WS_C128 + 2 * MiB;
constexpr size_t WS_C64   = WS_S128 + 2 * MiB;
constexpr size_t WS_S64   = WS_C64 + 1 * MiB;
constexpr size_t WS_HQ    = WS_S64 + 1 * MiB;
constexpr size_t WS_HKV   = WS_HQ + 8 * MiB;
constexpr size_t WS_HR    = WS_HKV + 4 * MiB;
constexpr size_t WS_KPE   = WS_HR + 4 * MiB;
constexpr size_t WS_MQ    = WS_KPE + 1 * MiB;
constexpr size_t WS_MK    = WS_MQ + 16 * MiB;
constexpr size_t WS_MV    = WS_MK + 16 * MiB;
constexpr size_t WS_RSQ   = WS_MV + 16 * MiB;
constexpr size_t WS_RSKV  = WS_RSQ + 1 * MiB;
constexpr size_t WS_QM    = WS_RSKV + 1 * MiB;
constexpr size_t WS_KVM   = WS_QM + 24 * MiB;
constexpr size_t WS_KBAR  = WS_KVM + 32 * MiB;
constexpr size_t WS_SEL   = WS_KBAR + 1 * MiB;
constexpr size_t WS_OMIX  = WS_SEL + 1 * MiB;
constexpr size_t WS_X1P   = WS_OMIX + 32 * MiB;
constexpr size_t WS_X1N   = WS_X1P + 64 * MiB;
constexpr size_t WS_X1B   = WS_X1N + 64 * MiB;
constexpr size_t WS_TOPE  = WS_X1B + 32 * MiB;
constexpr size_t WS_TOPR  = WS_TOPE + 1 * MiB;
constexpr size_t WS_TOPG  = WS_TOPR + 1 * MiB;
constexpr size_t WS_TOPROW= WS_TOPG + 1 * MiB;
constexpr size_t WS_RGATE = WS_TOPROW + 1 * MiB;
constexpr size_t WS_XG    = WS_RGATE + 1 * MiB;
constexpr size_t WS_ACT   = WS_XG + 80 * MiB;
constexpr size_t WS_Y     = WS_ACT + 80 * MiB;
constexpr size_t WS_WGU   = WS_Y + 160 * MiB;
constexpr size_t WS_WD    = WS_WGU + 256 * MiB;
constexpr size_t WS_END   = WS_WD + 128 * MiB;
constexpr float SC_X = 16.0f, SC_WGU = 512.0f, SC_ACT = 4.0f, SC_WD = 1024.0f;
constexpr int CW_BAR = 4096;
constexpr int CW_COUNT = 16384;
constexpr int CW_TILEE = 16384 + 64;
constexpr int CW_NRT = 16384 + 64 + 192;

constexpr int LDS_BYTES = 159744;
constexpr int LDSCTL_OFF = 158720;

namespace pg8 {
constexpr int BM = 256, BK = 64, HALF = 128, HTB = HALF * BK * 2, STAGE_BYTES = 8 * HTB, NXCD = 8, WGM = 8;
__host__ __device__ __forceinline__ int lds_byte(int r, int c) { const int st = (r >> 4) * 2 + (c >> 5), rr = r & 15, cc = c & 31, ob = rr * 64 + cc * 2; return st * 1024 + (ob ^ (((ob >> 9) & 1) << 5)); }
__host__ __device__ __forceinline__ void stage_rc(int b, int& R, int& C) { const int st = b / 1024, sb = b % 1024, swz = sb ^ (((sb >> 9) & 1) << 5); R = (st >> 1) * 16 + swz / 64; C = (st & 1) * 32 + (swz % 64) / 2; }
__host__ __device__ __forceinline__ int perm32(int rho) { const int n = rho >> 4, i = rho & 15; return 8 * (i >> 2) + 4 * n + (i & 3); }

struct Unit { int pm, pn, e; };
struct Gemm { const void* A; const void* Bt; int Kb, lda, ldb; size_t bes; };

struct StaticOrder {
    int nM, nN, nwg, G, c;
    __device__ void init(int M, int N, int G_, int c_) { nM = M / BM; nN = N / BM; nwg = nM * nN; G = G_; c = c_; }
    __device__ bool next(int i, Unit& u) const {
        const long L = (long)i * G + c; if (L >= nwg) return false;
        int wgid = (int)L; { const int q = nwg / NXCD, r = nwg % NXCD, xcd = wgid % NXCD, off = wgid / NXCD; wgid = (xcd < r ? xcd * (q + 1) : r * (q + 1) + (xcd - r) * q) + off; }
        const int nig = WGM * nN, gid = wgid / nig, fm = gid * WGM, gsz = (nM - fm) < WGM ? (nM - fm) : WGM;
        u.pm = fm + ((wgid % nig) % gsz); u.pn = (wgid % nig) / gsz; u.e = 0; return true;
    }
};
struct MoeOrder {
    const LAS unsigned* tile_e; int n_rt, lnpn, G, c;
    __device__ bool next(int i, Unit& u) const {
        const int L = i * G + c; if (L >= (n_rt << lnpn)) return false;
        const int rt = L >> lnpn; u.pm = rt; u.pn = L - (rt << lnpn);
        u.e = (int)__builtin_amdgcn_readfirstlane((int)tile_e[rt]); return true;
    }
};

typedef f32x4 Acc[2][2][4][2];

struct EpiInProj {
    static constexpr bool PERM = true;
    unsigned char* ws;
    __device__ __forceinline__ void operator()(const Acc& acc, const Unit& u, int wr, int wc, int fr, int fq) const {
        const int pn = u.pn; size_t off; int ldc, colt;
        if (pn < 4) { off = WS_HQ + (size_t)(pn >> 1) * (8u << 20) + (size_t)(pn == 3 ? 1 : 0) * (4u << 20); ldc = 512 - (pn >> 1) * 256; colt = (pn >> 1) ? 0 : pn * 256; }
        else { off = WS_MQ + (size_t)((pn - 4) >> 2) * (16u << 20); ldc = 1024; colt = ((pn - 4) & 3) * 256; }
        bf16* base = (bf16*)(ws + off);
        const int row0 = u.pm * BM + wr * 64 + fr, col0 = colt + wc * 32 + 8 * fq;
#pragma unroll
        for (int ai = 0; ai < 2; ++ai)
#pragma unroll
            for (int m = 0; m < 4; ++m) { bf16* rowp = base + (size_t)(row0 + ai * HALF + m * 16) * ldc + col0;
#pragma unroll
                for (int bj = 0; bj < 2; ++bj) { const f32x4 v0 = acc[ai][bj][m][0], v1 = acc[ai][bj][m][1];
                    v4u w; w.x = cvt_pk_bf16(v0[0], v0[1]); w.y = cvt_pk_bf16(v0[2], v0[3]); w.z = cvt_pk_bf16(v1[0], v1[1]); w.w = cvt_pk_bf16(v1[2], v1[3]);
                    *(v4u*)(rowp + bj * HALF) = w; } }
    }
};
struct EpiRowScale {
    static constexpr bool PERM = true;
    bf16* O; int ldc; const float* rs;
    __device__ __forceinline__ void operator()(const Acc& acc, const Unit& u, int wr, int wc, int fr, int fq) const {
        const int row0 = u.pm * BM + wr * 64 + fr, col0 = u.pn * BM + wc * 32 + 8 * fq;
#pragma unroll
        for (int ai = 0; ai < 2; ++ai)
#pragma unroll
            for (int m = 0; m < 4; ++m) { const int row = row0 + ai * HALF + m * 16; const float s = rs[row]; bf16* rowp = O + (size_t)row * ldc + col0;
#pragma unroll
                for (int bj = 0; bj < 2; ++bj) { const f32x4 v0 = acc[ai][bj][m][0] * s, v1 = acc[ai][bj][m][1] * s;
                    v4u w; w.x = cvt_pk_bf16(v0[0], v0[1]); w.y = cvt_pk_bf16(v0[2], v0[3]); w.z = cvt_pk_bf16(v1[0], v1[1]); w.w = cvt_pk_bf16(v1[2], v1[3]);
                    *(v4u*)(rowp + bj * HALF) = w; } }
    }
};
struct EpiResF32 {
    static constexpr bool PERM = false;
    const float* X; float* O; int ldc;
    __device__ __forceinline__ void operator()(const Acc& acc, const Unit& u, int wr, int wc, int fr, int fq) const {
        const int row0 = u.pm * BM + wr * 64 + fr, col0 = u.pn * BM + wc * 32 + 4 * fq;
#pragma unroll
        for (int ai = 0; ai < 2; ++ai)
#pragma unroll
            for (int m = 0; m < 4; ++m) { const size_t off = (size_t)(row0 + ai * HALF + m * 16) * ldc + col0;
#pragma unroll
                for (int bj = 0; bj < 2; ++bj)
#pragma unroll
                    for (int n = 0; n < 2; ++n) { const f32x4 xv = *(const f32x4*)(X + off + bj * HALF + n * 16); *(f32x4*)(O + off + bj * HALF + n * 16) = xv * ALPHA + acc[ai][bj][m][n]; }
                asm volatile("" ::: "memory"); }
    }
};
struct EpiSwiglu {
    static constexpr bool PERM = true;
    unsigned char* ACT; const float* bgu;
    __device__ __forceinline__ void operator()(const Acc& acc, const Unit& u, int wr, int wc, int fr, int fq) const {
        const int row0 = u.pm * BM + wr * 64 + fr, j0 = u.pn * HALF + wc * 32 + 8 * fq;
        const float* bg = bgu + (size_t)u.e * (2 * DFF) + j0; const float* bu = bg + DFF;
        const f32x4 bg0 = *(const f32x4*)bg, bg1 = *(const f32x4*)(bg + 4), bu0 = *(const f32x4*)bu, bu1 = *(const f32x4*)(bu + 4);
#pragma unroll
        for (int ai = 0; ai < 2; ++ai)
#pragma unroll
            for (int m = 0; m < 4; ++m) { unsigned char* rowp = ACT + (size_t)(row0 + ai * HALF + m * 16) * DFF + j0;
                float a[8];
#pragma unroll
                for (int n = 0; n < 2; ++n) { const f32x4 gv = acc[ai][0][m][n] * (1.0f / (SC_X * SC_WGU)) + (n ? bg1 : bg0), uv = acc[ai][1][m][n] * (1.0f / (SC_X * SC_WGU)) + (n ? bu1 : bu0);
#pragma unroll
                    for (int j = 0; j < 4; ++j) { const float g = fminf(gv[j], 7.0f), uu = fminf(fmaxf(uv[j], -7.0f), 7.0f);
                        const float sg = __builtin_amdgcn_rcpf(1.0f + __builtin_amdgcn_exp2f(g * (-1.702f * 1.4426950408889634f)));
                        a[n * 4 + j] = (uu + 1.0f) * g * sg * SC_ACT; } }
                v2u w; w.x = pk4_fp8(a[0], a[1], a[2], a[3]); w.y = pk4_fp8(a[4], a[5], a[6], a[7]);
                *(v2u*)rowp = w; }
    }
};
struct EpiDown {
    static constexpr bool PERM = true;
    bf16* Y; const float* bd; const float* rgate;
    __device__ __forceinline__ void operator()(const Acc& acc, const Unit& u, int wr, int wc, int fr, int fq) const {
        const int row0 = u.pm * BM + wr * 64 + fr, col0 = u.pn * BM + wc * 32 + 8 * fq;
        const float* bp = bd + (size_t)u.e * DM + col0;
        f32x4 bv[2][2];
#pragma unroll
        for (int bj = 0; bj < 2; ++bj)
#pragma unroll
            for (int n = 0; n < 2; ++n) bv[bj][n] = *(const f32x4*)(bp + bj * HALF + 4 * n);
#pragma unroll
        for (int ai = 0; ai < 2; ++ai)
#pragma unroll
            for (int m = 0; m < 4; ++m) { const int row = row0 + ai * HALF + m * 16; const float s = rgate[row]; bf16* rowp = Y + (size_t)row * DM + col0;
#pragma unroll
                for (int bj = 0; bj < 2; ++bj) { const f32x4 v0 = (acc[ai][bj][m][0] * (1.0f / (SC_ACT * SC_WD)) + bv[bj][0]) * s, v1 = (acc[ai][bj][m][1] * (1.0f / (SC_ACT * SC_WD)) + bv[bj][1]) * s;
                    v4u w; w.x = cvt_pk_bf16(v0[0], v0[1]); w.y = cvt_pk_bf16(v0[2], v0[3]); w.z = cvt_pk_bf16(v1[0], v1[1]); w.w = cvt_pk_bf16(v1[2], v1[3]);
                    *(v4u*)(rowp + bj * HALF) = w; } }
    }
};

template <class Epi, class Sched, bool F8 = false, bool ALIGN_EPI = true, bool SP2 = true>
__device__ __forceinline__ void gemm_phase(LAS unsigned char* lds, const Gemm g, const Sched& S, const Epi& E, const int wid  ) {
    const int lane = lane_id(), tid = wid * 64 + lane, wr = wid >> 2, wc = wid & 3, fr = lane & 15, fq = lane >> 4;
    const int nt = g.Kb / 128;
    const __amdgpu_buffer_rsrc_t rA = __builtin_amdgcn_make_buffer_rsrc((void*)g.A, 0, -1, 0x00020000);
    const __amdgpu_buffer_rsrc_t rB = __builtin_amdgcn_make_buffer_rsrc((void*)g.Bt, 0, -1, 0x00020000);
    unsigned voffA[2], voffB[2];
#pragma unroll
    for (int i = 0; i < 2; ++i) { int R, C; stage_rc(tid * 16 + i * 8192, R, C); const int Rb = Epi::PERM ? ((R & ~31) + perm32(R & 31)) : R;
        voffA[i] = (unsigned)(R * g.lda + C * 2); voffB[i] = (unsigned)(Rb * g.ldb + C * 2); }
    const unsigned kstep = 128u;
    const unsigned hstepA = (unsigned)HALF * g.lda, hstepB = (unsigned)HALF * g.ldb;
    const unsigned tstepA = 2 * hstepA, tstepB = 2 * hstepB;
    const unsigned ldsw = (unsigned)wid * 1024u;
    const int aoff = lds_byte(wr * 64 + fr, fq * 8), boff = lds_byte(wc * 32 + fr, fq * 8);
#define PG8_SA(b, h) (((b) * 2 + (h)) * HTB)
#define PG8_SB(b, h) ((4 + (b) * 2 + (h)) * HTB)
#define PG8_STAGE(bufoff, rsrc, soff, voff) do { _Pragma("unroll") for (int _i = 0; _i < 2; ++_i) \
        __builtin_amdgcn_raw_ptr_buffer_load_lds(rsrc, (LAS unsigned*)(lds + (bufoff) + ldsw + _i * 8192), 16, (voff)[_i], (soff), 0, 0); } while (0)
#define PG8_LDA(dst, b, h) do { _Pragma("unroll") for (int m = 0; m < 4; ++m) _Pragma("unroll") for (int k = 0; k < 2; ++k) dst[m][k] = *(const LAS bf16x8*)(lds + PG8_SA(b, h) + aoff + m * 2048 + k * 1024); } while (0)
#define PG8_LDB(dst, b, h) do { _Pragma("unroll") for (int n = 0; n < 2; ++n) _Pragma("unroll") for (int k = 0; k < 2; ++k) dst[n][k] = *(const LAS bf16x8*)(lds + PG8_SB(b, h) + boff + n * 2048 + k * 1024); } while (0)
#define PG8_MMA(ai, bj, At, Bt) do { __builtin_amdgcn_s_setprio(1); if constexpr (F8) { _Pragma("unroll") for (int m = 0; m < 4; ++m) _Pragma("unroll") for (int n = 0; n < 2; ++n) \
        acc[ai][bj][m][n] = __builtin_amdgcn_mfma_scale_f32_16x16x128_f8f6f4(cat8(Bt[n][0], Bt[n][1]), cat8(At[m][0], At[m][1]), acc[ai][bj][m][n], 0, 0, 0, 0, 0, 0); } \
        else { _Pragma("unroll") for (int m = 0; m < 4; ++m) _Pragma("unroll") for (int n = 0; n < 2; ++n) _Pragma("unroll") for (int k = 0; k < 2; ++k) \
        acc[ai][bj][m][n] = __builtin_amdgcn_mfma_f32_16x16x32_bf16(Bt[n][k], At[m][k], acc[ai][bj][m][n], 0, 0, 0); } __builtin_amdgcn_s_setprio(0); } while (0)
#define PG8_WAIT_V(n) asm volatile("s_waitcnt vmcnt(" #n ")" ::: "memory")
#define PG8_WAIT_L(n) asm volatile("s_waitcnt lgkmcnt(" #n ")" ::: "memory")
#define PG8_BAR __builtin_amdgcn_s_barrier()
#define PG8_SCHED __builtin_amdgcn_sched_barrier(0)
    Unit cur, nxt; int ui = 0;
    if (!S.next(0, cur)) return;
    Acc acc;
#pragma unroll
    for (int a = 0; a < 2; ++a)
#pragma unroll
        for (int b = 0; b < 2; ++b)
#pragma unroll
            for (int m = 0; m < 4; ++m)
#pragma unroll
                for (int n = 0; n < 2; ++n) acc[a][b][m][n] = (f32x4){0.f, 0.f, 0.f, 0.f};
    bf16x8 At[4][2], B0[2][2], B1[2][2];
    unsigned cA = (unsigned)cur.pm * tstepA, cB = (unsigned)((size_t)cur.e * g.bes) + (unsigned)cur.pn * tstepB;
    if constexpr (SP2) {
        PG8_STAGE(PG8_SB(0, 0), rB, cB, voffB); PG8_STAGE(PG8_SB(0, 1), rB, cB + hstepB, voffB); PG8_STAGE(PG8_SA(0, 0), rA, cA, voffA); PG8_STAGE(PG8_SA(0, 1), rA, cA + hstepA, voffA);
        if (wr == 1) PG8_BAR;
        PG8_WAIT_V(2); PG8_BAR;
        PG8_STAGE(PG8_SB(1, 0), rB, cB + kstep, voffB); PG8_STAGE(PG8_SA(1, 0), rA, cA + kstep, voffA); PG8_STAGE(PG8_SB(1, 1), rB, cB + hstepB + kstep, voffB);
        PG8_WAIT_V(6); PG8_BAR;
    } else {
        PG8_STAGE(PG8_SB(0, 0), rB, cB, voffB); PG8_STAGE(PG8_SA(0, 0), rA, cA, voffA); PG8_STAGE(PG8_SB(0, 1), rB, cB + hstepB, voffB); PG8_STAGE(PG8_SA(0, 1), rA, cA + hstepA, voffA);
        if (wr == 1) PG8_BAR;
        PG8_WAIT_V(4); PG8_BAR;
        PG8_STAGE(PG8_SB(1, 0), rB, cB + kstep, voffB); PG8_STAGE(PG8_SA(1, 0), rA, cA + kstep, voffA); PG8_STAGE(PG8_SB(1, 1), rB, cB + hstepB + kstep, voffB);
        PG8_WAIT_V(6); PG8_BAR;
    }
    for (;;) {
        const bool has_next = S.next(ui + 1, nxt);
        const unsigned nA = has_next ? (unsigned)nxt.pm * tstepA : cA; const unsigned nB = has_next ? (unsigned)((size_t)nxt.e * g.bes) + (unsigned)nxt.pn * tstepB : cB;
        for (int t = 0; t < nt; t += 2) {
            const bool last = (t == nt - 2);
            const unsigned a1 = cA + (unsigned)(t + 1) * kstep;
            const unsigned a2 = last ? nA : cA + (unsigned)(t + 2) * kstep; const unsigned b2 = last ? nB : cB + (unsigned)(t + 2) * kstep;
            const unsigned a3 = a2 + kstep; const unsigned b3 = b2 + kstep;
            if constexpr (SP2) {
            PG8_LDB(B0, 0, 0); PG8_LDB(B1, 0, 1); PG8_SCHED; PG8_LDA(At, 0, 0); PG8_STAGE(PG8_SA(1, 1), rA, a1 + hstepA, voffA);
            PG8_WAIT_V(8); PG8_WAIT_L(0); PG8_BAR; PG8_MMA(0, 0, At, B0); PG8_MMA(0, 1, At, B1); PG8_BAR; PG8_SCHED;
            PG8_LDA(At, 0, 1); PG8_STAGE(PG8_SB(0, 0), rB, b2, voffB); PG8_STAGE(PG8_SB(0, 1), rB, b2 + hstepB, voffB); PG8_STAGE(PG8_SA(0, 0), rA, a2, voffA);
            PG8_WAIT_V(8); PG8_WAIT_L(0); PG8_BAR; PG8_MMA(1, 0, At, B0); PG8_MMA(1, 1, At, B1); PG8_BAR; PG8_SCHED;
            PG8_LDB(B0, 1, 0); PG8_LDB(B1, 1, 1); PG8_SCHED; PG8_LDA(At, 1, 0); PG8_STAGE(PG8_SA(0, 1), rA, a2 + hstepA, voffA);
            PG8_WAIT_V(8); PG8_WAIT_L(0); PG8_BAR; PG8_MMA(0, 0, At, B0); PG8_MMA(0, 1, At, B1); PG8_BAR; PG8_SCHED;
            PG8_LDA(At, 1, 1); PG8_STAGE(PG8_SB(1, 0), rB, b3, voffB); PG8_STAGE(PG8_SB(1, 1), rB, b3 + hstepB, voffB); PG8_STAGE(PG8_SA(1, 0), rA, a3, voffA);
            PG8_WAIT_V(8); PG8_WAIT_L(0); PG8_BAR; PG8_MMA(1, 0, At, B0); PG8_MMA(1, 1, At, B1); PG8_BAR; PG8_SCHED;
            } else {
            PG8_LDB(B0, 0, 0); PG8_SCHED; PG8_LDA(At, 0, 0); PG8_STAGE(PG8_SA(1, 1), rA, a1 + hstepA, voffA);
            PG8_WAIT_L(8); PG8_BAR; PG8_WAIT_L(0); PG8_MMA(0, 0, At, B0); PG8_BAR; PG8_SCHED;
            PG8_LDB(B1, 0, 1); PG8_STAGE(PG8_SB(0, 0), rB, b2, voffB);
            PG8_BAR; PG8_WAIT_L(0); PG8_MMA(0, 1, At, B1); PG8_BAR;
            PG8_LDA(At, 0, 1); PG8_STAGE(PG8_SA(0, 0), rA, a2, voffA);
            PG8_BAR; PG8_WAIT_L(0); PG8_MMA(1, 0, At, B0); PG8_BAR; PG8_SCHED;
            PG8_STAGE(PG8_SB(0, 1), rB, b2 + hstepB, voffB);
            PG8_WAIT_V(6); PG8_BAR; PG8_MMA(1, 1, At, B1); PG8_BAR;
            PG8_LDB(B0, 1, 0); PG8_SCHED; PG8_LDA(At, 1, 0); PG8_STAGE(PG8_SA(0, 1), rA, a2 + hstepA, voffA);
            PG8_WAIT_L(8); PG8_BAR; PG8_WAIT_L(0); PG8_MMA(0, 0, At, B0); PG8_BAR; PG8_SCHED;
            PG8_LDB(B1, 1, 1); PG8_STAGE(PG8_SB(1, 0), rB, b3, voffB);
            PG8_BAR; PG8_WAIT_L(0); PG8_MMA(0, 1, At, B1); PG8_BAR;
            PG8_LDA(At, 1, 1); PG8_STAGE(PG8_SA(1, 0), rA, a3, voffA);
            PG8_BAR; PG8_WAIT_L(0); PG8_MMA(1, 0, At, B0); PG8_BAR; PG8_SCHED;
            PG8_STAGE(PG8_SB(1, 1), rB, b3 + hstepB, voffB);
            PG8_WAIT_V(6); PG8_BAR; PG8_MMA(1, 1, At, B1); PG8_BAR;
            }
        }
        if constexpr (ALIGN_EPI) { if (wr == 0) PG8_BAR; }
        { const int l2 = lane_id(); E(acc, cur, wr, wc, l2 & 15, l2 >> 4); }
        if (!has_next) break;
#pragma unroll
        for (int a = 0; a < 2; ++a)
#pragma unroll
            for (int b = 0; b < 2; ++b)
#pragma unroll
                for (int m = 0; m < 4; ++m)
#pragma unroll
                    for (int n = 0; n < 2; ++n) acc[a][b][m][n] = (f32x4){0.f, 0.f, 0.f, 0.f};
        cur = nxt; cA = nA; cB = nB; ++ui;
        if constexpr (ALIGN_EPI) { if (wr == 1) PG8_BAR; }
    }
    PG8_WAIT_V(0);
    if constexpr (!ALIGN_EPI) { if (wr == 0) PG8_BAR; }
    PG8_BAR;
#undef PG8_SA
#undef PG8_SB
#undef PG8_STAGE
#undef PG8_LDA
#undef PG8_LDB
#undef PG8_MMA
#undef PG8_WAIT_V
#undef PG8_WAIT_L
#undef PG8_BAR
#undef PG8_SCHED
}
}

namespace at {
constexpr int SHM_V = 16384, SHM_K = 16384, SHM_K2 = 8192;
constexpr int OFF_V = 0, OFF_K = 2 * SHM_V, OFF_K2 = OFF_K + 2 * SHM_K, OFF_WS = OFF_K2 + 2 * SHM_K2, ATTN_LDS = OFF_WS + 8 * 64 * 4;
#define KSWZ(row, colB) ((row) * 256 + ((colB) ^ (((row) & 7) << 4)))
#define K2SWZ(row, colB) ((row) * 128 + ((colB) ^ ((((row) >> 1) & 7) << 4)))
__device__ __forceinline__ int v_st(int k, int c) { const int kk = (k & ~0xC) | ((k & 4) << 1) | ((k & 8) >> 1); return ((kk >> 3) * 4 + (c >> 5)) * 512 + ((kk & 7) * 32 + (c & 31)) * 2; }
__device__ __forceinline__ int v_rd_base(int lane) { return ((lane & 3) << 3) | (((lane >> 2) & 3) << 6) | (((lane >> 4) & 1) << 5) | (((lane >> 5) & 1) << 8); }
constexpr int v_rd_off(int d0, int ks, int half) { return d0 * 512 + ks * 4096 + half * 2048; }
__device__ __forceinline__ int crow(int r, int hi) { return (r & 3) + 8 * (r >> 2) + 4 * hi; }

template <int VB>
__device__ __forceinline__ void pv_tile(f32x16* o, int vb0, bf16x8 pa0, bf16x8 pa1, bf16x8 pa2, bf16x8 pa3) {
#define TRRD(dst, off) asm volatile("ds_read_b64_tr_b16 %0, %1 offset:%2" : "=&v"(dst) : "v"(vb0), "i"(off) : "memory")
#define PV_D0(d0) do { s16x4 l0, l1, l2, l3, h0, h1, h2, h3; constexpr int b_ = VB * SHM_V + v_rd_off(d0, 0, 0); \
        TRRD(l0, b_); TRRD(h0, b_ + 2048); TRRD(l1, b_ + 4096); TRRD(h1, b_ + 6144); TRRD(l2, b_ + 8192); TRRD(h2, b_ + 10240); TRRD(l3, b_ + 12288); TRRD(h3, b_ + 14336); \
        asm volatile("s_waitcnt lgkmcnt(0)" ::: "memory"); SBAR(); \
        o[d0] = __builtin_amdgcn_mfma_f32_32x32x16_bf16(pa0, (bf16x8){l0[0], l0[1], l0[2], l0[3], h0[0], h0[1], h0[2], h0[3]}, o[d0], 0, 0, 0); \
        o[d0] = __builtin_amdgcn_mfma_f32_32x32x16_bf16(pa1, (bf16x8){l1[0], l1[1], l1[2], l1[3], h1[0], h1[1], h1[2], h1[3]}, o[d0], 0, 0, 0); \
        o[d0] = __builtin_amdgcn_mfma_f32_32x32x16_bf16(pa2, (bf16x8){l2[0], l2[1], l2[2], l2[3], h2[0], h2[1], h2[2], h2[3]}, o[d0], 0, 0, 0); \
        o[d0] = __builtin_amdgcn_mfma_f32_32x32x16_bf16(pa3, (bf16x8){l3[0], l3[1], l3[2], l3[3], h3[0], h3[1], h3[2], h3[3]}, o[d0], 0, 0, 0); } while (0)
    PV_D0(0); PV_D0(1); PV_D0(2); PV_D0(3);
#undef PV_D0
#undef TRRD
}

struct St { bf16x8 k0, k1, v0, v1, k2; };

template <bool MLA>
__device__ __forceinline__ void attn_unit(const bf16* Qp, int ldq, const bf16* Kp, const bf16* Vp, int ldk, const bf16* K2p, bf16* Op, int ldo, int qb, const unsigned* selp, char* lds, const int wid) {
    constexpr float SCALE = MLA ? 0.07216878364870322f : 0.08838834764831845f;
    constexpr float C2 = 1.4426950408889634f * SCALE, THR = 8.f;
    const int lane = lane_id(), tid = wid * 64 + lane, r32 = lane & 31, hi = lane >> 5;
    const int q0 = qb * 256, qlo = q0 + wid * 32, qrow = qlo + r32, qm = qrow - 4 * hi;
    char* V_lds = lds + OFF_V; char* K_lds = lds + OFF_K; char* K2_lds = lds + OFF_K2;
    float* ws = (float*)(lds + OFF_WS) + wid * 64; float* li_l = ws; float* al_l = ws + 32;
    bf16x8 qr[8], qr2[4];
    { const bf16* Qw = Qp + (size_t)qrow * ldq + hi * 8;
#pragma unroll
      for (int d0 = 0; d0 < 8; ++d0) qr[d0] = *(const bf16x8*)(Qw + d0 * 16);
      if constexpr (MLA) {
#pragma unroll
          for (int d0 = 0; d0 < 4; ++d0) qr2[d0] = *(const bf16x8*)(Qw + 128 + d0 * 16); } }
    unsigned sel = 0u; if constexpr (!MLA) sel = selp[(size_t)qrow * NH];
    const int sr = tid >> 4, sc = (tid & 15) * 8, vst0 = v_st(sr, sc), vst1 = v_st(32 + sr, sc), kws = KSWZ(sr, sc * 2);
    const int k2r = tid >> 3, k2c = (tid & 7) * 8, k2ws = K2SWZ(k2r, k2c * 2);
    const int vb0 = (int)(uintptr_t)V_lds + v_rd_base(lane);
    float m_reg = -1e30f, l_reg = 0.f; f32x16 o[4];
#pragma unroll
    for (int d = 0; d < 4; ++d) o[d] = f32x16{};
    St S;
#define SLOAD(k0_) do { S.v0 = *(const bf16x8*)(Vp + (size_t)((k0_) + sr) * ldk + sc); S.v1 = *(const bf16x8*)(Vp + (size_t)((k0_) + 32 + sr) * ldk + sc); \
        S.k0 = *(const bf16x8*)(Kp + (size_t)((k0_) + sr) * ldk + sc); S.k1 = *(const bf16x8*)(Kp + (size_t)((k0_) + 32 + sr) * ldk + sc); \
        if constexpr (MLA) S.k2 = *(const bf16x8*)(K2p + (size_t)((k0_) + k2r) * ROPE + k2c); } while (0)
#define SWRITE(bf) do { *(bf16x8*)(V_lds + (bf) * SHM_V + vst0) = S.v0; *(bf16x8*)(V_lds + (bf) * SHM_V + vst1) = S.v1; \
        *(bf16x8*)(K_lds + (bf) * SHM_K + kws) = S.k0; *(bf16x8*)(K_lds + (bf) * SHM_K + kws + 32 * 256) = S.k1; \
        if constexpr (MLA) *(bf16x8*)(K2_lds + (bf) * SHM_K2 + k2ws) = S.k2; } while (0)
    const int NT = 4 * (qb + 1);
    SLOAD(0); VM_WAIT(); SWRITE(0); __syncthreads();
#define TILE_STEP(BF, t_) do { const int t = (t_); const int kb = t * 64; \
        if (t + 1 < NT) SLOAD(kb + 64); \
        bool act = kb <= qlo + 31; const int jblk = t >> 2; \
        if constexpr (!MLA) { if (jblk < qb) act = __any((int)((sel >> jblk) & 1u)) != 0; } \
        if (act) { \
            f32x16 p0 = f32x16{}, p1 = f32x16{}; \
            { const char* kbs[4]; _Pragma("unroll") for (int dd = 0; dd < 4; ++dd) kbs[dd] = K_lds + (BF) * SHM_K + KSWZ(r32, (dd * 16 + hi * 8) * 2); \
              _Pragma("unroll") for (int d0 = 0; d0 < 8; ++d0) { const char* a = kbs[d0 & 3] + (d0 >> 2) * 128; \
                const bf16x8 b0 = *(const bf16x8*)a; const bf16x8 b1 = *(const bf16x8*)(a + 32 * 256); \
                p0 = __builtin_amdgcn_mfma_f32_32x32x16_bf16(b0, qr[d0], p0, 0, 0, 0); p1 = __builtin_amdgcn_mfma_f32_32x32x16_bf16(b1, qr[d0], p1, 0, 0, 0); } } \
            if constexpr (MLA) { _Pragma("unroll") for (int d0 = 0; d0 < 4; ++d0) { const char* a = K2_lds + (BF) * SHM_K2 + K2SWZ(r32, (d0 * 16 + hi * 8) * 2); \
                const bf16x8 b0 = *(const bf16x8*)a; const bf16x8 b1 = *(const bf16x8*)(a + 32 * 128); \
                p0 = __builtin_amdgcn_mfma_f32_32x32x16_bf16(b0, qr2[d0], p0, 0, 0, 0); p1 = __builtin_amdgcn_mfma_f32_32x32x16_bf16(b1, qr2[d0], p1, 0, 0, 0); } } \
            const float NEG = -__builtin_inff(); \
            if (kb + 63 > qlo) { const int dq = qm - kb; \
                _Pragma("unroll") for (int r = 0; r < 16; ++r) { const int c = (r & 3) + 8 * (r >> 2); if (dq - c < 0) p0[r] = NEG; if (dq - c - 32 < 0) p1[r] = NEG; } } \
            if constexpr (!MLA) { if (jblk < qb) { if (((sel >> jblk) & 1u) == 0u) { _Pragma("unroll") for (int r = 0; r < 16; ++r) { p0[r] = NEG; p1[r] = NEG; } } } } \
            float pmax = p0[0]; _Pragma("unroll") for (int r = 1; r < 16; ++r) pmax = fmaxf(pmax, p0[r]); _Pragma("unroll") for (int r = 0; r < 16; ++r) pmax = fmaxf(pmax, p1[r]); \
            { auto rr = __builtin_amdgcn_permlane32_swap(__float_as_uint(pmax), __float_as_uint(pmax), false, false); pmax = fmaxf(__uint_as_float(rr[0]), __uint_as_float(rr[1])); } \
            float mn, alpha; \
            if (__builtin_expect(__all((pmax - m_reg) * SCALE <= THR), 1)) { mn = m_reg; alpha = 1.f; } \
            else { mn = fmaxf(m_reg, pmax); alpha = __builtin_amdgcn_exp2f((m_reg - mn) * C2); m_reg = mn; } \
            const float mnL = -mn * C2; \
            _Pragma("unroll") for (int r = 0; r < 16; ++r) { p0[r] = __builtin_amdgcn_exp2f(fmaf(p0[r], C2, mnL)); p1[r] = __builtin_amdgcn_exp2f(fmaf(p1[r], C2, mnL)); } \
            float ps = 0.f; _Pragma("unroll") for (int r = 0; r < 16; ++r) ps += p0[r]; _Pragma("unroll") for (int r = 0; r < 16; ++r) ps += p1[r]; \
            { auto rr = __builtin_amdgcn_permlane32_swap(__float_as_uint(ps), __float_as_uint(ps), false, false); ps = __uint_as_float(rr[0]) + __uint_as_float(rr[1]); } \
            l_reg = l_reg * alpha + ps; \
            if (__any(alpha < 1.f)) { if (hi == 0) al_l[r32] = alpha; LDS_WAIT(); \
                _Pragma("unroll") for (int d_ = 0; d_ < 4; ++d_) _Pragma("unroll") for (int r = 0; r < 16; ++r) o[d_][r] *= al_l[crow(r, hi)]; } \
            bf16x8 pa0, pa1, pa2, pa3; \
            PK4(p0, 0, pa0); PK4(p0, 8, pa1); PK4(p1, 0, pa2); PK4(p1, 8, pa3); \
            SBAR(); pv_tile<BF>(o, vb0, pa0, pa1, pa2, pa3); \
        } \
        if (t + 1 < NT) { VM_WAIT(); SWRITE((BF) ^ 1); } \
        __syncthreads(); } while (0)
#define PK4(P, B_, OUT) do { const unsigned a0 = cvt_pk_bf16(P[B_+0], P[B_+1]), a1 = cvt_pk_bf16(P[B_+2], P[B_+3]); \
        const unsigned b0_ = cvt_pk_bf16(P[B_+4], P[B_+5]), b1_ = cvt_pk_bf16(P[B_+6], P[B_+7]); \
        auto r0 = __builtin_amdgcn_permlane32_swap(a0, b0_, false, false); auto r1 = __builtin_amdgcn_permlane32_swap(a1, b1_, false, false); \
        v4u w = {r0[0], r1[0], r0[1], r1[1]}; OUT = *reinterpret_cast<bf16x8*>(&w); } while (0)
    for (int t2 = 0; t2 < NT; t2 += 2) { TILE_STEP(0, t2); TILE_STEP(1, t2 + 1); }
#undef PK4
#undef TILE_STEP
#undef SLOAD
#undef SWRITE
    if (hi == 0) li_l[r32] = l_reg; LDS_WAIT();
    float rli[16];
#pragma unroll
    for (int r = 0; r < 16; ++r) rli[r] = __builtin_amdgcn_rcpf(li_l[crow(r, hi)]);
    bf16* Ow = Op + (size_t)qlo * ldo;
#pragma unroll
    for (int r = 0; r < 16; ++r) { const int orow = crow(r, hi);
#pragma unroll
        for (int d0 = 0; d0 < 4; ++d0) { const float v = o[d0][r] * rli[r]; const float vn = __shfl_xor(v, 1);
            if ((r32 & 1) == 0) *(unsigned*)(Ow + (size_t)orow * ldo + d0 * 32 + r32) = cvt_pk_bf16(v, vn); } }
    __syncthreads();
}
}

#define XB_TMO      128
#define XB_XCNT(j)  (256  + 64 * (j))
#define XB_XSUB(j)  (1280 + 64 * (j))
#define XB_XGEN(j)  (2304 + 64 * (j))
#define XB_TOP      3328
#define XB_TOPGEN   3392
#define XCD_BAR_WORDS 3456
#define XB_SPIN_CAP (1u << 18)
__device__ __forceinline__ unsigned xb_ld(unsigned* p)              { return __hip_atomic_load(p, __ATOMIC_RELAXED, __HIP_MEMORY_SCOPE_AGENT); }
__device__ __forceinline__ unsigned xb_add(unsigned* p, unsigned v) { return __hip_atomic_fetch_add(p, v, __ATOMIC_RELAXED, __HIP_MEMORY_SCOPE_AGENT); }
__device__ __forceinline__ unsigned xb_xcc_id() { return (unsigned)__builtin_amdgcn_s_getreg((3 << 11) | 20) & 0xFu; }
#define XB_SPIN(cond, bar) do { unsigned _sp = 0; while (cond) { __builtin_amdgcn_s_sleep(1); \
    if ((++_sp & 255u) == 0u) { if (xb_ld(&(bar)[XB_TMO])) break; if (_sp > XB_SPIN_CAP) { atomicAdd(&(bar)[XB_TMO], 1u); break; } } } } while (0)
struct XcdBarrier { unsigned* bar; unsigned x; volatile LAS unsigned* st; };
__device__ __forceinline__ XcdBarrier xcd_barrier_post(unsigned* bar, volatile LAS unsigned* st, bool t0  ) {
    XcdBarrier b; b.bar = bar; b.x = xb_xcc_id(); b.st = st;
    if (t0) (void)xb_add(&bar[XB_XCNT(b.x)], 1u);
    return b;
}
__device__ __forceinline__ void xcd_barrier_complete(unsigned* bar, unsigned x, unsigned& nloc, unsigned& nx) {
    const unsigned G = gridDim.x * gridDim.y * gridDim.z;
    unsigned sum, cnt, mine, sp = 0u;
    for (;;) {
        sum = 0u; cnt = 0u; mine = 0u;
#pragma unroll
        for (unsigned j = 0; j < 16; ++j) { const unsigned c = xb_ld(&bar[XB_XCNT(j)]); sum += c; cnt += (c > 0u) ? 1u : 0u; mine = (j == x) ? c : mine; }
        if (sum == G) break;
        __builtin_amdgcn_s_sleep(1);
        if ((++sp & 255u) == 0u) { if (xb_ld(&bar[XB_TMO])) break; if (sp > XB_SPIN_CAP) { atomicAdd(&bar[XB_TMO], 1u); break; } }
    }
    nloc = mine > 0u ? mine : 1u; nx = cnt > 0u ? cnt : 1u;
}
__device__ __forceinline__ void xcd_barrier(const XcdBarrier& b, bool t0  ) {
    asm volatile("s_waitcnt vmcnt(0)" ::: "memory");
    __syncthreads();
    if (t0) {
        unsigned* bar = b.bar;
        __builtin_amdgcn_s_waitcnt(0);
        unsigned nloc = b.st[0], nx = b.st[1];
        if (nloc == 0u) { xcd_barrier_complete(bar, b.x, nloc, nx); b.st[0] = nloc; b.st[1] = nx; }
        const unsigned old = xb_add(&bar[XB_XSUB(b.x)], 1u);
        const unsigned gen = old / nloc;
        if (old + 1u == (gen + 1u) * nloc) {
            __builtin_amdgcn_fence(__ATOMIC_RELEASE, "agent");
            asm volatile("s_waitcnt vmcnt(0)" ::: "memory");
            const unsigned og = xb_add(&bar[XB_TOP], 1u);
            const unsigned tg = og / nx;
            if (og + 1u == (tg + 1u) * nx) xb_add(&bar[XB_TOPGEN], 1u);
            else XB_SPIN(xb_ld(&bar[XB_TOPGEN]) == tg, bar);
            __builtin_amdgcn_fence(__ATOMIC_ACQUIRE, "agent");
            xb_add(&bar[XB_XGEN(b.x)], 1u);
            asm volatile("s_waitcnt vmcnt(0)" ::: "memory");
        } else {
            XB_SPIN(xb_ld(&bar[XB_XGEN(b.x)]) == gen, bar);
            __builtin_amdgcn_fence(__ATOMIC_ACQUIRE, "agent");
            asm volatile("s_waitcnt vmcnt(0)" ::: "memory");
        }
    }
    __syncthreads();
}

struct Args;
typedef const __attribute__((address_space(4))) struct Args* KArgsFwd;
struct Args {
    const float* x; const int* pos; const float* w_in; const float* g_q_a; const float* w_q_b; const float* g_kv_a; const float* w_kv_b;
    const float* g_out_mla; const float* g_out_moba; const float* w_o; const float* ln1_g; const float* ln1_b; const float* w_router; const float* b_router;
    const float* w_gate_up; const float* b_gate_up; const float* w_down; const float* b_down; const float* ln2_g; const float* ln2_b;
    float* out; unsigned char* ws; int ph_lo, ph_hi;
};
constexpr int NPHASES = 14;

__device__ __forceinline__ void tr_item(const float* W, int N, bf16* WT, int K, int k0, int n0, int prow0, const float* sc, int lane) {
    float tv[64]; const unsigned off0 = (unsigned)(k0 * N + n0 + lane) * 4u, rb = (unsigned)N * 4u;
#pragma unroll
    for (int i = 0; i < 64; ++i) tv[i] = __builtin_nontemporal_load((const float*)((const char*)W + (off0 + (unsigned)i * rb)));
    if (sc) {
#pragma unroll
        for (int i = 0; i < 64; i += 4) { const f32x4 g4 = *(const f32x4*)(sc + k0 + i); tv[i] *= g4[0]; tv[i + 1] *= g4[1]; tv[i + 2] *= g4[2]; tv[i + 3] *= g4[3]; } }
    bf16* dst = WT + (size_t)(prow0 + lane) * K + k0;
#pragma unroll
    for (int j = 0; j < 8; ++j) { v4u o; o.x = cvt_pk_bf16(tv[8 * j], tv[8 * j + 1]); o.y = cvt_pk_bf16(tv[8 * j + 2], tv[8 * j + 3]); o.z = cvt_pk_bf16(tv[8 * j + 4], tv[8 * j + 5]); o.w = cvt_pk_bf16(tv[8 * j + 6], tv[8 * j + 7]);
        *(v4u*)(dst + 8 * j) = o; }
}
template <bool GU>
__device__ __forceinline__ void tr_item_f8(const float* W, int N, unsigned char* WT, int K, int k0, int n0, float cs, int lane) {
    f32x4 tv[16]; const unsigned off0 = (unsigned)(k0 * N + n0 + 4 * lane) * 4u, rb = (unsigned)N * 4u;
#pragma unroll
    for (int i = 0; i < 16; ++i) tv[i] = __builtin_nontemporal_load((const f32x4*)((const char*)W + (off0 + (unsigned)i * rb)));
    const int n = n0 + 4 * lane;
    const int prow = GU ? (n < DFF ? (n >> 7) * 256 + (n & 127) : ((n - DFF) >> 7) * 256 + 128 + ((n - DFF) & 127)) : n;
    unsigned char* dst = WT + (size_t)prow * K + k0;
#pragma unroll
    for (int c = 0; c < 4; ++c) { v4u o;
        o.x = pk4_fp8(tv[0][c] * cs, tv[1][c] * cs, tv[2][c] * cs, tv[3][c] * cs); o.y = pk4_fp8(tv[4][c] * cs, tv[5][c] * cs, tv[6][c] * cs, tv[7][c] * cs);
        o.z = pk4_fp8(tv[8][c] * cs, tv[9][c] * cs, tv[10][c] * cs, tv[11][c] * cs); o.w = pk4_fp8(tv[12][c] * cs, tv[13][c] * cs, tv[14][c] * cs, tv[15][c] * cs);
        *(v4u*)(dst + (size_t)c * K) = o; }
}
constexpr int BG_ITEMS = NE * 32 * 64 + NE * 32 * 32, BG_ROUNDS = 48;
constexpr int BG_P1 = 6, BG_P6 = 44, BG_P8 = 48;
__device__ __forceinline__ void bg_rounds(KArgsFwd ka, GAS unsigned char* ws, int r0, int r1, int gw, int NGW, int lane) {
    for (int r = r0; r < r1; ++r) { int it = r * NGW + gw; if (it >= BG_ITEMS) break;
        if (it < NE * 2048) { const int e = it >> 11, q = it & 2047, kb = q & 127, nb = q >> 7;
            tr_item_f8<true>(((const float*)(GAS const float*)ka->w_gate_up) + (size_t)e * DM * 2 * DFF, 2 * DFF, (unsigned char*)(ws + WS_WGU) + (size_t)e * 2 * DFF * DM, DM, kb * 16, nb * 256, SC_WGU, lane); }
        else { it -= NE * 2048; const int e = it >> 10, q = it & 1023, kb = q & 127, nb = q >> 7;
            tr_item_f8<false>(((const float*)(GAS const float*)ka->w_down) + (size_t)e * DFF * DM, DM, (unsigned char*)(ws + WS_WD) + (size_t)e * DM * DFF, DFF, kb * 16, nb * 256, SC_WD, lane); } }
}
__device__ __forceinline__ void sincos_d(double x, float& sn, float& cs) {
    const double inv2pi = 0.15915494309189533577, pi2hi = 6.283185307179586232, pi2lo = 2.4492935982947064e-16;
    const double n = rint(x * inv2pi); double r = fma(-n, pi2hi, x); r = fma(-n, pi2lo, r);
    const double r2 = r * r; double s = 1.0, c = 1.0;
    double ts = 0.0, tc = 0.0;
#pragma unroll
    for (int k = 14; k >= 1; --k) { ts = (ts + 1.0) * (-r2 * (1.0 / (double)((2 * k) * (2 * k + 1)))); tc = (tc + 1.0) * (-r2 * (1.0 / (double)((2 * k - 1) * (2 * k)))); }
    s = r * (1.0 + ts); c = 1.0 + tc; sn = (float)s; cs = (float)c;
}

#define XB   ((bf16*)(ws + WS_XB))
#define WIN  ((bf16*)(ws + WS_WIN))
#define WQB  ((bf16*)(ws + WS_WQB))
#define WKVB ((bf16*)(ws + WS_WKVB))
#define WO   ((bf16*)(ws + WS_WO))
#define C128 ((float*)(ws + WS_C128))
#define S128 ((float*)(ws + WS_S128))
#define C64  ((float*)(ws + WS_C64))
#define S64  ((float*)(ws + WS_S64))
#define HQ   ((bf16*)(ws + WS_HQ))
#define HKV  ((bf16*)(ws + WS_HKV))
#define HR   ((bf16*)(ws + WS_HR))
#define KPE  ((bf16*)(ws + WS_KPE))
#define MQ   ((bf16*)(ws + WS_MQ))
#define MK   ((bf16*)(ws + WS_MK))
#define MV   ((bf16*)(ws + WS_MV))
#define RSQ  ((float*)(ws + WS_RSQ))
#define RSKV ((float*)(ws + WS_RSKV))
#define QM   ((bf16*)(ws + WS_QM))
#define KVM  ((bf16*)(ws + WS_KVM))
#define KBAR ((float*)(ws + WS_KBAR))
#define SEL  ((unsigned*)(ws + WS_SEL))
#define OMIX ((bf16*)(ws + WS_OMIX))
#define X1P  ((float*)(ws + WS_X1P))
#define X1N  ((float*)(ws + WS_X1N))
#define X1B  ((unsigned char*)(ws + WS_X1B))
#define TOPE ((int*)(ws + WS_TOPE))
#define TOPR ((int*)(ws + WS_TOPR))
#define TOPG ((float*)(ws + WS_TOPG))
#define TOPROW ((int*)(ws + WS_TOPROW))
#define RGATE ((float*)(ws + WS_RGATE))
#define XG   ((unsigned char*)(ws + WS_XG))
#define ACT  ((unsigned char*)(ws + WS_ACT))
#define YB   ((bf16*)(ws + WS_Y))
#define WGU  ((unsigned char*)(ws + WS_WGU))
#define WD   ((unsigned char*)(ws + WS_WD))
__device__ __forceinline__ GAS unsigned char* opq(const void* p) { GAS unsigned char* q = (GAS unsigned char*)p; asm volatile("" : "+s"(q)); return q; }
typedef const __attribute__((address_space(4))) struct Args* KArgs;
__device__ __forceinline__ KArgs kargs() { auto p = __builtin_amdgcn_kernarg_segment_ptr(); asm volatile("" : "+s"(p)); return (KArgs)p; }

__global__ void __launch_bounds__(512, 2) fwd(Args a) {
    extern __shared__ __attribute__((aligned(16))) unsigned char lds[];
    LAS unsigned char* L = (LAS unsigned char*)lds;
    const int wave = __builtin_amdgcn_readfirstlane((int)threadIdx.x >> 6);
    const int G = gridDim.x, bid = blockIdx.x;
    const int gw = bid * 8 + wave, NGW = G * 8;
    const int NGT = G * 512;
    gu32* ctl = (gu32*)(a.ws + WS_CTL);
    for (int u = wave * 64 + lane_id(); u < (LDS_BYTES - LDSCTL_OFF) / 4; u += 512) ((LAS unsigned*)(L + LDSCTL_OFF))[u] = 0u;
    __syncthreads();
    XcdBarrier bar; bar.bar = (unsigned*)(ctl + CW_BAR); bar.x = 0; bar.st = nullptr;
    if (MK_N_LAUNCHES == 1) bar = xcd_barrier_post((unsigned*)(ctl + CW_BAR), (volatile LAS unsigned*)(L + LDSCTL_OFF), wave == 0 && lane_id() == 0);
    const int lo = a.ph_lo, hi = a.ph_hi;
#define IN(k) (lo <= (k) && (k) < hi)
#define REPS(k) ((((PROBE_REP_MASK) >> (k)) & 1) + 1)
#define SEAM(k) do { if (IN(k) && IN((k) + 1)) { XcdBarrier b2_ = bar; b2_.bar = (unsigned*)(opq(kargs()->ws) + WS_CTL + (size_t)CW_BAR * 4); xcd_barrier(b2_, wave == 0 && lane_id() == 0); } } while (0)

    if (IN(0)) for (int rep_ = 0; rep_ < REPS(0); ++rep_) { KArgs ka = kargs(); GAS unsigned char* ws = opq(ka->ws); const int lane = lane_id(), tid = wave * 64 + lane, gt = bid * 512 + tid; (void)gt;
        constexpr int I0 = 32 * 61, I1 = 8 * 24, I2 = 4 * 32, I3 = 32 * 32;
        constexpr int NIT = I0 + I1 + I2 + I3;
        for (int it = gw; it < NIT; it += NGW) {
            int r = it;
            if (r < I0) { const int kb = r / 61, nb = r % 61, n0 = nb * 64; tr_item(((const float*)(GAS const float*)ka->w_in), INC, WIN, DM, kb * 64, n0, n0 < 832 ? n0 : n0 + 192, nullptr, lane); continue; } r -= I0;
            if (r < I1) { const int kb = r / 24, nb = r % 24; tr_item(((const float*)(GAS const float*)ka->w_q_b), 1536, WQB, QLORA, kb * 64, nb * 64, nb * 64, ((const float*)(GAS const float*)ka->g_q_a), lane); continue; } r -= I1;
            if (r < I2) { const int kb = r / 32, nb = r % 32; tr_item(((const float*)(GAS const float*)ka->w_kv_b), 2048, WKVB, KVLORA, kb * 64, nb * 64, nb * 64, ((const float*)(GAS const float*)ka->g_kv_a), lane); continue; } r -= I2;
            { const int kb = r / 32, nb = r % 32; tr_item(((const float*)(GAS const float*)ka->w_o), DM, WO, DM, kb * 64, nb * 64, nb * 64, kb < 16 ? ((const float*)(GAS const float*)ka->g_out_mla) : ((const float*)(GAS const float*)ka->g_out_moba) - MW, lane); }
        }
        for (int i = gt; i < 192 * DM / 8; i += NGT) *(v4u*)(WIN + (size_t)832 * DM + (size_t)i * 8) = (v4u){0u, 0u, 0u, 0u};
        for (int i = gt; i < T * DM / 8; i += NGT) { const f32x4 v0 = *(const f32x4*)(((const float*)(GAS const float*)ka->x) + (size_t)i * 8), v1 = *(const f32x4*)(((const float*)(GAS const float*)ka->x) + (size_t)i * 8 + 4);
            v4u w; w.x = cvt_pk_bf16(v0[0], v0[1]); w.y = cvt_pk_bf16(v0[2], v0[3]); w.z = cvt_pk_bf16(v1[0], v1[1]); w.w = cvt_pk_bf16(v1[2], v1[3]); *(v4u*)(XB + (size_t)i * 8) = w; }
        for (int i = gt; i < T * 96; i += NGT) { const int t = i / 96, j = i % 96; const float p = (float)((const int*)(GAS const int*)ka->pos)[t];
            if (j < 64) { const float inv = (float)exp2(-(double)j * (2.0 / 128.0) * 13.287712379549449); float sn, cs; sincos_d((double)(p * inv), sn, cs); C128[t * 64 + j] = cs; S128[t * 64 + j] = sn; }
            else { const int jj = j - 64; const float inv = (float)exp2(-(double)jj * (2.0 / 64.0) * 13.287712379549449); float sn, cs; sincos_d((double)(p * inv), sn, cs); C64[t * 32 + jj] = cs; S64[t * 32 + jj] = sn; } }
    }
    SEAM(0);

    if (IN(1)) for (int rep_ = 0; rep_ < REPS(1); ++rep_) { KArgs ka = kargs(); GAS unsigned char* ws = opq(ka->ws);
        pg8::Gemm g{XB, WIN, DM * 2, DM * 2, DM * 2, 0}; pg8::StaticOrder S; S.init(T, INP, G, bid);
        pg8::EpiInProj E{(unsigned char*)ws};
        const bool bg_first = ((bid >> 3) & 1) == 0;
        if (bg_first) bg_rounds(ka, ws, 0, BG_P1, gw, NGW, lane_id());
        pg8::gemm_phase<pg8::EpiInProj, pg8::StaticOrder>(L, g, S, E, wave);
        if (!bg_first) bg_rounds(ka, ws, 0, BG_P1, gw, NGW, lane_id());
    }
    SEAM(1);

    if (IN(2)) for (int rep_ = 0; rep_ < REPS(2); ++rep_) { KArgs ka = kargs(); GAS unsigned char* ws = opq(ka->ws); const int lane = lane_id(), tid = wave * 64 + lane, gt = bid * 512 + tid; (void)gt;
        for (int r = gw; r < T; r += NGW) {
            { const v4u w = *(const v4u*)(HQ + (size_t)r * QLORA + lane * 8); float s = 0.f;
              s += bflo(w.x) * bflo(w.x) + bfhi(w.x) * bfhi(w.x) + bflo(w.y) * bflo(w.y) + bfhi(w.y) * bfhi(w.y) + bflo(w.z) * bflo(w.z) + bfhi(w.z) * bfhi(w.z) + bflo(w.w) * bflo(w.w) + bfhi(w.w) * bfhi(w.w);
              s = wave_sum(s); if (lane == 0) RSQ[r] = 1.0f / sqrtf(s * (1.0f / QLORA) + RMS_EPS); }
            { const v2u w = *(const v2u*)(HKV + (size_t)r * KVLORA + lane * 4); float s = 0.f;
              s += bflo(w.x) * bflo(w.x) + bfhi(w.x) * bfhi(w.x) + bflo(w.y) * bflo(w.y) + bfhi(w.y) * bfhi(w.y);
              s = wave_sum(s); if (lane == 0) RSKV[r] = 1.0f / sqrtf(s * (1.0f / KVLORA) + RMS_EPS); }
            if (lane < 32) { const float x1 = bf2f(HR[(size_t)r * 256 + lane]), x2 = bf2f(HR[(size_t)r * 256 + 32 + lane]); const float c = C64[r * 32 + lane], s = S64[r * 32 + lane];
                KPE[(size_t)r * ROPE + lane] = f2bf(x1 * c - x2 * s); KPE[(size_t)r * ROPE + 32 + lane] = f2bf(x2 * c + x1 * s); }
            const float c = C128[r * 64 + lane], s = S128[r * 64 + lane];
#pragma unroll
            for (int h = 0; h < NH; ++h) {
                bf16* q = MQ + (size_t)r * MW + h * 128; const float q1 = bf2f(q[lane]), q2 = bf2f(q[64 + lane]); q[lane] = f2bf(q1 * c - q2 * s); q[64 + lane] = f2bf(q2 * c + q1 * s);
                bf16* k = MK + (size_t)r * MW + h * 128; const float k1 = bf2f(k[lane]), k2 = bf2f(k[64 + lane]); k[lane] = f2bf(k1 * c - k2 * s); k[64 + lane] = f2bf(k2 * c + k1 * s); }
        }
    }
    SEAM(2);

    if (IN(3)) for (int rep_ = 0; rep_ < REPS(3); ++rep_) { KArgs ka = kargs(); GAS unsigned char* ws = opq(ka->ws);
        { pg8::Gemm g{HQ, WQB, QLORA * 2, QLORA * 2, QLORA * 2, 0}; pg8::StaticOrder S; S.init(T, 1536, G, bid); pg8::EpiRowScale E{QM, 1536, RSQ};
          pg8::gemm_phase<pg8::EpiRowScale, pg8::StaticOrder>(L, g, S, E, wave); }
        { pg8::Gemm g{HKV, WKVB, KVLORA * 2, KVLORA * 2, KVLORA * 2, 0}; pg8::StaticOrder S; S.init(T, 2048, G, bid); pg8::EpiRowScale E{KVM, 2048, RSKV};
          pg8::gemm_phase<pg8::EpiRowScale, pg8::StaticOrder>(L, g, S, E, wave); }
    }
    SEAM(3);

    if (IN(4)) for (int rep_ = 0; rep_ < REPS(4); ++rep_) { KArgs ka = kargs(); GAS unsigned char* ws = opq(ka->ws); const int lane = lane_id(), tid = wave * 64 + lane, gt = bid * 512 + tid; (void)gt;
        for (int r = gw; r < T; r += NGW) {
#pragma unroll
            for (int j = 0; j < 4; ++j) { const int idx = lane + 64 * j, h = idx >> 5, i = idx & 31; bf16* q = QM + (size_t)r * 1536 + h * QKH + NOPE;
                const float c = C64[r * 32 + i], s = S64[r * 32 + i]; const float x1 = bf2f(q[i]), x2 = bf2f(q[32 + i]); q[i] = f2bf(x1 * c - x2 * s); q[32 + i] = f2bf(x2 * c + x1 * s); }
        }
        for (int it = gw; it < NH * 32; it += NGW) { const int h = it >> 5, blk = it & 31; float s0 = 0.f, s1 = 0.f;
            const bf16* p = MK + (size_t)blk * 256 * MW + h * 128 + 2 * lane;
            for (int rr = 0; rr < 256; ++rr) { const unsigned w = *(const unsigned*)(p + (size_t)rr * MW); s0 += bflo(w); s1 += bfhi(w); }
            KBAR[(h * 32 + blk) * 128 + 2 * lane] = s0 * (1.0f / 256.0f); KBAR[(h * 32 + blk) * 128 + 2 * lane + 1] = s1 * (1.0f / 256.0f); }
    }
    SEAM(4);

    if (IN(5)) for (int rep_ = 0; rep_ < REPS(5); ++rep_) { KArgs ka = kargs(); GAS unsigned char* ws = opq(ka->ws); const int lane = lane_id(), tid = wave * 64 + lane, gt = bid * 512 + tid; (void)gt;
        LAS float* kb = (LAS float*)L;
        for (int i = tid; i < NH * 32 * 128; i += 512) kb[(i >> 7) * 129 + (i & 127)] = KBAR[i];
        LAS unsigned* qs = (LAS unsigned*)(L + 132096 + wave * 2048);
        __syncthreads();
        for (int t = gw; t < T; t += NGW) {
            const int blk = t >> 8;
            { const v4u w0 = *(const v4u*)(MQ + (size_t)t * MW + lane * 8), w1 = *(const v4u*)(MQ + (size_t)t * MW + 512 + lane * 8);
              *(LAS v4u*)(qs + lane * 4) = w0; *(LAS v4u*)(qs + 256 + lane * 4) = w1; }
            LDS_WAIT(); asm volatile("" ::: "memory");
            const int n = lane & 31;
#pragma unroll 1
            for (int hp = 0; hp < 4; ++hp) { const int h = 2 * hp + (lane >> 5);
                const LAS float* kr = kb + (h * 32 + n) * 129; const LAS unsigned* qh = qs + h * 64; float dot = 0.f;
#pragma unroll 8
                for (int d = 0; d < 64; ++d) { const unsigned w = qh[d]; dot = fmaf(bflo(w), kr[2 * d], dot); dot = fmaf(bfhi(w), kr[2 * d + 1], dot); }
                float gate = n < blk ? dot : -__builtin_inff(); unsigned bits = 0u;
#pragma unroll
                for (int k = 0; k < 3; ++k) { float v = gate; int idx = n;
#pragma unroll
                    for (int off = 16; off >= 1; off >>= 1) { const float ov = __shfl_xor(v, off); const int oi = __shfl_xor(idx, off); if (ov > v || (ov == v && oi < idx)) { v = ov; idx = oi; } }
                    if (k < blk) bits |= 1u << idx;
                    if (n == idx) gate = -__builtin_inff(); }
                if (n == 0) SEL[(size_t)t * NH + h] = bits; }
            LDS_WAIT(); asm volatile("" ::: "memory");
        }
        __syncthreads();
    }
    SEAM(5);

    if (IN(6)) for (int rep_ = 0; rep_ < REPS(6); ++rep_) { KArgs ka = kargs(); GAS unsigned char* ws = opq(ka->ws);
        for (int it = bid; it < 256; it += G) { const int h = it & 7, s = it >> 3;
            at::attn_unit<true>((const bf16*)QM + h * QKH, 1536, (const bf16*)KVM + h * 256, (const bf16*)KVM + h * 256 + 128, 2048, (const bf16*)KPE, OMIX + h * 128, DM, s, nullptr, (char*)lds, wave);
            if (it == bid) bg_rounds(ka, ws, BG_P1, BG_P6, gw, NGW, lane_id());
            at::attn_unit<false>((const bf16*)MQ + h * 128, MW, (const bf16*)MK + h * 128, (const bf16*)MV + h * 128, MW, nullptr, OMIX + MW + h * 128, DM, 31 - s, SEL + h, (char*)lds, wave);
        }
    }
    SEAM(6);

    if (IN(7)) for (int rep_ = 0; rep_ < REPS(7); ++rep_) { KArgs ka = kargs(); GAS unsigned char* ws = opq(ka->ws); const int lane = lane_id(), tid = wave * 64 + lane, gt = bid * 512 + tid; (void)gt;
        for (int r = gw; r < T; r += NGW) { v4u w[4]; float ss[2] = {0.f, 0.f};
#pragma unroll
            for (int j = 0; j < 4; ++j) { w[j] = *(const v4u*)(OMIX + (size_t)r * DM + j * 512 + lane * 8); float s = 0.f;
                s += bflo(w[j].x) * bflo(w[j].x) + bfhi(w[j].x) * bfhi(w[j].x) + bflo(w[j].y) * bflo(w[j].y) + bfhi(w[j].y) * bfhi(w[j].y) + bflo(w[j].z) * bflo(w[j].z) + bfhi(w[j].z) * bfhi(w[j].z) + bflo(w[j].w) * bflo(w[j].w) + bfhi(w[j].w) * bfhi(w[j].w);
                ss[j >> 1] += s; }
            const float r0 = 1.0f / sqrtf(wave_sum(ss[0]) * (1.0f / MW) + RMS_EPS), r1 = 1.0f / sqrtf(wave_sum(ss[1]) * (1.0f / MW) + RMS_EPS);
#pragma unroll
            for (int j = 0; j < 4; ++j) { const float sc = j < 2 ? r0 : r1; v4u o;
                o.x = cvt_pk_bf16(bflo(w[j].x) * sc, bfhi(w[j].x) * sc); o.y = cvt_pk_bf16(bflo(w[j].y) * sc, bfhi(w[j].y) * sc); o.z = cvt_pk_bf16(bflo(w[j].z) * sc, bfhi(w[j].z) * sc); o.w = cvt_pk_bf16(bflo(w[j].w) * sc, bfhi(w[j].w) * sc);
                *(v4u*)(OMIX + (size_t)r * DM + j * 512 + lane * 8) = o; } }
    }
    SEAM(7);

    if (IN(8)) for (int rep_ = 0; rep_ < REPS(8); ++rep_) { KArgs ka = kargs(); GAS unsigned char* ws = opq(ka->ws);
        pg8::Gemm g{OMIX, WO, DM * 2, DM * 2, DM * 2, 0}; pg8::StaticOrder S; S.init(T, DM, G, bid); pg8::EpiResF32 E{((const float*)(GAS const float*)ka->x), X1P, DM};
        const bool bg_first = ((bid >> 3) & 1) == 0;
        if (bg_first) bg_rounds(ka, ws, BG_P6, BG_P8, gw, NGW, lane_id());
        pg8::gemm_phase<pg8::EpiResF32, pg8::StaticOrder>(L, g, S, E, wave);
        if (!bg_first) bg_rounds(ka, ws, BG_P6, BG_P8, gw, NGW, lane_id());
    }
    SEAM(8);

    if (IN(9)) for (int rep_ = 0; rep_ < REPS(9); ++rep_) { KArgs ka = kargs(); GAS unsigned char* ws = opq(ka->ws); const int lane = lane_id(), tid = wave * 64 + lane, gt = bid * 512 + tid; (void)gt;
        LAS float* part = (LAS float*)L;
        LAS float* lg = (LAS float*)(L + 32768);
        for (int rg = bid; rg < T / 32; rg += G) { const int R0 = rg * 32;
            for (int rr = 0; rr < 4; ++rr) { const int r = R0 + wave * 4 + rr; f32x4 v[8]; float s = 0.f;
#pragma unroll
                for (int j = 0; j < 8; ++j) { v[j] = *(const f32x4*)(X1P + (size_t)r * DM + j * 256 + lane * 4); s += (v[j][0] + v[j][1]) + (v[j][2] + v[j][3]); }
                const float mean = wave_sum(s) * (1.0f / DM); float q = 0.f;
#pragma unroll
                for (int j = 0; j < 8; ++j) { v[j] = v[j] - mean; q += (v[j][0] * v[j][0] + v[j][1] * v[j][1]) + (v[j][2] * v[j][2] + v[j][3] * v[j][3]); }
                const float rstd = 1.0f / sqrtf(wave_sum(q) * (1.0f / DM) + LN_EPS);
#pragma unroll
                for (int j = 0; j < 8; ++j) { const int c = j * 256 + lane * 4; const f32x4 gg = *(const f32x4*)(((const float*)(GAS const float*)ka->ln1_g) + c), bb = *(const f32x4*)(((const float*)(GAS const float*)ka->ln1_b) + c);
                    const f32x4 y = v[j] * rstd * gg + bb; *(f32x4*)(X1N + (size_t)r * DM + c) = y;
                    *(unsigned*)(X1B + (size_t)r * DM + c) = pk4_fp8(y[0] * SC_X, y[1] * SC_X, y[2] * SC_X, y[3] * SC_X); } }
            VM_WAIT(); __syncthreads();
            { f32x16 acc = f32x16{}; const int hh = lane >> 5, li = lane & 31;
              const float* ap = X1N + (size_t)(R0 + li) * DM + wave * 256 + 4 * hh; const float* bp = ((const float*)(GAS const float*)ka->w_router) + (size_t)(wave * 256 + 4 * hh) * NE + li;
#pragma unroll 4
              for (int kk = 0; kk < 32; ++kk) { const f32x4 av = *(const f32x4*)(ap + kk * 8); const float* b = bp + (size_t)kk * 8 * NE;
                  acc = __builtin_amdgcn_mfma_f32_32x32x2f32(av[0], b[0], acc, 0, 0, 0); acc = __builtin_amdgcn_mfma_f32_32x32x2f32(av[1], b[NE], acc, 0, 0, 0);
                  acc = __builtin_amdgcn_mfma_f32_32x32x2f32(av[2], b[2 * NE], acc, 0, 0, 0); acc = __builtin_amdgcn_mfma_f32_32x32x2f32(av[3], b[3 * NE], acc, 0, 0, 0); }
#pragma unroll
              for (int r = 0; r < 16; ++r) part[(wave * 32 + at::crow(r, hh)) * 32 + li] = acc[r]; }
            __syncthreads();
            for (int i = tid; i < 1024; i += 512) { float s = ((const float*)(GAS const float*)ka->b_router)[i & 31];
#pragma unroll
                for (int w = 0; w < 8; ++w) s += part[w * 1024 + i];
                lg[(i >> 5) * 33 + (i & 31)] = s; }
            __syncthreads();
            if (tid < 32) { float v[32];
#pragma unroll
                for (int e = 0; e < 32; ++e) v[e] = lg[tid * 33 + e];
                float tv[4]; int ti[4];
#pragma unroll
                for (int k = 0; k < 4; ++k) { float best = -__builtin_inff(); int bi = 0;
#pragma unroll
                    for (int e = 0; e < 32; ++e) { if (v[e] > best) { best = v[e]; bi = e; } }
                    tv[k] = best; ti[k] = bi;
#pragma unroll
                    for (int e = 0; e < 32; ++e) if (e == bi) v[e] = -__builtin_inff(); }
                const float e1 = __expf(tv[1] - tv[0]), e2 = __expf(tv[2] - tv[0]), e3 = __expf(tv[3] - tv[0]); const float inv = 1.0f / (1.0f + e1 + e2 + e3);
                const float gk[4] = {inv, e1 * inv, e2 * inv, e3 * inv}; const int r = R0 + tid;
#pragma unroll
                for (int k = 0; k < 4; ++k) { const unsigned rank = __hip_atomic_fetch_add((unsigned*)(ctl + CW_COUNT + ti[k]), 1u, RLX_AGENT);
                    TOPE[r * 4 + k] = ti[k]; TOPR[r * 4 + k] = (int)rank; TOPG[r * 4 + k] = gk[k]; } }
            __syncthreads();
        }
    }
    SEAM(9);

    if (IN(10)) for (int rep_ = 0; rep_ < REPS(10); ++rep_) { KArgs ka = kargs(); GAS unsigned char* ws = opq(ka->ws); const int lane = lane_id(), tid = wave * 64 + lane, gt = bid * 512 + tid; (void)gt;
        LAS int* ps = (LAS int*)L;
        if (tid == 0) { int acc_ = 0; for (int e = 0; e < NE; ++e) { const int c = (int)__hip_atomic_load((unsigned*)(ctl + CW_COUNT + e), RLX_AGENT); const int p = (c + 255) & ~255; ps[e] = acc_; ps[32 + e] = c; ps[64 + e] = p; acc_ += p; } ps[96] = acc_; }
        __syncthreads();
        if (bid == 0) { if (tid == 0) __hip_atomic_store((unsigned*)(ctl + CW_NRT), (unsigned)(ps[96] >> 8), RLX_AGENT);
            if (tid < NE) { const int e = tid; for (int rt = ps[e] >> 8; rt < (ps[e] + ps[64 + e]) >> 8; ++rt) __hip_atomic_store((unsigned*)(ctl + CW_TILEE + rt), (unsigned)e, RLX_AGENT); } }
        for (int it = gw; it < T * TOPK; it += NGW) { const int t = it >> 2; const int e = TOPE[it], rk = TOPR[it]; const int row = ps[e] + rk;
            const v4u* src = (const v4u*)(X1B + (size_t)t * DM); v4u* dst = (v4u*)(XG + (size_t)row * DM);
#pragma unroll
            for (int j = 0; j < 2; ++j) dst[j * 64 + lane] = src[j * 64 + lane];
            if (lane == 0) { RGATE[row] = TOPG[it]; TOPROW[it] = row; } }
        for (int it = gw; it < NE * 256; it += NGW) { const int e = it >> 8, i = it & 255; const int rk = ps[32 + e] + i;
            if (rk < ps[64 + e]) { const int row = ps[e] + rk; v4u* dst = (v4u*)(XG + (size_t)row * DM);
#pragma unroll
                for (int j = 0; j < 2; ++j) dst[j * 64 + lane] = (v4u){0u, 0u, 0u, 0u};
                if (lane == 0) RGATE[row] = 0.f; } }
        __syncthreads();
    }
    SEAM(10);

    if (IN(11)) for (int rep_ = 0; rep_ < REPS(11); ++rep_) { KArgs ka = kargs(); GAS unsigned char* ws = opq(ka->ws);
        const int n_rt = (int)__builtin_amdgcn_readfirstlane((int)__hip_atomic_load((unsigned*)(ctl + CW_NRT), RLX_AGENT));
        LAS unsigned* te = (LAS unsigned*)(L + LDSCTL_OFF + 64);
        { const int i_ = wave * 64 + lane_id(); if (i_ < MAXRT) te[i_] = i_ < n_rt ? __hip_atomic_load((unsigned*)(ctl + CW_TILEE + i_), RLX_AGENT) : 0u; }
        __syncthreads();
        pg8::Gemm g{XG, WGU, DM, DM, DM, (size_t)2 * DFF * DM}; pg8::MoeOrder S{te, n_rt, 4, G, bid};
        pg8::EpiSwiglu E{ACT, ((const float*)(GAS const float*)ka->b_gate_up)};
        pg8::gemm_phase<pg8::EpiSwiglu, pg8::MoeOrder, true>(L, g, S, E, wave);
    }
    SEAM(11);

    if (IN(12)) for (int rep_ = 0; rep_ < REPS(12); ++rep_) { KArgs ka = kargs(); GAS unsigned char* ws = opq(ka->ws);
        const int n_rt = (int)__builtin_amdgcn_readfirstlane((int)__hip_atomic_load((unsigned*)(ctl + CW_NRT), RLX_AGENT));
        LAS unsigned* te = (LAS unsigned*)(L + LDSCTL_OFF + 64);
        { const int i_ = wave * 64 + lane_id(); if (i_ < MAXRT) te[i_] = i_ < n_rt ? __hip_atomic_load((unsigned*)(ctl + CW_TILEE + i_), RLX_AGENT) : 0u; }
        __syncthreads();
        pg8::Gemm g{ACT, WD, DFF, DFF, DFF, (size_t)DM * DFF}; pg8::MoeOrder S{te, n_rt, 3, G, bid};
        pg8::EpiDown E{YB, ((const float*)(GAS const float*)ka->b_down), RGATE};
        pg8::gemm_phase<pg8::EpiDown, pg8::MoeOrder, true>(L, g, S, E, wave);
    }
    SEAM(12);

    if (IN(13)) for (int rep_ = 0; rep_ < REPS(13); ++rep_) { KArgs ka = kargs(); GAS unsigned char* ws = opq(ka->ws); const int lane = lane_id(), tid = wave * 64 + lane, gt = bid * 512 + tid; (void)gt;
        for (int t = gw; t < T; t += NGW) { int rows[4];
#pragma unroll
            for (int k = 0; k < 4; ++k) rows[k] = TOPROW[t * 4 + k];
            f32x4 v[8]; float s = 0.f;
#pragma unroll
            for (int j = 0; j < 8; ++j) { const int c = j * 256 + lane * 4; f32x4 y = *(const f32x4*)(X1N + (size_t)t * DM + c) * ALPHA;
#pragma unroll
                for (int k = 0; k < 4; ++k) { const v2u w = *(const v2u*)(YB + (size_t)rows[k] * DM + c); y[0] += bflo(w.x); y[1] += bfhi(w.x); y[2] += bflo(w.y); y[3] += bfhi(w.y); }
                v[j] = y; s += (y[0] + y[1]) + (y[2] + y[3]); }
            const float mean = wave_sum(s) * (1.0f / DM); float q = 0.f;
#pragma unroll
            for (int j = 0; j < 8; ++j) { v[j] = v[j] - mean; q += (v[j][0] * v[j][0] + v[j][1] * v[j][1]) + (v[j][2] * v[j][2] + v[j][3] * v[j][3]); }
            const float rstd = 1.0f / sqrtf(wave_sum(q) * (1.0f / DM) + LN_EPS);
#pragma unroll
            for (int j = 0; j < 8; ++j) { const int c = j * 256 + lane * 4; const f32x4 gg = *(const f32x4*)(((const float*)(GAS const float*)ka->ln2_g) + c), bb = *(const f32x4*)(((const float*)(GAS const float*)ka->ln2_b) + c);
                *(f32x4*)(((float*)(GAS float*)ka->out) + (size_t)t * DM + c) = v[j] * rstd * gg + bb; } }
    }
#undef IN
#undef SEAM
}

extern "C" void kernel_launch(void* const* d_in, const int* in_sizes, int n_in, void* d_out, int out_size, void* d_ws, size_t ws_size, hipStream_t stream) {
    static int grid = 0;
    if (grid == 0) {
        if (n_in != 20 || in_sizes[0] != T * DM || out_size != T * DM || ws_size < WS_END) { fprintf(stderr, "kernel_launch: unexpected shapes (n_in %d, in0 %d, out %d, ws %zu < %zu)\n", n_in, n_in > 0 ? in_sizes[0] : -1, out_size, ws_size, (size_t)WS_END); grid = -1; return; }
        int dev = 0, cus = 0, per_cu = 0;
        if (hipGetDevice(&dev) != hipSuccess || hipDeviceGetAttribute(&cus, hipDeviceAttributeMultiprocessorCount, dev) != hipSuccess) { grid = -1; return; }
        if (hipFuncSetAttribute((const void*)fwd, hipFuncAttributeMaxDynamicSharedMemorySize, LDS_BYTES) != hipSuccess) { fprintf(stderr, "kernel_launch: hipFuncSetAttribute failed\n"); grid = -1; return; }
        if (hipOccupancyMaxActiveBlocksPerMultiprocessor(&per_cu, (const void*)fwd, 512, LDS_BYTES) != hipSuccess || per_cu < 1) fprintf(stderr, "kernel_launch: occupancy query says %d\n", per_cu);
        (void)hipGetLastError();
        grid = cus;
    }
    if (grid < 0) return;
    (void)hipMemsetAsync((char*)d_ws + WS_CTL, 0, CTL_ZERO_BYTES, stream);
    Args a{};
    a.x = (const float*)d_in[0]; a.pos = (const int*)d_in[1]; a.w_in = (const float*)d_in[2]; a.g_q_a = (const float*)d_in[3]; a.w_q_b = (const float*)d_in[4];
    a.g_kv_a = (const float*)d_in[5]; a.w_kv_b = (const float*)d_in[6]; a.g_out_mla = (const float*)d_in[7]; a.g_out_moba = (const float*)d_in[8]; a.w_o = (const float*)d_in[9];
    a.ln1_g = (const float*)d_in[10]; a.ln1_b = (const float*)d_in[11]; a.w_router = (const float*)d_in[12]; a.b_router = (const float*)d_in[13];
    a.w_gate_up = (const float*)d_in[14]; a.b_gate_up = (const float*)d_in[15]; a.w_down = (const float*)d_in[16]; a.b_down = (const float*)d_in[17];
    a.ln2_g = (const float*)d_in[18]; a.ln2_b = (const float*)d_in[19];
    a.out = (float*)d_out; a.ws = (unsigned char*)d_ws;
    if (MK_N_LAUNCHES == 1) { a.ph_lo = 0; a.ph_hi = NPHASES; hipLaunchKernelGGL(fwd, dim3(grid), dim3(512), LDS_BYTES, stream, a); }
    else { for (int p = 0; p < NPHASES; ++p) { a.ph_lo = p; a.ph_hi = p + 1; hipLaunchKernelGGL(fwd, dim3(grid), dim3(512), LDS_BYTES, stream, a); } }
    const hipError_t le = hipPeekAtLastError();
    if (le != hipSuccess) fprintf(stderr, "kernel_launch: launch failed: %s\n", hipGetErrorName(le));
}
```

```cpp
#include <hip/hip_runtime.h>
#include <cstdio>
#include <cstdint>

#ifndef PROBE_REP_MASK
#define PROBE_REP_MASK 0
#endif
#ifndef MK_N_LAUNCHES
#define MK_N_LAUNCHES 1
#endif

constexpr int T = 8192, DM = 2048, NH = 8;
constexpr int QLORA = 512, KVLORA = 256, ROPE = 64, NOPE = 128, VH = 128, QKH = NOPE + ROPE;
constexpr int MW = 1024;
constexpr int INC = 3904, INP = 4096;
constexpr int NE = 32, TOPK = 4, DFF = 2048;
constexpr int MAXROWS = T * TOPK + NE * 256;
constexpr int MAXRT = MAXROWS / 256;
constexpr float ALPHA = 1.189207115002721f;
constexpr float RMS_EPS = 1e-6f, LN_EPS = 1e-5f;

#define GAS __attribute__((address_space(1)))
#define LAS __attribute__((address_space(3)))
typedef unsigned short bf16;
typedef unsigned v4u __attribute__((ext_vector_type(4)));
typedef unsigned v2u __attribute__((ext_vector_type(2)));
typedef float f32x4 __attribute__((ext_vector_type(4)));
typedef float f32x2 __attribute__((ext_vector_type(2)));
typedef float f32x16 __attribute__((ext_vector_type(16)));
typedef short bf16x8 __attribute__((ext_vector_type(8)));
typedef short s16x4 __attribute__((ext_vector_type(4)));
typedef GAS unsigned gu32;
#define RLX_AGENT __ATOMIC_RELAXED, __HIP_MEMORY_SCOPE_AGENT
#define LDS_WAIT() asm volatile("s_waitcnt lgkmcnt(0)" ::: "memory")
#define VM_WAIT() asm volatile("s_waitcnt vmcnt(0)" ::: "memory")
#define SBAR() __builtin_amdgcn_sched_barrier(0)

__device__ __forceinline__ unsigned cvt_pk_bf16(float lo, float hi) { unsigned r; asm volatile("v_cvt_pk_bf16_f32 %0, %1, %2" : "=v"(r) : "v"(lo), "v"(hi)); return r; }
__device__ __forceinline__ float bf2f(unsigned short b) { return __uint_as_float(((unsigned)b) << 16); }
__device__ __forceinline__ float bflo(unsigned w) { return __uint_as_float(w << 16); }
__device__ __forceinline__ float bfhi(unsigned w) { return __uint_as_float(w & 0xffff0000u); }
__device__ __forceinline__ unsigned short f2bf(float f) { return (unsigned short)(cvt_pk_bf16(f, f) & 0xffffu); }
__device__ __forceinline__ unsigned pk4_fp8(float a, float b, float c, float d) { int w = 0; w = __builtin_amdgcn_cvt_pk_fp8_f32(a, b, w, false); w = __builtin_amdgcn_cvt_pk_fp8_f32(c, d, w, true); return (unsigned)w; }
typedef int v4i __attribute__((ext_vector_type(4)));
typedef int v8i __attribute__((ext_vector_type(8)));
__device__ __forceinline__ v8i cat8(bf16x8 a, bf16x8 b) { const v4i x = __builtin_bit_cast(v4i, a), y = __builtin_bit_cast(v4i, b); return __builtin_shufflevector(x, y, 0, 1, 2, 3, 4, 5, 6, 7); }
__device__ __forceinline__ int lane_id() { int l = (int)__builtin_amdgcn_mbcnt_hi(~0u, __builtin_amdgcn_mbcnt_lo(~0u, 0u)); asm volatile("" : "+v"(l)); return l; }
__device__ __forceinline__ float wave_sum(float v) {
#pragma unroll
    for (int o = 1; o < 64; o <<= 1) v += __shfl_xor(v, o);
    return v;
}

constexpr size_t MiB = 1u << 20;
constexpr size_t WS_CTL = 0, CTL_ZERO_BYTES = 1 * MiB;
constexpr size_t WS_XB    = 2 * MiB;
constexpr size_t WS_WIN   = WS_XB + 32 * MiB;
constexpr size_t WS_WQB   = WS_WIN + 16 * MiB;
constexpr size_t WS_WKVB  = WS_WQB + 2 * MiB;
constexpr size_t WS_WO    = WS_WKVB + 1 * MiB;
constexpr size_t WS_C128  = WS_WO + 8 * MiB;
constexpr size_t WS_S128  = WS_C128 + 2 * MiB;
constexpr size_t WS_C64   = WS_S128 + 2 * MiB;
constexpr size_t WS_S64   = WS_C64 + 1 * MiB;
constexpr size_t WS_HQ    = WS_S64 + 1 * MiB;
constexpr size_t WS_HKV   = WS_HQ + 8 * MiB;
constexpr size_t WS_HR    = WS_HKV + 4 * MiB;
constexpr size_t WS_KPE   = WS_HR + 4 * MiB;
constexpr size_t WS_MQ    = WS_KPE + 1 * MiB;
constexpr size_t WS_MK    = WS_MQ + 16 * MiB;
constexpr size_t WS_MV    = WS_MK + 16 * MiB;
constexpr size_t WS_RSQ   = WS_MV + 16 * MiB;
constexpr size_t WS_RSKV  = WS_RSQ + 1 * MiB;
constexpr size_t WS_QM    = WS_RSKV + 1 * MiB;
constexpr size_t WS_KVM   = WS_QM + 24 * MiB;
constexpr size_t WS_KBAR  = WS_KVM + 32 * MiB;
constexpr size_t WS_SEL   = WS_KBAR + 1 * MiB;
constexpr size_t WS_OMIX  = WS_SEL + 1 * MiB;
constexpr size_t WS_X1P   = WS_OMIX + 32 * MiB;
constexpr size_t WS_X1N   = WS_X1P + 64 * MiB;
constexpr size_t WS_X1B   = WS_X1N + 64 * MiB;
constexpr size_t WS_TOPE  = WS_X1B + 32 * MiB;
constexpr size_t WS_TOPR  = WS_TOPE + 1 * MiB;
constexpr size_t WS_TOPG  = WS_TOPR + 1 * MiB;
constexpr size_t WS_TOPROW= WS_TOPG + 1 * MiB;
constexpr size_t WS_RGATE = WS_TOPROW + 1 * MiB;
constexpr size_t WS_XG    = WS_RGATE + 1 * MiB;
constexpr size_t WS_ACT   = WS_XG + 80 * MiB;
constexpr size_t WS_Y     = WS_ACT + 80 * MiB;
constexpr size_t WS_WGU   = WS_Y + 160 * MiB;
constexpr size_t WS_WD    = WS_WGU + 256 * MiB;
constexpr size_t WS_END   = WS_WD + 128 * MiB;
constexpr float SC_X = 16.0f, SC_WGU = 512.0f, SC_ACT = 4.0f, SC_WD = 1024.0f;
constexpr int CW_BAR = 4096;
constexpr int CW_COUNT = 16384;
constexpr int CW_TILEE = 16384 + 64;
constexpr int CW_NRT = 16384 + 64 + 192;

constexpr int LDS_BYTES = 159744;
constexpr int LDSCTL_OFF = 158720;

namespace pg8 {
constexpr int BM = 256, BK = 64, HALF = 128, HTB = HALF * BK * 2, STAGE_BYTES = 8 * HTB, NXCD = 8, WGM = 8;
__host__ __device__ __forceinline__ int lds_byte(int r, int c) { const int st = (r >> 4) * 2 + (c >> 5), rr = r & 15, cc = c & 31, ob = rr * 64 + cc * 2; return st * 1024 + (ob ^ (((ob >> 9) & 1) << 5)); }
__host__ __device__ __forceinline__ void stage_rc(int b, int& R, int& C) { const int st = b / 1024, sb = b % 1024, swz = sb ^ (((sb >> 9) & 1) << 5); R = (st >> 1) * 16 + swz / 64; C = (st & 1) * 32 + (swz % 64) / 2; }
__host__ __device__ __forceinline__ int perm32(int rho) { const int n = rho >> 4, i = rho & 15; return 8 * (i >> 2) + 4 * n + (i & 3); }

struct Unit { int pm, pn, e; };
struct Gemm { const void* A; const void* Bt; int Kb, lda, ldb; size_t bes; };

struct StaticOrder {
    int nM, nN, nwg, G, c;
    __device__ void init(int M, int N, int G_, int c_) { nM = M / BM; nN = N / BM; nwg = nM * nN; G = G_; c = c_; }
    __device__ bool next(int i, Unit& u) const {
        const long L = (long)i * G + c; if (L >= nwg) return false;
        int wgid = (int)L; { const int q = nwg / NXCD, r = nwg % NXCD, xcd = wgid % NXCD, off = wgid / NXCD; wgid = (xcd < r ? xcd * (q + 1) : r * (q + 1) + (xcd - r) * q) + off; }
        const int nig = WGM * nN, gid = wgid / nig, fm = gid * WGM, gsz = (nM - fm) < WGM ? (nM - fm) : WGM;
        u.pm = fm + ((wgid % nig) % gsz); u.pn = (wgid % nig) / gsz; u.e = 0; return true;
    }
};
struct MoeOrder {
    const LAS unsigned* tile_e; int n_rt, lnpn, G, c;
    __device__ bool next(int i, Unit& u) const {
        const int L = i * G + c; if (L >= (n_rt << lnpn)) return false;
        const int rt = L >> lnpn; u.pm = rt; u.pn = L - (rt << lnpn);
        u.e = (int)__builtin_amdgcn_readfirstlane((int)tile_e[rt]); return true;
    }
};

typedef f32x4 Acc[2][2][4][2];

struct EpiInProj {
    static constexpr bool PERM = true;
    unsigned char* ws;
    __device__ __forceinline__ void operator()(const Acc& acc, const Unit& u, int wr, int wc, int fr, int fq) const {
        const int pn = u.pn; size_t off; int ldc, colt;
        if (pn < 4) { off = WS_HQ + (size_t)(pn >> 1) * (8u << 20) + (size_t)(pn == 3 ? 1 : 0) * (4u << 20); ldc = 512 - (pn >> 1) * 256; colt = (pn >> 1) ? 0 : pn * 256; }
        else { off = WS_MQ + (size_t)((pn - 4) >> 2) * (16u << 20); ldc = 1024; colt = ((pn - 4) & 3) * 256; }
        bf16* base = (bf16*)(ws + off);
        const int row0 = u.pm * BM + wr * 64 + fr, col0 = colt + wc * 32 + 8 * fq;
#pragma unroll
        for (int ai = 0; ai < 2; ++ai)
#pragma unroll
            for (int m = 0; m < 4; ++m) { bf16* rowp = base + (size_t)(row0 + ai * HALF + m * 16) * ldc + col0;
#pragma unroll
                for (int bj = 0; bj < 2; ++bj) { const f32x4 v0 = acc[ai][bj][m][0], v1 = acc[ai][bj][m][1];
                    v4u w; w.x = cvt_pk_bf16(v0[0], v0[1]); w.y = cvt_pk_bf16(v0[2], v0[3]); w.z = cvt_pk_bf16(v1[0], v1[1]); w.w = cvt_pk_bf16(v1[2], v1[3]);
                    *(v4u*)(rowp + bj * HALF) = w; } }
    }
};
struct EpiRowScale {
    static constexpr bool PERM = true;
    bf16* O; int ldc; const float* rs;
    __device__ __forceinline__ void operator()(const Acc& acc, const Unit& u, int wr, int wc, int fr, int fq) const {
        const int row0 = u.pm * BM + wr * 64 + fr, col0 = u.pn * BM + wc * 32 + 8 * fq;
#pragma unroll
        for (int ai = 0; ai < 2; ++ai)
#pragma unroll
            for (int m = 0; m < 4; ++m) { const int row = row0 + ai * HALF + m * 16; const float s = rs[row]; bf16* rowp = O + (size_t)row * ldc + col0;
#pragma unroll
                for (int bj = 0; bj < 2; ++bj) { const f32x4 v0 = acc[ai][bj][m][0] * s, v1 = acc[ai][bj][m][1] * s;
                    v4u w; w.x = cvt_pk_bf16(v0[0], v0[1]); w.y = cvt_pk_bf16(v0[2], v0[3]); w.z = cvt_pk_bf16(v1[0], v1[1]); w.w = cvt_pk_bf16(v1[2], v1[3]);
                    *(v4u*)(rowp + bj * HALF) = w; } }
    }
};
struct EpiResF32 {
    static constexpr bool PERM = false;
    const float* X; float* O; int ldc;
    __device__ __forceinline__ void operator()(const Acc& acc, const Unit& u, int wr, int wc, int fr, int fq) const {
        const int row0 = u.pm * BM + wr * 64 + fr, col0 = u.pn * BM + wc * 32 + 4 * fq;
#pragma unroll
        for (int ai = 0; ai < 2; ++ai)
#pragma unroll
            for (int m = 0; m < 4; ++m) { const size_t off = (size_t)(row0 + ai * HALF + m * 16) * ldc + col0;
#pragma unroll
                for (int bj = 0; bj < 2; ++bj)
#pragma unroll
                    for (int n = 0; n < 2; ++n) { const f32x4 xv = *(const f32x4*)(X + off + bj * HALF + n * 16); *(f32x4*)(O + off + bj * HALF + n * 16) = xv * ALPHA + acc[ai][bj][m][n]; }
                asm volatile("" ::: "memory"); }
    }
};
struct EpiSwiglu {
    static constexpr bool PERM = true;
    unsigned char* ACT; const float* bgu;
    __device__ __forceinline__ void operator()(const Acc& acc, const Unit& u, int wr, int wc, int fr, int fq) const {
        const int row0 = u.pm * BM + wr * 64 + fr, j0 = u.pn * HALF + wc * 32 + 8 * fq;
        const float* bg = bgu + (size_t)u.e * (2 * DFF) + j0; const float* bu = bg + DFF;
        const f32x4 bg0 = *(const f32x4*)bg, bg1 = *(const f32x4*)(bg + 4), bu0 = *(const f32x4*)bu, bu1 = *(const f32x4*)(bu + 4);
#pragma unroll
        for (int ai = 0; ai < 2; ++ai)
#pragma unroll
            for (int m = 0; m < 4; ++m) { unsigned char* rowp = ACT + (size_t)(row0 + ai * HALF + m * 16) * DFF + j0;
                float a[8];
#pragma unroll
                for (int n = 0; n < 2; ++n) { const f32x4 gv = acc[ai][0][m][n] * (1.0f / (SC_X * SC_WGU)) + (n ? bg1 : bg0), uv = acc[ai][1][m][n] * (1.0f / (SC_X * SC_WGU)) + (n ? bu1 : bu0);
#pragma unroll
                    for (int j = 0; j < 4; ++j) { const float g = fminf(gv[j], 7.0f), uu = fminf(fmaxf(uv[j], -7.0f), 7.0f);
                        const float sg = __builtin_amdgcn_rcpf(1.0f + __builtin_amdgcn_exp2f(g * (-1.702f * 1.4426950408889634f)));
                        a[n * 4 + j] = (uu + 1.0f) * g * sg * SC_ACT; } }
                v2u w; w.x = pk4_fp8(a[0], a[1], a[2], a[3]); w.y = pk4_fp8(a[4], a[5], a[6], a[7]);
                *(v2u*)rowp = w; }
    }
};
struct EpiDown {
    static constexpr bool PERM = true;
    bf16* Y; const float* bd; const float* rgate;
    __device__ __forceinline__ void operator()(const Acc& acc, const Unit& u, int wr, int wc, int fr, int fq) const {
        const int row0 = u.pm * BM + wr * 64 + fr, col0 = u.pn * BM + wc * 32 + 8 * fq;
        const float* bp = bd + (size_t)u.e * DM + col0;
        f32x4 bv[2][2];
#pragma unroll
        for (int bj = 0; bj < 2; ++bj)
#pragma unroll
            for (int n = 0; n < 2; ++n) bv[bj][n] = *(const f32x4*)(bp + bj * HALF + 4 * n);
#pragma unroll
        for (int ai = 0; ai < 2; ++ai)
#pragma unroll
            for (int m = 0; m < 4; ++m) { const int row = row0 + ai * HALF + m * 16; const float s = rgate[row]; bf16* rowp = Y + (size_t)row * DM + col0;
#pragma unroll
                for (int bj = 0; bj < 2; ++bj) { const f32x4 v0 = (acc[ai][bj][m][0] * (1.0f / (SC_ACT * SC_WD)) + bv[bj][0]) * s, v1 = (acc[ai][bj][m][1] * (1.0f / (SC_ACT * SC_WD)) + bv[bj][1]) * s;
                    v4u w; w.x = cvt_pk_bf16(v0[0], v0[1]); w.y = cvt_pk_bf16(v0[2], v0[3]); w.z = cvt_pk_bf16(v1[0], v1[1]); w.w = cvt_pk_bf16(v1[2], v1[3]);
                    *(v4u*)(rowp + bj * HALF) = w; } }
    }
};

template <class Epi, class Sched, bool F8 = false, bool ALIGN_EPI = true, bool SP2 = true>
__device__ __forceinline__ void gemm_phase(LAS unsigned char* lds, const Gemm g, const Sched& S, const Epi& E, const int wid  ) {
    const int lane = lane_id(), tid = wid * 64 + lane, wr = wid >> 2, wc = wid & 3, fr = lane & 15, fq = lane >> 4;
    const int nt = g.Kb / 128;
    const __amdgpu_buffer_rsrc_t rA = __builtin_amdgcn_make_buffer_rsrc((void*)g.A, 0, -1, 0x00020000);
    const __amdgpu_buffer_rsrc_t rB = __builtin_amdgcn_make_buffer_rsrc((void*)g.Bt, 0, -1, 0x00020000);
    unsigned voffA[2], voffB[2];
#pragma unroll
    for (int i = 0; i < 2; ++i) { int R, C; stage_rc(tid * 16 + i * 8192, R, C); const int Rb = Epi::PERM ? ((R & ~31) + perm32(R & 31)) : R;
        voffA[i] = (unsigned)(R * g.lda + C * 2); voffB[i] = (unsigned)(Rb * g.ldb + C * 2); }
    const unsigned kstep = 128u;
    const unsigned hstepA = (unsigned)HALF * g.lda, hstepB = (unsigned)HALF * g.ldb;
    const unsigned tstepA = 2 * hstepA, tstepB = 2 * hstepB;
    const unsigned ldsw = (unsigned)wid * 1024u;
    const int aoff = lds_byte(wr * 64 + fr, fq * 8), boff = lds_byte(wc * 32 + fr, fq * 8);
#define PG8_SA(b, h) (((b) * 2 + (h)) * HTB)
#define PG8_SB(b, h) ((4 + (b) * 2 + (h)) * HTB)
#define PG8_STAGE(bufoff, rsrc, soff, voff) do { _Pragma("unroll") for (int _i = 0; _i < 2; ++_i) \
        __builtin_amdgcn_raw_ptr_buffer_load_lds(rsrc, (LAS unsigned*)(lds + (bufoff) + ldsw + _i * 8192), 16, (voff)[_i], (soff), 0, 0); } while (0)
#define PG8_LDA(dst, b, h) do { _Pragma("unroll") for (int m = 0; m < 4; ++m) _Pragma("unroll") for (int k = 0; k < 2; ++k) dst[m][k] = *(const LAS bf16x8*)(lds + PG8_SA(b, h) + aoff + m * 2048 + k * 1024); } while (0)
#define PG8_LDB(dst, b, h) do { _Pragma("unroll") for (int n = 0; n < 2; ++n) _Pragma("unroll") for (int k = 0; k < 2; ++k) dst[n][k] = *(const LAS bf16x8*)(lds + PG8_SB(b, h) + boff + n * 2048 + k * 1024); } while (0)
#define PG8_MMA(ai, bj, At, Bt) do { __builtin_amdgcn_s_setprio(1); if constexpr (F8) { _Pragma("unroll") for (int m = 0; m < 4; ++m) _Pragma("unroll") for (int n = 0; n < 2; ++n) \
        acc[ai][bj][m][n] = __builtin_amdgcn_mfma_scale_f32_16x16x128_f8f6f4(cat8(Bt[n][0], Bt[n][1]), cat8(At[m][0], At[m][1]), acc[ai][bj][m][n], 0, 0, 0, 0, 0, 0); } \
        else { _Pragma("unroll") for (int m = 0; m < 4; ++m) _Pragma("unroll") for (int n = 0; n < 2; ++n) _Pragma("unroll") for (int k = 0; k < 2; ++k) \
        acc[ai][bj][m][n] = __builtin_amdgcn_mfma_f32_16x16x32_bf16(Bt[n][k], At[m][k], acc[ai][bj][m][n], 0, 0, 0); } __builtin_amdgcn_s_setprio(0); } while (0)
#define PG8_WAIT_V(n) asm volatile("s_waitcnt vmcnt(" #n ")" ::: "memory")
#define PG8_WAIT_L(n) asm volatile("s_waitcnt lgkmcnt(" #n ")" ::: "memory")
#define PG8_BAR __builtin_amdgcn_s_barrier()
#define PG8_SCHED __builtin_amdgcn_sched_barrier(0)
    Unit cur, nxt; int ui = 0;
    if (!S.next(0, cur)) return;
    Acc acc;
#pragma unroll
    for (int a = 0; a < 2; ++a)
#pragma unroll
        for (int b = 0; b < 2; ++b)
#pragma unroll
            for (int m = 0; m < 4; ++m)
#pragma unroll
                for (int n = 0; n < 2; ++n) acc[a][b][m][n] = (f32x4){0.f, 0.f, 0.f, 0.f};
    bf16x8 At[4][2], B0[2][2], B1[2][2];
    unsigned cA = (unsigned)cur.pm * tstepA, cB = (unsigned)((size_t)cur.e * g.bes) + (unsigned)cur.pn * tstepB;
    if constexpr (SP2) {
        PG8_STAGE(PG8_SB(0, 0), rB, cB, voffB); PG8_STAGE(PG8_SB(0, 1), rB, cB + hstepB, voffB); PG8_STAGE(PG8_SA(0, 0), rA, cA, voffA); PG8_STAGE(PG8_SA(0, 1), rA, cA + hstepA, voffA);
        if (wr == 1) PG8_BAR;
        PG8_WAIT_V(2); PG8_BAR;
        PG8_STAGE(PG8_SB(1, 0), rB, cB + kstep, voffB); PG8_STAGE(PG8_SA(1, 0), rA, cA + kstep, voffA); PG8_STAGE(PG8_SB(1, 1), rB, cB + hstepB + kstep, voffB);
        PG8_WAIT_V(6); PG8_BAR;
    } else {
        PG8_STAGE(PG8_SB(0, 0), rB, cB, voffB); PG8_STAGE(PG8_SA(0, 0), rA, cA, voffA); PG8_STAGE(PG8_SB(0, 1), rB, cB + hstepB, voffB); PG8_STAGE(PG8_SA(0, 1), rA, cA + hstepA, voffA);
        if (wr == 1) PG8_BAR;
        PG8_WAIT_V(4); PG8_BAR;
        PG8_STAGE(PG8_SB(1, 0), rB, cB + kstep, voffB); PG8_STAGE(PG8_SA(1, 0), rA, cA + kstep, voffA); PG8_STAGE(PG8_SB(1, 1), rB, cB + hstepB + kstep, voffB);
        PG8_WAIT_V(6); PG8_BAR;
    }
    for (;;) {
        const bool has_next = S.next(ui + 1, nxt);
        const unsigned nA = has_next ? (unsigned)nxt.pm * tstepA : cA; const unsigned nB = has_next ? (unsigned)((size_t)nxt.e * g.bes) + (unsigned)nxt.pn * tstepB : cB;
        for (int t = 0; t < nt; t += 2) {
            const bool last = (t == nt - 2);
            const unsigned a1 = cA + (unsigned)(t + 1) * kstep;
            const unsigned a2 = last ? nA : cA + (unsigned)(t + 2) * kstep; const unsigned b2 = last ? nB : cB + (unsigned)(t + 2) * kstep;
            const unsigned a3 = a2 + kstep; const unsigned b3 = b2 + kstep;
            if constexpr (SP2) {
            PG8_LDB(B0, 0, 0); PG8_LDB(B1, 0, 1); PG8_SCHED; PG8_LDA(At, 0, 0); PG8_STAGE(PG8_SA(1, 1), rA, a1 + hstepA, voffA);
            PG8_WAIT_V(8); PG8_WAIT_L(0); PG8_BAR; PG8_MMA(0, 0, At, B0); PG8_MMA(0, 1, At, B1); PG8_BAR; PG8_SCHED;
            PG8_LDA(At, 0, 1); PG8_STAGE(PG8_SB(0, 0), rB, b2, voffB); PG8_STAGE(PG8_SB(0, 1), rB, b2 + hstepB, voffB); PG8_STAGE(PG8_SA(0, 0), rA, a2, voffA);
            PG8_WAIT_V(8); PG8_WAIT_L(0); PG8_BAR; PG8_MMA(1, 0, At, B0); PG8_MMA(1, 1, At, B1); PG8_BAR; PG8_SCHED;
            PG8_LDB(B0, 1, 0); PG8_LDB(B1, 1, 1); PG8_SCHED; PG8_LDA(At, 1, 0); PG8_STAGE(PG8_SA(0, 1), rA, a2 + hstepA, voffA);
            PG8_WAIT_V(8); PG8_WAIT_L(0); PG8_BAR; PG8_MMA(0, 0, At, B0); PG8_MMA(0, 1, At, B1); PG8_BAR; PG8_SCHED;
            PG8_LDA(At, 1, 1); PG8_STAGE(PG8_SB(1, 0), rB, b3, voffB); PG8_STAGE(PG8_SB(1, 1), rB, b3 + hstepB, voffB); PG8_STAGE(PG8_SA(1, 0), rA, a3, voffA);
            PG8_WAIT_V(8); PG8_WAIT_L(0); PG8_BAR; PG8_MMA(1, 0, At, B0); PG8_MMA(1, 1, At, B1); PG8_BAR; PG8_SCHED;
            } else {
            PG8_LDB(B0, 0, 0); PG8_SCHED; PG8_LDA(At, 0, 0); PG8_STAGE(PG8_SA(1, 1), rA, a1 + hstepA, voffA);
            PG8_WAIT_L(8); PG8_BAR; PG8_WAIT_L(0); PG8_MMA(0, 0, At, B0); PG8_BAR; PG8_SCHED;
            PG8_LDB(B1, 0, 1); PG8_STAGE(PG8_SB(0, 0), rB, b2, voffB);
            PG8_BAR; PG8_WAIT_L(0); PG8_MMA(0, 1, At, B1); PG8_BAR;
            PG8_LDA(At, 0, 1); PG8_STAGE(PG8_SA(0, 0), rA, a2, voffA);
            PG8_BAR; PG8_WAIT_L(0); PG8_MMA(1, 0, At, B0); PG8_BAR; PG8_SCHED;
            PG8_STAGE(PG8_SB(0, 1), rB, b2 + hstepB, voffB);
            PG8_WAIT_V(6); PG8_BAR; PG8_MMA(1, 1, At, B1); PG8_BAR;
            PG8_LDB(B0, 1, 0); PG8_SCHED; PG8_LDA(At, 1, 0); PG8_STAGE(PG8_SA(0, 1), rA, a2 + hstepA, voffA);
            PG8_WAIT_L(8); PG8_BAR; PG8_WAIT_L(0); PG8_MMA(0, 0, At, B0); PG8_BAR; PG8_SCHED;
            PG8_LDB(B1, 1, 1); PG8_STAGE(PG8_SB(1, 0), rB, b3, voffB);
            PG8_BAR; PG8_WAIT_L(0); PG8_MMA(0, 1, At, B1); PG8_BAR;
            PG8_LDA(At, 1, 1); PG8_STAGE(PG8_SA(1, 0), rA, a3, voffA);
            PG8_BAR; PG8_WAIT_L(0); PG8_MMA(1, 0, At, B0); PG8_BAR; PG8_SCHED;
            PG8_STAGE(PG8_SB(1, 1), rB, b3 + hstepB, voffB);
            PG8_WAIT_V(6); PG8_BAR; PG8_MMA(1, 1, At, B1); PG8_BAR;
            }
        }
        if constexpr (ALIGN_EPI) { if (wr == 0) PG8_BAR; }
        { const int l2 = lane_id(); E(acc, cur, wr, wc, l2 & 15, l2 >> 4); }
        if (!has_next) break;
#pragma unroll
        for (int a = 0; a < 2; ++a)
#pragma unroll
            for (int b = 0; b < 2; ++b)
#pragma unroll
                for (int m = 0; m < 4; ++m)
#pragma unroll
                    for (int n = 0; n < 2; ++n) acc[a][b][m][n] = (f32x4){0.f, 0.f, 0.f, 0.f};
        cur = nxt; cA = nA; cB = nB; ++ui;
        if constexpr (ALIGN_EPI) { if (wr == 1) PG8_BAR; }
    }
    PG8_WAIT_V(0);
    if constexpr (!ALIGN_EPI) { if (wr == 0) PG8_BAR; }
    PG8_BAR;
#undef PG8_SA
#undef PG8_SB
#undef PG8_STAGE
#undef PG8_LDA
#undef PG8_LDB
#undef PG8_MMA
#undef PG8_WAIT_V
#undef PG8_WAIT_L
#undef PG8_BAR
#undef PG8_SCHED
}
}

namespace at {
constexpr int SHM_V = 16384, SHM_K = 16384, SHM_K2 = 8192;
constexpr int OFF_V = 0, OFF_K = 2 * SHM_V, OFF_K2 = OFF_K + 2 * SHM_K, OFF_WS = OFF_K2 + 2 * SHM_K2, ATTN_LDS = OFF_WS + 8 * 64 * 4;
#define KSWZ(row, colB) ((row) * 256 + ((colB) ^ (((row) & 7) << 4)))
#define K2SWZ(row, colB) ((row) * 128 + ((colB) ^ ((((row) >> 1) & 7) << 4)))
__device__ __forceinline__ int v_st(int k, int c) { const int kk = (k & ~0xC) | ((k & 4) << 1) | ((k & 8) >> 1); return ((kk >> 3) * 4 + (c >> 5)) * 512 + ((kk & 7) * 32 + (c & 31)) * 2; }
__device__ __forceinline__ int v_rd_base(int lane) { return ((lane & 3) << 3) | (((lane >> 2) & 3) << 6) | (((lane >> 4) & 1) << 5) | (((lane >> 5) & 1) << 8); }
constexpr int v_rd_off(int d0, int ks, int half) { return d0 * 512 + ks * 4096 + half * 2048; }
__device__ __forceinline__ int crow(int r, int hi) { return (r & 3) + 8 * (r >> 2) + 4 * hi; }

template <int VB>
__device__ __forceinline__ void pv_tile(f32x16* o, int vb0, bf16x8 pa0, bf16x8 pa1, bf16x8 pa2, bf16x8 pa3) {
#define TRRD(dst, off) asm volatile("ds_read_b64_tr_b16 %0, %1 offset:%2" : "=&v"(dst) : "v"(vb0), "i"(off) : "memory")
#define PV_D0(d0) do { s16x4 l0, l1, l2, l3, h0, h1, h2, h3; constexpr int b_ = VB * SHM_V + v_rd_off(d0, 0, 0); \
        TRRD(l0, b_); TRRD(h0, b_ + 2048); TRRD(l1, b_ + 4096); TRRD(h1, b_ + 6144); TRRD(l2, b_ + 8192); TRRD(h2, b_ + 10240); TRRD(l3, b_ + 12288); TRRD(h3, b_ + 14336); \
        asm volatile("s_waitcnt lgkmcnt(0)" ::: "memory"); SBAR(); \
        o[d0] = __builtin_amdgcn_mfma_f32_32x32x16_bf16(pa0, (bf16x8){l0[0], l0[1], l0[2], l0[3], h0[0], h0[1], h0[2], h0[3]}, o[d0], 0, 0, 0); \
        o[d0] = __builtin_amdgcn_mfma_f32_32x32x16_bf16(pa1, (bf16x8){l1[0], l1[1], l1[2], l1[3], h1[0], h1[1], h1[2], h1[3]}, o[d0], 0, 0, 0); \
        o[d0] = __builtin_amdgcn_mfma_f32_32x32x16_bf16(pa2, (bf16x8){l2[0], l2[1], l2[2], l2[3], h2[0], h2[1], h2[2], h2[3]}, o[d0], 0, 0, 0); \
        o[d0] = __builtin_amdgcn_mfma_f32_32x32x16_bf16(pa3, (bf16x8){l3[0], l3[1], l3[2], l3[3], h3[0], h3[1], h3[2], h3[3]}, o[d0], 0, 0, 0); } while (0)
    PV_D0(0); PV_D0(1); PV_D0(2); PV_D0(3);
#undef PV_D0
#undef TRRD
}

struct St { bf16x8 k0, k1, v0, v1, k2; };

template <bool MLA>
__device__ __forceinline__ void attn_unit(const bf16* Qp, int ldq, const bf16* Kp, const bf16* Vp, int ldk, const bf16* K2p, bf16* Op, int ldo, int qb, const unsigned* selp, char* lds, const int wid) {
    constexpr float SCALE = MLA ? 0.07216878364870322f : 0.08838834764831845f;
    constexpr float C2 = 1.4426950408889634f * SCALE, THR = 8.f;
    const int lane = lane_id(), tid = wid * 64 + lane, r32 = lane & 31, hi = lane >> 5;
    const int q0 = qb * 256, qlo = q0 + wid * 32, qrow = qlo + r32, qm = qrow - 4 * hi;
    char* V_lds = lds + OFF_V; char* K_lds = lds + OFF_K; char* K2_lds = lds + OFF_K2;
    float* ws = (float*)(lds + OFF_WS) + wid * 64; float* li_l = ws; float* al_l = ws + 32;
    bf16x8 qr[8], qr2[4];
    { const bf16* Qw = Qp + (size_t)qrow * ldq + hi * 8;
#pragma unroll
      for (int d0 = 0; d0 < 8; ++d0) qr[d0] = *(const bf16x8*)(Qw + d0 * 16);
      if constexpr (MLA) {
#pragma unroll
          for (int d0 = 0; d0 < 4; ++d0) qr2[d0] = *(const bf16x8*)(Qw + 128 + d0 * 16); } }
    unsigned sel = 0u; if constexpr (!MLA) sel = selp[(size_t)qrow * NH];
    const int sr = tid >> 4, sc = (tid & 15) * 8, vst0 = v_st(sr, sc), vst1 = v_st(32 + sr, sc), kws = KSWZ(sr, sc * 2);
    const int k2r = tid >> 3, k2c = (tid & 7) * 8, k2ws = K2SWZ(k2r, k2c * 2);
    const int vb0 = (int)(uintptr_t)V_lds + v_rd_base(lane);
    float m_reg = -1e30f, l_reg = 0.f; f32x16 o[4];
#pragma unroll
    for (int d = 0; d < 4; ++d) o[d] = f32x16{};
    St S;
#define SLOAD(k0_) do { S.v0 = *(const bf16x8*)(Vp + (size_t)((k0_) + sr) * ldk + sc); S.v1 = *(const bf16x8*)(Vp + (size_t)((k0_) + 32 + sr) * ldk + sc); \
        S.k0 = *(const bf16x8*)(Kp + (size_t)((k0_) + sr) * ldk + sc); S.k1 = *(const bf16x8*)(Kp + (size_t)((k0_) + 32 + sr) * ldk + sc); \
        if constexpr (MLA) S.k2 = *(const bf16x8*)(K2p + (size_t)((k0_) + k2r) * ROPE + k2c); } while (0)
#define SWRITE(bf) do { *(bf16x8*)(V_lds + (bf) * SHM_V + vst0) = S.v0; *(bf16x8*)(V_lds + (bf) * SHM_V + vst1) = S.v1; \
        *(bf16x8*)(K_lds + (bf) * SHM_K + kws) = S.k0; *(bf16x8*)(K_lds + (bf) * SHM_K + kws + 32 * 256) = S.k1; \
        if constexpr (MLA) *(bf16x8*)(K2_lds + (bf) * SHM_K2 + k2ws) = S.k2; } while (0)
    const int NT = 4 * (qb + 1);
    SLOAD(0); VM_WAIT(); SWRITE(0); __syncthreads();
#define TILE_STEP(BF, t_) do { const int t = (t_); const int kb = t * 64; \
        if (t + 1 < NT) SLOAD(kb + 64); \
        bool act = kb <= qlo + 31; const int jblk = t >> 2; \
        if constexpr (!MLA) { if (jblk < qb) act = __any((int)((sel >> jblk) & 1u)) != 0; } \
        if (act) { \
            f32x16 p0 = f32x16{}, p1 = f32x16{}; \
            { const char* kbs[4]; _Pragma("unroll") for (int dd = 0; dd < 4; ++dd) kbs[dd] = K_lds + (BF) * SHM_K + KSWZ(r32, (dd * 16 + hi * 8) * 2); \
              _Pragma("unroll") for (int d0 = 0; d0 < 8; ++d0) { const char* a = kbs[d0 & 3] + (d0 >> 2) * 128; \
                const bf16x8 b0 = *(const bf16x8*)a; const bf16x8 b1 = *(const bf16x8*)(a + 32 * 256); \
                p0 = __builtin_amdgcn_mfma_f32_32x32x16_bf16(b0, qr[d0], p0, 0, 0, 0); p1 = __builtin_amdgcn_mfma_f32_32x32x16_bf16(b1, qr[d0], p1, 0, 0, 0); } } \
            if constexpr (MLA) { _Pragma("unroll") for (int d0 = 0; d0 < 4; ++d0) { const char* a = K2_lds + (BF) * SHM_K2 + K2SWZ(r32, (d0 * 16 + hi * 8) * 2); \
                const bf16x8 b0 = *(const bf16x8*)a; const bf16x8 b1 = *(const bf16x8*)(a + 32 * 128); \
                p0 = __builtin_amdgcn_mfma_f32_32x32x16_bf16(b0, qr2[d0], p0, 0, 0, 0); p1 = __builtin_amdgcn_mfma_f32_32x32x16_bf16(b1, qr2[d0], p1, 0, 0, 0); } } \
            const float NEG = -__builtin_inff(); \
            if (kb + 63 > qlo) { const int dq = qm - kb; \
                _Pragma("unroll") for (int r = 0; r < 16; ++r) { const int c = (r & 3) + 8 * (r >> 2); if (dq - c < 0) p0[r] = NEG; if (dq - c - 32 < 0) p1[r] = NEG; } } \
            if constexpr (!MLA) { if (jblk < qb) { if (((sel >> jblk) & 1u) == 0u) { _Pragma("unroll") for (int r = 0; r < 16; ++r) { p0[r] = NEG; p1[r] = NEG; } } } } \
            float pmax = p0[0]; _Pragma("unroll") for (int r = 1; r < 16; ++r) pmax = fmaxf(pmax, p0[r]); _Pragma("unroll") for (int r = 0; r < 16; ++r) pmax = fmaxf(pmax, p1[r]); \
            { auto rr = __builtin_amdgcn_permlane32_swap(__float_as_uint(pmax), __float_as_uint(pmax), false, false); pmax = fmaxf(__uint_as_float(rr[0]), __uint_as_float(rr[1])); } \
            float mn, alpha; \
            if (__builtin_expect(__all((pmax - m_reg) * SCALE <= THR), 1)) { mn = m_reg; alpha = 1.f; } \
            else { mn = fmaxf(m_reg, pmax); alpha = __builtin_amdgcn_exp2f((m_reg - mn) * C2); m_reg = mn; } \
            const float mnL = -mn * C2; \
            _Pragma("unroll") for (int r = 0; r < 16; ++r) { p0[r] = __builtin_amdgcn_exp2f(fmaf(p0[r], C2, mnL)); p1[r] = __builtin_amdgcn_exp2f(fmaf(p1[r], C2, mnL)); } \
            float ps = 0.f; _Pragma("unroll") for (int r = 0; r < 16; ++r) ps += p0[r]; _Pragma("unroll") for (int r = 0; r < 16; ++r) ps += p1[r]; \
            { auto rr = __builtin_amdgcn_permlane32_swap(__float_as_uint(ps), __float_as_uint(ps), false, false); ps = __uint_as_float(rr[0]) + __uint_as_float(rr[1]); } \
            l_reg = l_reg * alpha + ps; \
            if (__any(alpha < 1.f)) { if (hi == 0) al_l[r32] = alpha; LDS_WAIT(); \
                _Pragma("unroll") for (int d_ = 0; d_ < 4; ++d_) _Pragma("unroll") for (int r = 0; r < 16; ++r) o[d_][r] *= al_l[crow(r, hi)]; } \
            bf16x8 pa0, pa1, pa2, pa3; \
            PK4(p0, 0, pa0); PK4(p0, 8, pa1); PK4(p1, 0, pa2); PK4(p1, 8, pa3); \
            SBAR(); pv_tile<BF>(o, vb0, pa0, pa1, pa2, pa3); \
        } \
        if (t + 1 < NT) { VM_WAIT(); SWRITE((BF) ^ 1); } \
        __syncthreads(); } while (0)
#define PK4(P, B_, OUT) do { const unsigned a0 = cvt_pk_bf16(P[B_+0], P[B_+1]), a1 = cvt_pk_bf16(P[B_+2], P[B_+3]); \
        const unsigned b0_ = cvt_pk_bf16(P[B_+4], P[B_+5]), b1_ = cvt_pk_bf16(P[B_+6], P[B_+7]); \
        auto r0 = __builtin_amdgcn_permlane32_swap(a0, b0_, false, false); auto r1 = __builtin_amdgcn_permlane32_swap(a1, b1_, false, false); \
        v4u w = {r0[0], r1[0], r0[1], r1[1]}; OUT = *reinterpret_cast<bf16x8*>(&w); } while (0)
    for (int t2 = 0; t2 < NT; t2 += 2) { TILE_STEP(0, t2); TILE_STEP(1, t2 + 1); }
#undef PK4
#undef TILE_STEP
#undef SLOAD
#undef SWRITE
    if (hi == 0) li_l[r32] = l_reg; LDS_WAIT();
    float rli[16];
#pragma unroll
    for (int r = 0; r < 16; ++r) rli[r] = __builtin_amdgcn_rcpf(li_l[crow(r, hi)]);
    bf16* Ow = Op + (size_t)qlo * ldo;
#pragma unroll
    for (int r = 0; r < 16; ++r) { const int orow = crow(r, hi);
#pragma unroll
        for (int d0 = 0; d0 < 4; ++d0) { const float v = o[d0][r] * rli[r]; const float vn = __shfl_xor(v, 1);
            if ((r32 & 1) == 0) *(unsigned*)(Ow + (size_t)orow * ldo + d0 * 32 + r32) = cvt_pk_bf16(v, vn); } }
    __syncthreads();
}
}

#define XB_TMO      128
#define XB_XCNT(j)  (256  + 64 * (j))
#define XB_XSUB(j)  (1280 + 64 * (j))
#define XB_XGEN(j)  (2304 + 64 * (j))
#define XB_TOP      3328
#define XB_TOPGEN   3392
#define XCD_BAR_WORDS 3456
#define XB_SPIN_CAP (1u << 18)
__device__ __forceinline__ unsigned xb_ld(unsigned* p)              { return __hip_atomic_load(p, __ATOMIC_RELAXED, __HIP_MEMORY_SCOPE_AGENT); }
__device__ __forceinline__ unsigned xb_add(unsigned* p, unsigned v) { return __hip_atomic_fetch_add(p, v, __ATOMIC_RELAXED, __HIP_MEMORY_SCOPE_AGENT); }
__device__ __forceinline__ unsigned xb_xcc_id() { return (unsigned)__builtin_amdgcn_s_getreg((3 << 11) | 20) & 0xFu; }
#define XB_SPIN(cond, bar) do { unsigned _sp = 0; while (cond) { __builtin_amdgcn_s_sleep(1); \
    if ((++_sp & 255u) == 0u) { if (xb_ld(&(bar)[XB_TMO])) break; if (_sp > XB_SPIN_CAP) { atomicAdd(&(bar)[XB_TMO], 1u); break; } } } } while (0)
struct XcdBarrier { unsigned* bar; unsigned x; volatile LAS unsigned* st; };
__device__ __forceinline__ XcdBarrier xcd_barrier_post(unsigned* bar, volatile LAS unsigned* st, bool t0  ) {
    XcdBarrier b; b.bar = bar; b.x = xb_xcc_id(); b.st = st;
    if (t0) (void)xb_add(&bar[XB_XCNT(b.x)], 1u);
    return b;
}
__device__ __forceinline__ void xcd_barrier_complete(unsigned* bar, unsigned x, unsigned& nloc, unsigned& nx) {
    const unsigned G = gridDim.x * gridDim.y * gridDim.z;
    unsigned sum, cnt, mine, sp = 0u;
    for (;;) {
        sum = 0u; cnt = 0u; mine = 0u;
#pragma unroll
        for (unsigned j = 0; j < 16; ++j) { const unsigned c = xb_ld(&bar[XB_XCNT(j)]); sum += c; cnt += (c > 0u) ? 1u : 0u; mine = (j == x) ? c : mine; }
        if (sum == G) break;
        __builtin_amdgcn_s_sleep(1);
        if ((++sp & 255u) == 0u) { if (xb_ld(&bar[XB_TMO])) break; if (sp > XB_SPIN_CAP) { atomicAdd(&bar[XB_TMO], 1u); break; } }
    }
    nloc = mine > 0u ? mine : 1u; nx = cnt > 0u ? cnt : 1u;
}
__device__ __forceinline__ void xcd_barrier(const XcdBarrier& b, bool t0  ) {
    asm volatile("s_waitcnt vmcnt(0)" ::: "memory");
    __syncthreads();
    if (t0) {
        unsigned* bar = b.bar;
        __builtin_amdgcn_s_waitcnt(0);
        unsigned nloc = b.st[0], nx = b.st[1];
        if (nloc == 0u) { xcd_barrier_complete(bar, b.x, nloc, nx); b.st[0] = nloc; b.st[1] = nx; }
        const unsigned old = xb_add(&bar[XB_XSUB(b.x)], 1u);
        const unsigned gen = old / nloc;
        if (old + 1u == (gen + 1u) * nloc) {
            __builtin_amdgcn_fence(__ATOMIC_RELEASE, "agent");
            asm volatile("s_waitcnt vmcnt(0)" ::: "memory");
            const unsigned og = xb_add(&bar[XB_TOP], 1u);
            const unsigned tg = og / nx;
            if (og + 1u == (tg + 1u) * nx) xb_add(&bar[XB_TOPGEN], 1u);
            else XB_SPIN(xb_ld(&bar[XB_TOPGEN]) == tg, bar);
            __builtin_amdgcn_fence(__ATOMIC_ACQUIRE, "agent");
            xb_add(&bar[XB_XGEN(b.x)], 1u);
            asm volatile("s_waitcnt vmcnt(0)" ::: "memory");
        } else {
            XB_SPIN(xb_ld(&bar[XB_XGEN(b.x)]) == gen, bar);
            __builtin_amdgcn_fence(__ATOMIC_ACQUIRE, "agent");
            asm volatile("s_waitcnt vmcnt(0)" ::: "memory");
        }
    }
    __syncthreads();
}

struct Args;
typedef const __attribute__((address_space(4))) struct Args* KArgsFwd;
struct Args {
    const float* x; const int* pos; const float* w_in; const float* g_q_a; const float* w_q_b; const float* g_kv_a; const float* w_kv_b;
    const float* g_out_mla; const float* g_out_moba; const float* w_o; const float* ln1_g; const float* ln1_b; const float* w_router; const float* b_router;
    const float* w_gate_up; const float* b_gate_up; const float* w_down; const float* b_down; const float* ln2_g; const float* ln2_b;
    float* out; unsigned char* ws; int ph_lo, ph_hi;
};
constexpr int NPHASES = 14;

__device__ __forceinline__ void tr_item(const float* W, int N, bf16* WT, int K, int k0, int n0, int prow0, const float* sc, int lane) {
    float tv[64]; const unsigned off0 = (unsigned)(k0 * N + n0 + lane) * 4u, rb = (unsigned)N * 4u;
#pragma unroll
    for (int i = 0; i < 64; ++i) tv[i] = __builtin_nontemporal_load((const float*)((const char*)W + (off0 + (unsigned)i * rb)));
    if (sc) {
#pragma unroll
        for (int i = 0; i < 64; i += 4) { const f32x4 g4 = *(const f32x4*)(sc + k0 + i); tv[i] *= g4[0]; tv[i + 1] *= g4[1]; tv[i + 2] *= g4[2]; tv[i + 3] *= g4[3]; } }
    bf16* dst = WT + (size_t)(prow0 + lane) * K + k0;
#pragma unroll
    for (int j = 0; j < 8; ++j) { v4u o; o.x = cvt_pk_bf16(tv[8 * j], tv[8 * j + 1]); o.y = cvt_pk_bf16(tv[8 * j + 2], tv[8 * j + 3]); o.z = cvt_pk_bf16(tv[8 * j + 4], tv[8 * j + 5]); o.w = cvt_pk_bf16(tv[8 * j + 6], tv[8 * j + 7]);
        *(v4u*)(dst + 8 * j) = o; }
}
constexpr int BG_ITEMS = NE * 32 * 64 + NE * 32 * 32, BG_ROUNDS = 48;
constexpr int BG_P1 = 6, BG_P6 = 44, BG_P8 = 48;
struct BgItem { const float* W; unsigned char* WT; unsigned rb; int K, k0, n0, prow0; float cs; };
__device__ __forceinline__ BgItem bg_decode(KArgsFwd ka, GAS unsigned char* ws, int it) {
    BgItem b; it = it < BG_ITEMS ? it : BG_ITEMS - 1;
    if (it < NE * 2048) { const int e = it >> 11, q = it & 2047, kb = q >> 6, nb = q & 63, n0 = nb * 64;
        b.W = ((const float*)(GAS const float*)ka->w_gate_up) + (size_t)e * DM * 2 * DFF; b.WT = (unsigned char*)(ws + WS_WGU) + (size_t)e * 2 * DFF * DM; b.rb = 2 * DFF * 4; b.K = DM; b.k0 = kb * 64; b.n0 = n0;
        b.prow0 = n0 < DFF ? (n0 >> 7) * 256 + (n0 & 127) : ((n0 - DFF) >> 7) * 256 + 128 + ((n0 - DFF) & 127); b.cs = SC_WGU; }
    else { it -= NE * 2048; const int e = it >> 10, q = it & 1023, kb = q >> 5, nb = q & 31;
        b.W = ((const float*)(GAS const float*)ka->w_down) + (size_t)e * DFF * DM; b.WT = (unsigned char*)(ws + WS_WD) + (size_t)e * DM * DFF; b.rb = DM * 4; b.K = DFF; b.k0 = kb * 64; b.n0 = nb * 64; b.prow0 = nb * 64; b.cs = SC_WD; }
    return b;
}
#define BG_LOAD(TV, B) do { const unsigned off0_ = (unsigned)((B).k0 + 16 * (lane >> 4)) * (B).rb + (unsigned)((B).n0 + 4 * (lane & 15)) * 4u; \
    _Pragma("unroll") for (int i_ = 0; i_ < 16; ++i_) TV[i_] = __builtin_nontemporal_load((const f32x4*)((const char*)(B).W + (off0_ + (unsigned)i_ * (B).rb))); } while (0)
#define BG_STORE(TV, B) do { unsigned char* dst_ = (B).WT + (size_t)((B).prow0 + 4 * (lane & 15)) * (B).K + (B).k0 + 16 * (lane >> 4); const float cs_ = (B).cs; \
    _Pragma("unroll") for (int c_ = 0; c_ < 4; ++c_) { v4u o_; \
        o_.x = pk4_fp8(TV[0][c_] * cs_, TV[1][c_] * cs_, TV[2][c_] * cs_, TV[3][c_] * cs_); o_.y = pk4_fp8(TV[4][c_] * cs_, TV[5][c_] * cs_, TV[6][c_] * cs_, TV[7][c_] * cs_); \
        o_.z = pk4_fp8(TV[8][c_] * cs_, TV[9][c_] * cs_, TV[10][c_] * cs_, TV[11][c_] * cs_); o_.w = pk4_fp8(TV[12][c_] * cs_, TV[13][c_] * cs_, TV[14][c_] * cs_, TV[15][c_] * cs_); \
        *(v4u*)(dst_ + (size_t)c_ * (B).K) = o_; } } while (0)
__device__ __forceinline__ void bg_rounds(KArgsFwd ka, GAS unsigned char* ws, int r0, int r1, int gw, int NGW, int lane) {
    if (r0 >= r1) return;
    f32x4 ta[16], tb[16];
    BgItem A = bg_decode(ka, ws, r0 * NGW + gw), B = A;
    BG_LOAD(ta, A);
    for (int r = r0; r < r1; r += 2) {
        const bool hb = r + 1 < r1, ha = r + 2 < r1;
        if (hb) { B = bg_decode(ka, ws, (r + 1) * NGW + gw); BG_LOAD(tb, B); }
        BG_STORE(ta, A);
        if (ha) { A = bg_decode(ka, ws, (r + 2) * NGW + gw); BG_LOAD(ta, A); }
        if (hb) BG_STORE(tb, B);
    }
}
#undef BG_LOAD
#undef BG_STORE
__device__ __forceinline__ void sincos_d(double x, float& sn, float& cs) {
    const double inv2pi = 0.15915494309189533577, pi2hi = 6.283185307179586232, pi2lo = 2.4492935982947064e-16;
    const double n = rint(x * inv2pi); double r = fma(-n, pi2hi, x); r = fma(-n, pi2lo, r);
    const double r2 = r * r; double s = 1.0, c = 1.0;
    double ts = 0.0, tc = 0.0;
#pragma unroll
    for (int k = 14; k >= 1; --k) { ts = (ts + 1.0) * (-r2 * (1.0 / (double)((2 * k) * (2 * k + 1)))); tc = (tc + 1.0) * (-r2 * (1.0 / (double)((2 * k - 1) * (2 * k)))); }
    s = r * (1.0 + ts); c = 1.0 + tc; sn = (float)s; cs = (float)c;
}

#define XB   ((bf16*)(ws + WS_XB))
#define WIN  ((bf16*)(ws + WS_WIN))
#define WQB  ((bf16*)(ws + WS_WQB))
#define WKVB ((bf16*)(ws + WS_WKVB))
#define WO   ((bf16*)(ws + WS_WO))
#define C128 ((float*)(ws + WS_C128))
#define S128 ((float*)(ws + WS_S128))
#define C64  ((float*)(ws + WS_C64))
#define S64  ((float*)(ws + WS_S64))
#define HQ   ((bf16*)(ws + WS_HQ))
#define HKV  ((bf16*)(ws + WS_HKV))
#define HR   ((bf16*)(ws + WS_HR))
#define KPE  ((bf16*)(ws + WS_KPE))
#define MQ   ((bf16*)(ws + WS_MQ))
#define MK   ((bf16*)(ws + WS_MK))
#define MV   ((bf16*)(ws + WS_MV))
#define RSQ  ((float*)(ws + WS_RSQ))
#define RSKV ((float*)(ws + WS_RSKV))
#define QM   ((bf16*)(ws + WS_QM))
#define KVM  ((bf16*)(ws + WS_KVM))
#define KBAR ((float*)(ws + WS_KBAR))
#define SEL  ((unsigned*)(ws + WS_SEL))
#define OMIX ((bf16*)(ws + WS_OMIX))
#define X1P  ((float*)(ws + WS_X1P))
#define X1N  ((float*)(ws + WS_X1N))
#define X1B  ((unsigned char*)(ws + WS_X1B))
#define TOPE ((int*)(ws + WS_TOPE))
#define TOPR ((int*)(ws + WS_TOPR))
#define TOPG ((float*)(ws + WS_TOPG))
#define TOPROW ((int*)(ws + WS_TOPROW))
#define RGATE ((float*)(ws + WS_RGATE))
#define XG   ((unsigned char*)(ws + WS_XG))
#define ACT  ((unsigned char*)(ws + WS_ACT))
#define YB   ((bf16*)(ws + WS_Y))
#define WGU  ((unsigned char*)(ws + WS_WGU))
#define WD   ((unsigned char*)(ws + WS_WD))
__device__ __forceinline__ GAS unsigned char* opq(const void* p) { GAS unsigned char* q = (GAS unsigned char*)p; asm volatile("" : "+s"(q)); return q; }
typedef const __attribute__((address_space(4))) struct Args* KArgs;
__device__ __forceinline__ KArgs kargs() { auto p = __builtin_amdgcn_kernarg_segment_ptr(); asm volatile("" : "+s"(p)); return (KArgs)p; }

__global__ void __launch_bounds__(512, 2) fwd(Args a) {
    extern __shared__ __attribute__((aligned(16))) unsigned char lds[];
    LAS unsigned char* L = (LAS unsigned char*)lds;
    const int wave = __builtin_amdgcn_readfirstlane((int)threadIdx.x >> 6);
    const int G = gridDim.x, bid = blockIdx.x;
    const int gw = bid * 8 + wave, NGW = G * 8;
    const int NGT = G * 512;
    gu32* ctl = (gu32*)(a.ws + WS_CTL);
    for (int u = wave * 64 + lane_id(); u < (LDS_BYTES - LDSCTL_OFF) / 4; u += 512) ((LAS unsigned*)(L + LDSCTL_OFF))[u] = 0u;
    __syncthreads();
    XcdBarrier bar; bar.bar = (unsigned*)(ctl + CW_BAR); bar.x = 0; bar.st = nullptr;
    if (MK_N_LAUNCHES == 1) bar = xcd_barrier_post((unsigned*)(ctl + CW_BAR), (volatile LAS unsigned*)(L + LDSCTL_OFF), wave == 0 && lane_id() == 0);
    const int lo = a.ph_lo, hi = a.ph_hi;
#define IN(k) (lo <= (k) && (k) < hi)
#define REPS(k) ((((PROBE_REP_MASK) >> (k)) & 1) + 1)
#define SEAM(k) do { if (IN(k) && IN((k) + 1)) { XcdBarrier b2_ = bar; b2_.bar = (unsigned*)(opq(kargs()->ws) + WS_CTL + (size_t)CW_BAR * 4); xcd_barrier(b2_, wave == 0 && lane_id() == 0); } } while (0)

    if (IN(0)) for (int rep_ = 0; rep_ < REPS(0); ++rep_) { KArgs ka = kargs(); GAS unsigned char* ws = opq(ka->ws); const int lane = lane_id(), tid = wave * 64 + lane, gt = bid * 512 + tid; (void)gt;
        constexpr int I0 = 32 * 61, I1 = 8 * 24, I2 = 4 * 32, I3 = 32 * 32;
        constexpr int NIT = I0 + I1 + I2 + I3;
        for (int it = gw; it < NIT; it += NGW) {
            int r = it;
            if (r < I0) { const int kb = r / 61, nb = r % 61, n0 = nb * 64; tr_item(((const float*)(GAS const float*)ka->w_in), INC, WIN, DM, kb * 64, n0, n0 < 832 ? n0 : n0 + 192, nullptr, lane); continue; } r -= I0;
            if (r < I1) { const int kb = r / 24, nb = r % 24; tr_item(((const float*)(GAS const float*)ka->w_q_b), 1536, WQB, QLORA, kb * 64, nb * 64, nb * 64, ((const float*)(GAS const float*)ka->g_q_a), lane); continue; } r -= I1;
            if (r < I2) { const int kb = r / 32, nb = r % 32; tr_item(((const float*)(GAS const float*)ka->w_kv_b), 2048, WKVB, KVLORA, kb * 64, nb * 64, nb * 64, ((const float*)(GAS const float*)ka->g_kv_a), lane); continue; } r -= I2;
            { const int kb = r / 32, nb = r % 32; tr_item(((const float*)(GAS const float*)ka->w_o), DM, WO, DM, kb * 64, nb * 64, nb * 64, kb < 16 ? ((const float*)(GAS const float*)ka->g_out_mla) : ((const float*)(GAS const float*)ka->g_out_moba) - MW, lane); }
        }
        for (int i = gt; i < 192 * DM / 8; i += NGT) *(v4u*)(WIN + (size_t)832 * DM + (size_t)i * 8) = (v4u){0u, 0u, 0u, 0u};
        for (int i = gt; i < T * DM / 8; i += NGT) { const f32x4 v0 = *(const f32x4*)(((const float*)(GAS const float*)ka->x) + (size_t)i * 8), v1 = *(const f32x4*)(((const float*)(GAS const float*)ka->x) + (size_t)i * 8 + 4);
            v4u w; w.x = cvt_pk_bf16(v0[0], v0[1]); w.y = cvt_pk_bf16(v0[2], v0[3]); w.z = cvt_pk_bf16(v1[0], v1[1]); w.w = cvt_pk_bf16(v1[2], v1[3]); *(v4u*)(XB + (size_t)i * 8) = w; }
        for (int i = gt; i < T * 96; i += NGT) { const int t = i / 96, j = i % 96; const float p = (float)((const int*)(GAS const int*)ka->pos)[t];
            if (j < 64) { const float inv = (float)exp2(-(double)j * (2.0 / 128.0) * 13.287712379549449); float sn, cs; sincos_d((double)(p * inv), sn, cs); C128[t * 64 + j] = cs; S128[t * 64 + j] = sn; }
            else { const int jj = j - 64; const float inv = (float)exp2(-(double)jj * (2.0 / 64.0) * 13.287712379549449); float sn, cs; sincos_d((double)(p * inv), sn, cs); C64[t * 32 + jj] = cs; S64[t * 32 + jj] = sn; } }
    }
    SEAM(0);

    if (IN(1)) for (int rep_ = 0; rep_ < REPS(1); ++rep_) { KArgs ka = kargs(); GAS unsigned char* ws = opq(ka->ws);
        pg8::Gemm g{XB, WIN, DM * 2, DM * 2, DM * 2, 0}; pg8::StaticOrder S; S.init(T, INP, G, bid);
        pg8::EpiInProj E{(unsigned char*)ws};
        const bool bg_first = ((bid >> 3) & 1) == 0;
        if (bg_first) bg_rounds(ka, ws, 0, BG_P1, gw, NGW, lane_id());
        pg8::gemm_phase<pg8::EpiInProj, pg8::StaticOrder>(L, g, S, E, wave);
        if (!bg_first) bg_rounds(ka, ws, 0, BG_P1, gw, NGW, lane_id());
    }
    SEAM(1);

    if (IN(2)) for (int rep_ = 0; rep_ < REPS(2); ++rep_) { KArgs ka = kargs(); GAS unsigned char* ws = opq(ka->ws); const int lane = lane_id(), tid = wave * 64 + lane, gt = bid * 512 + tid; (void)gt;
        for (int r = gw; r < T; r += NGW) {
            { const v4u w = *(const v4u*)(HQ + (size_t)r * QLORA + lane * 8); float s = 0.f;
              s += bflo(w.x) * bflo(w.x) + bfhi(w.x) * bfhi(w.x) + bflo(w.y) * bflo(w.y) + bfhi(w.y) * bfhi(w.y) + bflo(w.z) * bflo(w.z) + bfhi(w.z) * bfhi(w.z) + bflo(w.w) * bflo(w.w) + bfhi(w.w) * bfhi(w.w);
              s = wave_sum(s); if (lane == 0) RSQ[r] = 1.0f / sqrtf(s * (1.0f / QLORA) + RMS_EPS); }
            { const v2u w = *(const v2u*)(HKV + (size_t)r * KVLORA + lane * 4); float s = 0.f;
              s += bflo(w.x) * bflo(w.x) + bfhi(w.x) * bfhi(w.x) + bflo(w.y) * bflo(w.y) + bfhi(w.y) * bfhi(w.y);
              s = wave_sum(s); if (lane == 0) RSKV[r] = 1.0f / sqrtf(s * (1.0f / KVLORA) + RMS_EPS); }
            if (lane < 32) { const float x1 = bf2f(HR[(size_t)r * 256 + lane]), x2 = bf2f(HR[(size_t)r * 256 + 32 + lane]); const float c = C64[r * 32 + lane], s = S64[r * 32 + lane];
                KPE[(size_t)r * ROPE + lane] = f2bf(x1 * c - x2 * s); KPE[(size_t)r * ROPE + 32 + lane] = f2bf(x2 * c + x1 * s); }
            const float c = C128[r * 64 + lane], s = S128[r * 64 + lane];
#pragma unroll
            for (int h = 0; h < NH; ++h) {
                bf16* q = MQ + (size_t)r * MW + h * 128; const float q1 = bf2f(q[lane]), q2 = bf2f(q[64 + lane]); q[lane] = f2bf(q1 * c - q2 * s); q[64 + lane] = f2bf(q2 * c + q1 * s);
                bf16* k = MK + (size_t)r * MW + h * 128; const float k1 = bf2f(k[lane]), k2 = bf2f(k[64 + lane]); k[lane] = f2bf(k1 * c - k2 * s); k[64 + lane] = f2bf(k2 * c + k1 * s); }
        }
    }
    SEAM(2);

    if (IN(3)) for (int rep_ = 0; rep_ < REPS(3); ++rep_) { KArgs ka = kargs(); GAS unsigned char* ws = opq(ka->ws);
        { pg8::Gemm g{HQ, WQB, QLORA * 2, QLORA * 2, QLORA * 2, 0}; pg8::StaticOrder S; S.init(T, 1536, G, bid); pg8::EpiRowScale E{QM, 1536, RSQ};
          pg8::gemm_phase<pg8::EpiRowScale, pg8::StaticOrder>(L, g, S, E, wave); }
        { pg8::Gemm g{HKV, WKVB, KVLORA * 2, KVLORA * 2, KVLORA * 2, 0}; pg8::StaticOrder S; S.init(T, 2048, G, bid); pg8::EpiRowScale E{KVM, 2048, RSKV};
          pg8::gemm_phase<pg8::EpiRowScale, pg8::StaticOrder>(L, g, S, E, wave); }
    }
    SEAM(3);

    if (IN(4)) for (int rep_ = 0; rep_ < REPS(4); ++rep_) { KArgs ka = kargs(); GAS unsigned char* ws = opq(ka->ws); const int lane = lane_id(), tid = wave * 64 + lane, gt = bid * 512 + tid; (void)gt;
        for (int r = gw; r < T; r += NGW) {
#pragma unroll
            for (int j = 0; j < 4; ++j) { const int idx = lane + 64 * j, h = idx >> 5, i = idx & 31; bf16* q = QM + (size_t)r * 1536 + h * QKH + NOPE;
                const float c = C64[r * 32 + i], s = S64[r * 32 + i]; const float x1 = bf2f(q[i]), x2 = bf2f(q[32 + i]); q[i] = f2bf(x1 * c - x2 * s); q[32 + i] = f2bf(x2 * c + x1 * s); }
        }
        for (int it = gw; it < NH * 32; it += NGW) { const int h = it >> 5, blk = it & 31; float s0 = 0.f, s1 = 0.f;
            const bf16* p = MK + (size_t)blk * 256 * MW + h * 128 + 2 * lane;
            for (int rr = 0; rr < 256; ++rr) { const unsigned w = *(const unsigned*)(p + (size_t)rr * MW); s0 += bflo(w); s1 += bfhi(w); }
            KBAR[(h * 32 + blk) * 128 + 2 * lane] = s0 * (1.0f / 256.0f); KBAR[(h * 32 + blk) * 128 + 2 * lane + 1] = s1 * (1.0f / 256.0f); }
    }
    SEAM(4);

    if (IN(5)) for (int rep_ = 0; rep_ < REPS(5); ++rep_) { KArgs ka = kargs(); GAS unsigned char* ws = opq(ka->ws); const int lane = lane_id(), tid = wave * 64 + lane, gt = bid * 512 + tid; (void)gt;
        LAS float* kb = (LAS float*)L;
        for (int i = tid; i < NH * 32 * 128; i += 512) kb[(i >> 7) * 129 + (i & 127)] = KBAR[i];
        LAS unsigned* qs = (LAS unsigned*)(L + 132096 + wave * 2048);
        __syncthreads();
        for (int t = gw; t < T; t += NGW) {
            const int blk = t >> 8;
            { const v4u w0 = *(const v4u*)(MQ + (size_t)t * MW + lane * 8), w1 = *(const v4u*)(MQ + (size_t)t * MW + 512 + lane * 8);
              *(LAS v4u*)(qs + lane * 4) = w0; *(LAS v4u*)(qs + 256 + lane * 4) = w1; }
            LDS_WAIT(); asm volatile("" ::: "memory");
            const int n = lane & 31;
#pragma unroll 1
            for (int hp = 0; hp < 4; ++hp) { const int h = 2 * hp + (lane >> 5);
                const LAS float* kr = kb + (h * 32 + n) * 129; const LAS unsigned* qh = qs + h * 64; float dot = 0.f;
#pragma unroll 8
                for (int d = 0; d < 64; ++d) { const unsigned w = qh[d]; dot = fmaf(bflo(w), kr[2 * d], dot); dot = fmaf(bfhi(w), kr[2 * d + 1], dot); }
                float gate = n < blk ? dot : -__builtin_inff(); unsigned bits = 0u;
#pragma unroll
                for (int k = 0; k < 3; ++k) { float v = gate; int idx = n;
#pragma unroll
                    for (int off = 16; off >= 1; off >>= 1) { const float ov = __shfl_xor(v, off); const int oi = __shfl_xor(idx, off); if (ov > v || (ov == v && oi < idx)) { v = ov; idx = oi; } }
                    if (k < blk) bits |= 1u << idx;
                    if (n == idx) gate = -__builtin_inff(); }
                if (n == 0) SEL[(size_t)t * NH + h] = bits; }
            LDS_WAIT(); asm volatile("" ::: "memory");
        }
        __syncthreads();
    }
    SEAM(5);

    if (IN(6)) for (int rep_ = 0; rep_ < REPS(6); ++rep_) { KArgs ka = kargs(); GAS unsigned char* ws = opq(ka->ws);
        for (int it = bid; it < 256; it += G) { const int h = it & 7, s = it >> 3;
            at::attn_unit<true>((const bf16*)QM + h * QKH, 1536, (const bf16*)KVM + h * 256, (const bf16*)KVM + h * 256 + 128, 2048, (const bf16*)KPE, OMIX + h * 128, DM, s, nullptr, (char*)lds, wave);
            if (it == bid) bg_rounds(ka, ws, BG_P1, BG_P6, gw, NGW, lane_id());
            at::attn_unit<false>((const bf16*)MQ + h * 128, MW, (const bf16*)MK + h * 128, (const bf16*)MV + h * 128, MW, nullptr, OMIX + MW + h * 128, DM, 31 - s, SEL + h, (char*)lds, wave);
        }
    }
    SEAM(6);

    if (IN(7)) for (int rep_ = 0; rep_ < REPS(7); ++rep_) { KArgs ka = kargs(); GAS unsigned char* ws = opq(ka->ws); const int lane = lane_id(), tid = wave * 64 + lane, gt = bid * 512 + tid; (void)gt;
        for (int r = gw; r < T; r += NGW) { v4u w[4]; float ss[2] = {0.f, 0.f};
#pragma unroll
            for (int j = 0; j < 4; ++j) { w[j] = *(const v4u*)(OMIX + (size_t)r * DM + j * 512 + lane * 8); float s = 0.f;
                s += bflo(w[j].x) * bflo(w[j].x) + bfhi(w[j].x) * bfhi(w[j].x) + bflo(w[j].y) * bflo(w[j].y) + bfhi(w[j].y) * bfhi(w[j].y) + bflo(w[j].z) * bflo(w[j].z) + bfhi(w[j].z) * bfhi(w[j].z) + bflo(w[j].w) * bflo(w[j].w) + bfhi(w[j].w) * bfhi(w[j].w);
                ss[j >> 1] += s; }
            const float r0 = 1.0f / sqrtf(wave_sum(ss[0]) * (1.0f / MW) + RMS_EPS), r1 = 1.0f / sqrtf(wave_sum(ss[1]) * (1.0f / MW) + RMS_EPS);
#pragma unroll
            for (int j = 0; j < 4; ++j) { const float sc = j < 2 ? r0 : r1; v4u o;
                o.x = cvt_pk_bf16(bflo(w[j].x) * sc, bfhi(w[j].x) * sc); o.y = cvt_pk_bf16(bflo(w[j].y) * sc, bfhi(w[j].y) * sc); o.z = cvt_pk_bf16(bflo(w[j].z) * sc, bfhi(w[j].z) * sc); o.w = cvt_pk_bf16(bflo(w[j].w) * sc, bfhi(w[j].w) * sc);
                *(v4u*)(OMIX + (size_t)r * DM + j * 512 + lane * 8) = o; } }
    }
    SEAM(7);

    if (IN(8)) for (int rep_ = 0; rep_ < REPS(8); ++rep_) { KArgs ka = kargs(); GAS unsigned char* ws = opq(ka->ws);
        pg8::Gemm g{OMIX, WO, DM * 2, DM * 2, DM * 2, 0}; pg8::StaticOrder S; S.init(T, DM, G, bid); pg8::EpiResF32 E{((const float*)(GAS const float*)ka->x), X1P, DM};
        const bool bg_first = ((bid >> 3) & 1) == 0;
        if (bg_first) bg_rounds(ka, ws, BG_P6, BG_P8, gw, NGW, lane_id());
        pg8::gemm_phase<pg8::EpiResF32, pg8::StaticOrder>(L, g, S, E, wave);
        if (!bg_first) bg_rounds(ka, ws, BG_P6, BG_P8, gw, NGW, lane_id());
    }
    SEAM(8);

    if (IN(9)) for (int rep_ = 0; rep_ < REPS(9); ++rep_) { KArgs ka = kargs(); GAS unsigned char* ws = opq(ka->ws); const int lane = lane_id(), tid = wave * 64 + lane, gt = bid * 512 + tid; (void)gt;
        LAS float* part = (LAS float*)L;
        LAS float* lg = (LAS float*)(L + 32768);
        for (int rg = bid; rg < T / 32; rg += G) { const int R0 = rg * 32;
            for (int rr = 0; rr < 4; ++rr) { const int r = R0 + wave * 4 + rr; f32x4 v[8]; float s = 0.f;
#pragma unroll
                for (int j = 0; j < 8; ++j) { v[j] = *(const f32x4*)(X1P + (size_t)r * DM + j * 256 + lane * 4); s += (v[j][0] + v[j][1]) + (v[j][2] + v[j][3]); }
                const float mean = wave_sum(s) * (1.0f / DM); float q = 0.f;
#pragma unroll
                for (int j = 0; j < 8; ++j) { v[j] = v[j] - mean; q += (v[j][0] * v[j][0] + v[j][1] * v[j][1]) + (v[j][2] * v[j][2] + v[j][3] * v[j][3]); }
                const float rstd = 1.0f / sqrtf(wave_sum(q) * (1.0f / DM) + LN_EPS);
#pragma unroll
                for (int j = 0; j < 8; ++j) { const int c = j * 256 + lane * 4; const f32x4 gg = *(const f32x4*)(((const float*)(GAS const float*)ka->ln1_g) + c), bb = *(const f32x4*)(((const float*)(GAS const float*)ka->ln1_b) + c);
                    const f32x4 y = v[j] * rstd * gg + bb; *(f32x4*)(X1N + (size_t)r * DM + c) = y;
                    *(unsigned*)(X1B + (size_t)r * DM + c) = pk4_fp8(y[0] * SC_X, y[1] * SC_X, y[2] * SC_X, y[3] * SC_X); } }
            VM_WAIT(); __syncthreads();
            { f32x16 acc = f32x16{}; const int hh = lane >> 5, li = lane & 31;
              const float* ap = X1N + (size_t)(R0 + li) * DM + wave * 256 + 4 * hh; const float* bp = ((const float*)(GAS const float*)ka->w_router) + (size_t)(wave * 256 + 4 * hh) * NE + li;
#pragma unroll 4
              for (int kk = 0; kk < 32; ++kk) { const f32x4 av = *(const f32x4*)(ap + kk * 8); const float* b = bp + (size_t)kk * 8 * NE;
                  acc = __builtin_amdgcn_mfma_f32_32x32x2f32(av[0], b[0], acc, 0, 0, 0); acc = __builtin_amdgcn_mfma_f32_32x32x2f32(av[1], b[NE], acc, 0, 0, 0);
                  acc = __builtin_amdgcn_mfma_f32_32x32x2f32(av[2], b[2 * NE], acc, 0, 0, 0); acc = __builtin_amdgcn_mfma_f32_32x32x2f32(av[3], b[3 * NE], acc, 0, 0, 0); }
#pragma unroll
              for (int r = 0; r < 16; ++r) part[(wave * 32 + at::crow(r, hh)) * 32 + li] = acc[r]; }
            __syncthreads();
            for (int i = tid; i < 1024; i += 512) { float s = ((const float*)(GAS const float*)ka->b_router)[i & 31];
#pragma unroll
                for (int w = 0; w < 8; ++w) s += part[w * 1024 + i];
                lg[(i >> 5) * 33 + (i & 31)] = s; }
            __syncthreads();
            if (tid < 32) { float v[32];
#pragma unroll
                for (int e = 0; e < 32; ++e) v[e] = lg[tid * 33 + e];
                float tv[4]; int ti[4];
#pragma unroll
                for (int k = 0; k < 4; ++k) { float best = -__builtin_inff(); int bi = 0;
#pragma unroll
                    for (int e = 0; e < 32; ++e) { if (v[e] > best) { best = v[e]; bi = e; } }
                    tv[k] = best; ti[k] = bi;
#pragma unroll
                    for (int e = 0; e < 32; ++e) if (e == bi) v[e] = -__builtin_inff(); }
                const float e1 = __expf(tv[1] - tv[0]), e2 = __expf(tv[2] - tv[0]), e3 = __expf(tv[3] - tv[0]); const float inv = 1.0f / (1.0f + e1 + e2 + e3);
                const float gk[4] = {inv, e1 * inv, e2 * inv, e3 * inv}; const int r = R0 + tid;
#pragma unroll
                for (int k = 0; k < 4; ++k) { const unsigned rank = __hip_atomic_fetch_add((unsigned*)(ctl + CW_COUNT + ti[k]), 1u, RLX_AGENT);
                    TOPE[r * 4 + k] = ti[k]; TOPR[r * 4 + k] = (int)rank; TOPG[r * 4 + k] = gk[k]; } }
            __syncthreads();
        }
    }
    SEAM(9);

    if (IN(10)) for (int rep_ = 0; rep_ < REPS(10); ++rep_) { KArgs ka = kargs(); GAS unsigned char* ws = opq(ka->ws); const int lane = lane_id(), tid = wave * 64 + lane, gt = bid * 512 + tid; (void)gt;
        LAS int* ps = (LAS int*)L;
        if (tid == 0) { int acc_ = 0; for (int e = 0; e < NE; ++e) { const int c = (int)__hip_atomic_load((unsigned*)(ctl + CW_COUNT + e), RLX_AGENT); const int p = (c + 255) & ~255; ps[e] = acc_; ps[32 + e] = c; ps[64 + e] = p; acc_ += p; } ps[96] = acc_; }
        __syncthreads();
        if (bid == 0) { if (tid == 0) __hip_atomic_store((unsigned*)(ctl + CW_NRT), (unsigned)(ps[96] >> 8), RLX_AGENT);
            if (tid < NE) { const int e = tid; for (int rt = ps[e] >> 8; rt < (ps[e] + ps[64 + e]) >> 8; ++rt) __hip_atomic_store((unsigned*)(ctl + CW_TILEE + rt), (unsigned)e, RLX_AGENT); } }
        for (int it = gw; it < T * TOPK; it += NGW) { const int t = it >> 2; const int e = TOPE[it], rk = TOPR[it]; const int row = ps[e] + rk;
            const v4u* src = (const v4u*)(X1B + (size_t)t * DM); v4u* dst = (v4u*)(XG + (size_t)row * DM);
#pragma unroll
            for (int j = 0; j < 2; ++j) dst[j * 64 + lane] = src[j * 64 + lane];
            if (lane == 0) { RGATE[row] = TOPG[it]; TOPROW[it] = row; } }
        for (int it = gw; it < NE * 256; it += NGW) { const int e = it >> 8, i = it & 255; const int rk = ps[32 + e] + i;
            if (rk < ps[64 + e]) { const int row = ps[e] + rk; v4u* dst = (v4u*)(XG + (size_t)row * DM);
#pragma unroll
                for (int j = 0; j < 2; ++j) dst[j * 64 + lane] = (v4u){0u, 0u, 0u, 0u};
                if (lane == 0) RGATE[row] = 0.f; } }
        __syncthreads();
    }
    SEAM(10);

    if (IN(11)) for (int rep_ = 0; rep_ < REPS(11); ++rep_) { KArgs ka = kargs(); GAS unsigned char* ws = opq(ka->ws);
        const int n_rt = (int)__builtin_amdgcn_readfirstlane((int)__hip_atomic_load((unsigned*)(ctl + CW_NRT), RLX_AGENT));
        LAS unsigned* te = (LAS unsigned*)(L + LDSCTL_OFF + 64);
        { const int i_ = wave * 64 + lane_id(); if (i_ < MAXRT) te[i_] = i_ < n_rt ? __hip_atomic_load((unsigned*)(ctl + CW_TILEE + i_), RLX_AGENT) : 0u; }
        __syncthreads();
        pg8::Gemm g{XG, WGU, DM, DM, DM, (size_t)2 * DFF * DM}; pg8::MoeOrder S{te, n_rt, 4, G, bid};
        pg8::EpiSwiglu E{ACT, ((const float*)(GAS const float*)ka->b_gate_up)};
        pg8::gemm_phase<pg8::EpiSwiglu, pg8::MoeOrder, true>(L, g, S, E, wave);
    }
    SEAM(11);

    if (IN(12)) for (int rep_ = 0; rep_ < REPS(12); ++rep_) { KArgs ka = kargs(); GAS unsigned char* ws = opq(ka->ws);
        const int n_rt = (int)__builtin_amdgcn_readfirstlane((int)__hip_atomic_load((unsigned*)(ctl + CW_NRT), RLX_AGENT));
        LAS unsigned* te = (LAS unsigned*)(L + LDSCTL_OFF + 64);
        { const int i_ = wave * 64 + lane_id(); if (i_ < MAXRT) te[i_] = i_ < n_rt ? __hip_atomic_load((unsigned*)(ctl + CW_TILEE + i_), RLX_AGENT) : 0u; }
        __syncthreads();
        pg8::Gemm g{ACT, WD, DFF, DFF, DFF, (size_t)DM * DFF}; pg8::MoeOrder S{te, n_rt, 3, G, bid};
        pg8::EpiDown E{YB, ((const float*)(GAS const float*)ka->b_down), RGATE};
        pg8::gemm_phase<pg8::EpiDown, pg8::MoeOrder, true>(L, g, S, E, wave);
    }
    SEAM(12);

    if (IN(13)) for (int rep_ = 0; rep_ < REPS(13); ++rep_) { KArgs ka = kargs(); GAS unsigned char* ws = opq(ka->ws); const int lane = lane_id(), tid = wave * 64 + lane, gt = bid * 512 + tid; (void)gt;
        for (int t = gw; t < T; t += NGW) { int rows[4];
#pragma unroll
            for (int k = 0; k < 4; ++k) rows[k] = TOPROW[t * 4 + k];
            f32x4 v[8]; float s = 0.f;
#pragma unroll
            for (int j = 0; j < 8; ++j) { const int c = j * 256 + lane * 4; f32x4 y = *(const f32x4*)(X1N + (size_t)t * DM + c) * ALPHA;
#pragma unroll
                for (int k = 0; k < 4; ++k) { const v2u w = *(const v2u*)(YB + (size_t)rows[k] * DM + c); y[0] += bflo(w.x); y[1] += bfhi(w.x); y[2] += bflo(w.y); y[3] += bfhi(w.y); }
                v[j] = y; s += (y[0] + y[1]) + (y[2] + y[3]); }
            const float mean = wave_sum(s) * (1.0f / DM); float q = 0.f;
#pragma unroll
            for (int j = 0; j < 8; ++j) { v[j] = v[j] - mean; q += (v[j][0] * v[j][0] + v[j][1] * v[j][1]) + (v[j][2] * v[j][2] + v[j][3] * v[j][3]); }
            const float rstd = 1.0f / sqrtf(wave_sum(q) * (1.0f / DM) + LN_EPS);
#pragma unroll
            for (int j = 0; j < 8; ++j) { const int c = j * 256 + lane * 4; const f32x4 gg = *(const f32x4*)(((const float*)(GAS const float*)ka->ln2_g) + c), bb = *(const f32x4*)(((const float*)(GAS const float*)ka->ln2_b) + c);
                *(f32x4*)(((float*)(GAS float*)ka->out) + (size_t)t * DM + c) = v[j] * rstd * gg + bb; } }
    }
#undef IN
#undef SEAM
}

extern "C" void kernel_launch(void* const* d_in, const int* in_sizes, int n_in, void* d_out, int out_size, void* d_ws, size_t ws_size, hipStream_t stream) {
    static int grid = 0;
    if (grid == 0) {
        if (n_in != 20 || in_sizes[0] != T * DM || out_size != T * DM || ws_size < WS_END) { fprintf(stderr, "kernel_launch: unexpected shapes (n_in %d, in0 %d, out %d, ws %zu < %zu)\n", n_in, n_in > 0 ? in_sizes[0] : -1, out_size, ws_size, (size_t)WS_END); grid = -1; return; }
        int dev = 0, cus = 0, per_cu = 0;
        if (hipGetDevice(&dev) != hipSuccess || hipDeviceGetAttribute(&cus, hipDeviceAttributeMultiprocessorCount, dev) != hipSuccess) { grid = -1; return; }
        if (hipFuncSetAttribute((const void*)fwd, hipFuncAttributeMaxDynamicSharedMemorySize, LDS_BYTES) != hipSuccess) { fprintf(stderr, "kernel_launch: hipFuncSetAttribute failed\n"); grid = -1; return; }
        if (hipOccupancyMaxActiveBlocksPerMultiprocessor(&per_cu, (const void*)fwd, 512, LDS_BYTES) != hipSuccess || per_cu < 1) fprintf(stderr, "kernel_launch: occupancy query says %d\n", per_cu);
        (void)hipGetLastError();
        grid = cus;
    }
    if (grid < 0) return;
    (void)hipMemsetAsync((char*)d_ws + WS_CTL, 0, CTL_ZERO_BYTES, stream);
    Args a{};
    a.x = (const float*)d_in[0]; a.pos = (const int*)d_in[1]; a.w_in = (const float*)d_in[2]; a.g_q_a = (const float*)d_in[3]; a.w_q_b = (const float*)d_in[4];
    a.g_kv_a = (const float*)d_in[5]; a.w_kv_b = (const float*)d_in[6]; a.g_out_mla = (const float*)d_in[7]; a.g_out_moba = (const float*)d_in[8]; a.w_o = (const float*)d_in[9];
    a.ln1_g = (const float*)d_in[10]; a.ln1_b = (const float*)d_in[11]; a.w_router = (const float*)d_in[12]; a.b_router = (const float*)d_in[13];
    a.w_gate_up = (const float*)d_in[14]; a.b_gate_up = (const float*)d_in[15]; a.w_down = (const float*)d_in[16]; a.b_down = (const float*)d_in[17];
    a.ln2_g = (const float*)d_in[18]; a.ln2_b = (const float*)d_in[19];
    a.out = (float*)d_out; a.ws = (unsigned char*)d_ws;
    if (MK_N_LAUNCHES == 1) { a.ph_lo = 0; a.ph_hi = NPHASES; hipLaunchKernelGGL(fwd, dim3(grid), dim3(512), LDS_BYTES, stream, a); }
    else { for (int p = 0; p < NPHASES; ++p) { a.ph_lo = p; a.ph_hi = p + 1; hipLaunchKernelGGL(fwd, dim3(grid), dim3(512), LDS_BYTES, stream, a); } }
    const hipError_t le = hipPeekAtLastError();
    if (le != hipSuccess) fprintf(stderr, "kernel_launch: launch failed: %s\n", hipGetErrorName(le));
}
```

```cpp
#include <hip/hip_runtime.h>
#include <cstdio>
#include <cstdint>

#ifndef PROBE_REP_MASK
#define PROBE_REP_MASK 0
#endif
#ifndef MK_N_LAUNCHES
#define MK_N_LAUNCHES 1
#endif

constexpr int T = 8192, DM = 2048, NH = 8;
constexpr int QLORA = 512, KVLORA = 256, ROPE = 64, NOPE = 128, VH = 128, QKH = NOPE + ROPE;
constexpr int MW = 1024;
constexpr int INC = 3904, INP = 4096;
constexpr int NE = 32, TOPK = 4, DFF = 2048;
constexpr int MAXROWS = T * TOPK + NE * 256;
constexpr int MAXRT = MAXROWS / 256;
constexpr float ALPHA = 1.189207115002721f;
constexpr float RMS_EPS = 1e-6f, LN_EPS = 1e-5f;

#define GAS __attribute__((address_space(1)))
#define LAS __attribute__((address_space(3)))
typedef unsigned short bf16;
typedef unsigned v4u __attribute__((ext_vector_type(4)));
typedef unsigned v2u __attribute__((ext_vector_type(2)));
typedef float f32x4 __attribute__((ext_vector_type(4)));
typedef float f32x2 __attribute__((ext_vector_type(2)));
typedef float f32x16 __attribute__((ext_vector_type(16)));
typedef short bf16x8 __attribute__((ext_vector_type(8)));
typedef short s16x4 __attribute__((ext_vector_type(4)));
typedef GAS unsigned gu32;
#define RLX_AGENT __ATOMIC_RELAXED, __HIP_MEMORY_SCOPE_AGENT
#define LDS_WAIT() asm volatile("s_waitcnt lgkmcnt(0)" ::: "memory")
#define VM_WAIT() asm volatile("s_waitcnt vmcnt(0)" ::: "memory")
#define SBAR() __builtin_amdgcn_sched_barrier(0)

__device__ __forceinline__ unsigned cvt_pk_bf16(float lo, float hi) { unsigned r; asm volatile("v_cvt_pk_bf16_f32 %0, %1, %2" : "=v"(r) : "v"(lo), "v"(hi)); return r; }
__device__ __forceinline__ float bf2f(unsigned short b) { return __uint_as_float(((unsigned)b) << 16); }
__device__ __forceinline__ float bflo(unsigned w) { return __uint_as_float(w << 16); }
__device__ __forceinline__ float bfhi(unsigned w) { return __uint_as_float(w & 0xffff0000u); }
__device__ __forceinline__ unsigned short f2bf(float f) { return (unsigned short)(cvt_pk_bf16(f, f) & 0xffffu); }
__device__ __forceinline__ unsigned pk4_fp8(float a, float b, float c, float d) { int w = 0; w = __builtin_amdgcn_cvt_pk_fp8_f32(a, b, w, false); w = __builtin_amdgcn_cvt_pk_fp8_f32(c, d, w, true); return (unsigned)w; }
typedef int v4i __attribute__((ext_vector_type(4)));
typedef int v8i __attribute__((ext_vector_type(8)));
__device__ __forceinline__ v8i cat8(bf16x8 a, bf16x8 b) { const v4i x = __builtin_bit_cast(v4i, a), y = __builtin_bit_cast(v4i, b); return __builtin_shufflevector(x, y, 0, 1, 2, 3, 4, 5, 6, 7); }
__device__ __forceinline__ int lane_id() { int l = (int)__builtin_amdgcn_mbcnt_hi(~0u, __builtin_amdgcn_mbcnt_lo(~0u, 0u)); asm volatile("" : "+v"(l)); return l; }
__device__ __forceinline__ float wave_sum(float v) {
#pragma unroll
    for (int o = 1; o < 64; o <<= 1) v += __shfl_xor(v, o);
    return v;
}

constexpr size_t MiB = 1u << 20;
constexpr size_t WS_CTL = 0, CTL_ZERO_BYTES = 1 * MiB;
constexpr size_t WS_XB    = 2 * MiB;
constexpr size_t WS_WIN   = WS_XB + 32 * MiB;
constexpr size_t WS_WQB   = WS_WIN + 16 * MiB;
constexpr size_t WS_WKVB  = WS_WQB + 2 * MiB;
constexpr size_t WS_WO    = WS_WKVB + 1 * MiB;
constexpr size_t WS_C128  = WS_WO + 8 * MiB;
constexpr size_t WS_S128  = WS_C128 + 2 * MiB;
constexpr size_t WS_C64   = WS_S128 + 2 * MiB;
constexpr size_t WS_S64   = WS_C64 + 1 * MiB;
constexpr size_t WS_HQ    = WS_S64 + 1 * MiB;
constexpr size_t WS_HKV   = WS_HQ + 8 * MiB;
constexpr size_t WS_HR    = WS_HKV + 4 * MiB;
constexpr size_t WS_KPE   = WS_HR + 4 * MiB;
constexpr size_t WS_MQ    = WS_KPE + 1 * MiB;
constexpr size_t WS_MK    = WS_MQ + 16 * MiB;
constexpr size_t WS_MV    = WS_MK + 16 * MiB;
constexpr size_t WS_RSQ   = WS_MV + 16 * MiB;
constexpr size_t WS_RSKV  = WS_RSQ + 1 * MiB;
constexpr size_t WS_QM    = WS_RSKV + 1 * MiB;
constexpr size_t WS_KVM   = WS_QM + 24 * MiB;
constexpr size_t WS_KBAR  = WS_KVM + 32 * MiB;
constexpr size_t WS_SEL   = WS_KBAR + 1 * MiB;
constexpr size_t WS_OMIX  = WS_SEL + 1 * MiB;
constexpr size_t WS_X1P   = WS_OMIX + 32 * MiB;
constexpr size_t WS_X1N   = WS_X1P + 64 * MiB;
constexpr size_t WS_X1B   = WS_X1N + 64 * MiB;
constexpr size_t WS_TOPE  = WS_X1B + 32 * MiB;
constexpr size_t WS_TOPR  = WS_TOPE + 1 * MiB;
constexpr size_t WS_TOPG  = WS_TOPR + 1 * MiB;
constexpr size_t WS_TOPROW= WS_TOPG + 1 * MiB;
constexpr size_t WS_RGATE = WS_TOPROW + 1 * MiB;
constexpr size_t WS_XG    = WS_RGATE + 1 * MiB;
constexpr size_t WS_ACT   = WS_XG + 80 * MiB;
constexpr size_t WS_Y     = WS_ACT + 80 * MiB;
constexpr size_t WS_WGU   = WS_Y + 160 * MiB;
constexpr size_t WS_WD    = WS_WGU + 256 * MiB;
constexpr size_t WS_LIST  = WS_WD + 128 * MiB;
constexpr size_t WS_PO    = WS_LIST + 8 * MiB;
constexpr size_t WS_PL    = WS_PO + 64 * MiB;
constexpr size_t WS_END   = WS_PL + 1 * MiB;
constexpr float SC_X = 16.0f, SC_WGU = 512.0f, SC_ACT = 4.0f, SC_WD = 1024.0f;
constexpr int CW_BAR = 4096;
constexpr int CW_COUNT = 65536;
constexpr int CW_TILEE = 16384 + 64;
constexpr int CW_NRT = 16384 + 64 + 192;
constexpr int CW_MCNT = 32768;
constexpr int CW_QHEAD = 20480;

constexpr int LDS_BYTES = 159744;
constexpr int LDSCTL_OFF = 158720;

namespace pg8 {
constexpr int BM = 256, BK = 64, HALF = 128, HTB = HALF * BK * 2, STAGE_BYTES = 8 * HTB, NXCD = 8, WGM = 8;
__host__ __device__ __forceinline__ int lds_byte(int r, int c) { const int st = (r >> 4) * 2 + (c >> 5), rr = r & 15, cc = c & 31, ob = rr * 64 + cc * 2; return st * 1024 + (ob ^ (((ob >> 9) & 1) << 5)); }
__host__ __device__ __forceinline__ void stage_rc(int b, int& R, int& C) { const int st = b / 1024, sb = b % 1024, swz = sb ^ (((sb >> 9) & 1) << 5); R = (st >> 1) * 16 + swz / 64; C = (st & 1) * 32 + (swz % 64) / 2; }
__host__ __device__ __forceinline__ int perm32(int rho) { const int n = rho >> 4, i = rho & 15; return 8 * (i >> 2) + 4 * n + (i & 3); }

struct Unit { int pm, pn, e; };
struct Gemm { const void* A; const void* Bt; int Kb, lda, ldb; size_t bes; };

struct StaticOrder {
    int nM, nN, nwg, G, c;
    __device__ void init(int M, int N, int G_, int c_) { nM = M / BM; nN = N / BM; nwg = nM * nN; G = G_; c = c_; }
    __device__ bool next(int i, Unit& u) const {
        const long L = (long)i * G + c; if (L >= nwg) return false;
        int wgid = (int)L; { const int q = nwg / NXCD, r = nwg % NXCD, xcd = wgid % NXCD, off = wgid / NXCD; wgid = (xcd < r ? xcd * (q + 1) : r * (q + 1) + (xcd - r) * q) + off; }
        const int nig = WGM * nN, gid = wgid / nig, fm = gid * WGM, gsz = (nM - fm) < WGM ? (nM - fm) : WGM;
        u.pm = fm + ((wgid % nig) % gsz); u.pn = (wgid % nig) / gsz; u.e = 0; return true;
    }
};
struct MoeOrder {
    const LAS unsigned* tile_e; int n_rt, lnpn, G, c;
    __device__ bool next(int i, Unit& u) const {
        const int L = i * G + c; if (L >= (n_rt << lnpn)) return false;
        const int rt = L >> lnpn; u.pm = rt; u.pn = L - (rt << lnpn);
        u.e = (int)__builtin_amdgcn_readfirstlane((int)tile_e[rt]); return true;
    }
};

typedef f32x4 Acc[2][2][4][2];

struct EpiInProj {
    static constexpr bool PERM = true;
    unsigned char* ws;
    __device__ __forceinline__ void operator()(const Acc& acc, const Unit& u, int wr, int wc, int fr, int fq) const {
        const int pn = u.pn; size_t off; int ldc, colt;
        if (pn < 4) { off = WS_HQ + (size_t)(pn >> 1) * (8u << 20) + (size_t)(pn == 3 ? 1 : 0) * (4u << 20); ldc = 512 - (pn >> 1) * 256; colt = (pn >> 1) ? 0 : pn * 256; }
        else { off = WS_MQ + (size_t)((pn - 4) >> 2) * (16u << 20); ldc = 1024; colt = ((pn - 4) & 3) * 256; }
        bf16* base = (bf16*)(ws + off);
        const int row0 = u.pm * BM + wr * 64 + fr, col0 = colt + wc * 32 + 8 * fq;
#pragma unroll
        for (int ai = 0; ai < 2; ++ai)
#pragma unroll
            for (int m = 0; m < 4; ++m) { bf16* rowp = base + (size_t)(row0 + ai * HALF + m * 16) * ldc + col0;
#pragma unroll
                for (int bj = 0; bj < 2; ++bj) { const f32x4 v0 = acc[ai][bj][m][0], v1 = acc[ai][bj][m][1];
                    v4u w; w.x = cvt_pk_bf16(v0[0], v0[1]); w.y = cvt_pk_bf16(v0[2], v0[3]); w.z = cvt_pk_bf16(v1[0], v1[1]); w.w = cvt_pk_bf16(v1[2], v1[3]);
                    *(v4u*)(rowp + bj * HALF) = w; } }
    }
};
struct EpiRowScale {
    static constexpr bool PERM = true;
    bf16* O; int ldc; const float* rs;
    __device__ __forceinline__ void operator()(const Acc& acc, const Unit& u, int wr, int wc, int fr, int fq) const {
        const int row0 = u.pm * BM + wr * 64 + fr, col0 = u.pn * BM + wc * 32 + 8 * fq;
#pragma unroll
        for (int ai = 0; ai < 2; ++ai)
#pragma unroll
            for (int m = 0; m < 4; ++m) { const int row = row0 + ai * HALF + m * 16; const float s = rs[row]; bf16* rowp = O + (size_t)row * ldc + col0;
#pragma unroll
                for (int bj = 0; bj < 2; ++bj) { const f32x4 v0 = acc[ai][bj][m][0] * s, v1 = acc[ai][bj][m][1] * s;
                    v4u w; w.x = cvt_pk_bf16(v0[0], v0[1]); w.y = cvt_pk_bf16(v0[2], v0[3]); w.z = cvt_pk_bf16(v1[0], v1[1]); w.w = cvt_pk_bf16(v1[2], v1[3]);
                    *(v4u*)(rowp + bj * HALF) = w; } }
    }
};
struct EpiResF32 {
    static constexpr bool PERM = false;
    const float* X; float* O; int ldc;
    __device__ __forceinline__ void operator()(const Acc& acc, const Unit& u, int wr, int wc, int fr, int fq) const {
        const int row0 = u.pm * BM + wr * 64 + fr, col0 = u.pn * BM + wc * 32 + 4 * fq;
#pragma unroll
        for (int ai = 0; ai < 2; ++ai)
#pragma unroll
            for (int m = 0; m < 4; ++m) { const size_t off = (size_t)(row0 + ai * HALF + m * 16) * ldc + col0;
#pragma unroll
                for (int bj = 0; bj < 2; ++bj)
#pragma unroll
                    for (int n = 0; n < 2; ++n) { const f32x4 xv = *(const f32x4*)(X + off + bj * HALF + n * 16); *(f32x4*)(O + off + bj * HALF + n * 16) = xv * ALPHA + acc[ai][bj][m][n]; }
                asm volatile("" ::: "memory"); }
    }
};
struct EpiSwiglu {
    static constexpr bool PERM = true;
    unsigned char* ACT; const float* bgu;
    __device__ __forceinline__ void operator()(const Acc& acc, const Unit& u, int wr, int wc, int fr, int fq) const {
        const int row0 = u.pm * BM + wr * 64 + fr, j0 = u.pn * HALF + wc * 32 + 8 * fq;
        const float* bg = bgu + (size_t)u.e * (2 * DFF) + j0; const float* bu = bg + DFF;
        const f32x4 bg0 = *(const f32x4*)bg, bg1 = *(const f32x4*)(bg + 4), bu0 = *(const f32x4*)bu, bu1 = *(const f32x4*)(bu + 4);
#pragma unroll
        for (int ai = 0; ai < 2; ++ai)
#pragma unroll
            for (int m = 0; m < 4; ++m) { unsigned char* rowp = ACT + (size_t)(row0 + ai * HALF + m * 16) * DFF + j0;
                float a[8];
#pragma unroll
                for (int n = 0; n < 2; ++n) { const f32x4 gv = acc[ai][0][m][n] * (1.0f / (SC_X * SC_WGU)) + (n ? bg1 : bg0), uv = acc[ai][1][m][n] * (1.0f / (SC_X * SC_WGU)) + (n ? bu1 : bu0);
#pragma unroll
                    for (int j = 0; j < 4; ++j) { const float g = fminf(gv[j], 7.0f), uu = fminf(fmaxf(uv[j], -7.0f), 7.0f);
                        const float sg = __builtin_amdgcn_rcpf(1.0f + __builtin_amdgcn_exp2f(g * (-1.702f * 1.4426950408889634f)));
                        a[n * 4 + j] = (uu + 1.0f) * g * sg * SC_ACT; } }
                v2u w; w.x = pk4_fp8(a[0], a[1], a[2], a[3]); w.y = pk4_fp8(a[4], a[5], a[6], a[7]);
                *(v2u*)rowp = w; }
    }
};
struct EpiDown {
    static constexpr bool PERM = true;
    bf16* Y; const float* bd; const float* rgate;
    __device__ __forceinline__ void operator()(const Acc& acc, const Unit& u, int wr, int wc, int fr, int fq) const {
        const int row0 = u.pm * BM + wr * 64 + fr, col0 = u.pn * BM + wc * 32 + 8 * fq;
        const float* bp = bd + (size_t)u.e * DM + col0;
        f32x4 bv[2][2];
#pragma unroll
        for (int bj = 0; bj < 2; ++bj)
#pragma unroll
            for (int n = 0; n < 2; ++n) bv[bj][n] = *(const f32x4*)(bp + bj * HALF + 4 * n);
#pragma unroll
        for (int ai = 0; ai < 2; ++ai)
#pragma unroll
            for (int m = 0; m < 4; ++m) { const int row = row0 + ai * HALF + m * 16; const float s = rgate[row]; bf16* rowp = Y + (size_t)row * DM + col0;
#pragma unroll
                for (int bj = 0; bj < 2; ++bj) { const f32x4 v0 = (acc[ai][bj][m][0] * (1.0f / (SC_ACT * SC_WD)) + bv[bj][0]) * s, v1 = (acc[ai][bj][m][1] * (1.0f / (SC_ACT * SC_WD)) + bv[bj][1]) * s;
                    v4u w; w.x = cvt_pk_bf16(v0[0], v0[1]); w.y = cvt_pk_bf16(v0[2], v0[3]); w.z = cvt_pk_bf16(v1[0], v1[1]); w.w = cvt_pk_bf16(v1[2], v1[3]);
                    *(v4u*)(rowp + bj * HALF) = w; } }
    }
};

template <class Epi, class Sched, bool F8 = false, bool ALIGN_EPI = true, bool SP2 = true>
__device__ __forceinline__ void gemm_phase(LAS unsigned char* lds, const Gemm g, const Sched& S, const Epi& E, const int wid  ) {
    const int lane = lane_id(), tid = wid * 64 + lane, wr = wid >> 2, wc = wid & 3, fr = lane & 15, fq = lane >> 4;
    const int nt = g.Kb / 128;
    const __amdgpu_buffer_rsrc_t rA = __builtin_amdgcn_make_buffer_rsrc((void*)g.A, 0, -1, 0x00020000);
    const __amdgpu_buffer_rsrc_t rB = __builtin_amdgcn_make_buffer_rsrc((void*)g.Bt, 0, -1, 0x00020000);
    unsigned voffA[2], voffB[2];
#pragma unroll
    for (int i = 0; i < 2; ++i) { int R, C; stage_rc(tid * 16 + i * 8192, R, C); const int Rb = Epi::PERM ? ((R & ~31) + perm32(R & 31)) : R;
        voffA[i] = (unsigned)(R * g.lda + C * 2); voffB[i] = (unsigned)(Rb * g.ldb + C * 2); }
    const unsigned kstep = 128u;
    const unsigned hstepA = (unsigned)HALF * g.lda, hstepB = (unsigned)HALF * g.ldb;
    const unsigned tstepA = 2 * hstepA, tstepB = 2 * hstepB;
    const unsigned ldsw = (unsigned)wid * 1024u;
    const int aoff = lds_byte(wr * 64 + fr, fq * 8), boff = lds_byte(wc * 32 + fr, fq * 8);
#define PG8_SA(b, h) (((b) * 2 + (h)) * HTB)
#define PG8_SB(b, h) ((4 + (b) * 2 + (h)) * HTB)
#define PG8_STAGE(bufoff, rsrc, soff, voff) do { _Pragma("unroll") for (int _i = 0; _i < 2; ++_i) \
        __builtin_amdgcn_raw_ptr_buffer_load_lds(rsrc, (LAS unsigned*)(lds + (bufoff) + ldsw + _i * 8192), 16, (voff)[_i], (soff), 0, 0); } while (0)
#define PG8_LDA(dst, b, h) do { _Pragma("unroll") for (int m = 0; m < 4; ++m) _Pragma("unroll") for (int k = 0; k < 2; ++k) dst[m][k] = *(const LAS bf16x8*)(lds + PG8_SA(b, h) + aoff + m * 2048 + k * 1024); } while (0)
#define PG8_LDB(dst, b, h) do { _Pragma("unroll") for (int n = 0; n < 2; ++n) _Pragma("unroll") for (int k = 0; k < 2; ++k) dst[n][k] = *(const LAS bf16x8*)(lds + PG8_SB(b, h) + boff + n * 2048 + k * 1024); } while (0)
#define PG8_MMA(ai, bj, At, Bt) do { __builtin_amdgcn_s_setprio(1); if constexpr (F8) { _Pragma("unroll") for (int m = 0; m < 4; ++m) _Pragma("unroll") for (int n = 0; n < 2; ++n) \
        acc[ai][bj][m][n] = __builtin_amdgcn_mfma_scale_f32_16x16x128_f8f6f4(cat8(Bt[n][0], Bt[n][1]), cat8(At[m][0], At[m][1]), acc[ai][bj][m][n], 0, 0, 0, 0, 0, 0); } \
        else { _Pragma("unroll") for (int m = 0; m < 4; ++m) _Pragma("unroll") for (int n = 0; n < 2; ++n) _Pragma("unroll") for (int k = 0; k < 2; ++k) \
        acc[ai][bj][m][n] = __builtin_amdgcn_mfma_f32_16x16x32_bf16(Bt[n][k], At[m][k], acc[ai][bj][m][n], 0, 0, 0); } __builtin_amdgcn_s_setprio(0); } while (0)
#define PG8_WAIT_V(n) asm volatile("s_waitcnt vmcnt(" #n ")" ::: "memory")
#define PG8_WAIT_L(n) asm volatile("s_waitcnt lgkmcnt(" #n ")" ::: "memory")
#define PG8_BAR __builtin_amdgcn_s_barrier()
#define PG8_SCHED __builtin_amdgcn_sched_barrier(0)
    Unit cur, nxt; int ui = 0;
    if (!S.next(0, cur)) return;
    Acc acc;
#pragma unroll
    for (int a = 0; a < 2; ++a)
#pragma unroll
        for (int b = 0; b < 2; ++b)
#pragma unroll
            for (int m = 0; m < 4; ++m)
#pragma unroll
                for (int n = 0; n < 2; ++n) acc[a][b][m][n] = (f32x4){0.f, 0.f, 0.f, 0.f};
    bf16x8 At[4][2], B0[2][2], B1[2][2];
    unsigned cA = (unsigned)cur.pm * tstepA, cB = (unsigned)((size_t)cur.e * g.bes) + (unsigned)cur.pn * tstepB;
    if constexpr (SP2) {
        PG8_STAGE(PG8_SB(0, 0), rB, cB, voffB); PG8_STAGE(PG8_SB(0, 1), rB, cB + hstepB, voffB); PG8_STAGE(PG8_SA(0, 0), rA, cA, voffA); PG8_STAGE(PG8_SA(0, 1), rA, cA + hstepA, voffA);
        if (wr == 1) PG8_BAR;
        PG8_WAIT_V(2); PG8_BAR;
        PG8_STAGE(PG8_SB(1, 0), rB, cB + kstep, voffB); PG8_STAGE(PG8_SA(1, 0), rA, cA + kstep, voffA); PG8_STAGE(PG8_SB(1, 1), rB, cB + hstepB + kstep, voffB);
        PG8_WAIT_V(6); PG8_BAR;
    } else {
        PG8_STAGE(PG8_SB(0, 0), rB, cB, voffB); PG8_STAGE(PG8_SA(0, 0), rA, cA, voffA); PG8_STAGE(PG8_SB(0, 1), rB, cB + hstepB, voffB); PG8_STAGE(PG8_SA(0, 1), rA, cA + hstepA, voffA);
        if (wr == 1) PG8_BAR;
        PG8_WAIT_V(4); PG8_BAR;
        PG8_STAGE(PG8_SB(1, 0), rB, cB + kstep, voffB); PG8_STAGE(PG8_SA(1, 0), rA, cA + kstep, voffA); PG8_STAGE(PG8_SB(1, 1), rB, cB + hstepB + kstep, voffB);
        PG8_WAIT_V(6); PG8_BAR;
    }
    for (;;) {
        const bool has_next = S.next(ui + 1, nxt);
        const unsigned nA = has_next ? (unsigned)nxt.pm * tstepA : cA; const unsigned nB = has_next ? (unsigned)((size_t)nxt.e * g.bes) + (unsigned)nxt.pn * tstepB : cB;
        for (int t = 0; t < nt; t += 2) {
            const bool last = (t == nt - 2);
            const unsigned a1 = cA + (unsigned)(t + 1) * kstep;
            const unsigned a2 = last ? nA : cA + (unsigned)(t + 2) * kstep; const unsigned b2 = last ? nB : cB + (unsigned)(t + 2) * kstep;
            const unsigned a3 = a2 + kstep; const unsigned b3 = b2 + kstep;
            if constexpr (SP2) {
            PG8_LDB(B0, 0, 0); PG8_LDB(B1, 0, 1); PG8_SCHED; PG8_LDA(At, 0, 0); PG8_STAGE(PG8_SA(1, 1), rA, a1 + hstepA, voffA);
            PG8_WAIT_V(8); PG8_WAIT_L(0); PG8_BAR; PG8_MMA(0, 0, At, B0); PG8_MMA(0, 1, At, B1); PG8_BAR; PG8_SCHED;
            PG8_LDA(At, 0, 1); PG8_STAGE(PG8_SB(0, 0), rB, b2, voffB); PG8_STAGE(PG8_SB(0, 1), rB, b2 + hstepB, voffB); PG8_STAGE(PG8_SA(0, 0), rA, a2, voffA);
            PG8_WAIT_V(8); PG8_WAIT_L(0); PG8_BAR; PG8_MMA(1, 0, At, B0); PG8_MMA(1, 1, At, B1); PG8_BAR; PG8_SCHED;
            PG8_LDB(B0, 1, 0); PG8_LDB(B1, 1, 1); PG8_SCHED; PG8_LDA(At, 1, 0); PG8_STAGE(PG8_SA(0, 1), rA, a2 + hstepA, voffA);
            PG8_WAIT_V(8); PG8_WAIT_L(0); PG8_BAR; PG8_MMA(0, 0, At, B0); PG8_MMA(0, 1, At, B1); PG8_BAR; PG8_SCHED;
            PG8_LDA(At, 1, 1); PG8_STAGE(PG8_SB(1, 0), rB, b3, voffB); PG8_STAGE(PG8_SB(1, 1), rB, b3 + hstepB, voffB); PG8_STAGE(PG8_SA(1, 0), rA, a3, voffA);
            PG8_WAIT_V(8); PG8_WAIT_L(0); PG8_BAR; PG8_MMA(1, 0, At, B0); PG8_MMA(1, 1, At, B1); PG8_BAR; PG8_SCHED;
            } else {
            PG8_LDB(B0, 0, 0); PG8_SCHED; PG8_LDA(At, 0, 0); PG8_STAGE(PG8_SA(1, 1), rA, a1 + hstepA, voffA);
            PG8_WAIT_L(8); PG8_BAR; PG8_WAIT_L(0); PG8_MMA(0, 0, At, B0); PG8_BAR; PG8_SCHED;
            PG8_LDB(B1, 0, 1); PG8_STAGE(PG8_SB(0, 0), rB, b2, voffB);
            PG8_BAR; PG8_WAIT_L(0); PG8_MMA(0, 1, At, B1); PG8_BAR;
            PG8_LDA(At, 0, 1); PG8_STAGE(PG8_SA(0, 0), rA, a2, voffA);
            PG8_BAR; PG8_WAIT_L(0); PG8_MMA(1, 0, At, B0); PG8_BAR; PG8_SCHED;
            PG8_STAGE(PG8_SB(0, 1), rB, b2 + hstepB, voffB);
            PG8_WAIT_V(6); PG8_BAR; PG8_MMA(1, 1, At, B1); PG8_BAR;
            PG8_LDB(B0, 1, 0); PG8_SCHED; PG8_LDA(At, 1, 0); PG8_STAGE(PG8_SA(0, 1), rA, a2 + hstepA, voffA);
            PG8_WAIT_L(8); PG8_BAR; PG8_WAIT_L(0); PG8_MMA(0, 0, At, B0); PG8_BAR; PG8_SCHED;
            PG8_LDB(B1, 1, 1); PG8_STAGE(PG8_SB(1, 0), rB, b3, voffB);
            PG8_BAR; PG8_WAIT_L(0); PG8_MMA(0, 1, At, B1); PG8_BAR;
            PG8_LDA(At, 1, 1); PG8_STAGE(PG8_SA(1, 0), rA, a3, voffA);
            PG8_BAR; PG8_WAIT_L(0); PG8_MMA(1, 0, At, B0); PG8_BAR; PG8_SCHED;
            PG8_STAGE(PG8_SB(1, 1), rB, b3 + hstepB, voffB);
            PG8_WAIT_V(6); PG8_BAR; PG8_MMA(1, 1, At, B1); PG8_BAR;
            }
        }
        if constexpr (ALIGN_EPI) { if (wr == 0) PG8_BAR; }
        { const int l2 = lane_id(); E(acc, cur, wr, wc, l2 & 15, l2 >> 4); }
        if (!has_next) break;
#pragma unroll
        for (int a = 0; a < 2; ++a)
#pragma unroll
            for (int b = 0; b < 2; ++b)
#pragma unroll
                for (int m = 0; m < 4; ++m)
#pragma unroll
                    for (int n = 0; n < 2; ++n) acc[a][b][m][n] = (f32x4){0.f, 0.f, 0.f, 0.f};
        cur = nxt; cA = nA; cB = nB; ++ui;
        if constexpr (ALIGN_EPI) { if (wr == 1) PG8_BAR; }
    }
    PG8_WAIT_V(0);
    if constexpr (!ALIGN_EPI) { if (wr == 0) PG8_BAR; }
    PG8_BAR;
#undef PG8_SA
#undef PG8_SB
#undef PG8_STAGE
#undef PG8_LDA
#undef PG8_LDB
#undef PG8_MMA
#undef PG8_WAIT_V
#undef PG8_WAIT_L
#undef PG8_BAR
#undef PG8_SCHED
}
}

namespace at {
constexpr int SHM_V = 16384, SHM_K = 16384, SHM_K2 = 8192;
constexpr int OFF_V = 0, OFF_K = 2 * SHM_V, OFF_K2 = OFF_K + 2 * SHM_K, OFF_WS = OFF_K2 + 2 * SHM_K2, ATTN_LDS = OFF_WS + 8 * 64 * 4;
#define KSWZ(row, colB) ((row) * 256 + ((colB) ^ (((row) & 7) << 4)))
#define K2SWZ(row, colB) ((row) * 128 + ((colB) ^ ((((row) >> 1) & 7) << 4)))
__device__ __forceinline__ int v_st(int k, int c) { const int kk = (k & ~0xC) | ((k & 4) << 1) | ((k & 8) >> 1); return ((kk >> 3) * 4 + (c >> 5)) * 512 + ((kk & 7) * 32 + (c & 31)) * 2; }
__device__ __forceinline__ int v_rd_base(int lane) { return ((lane & 3) << 3) | (((lane >> 2) & 3) << 6) | (((lane >> 4) & 1) << 5) | (((lane >> 5) & 1) << 8); }
constexpr int v_rd_off(int d0, int ks, int half) { return d0 * 512 + ks * 4096 + half * 2048; }
__device__ __forceinline__ int crow(int r, int hi) { return (r & 3) + 8 * (r >> 2) + 4 * hi; }

template <int VB>
__device__ __forceinline__ void pv_tile(f32x16* o, int vb0, bf16x8 pa0, bf16x8 pa1, bf16x8 pa2, bf16x8 pa3) {
#define TRRD(dst, off) asm volatile("ds_read_b64_tr_b16 %0, %1 offset:%2" : "=&v"(dst) : "v"(vb0), "i"(off) : "memory")
#define PV_D0(d0) do { s16x4 l0, l1, l2, l3, h0, h1, h2, h3; constexpr int b_ = VB * SHM_V + v_rd_off(d0, 0, 0); \
        TRRD(l0, b_); TRRD(h0, b_ + 2048); TRRD(l1, b_ + 4096); TRRD(h1, b_ + 6144); TRRD(l2, b_ + 8192); TRRD(h2, b_ + 10240); TRRD(l3, b_ + 12288); TRRD(h3, b_ + 14336); \
        asm volatile("s_waitcnt lgkmcnt(0)" ::: "memory"); SBAR(); \
        o[d0] = __builtin_amdgcn_mfma_f32_32x32x16_bf16(pa0, (bf16x8){l0[0], l0[1], l0[2], l0[3], h0[0], h0[1], h0[2], h0[3]}, o[d0], 0, 0, 0); \
        o[d0] = __builtin_amdgcn_mfma_f32_32x32x16_bf16(pa1, (bf16x8){l1[0], l1[1], l1[2], l1[3], h1[0], h1[1], h1[2], h1[3]}, o[d0], 0, 0, 0); \
        o[d0] = __builtin_amdgcn_mfma_f32_32x32x16_bf16(pa2, (bf16x8){l2[0], l2[1], l2[2], l2[3], h2[0], h2[1], h2[2], h2[3]}, o[d0], 0, 0, 0); \
        o[d0] = __builtin_amdgcn_mfma_f32_32x32x16_bf16(pa3, (bf16x8){l3[0], l3[1], l3[2], l3[3], h3[0], h3[1], h3[2], h3[3]}, o[d0], 0, 0, 0); } while (0)
    PV_D0(0); PV_D0(1); PV_D0(2); PV_D0(3);
#undef PV_D0
#undef TRRD
}

struct St { bf16x8 k0, k1, v0, v1, k2; };

template <bool MLA>
__device__ __forceinline__ void attn_unit(const bf16* Qp, int ldq, const bf16* Kp, const bf16* Vp, int ldk, const bf16* K2p, bf16* Op, int ldo, int qb, const unsigned* selp, char* lds, const int wid) {
    constexpr float SCALE = MLA ? 0.07216878364870322f : 0.08838834764831845f;
    constexpr float C2 = 1.4426950408889634f * SCALE, THR = 8.f;
    const int lane = lane_id(), tid = wid * 64 + lane, r32 = lane & 31, hi = lane >> 5;
    const int q0 = qb * 256, qlo = q0 + wid * 32, qrow = qlo + r32, qm = qrow - 4 * hi;
    char* V_lds = lds + OFF_V; char* K_lds = lds + OFF_K; char* K2_lds = lds + OFF_K2;
    float* ws = (float*)(lds + OFF_WS) + wid * 64; float* li_l = ws; float* al_l = ws + 32;
    bf16x8 qr[8], qr2[4];
    { const bf16* Qw = Qp + (size_t)qrow * ldq + hi * 8;
#pragma unroll
      for (int d0 = 0; d0 < 8; ++d0) qr[d0] = *(const bf16x8*)(Qw + d0 * 16);
      if constexpr (MLA) {
#pragma unroll
          for (int d0 = 0; d0 < 4; ++d0) qr2[d0] = *(const bf16x8*)(Qw + 128 + d0 * 16); } }
    unsigned sel = 0u; if constexpr (!MLA) sel = selp[(size_t)qrow * NH];
    const int sr = tid >> 4, sc = (tid & 15) * 8, vst0 = v_st(sr, sc), vst1 = v_st(32 + sr, sc), kws = KSWZ(sr, sc * 2);
    const int k2r = tid >> 3, k2c = (tid & 7) * 8, k2ws = K2SWZ(k2r, k2c * 2);
    const int vb0 = (int)(uintptr_t)V_lds + v_rd_base(lane);
    float m_reg = -1e30f, l_reg = 0.f; f32x16 o[4];
#pragma unroll
    for (int d = 0; d < 4; ++d) o[d] = f32x16{};
    St S;
#define SLOAD(k0_) do { S.v0 = *(const bf16x8*)(Vp + (size_t)((k0_) + sr) * ldk + sc); S.v1 = *(const bf16x8*)(Vp + (size_t)((k0_) + 32 + sr) * ldk + sc); \
        S.k0 = *(const bf16x8*)(Kp + (size_t)((k0_) + sr) * ldk + sc); S.k1 = *(const bf16x8*)(Kp + (size_t)((k0_) + 32 + sr) * ldk + sc); \
        if constexpr (MLA) S.k2 = *(const bf16x8*)(K2p + (size_t)((k0_) + k2r) * ROPE + k2c); } while (0)
#define SWRITE(bf) do { *(bf16x8*)(V_lds + (bf) * SHM_V + vst0) = S.v0; *(bf16x8*)(V_lds + (bf) * SHM_V + vst1) = S.v1; \
        *(bf16x8*)(K_lds + (bf) * SHM_K + kws) = S.k0; *(bf16x8*)(K_lds + (bf) * SHM_K + kws + 32 * 256) = S.k1; \
        if constexpr (MLA) *(bf16x8*)(K2_lds + (bf) * SHM_K2 + k2ws) = S.k2; } while (0)
    const int NT = 4 * (qb + 1);
    SLOAD(0); VM_WAIT(); SWRITE(0); __syncthreads();
#define TILE_STEP(BF, t_) do { const int t = (t_); const int kb = t * 64; \
        if (t + 1 < NT) SLOAD(kb + 64); \
        bool act = kb <= qlo + 31; const int jblk = t >> 2; \
        if constexpr (!MLA) { if (jblk < qb) act = __any((int)((sel >> jblk) & 1u)) != 0; } \
        if (act) { \
            f32x16 p0 = f32x16{}, p1 = f32x16{}; \
            { const char* kbs[4]; _Pragma("unroll") for (int dd = 0; dd < 4; ++dd) kbs[dd] = K_lds + (BF) * SHM_K + KSWZ(r32, (dd * 16 + hi * 8) * 2); \
              _Pragma("unroll") for (int d0 = 0; d0 < 8; ++d0) { const char* a = kbs[d0 & 3] + (d0 >> 2) * 128; \
                const bf16x8 b0 = *(const bf16x8*)a; const bf16x8 b1 = *(const bf16x8*)(a + 32 * 256); \
                p0 = __builtin_amdgcn_mfma_f32_32x32x16_bf16(b0, qr[d0], p0, 0, 0, 0); p1 = __builtin_amdgcn_mfma_f32_32x32x16_bf16(b1, qr[d0], p1, 0, 0, 0); } } \
            if constexpr (MLA) { _Pragma("unroll") for (int d0 = 0; d0 < 4; ++d0) { const char* a = K2_lds + (BF) * SHM_K2 + K2SWZ(r32, (d0 * 16 + hi * 8) * 2); \
                const bf16x8 b0 = *(const bf16x8*)a; const bf16x8 b1 = *(const bf16x8*)(a + 32 * 128); \
                p0 = __builtin_amdgcn_mfma_f32_32x32x16_bf16(b0, qr2[d0], p0, 0, 0, 0); p1 = __builtin_amdgcn_mfma_f32_32x32x16_bf16(b1, qr2[d0], p1, 0, 0, 0); } } \
            const float NEG = -__builtin_inff(); \
            if (kb + 63 > qlo) { const int dq = qm - kb; \
                _Pragma("unroll") for (int r = 0; r < 16; ++r) { const int c = (r & 3) + 8 * (r >> 2); if (dq - c < 0) p0[r] = NEG; if (dq - c - 32 < 0) p1[r] = NEG; } } \
            if constexpr (!MLA) { if (jblk < qb) { if (((sel >> jblk) & 1u) == 0u) { _Pragma("unroll") for (int r = 0; r < 16; ++r) { p0[r] = NEG; p1[r] = NEG; } } } } \
            float pmax = p0[0]; _Pragma("unroll") for (int r = 1; r < 16; ++r) pmax = fmaxf(pmax, p0[r]); _Pragma("unroll") for (int r = 0; r < 16; ++r) pmax = fmaxf(pmax, p1[r]); \
            { auto rr = __builtin_amdgcn_permlane32_swap(__float_as_uint(pmax), __float_as_uint(pmax), false, false); pmax = fmaxf(__uint_as_float(rr[0]), __uint_as_float(rr[1])); } \
            float mn, alpha; \
            if (__builtin_expect(__all((pmax - m_reg) * SCALE <= THR), 1)) { mn = m_reg; alpha = 1.f; } \
            else { mn = fmaxf(m_reg, pmax); alpha = __builtin_amdgcn_exp2f((m_reg - mn) * C2); m_reg = mn; } \
            const float mnL = -mn * C2; \
            _Pragma("unroll") for (int r = 0; r < 16; ++r) { p0[r] = __builtin_amdgcn_exp2f(fmaf(p0[r], C2, mnL)); p1[r] = __builtin_amdgcn_exp2f(fmaf(p1[r], C2, mnL)); } \
            float ps = 0.f; _Pragma("unroll") for (int r = 0; r < 16; ++r) ps += p0[r]; _Pragma("unroll") for (int r = 0; r < 16; ++r) ps += p1[r]; \
            { auto rr = __builtin_amdgcn_permlane32_swap(__float_as_uint(ps), __float_as_uint(ps), false, false); ps = __uint_as_float(rr[0]) + __uint_as_float(rr[1]); } \
            l_reg = l_reg * alpha + ps; \
            if (__any(alpha < 1.f)) { if (hi == 0) al_l[r32] = alpha; LDS_WAIT(); \
                _Pragma("unroll") for (int d_ = 0; d_ < 4; ++d_) _Pragma("unroll") for (int r = 0; r < 16; ++r) o[d_][r] *= al_l[crow(r, hi)]; } \
            bf16x8 pa0, pa1, pa2, pa3; \
            PK4(p0, 0, pa0); PK4(p0, 8, pa1); PK4(p1, 0, pa2); PK4(p1, 8, pa3); \
            SBAR(); pv_tile<BF>(o, vb0, pa0, pa1, pa2, pa3); \
        } \
        if (t + 1 < NT) { VM_WAIT(); SWRITE((BF) ^ 1); } \
        __syncthreads(); } while (0)
#define PK4(P, B_, OUT) do { const unsigned a0 = cvt_pk_bf16(P[B_+0], P[B_+1]), a1 = cvt_pk_bf16(P[B_+2], P[B_+3]); \
        const unsigned b0_ = cvt_pk_bf16(P[B_+4], P[B_+5]), b1_ = cvt_pk_bf16(P[B_+6], P[B_+7]); \
        auto r0 = __builtin_amdgcn_permlane32_swap(a0, b0_, false, false); auto r1 = __builtin_amdgcn_permlane32_swap(a1, b1_, false, false); \
        v4u w = {r0[0], r1[0], r0[1], r1[1]}; OUT = *reinterpret_cast<bf16x8*>(&w); } while (0)
    for (int t2 = 0; t2 < NT; t2 += 2) { TILE_STEP(0, t2); TILE_STEP(1, t2 + 1); }
#undef PK4
#undef TILE_STEP
#undef SLOAD
#undef SWRITE
    if (hi == 0) li_l[r32] = l_reg; LDS_WAIT();
    float rli[16];
#pragma unroll
    for (int r = 0; r < 16; ++r) rli[r] = __builtin_amdgcn_rcpf(li_l[crow(r, hi)]);
    bf16* Ow = Op + (size_t)qlo * ldo;
#pragma unroll
    for (int r = 0; r < 16; ++r) { const int orow = crow(r, hi);
#pragma unroll
        for (int d0 = 0; d0 < 4; ++d0) { const float v = o[d0][r] * rli[r]; const float vn = __shfl_xor(v, 1);
            if ((r32 & 1) == 0) *(unsigned*)(Ow + (size_t)orow * ldo + d0 * 32 + r32) = cvt_pk_bf16(v, vn); } }
    __syncthreads();
}

constexpr int MB_OFF_V = 0, MB_OFF_K = 65536, MB_OFF_WS = 131072, MOBA_LDS = MB_OFF_WS + 8 * 128 * 4;
__device__ __forceinline__ void moba_unit(const bf16* Qh, const bf16* Kh, const bf16* Vh, const int* list, int cnt, int j, int c, int h, bf16* PO, float* PL, char* lds, const int wid) {
    constexpr float SCALE = 0.08838834764831845f, C2 = 1.4426950408889634f * SCALE, THR = 8.f;
    const int lane = lane_id(), tid = wid * 64 + lane, r32 = lane & 31, hi = lane >> 5;
    char* V_lds = lds + MB_OFF_V; char* K_lds = lds + MB_OFF_K;
    float* ws = (float*)(lds + MB_OFF_WS) + wid * 128; float* li_l = ws; float* al_l = ws + 32; int* qi_l = (int*)(ws + 64);
    { const int sr = tid >> 4, sc = (tid & 15) * 8, vst0 = v_st(sr, sc), vst1 = v_st(32 + sr, sc), kws = KSWZ(sr, sc * 2);
      const bf16* kp = Kh + (size_t)(256 * j + sr) * MW + sc; const bf16* vp = Vh + (size_t)(256 * j + sr) * MW + sc;
      bf16x8 kk[8], vv[8];
#pragma unroll
      for (int t = 0; t < 4; ++t) { kk[2 * t] = *(const bf16x8*)(kp + (size_t)(64 * t) * MW); kk[2 * t + 1] = *(const bf16x8*)(kp + (size_t)(64 * t + 32) * MW);
          vv[2 * t] = *(const bf16x8*)(vp + (size_t)(64 * t) * MW); vv[2 * t + 1] = *(const bf16x8*)(vp + (size_t)(64 * t + 32) * MW); }
#pragma unroll
      for (int t = 0; t < 4; ++t) { *(bf16x8*)(K_lds + t * SHM_K + kws) = kk[2 * t]; *(bf16x8*)(K_lds + t * SHM_K + kws + 32 * 256) = kk[2 * t + 1];
          *(bf16x8*)(V_lds + t * SHM_V + vst0) = vv[2 * t]; *(bf16x8*)(V_lds + t * SHM_V + vst1) = vv[2 * t + 1]; } }
    const int i = wid * 32 + r32; int q, slot; bool valid = true;
    if (c == 0) { q = 256 * j + i; slot = 3; } else { const int li = (c - 1) * 256 + i; valid = li < cnt; const int e = list[valid ? li : 0]; q = e >> 2; slot = e & 3; }
    bf16x8 qr[8];
    { const bf16* Qw = Qh + (size_t)q * MW + hi * 8;
#pragma unroll
      for (int d0 = 0; d0 < 8; ++d0) qr[d0] = *(const bf16x8*)(Qw + d0 * 16); }
    __syncthreads();
    const int vb0 = (int)(uintptr_t)V_lds + v_rd_base(lane);
    float m_reg = -1e30f, l_reg = 0.f; f32x16 o[4];
#pragma unroll
    for (int d = 0; d < 4; ++d) o[d] = f32x16{};
    const int qm = i - 4 * hi;
#define PK4(P, B_, OUT) do { const unsigned a0 = cvt_pk_bf16(P[B_+0], P[B_+1]), a1 = cvt_pk_bf16(P[B_+2], P[B_+3]); \
        const unsigned b0_ = cvt_pk_bf16(P[B_+4], P[B_+5]), b1_ = cvt_pk_bf16(P[B_+6], P[B_+7]); \
        auto r0 = __builtin_amdgcn_permlane32_swap(a0, b0_, false, false); auto r1 = __builtin_amdgcn_permlane32_swap(a1, b1_, false, false); \
        v4u w = {r0[0], r1[0], r0[1], r1[1]}; OUT = *reinterpret_cast<bf16x8*>(&w); } while (0)
#define MB_STEP(TT) do { constexpr int kb = 64 * (TT); \
        const bool act = (c != 0) || (kb <= wid * 32 + 31); \
        if (act) { \
            f32x16 p0 = f32x16{}, p1 = f32x16{}; \
            { const char* kbs[4]; _Pragma("unroll") for (int dd = 0; dd < 4; ++dd) kbs[dd] = K_lds + (TT) * SHM_K + KSWZ(r32, (dd * 16 + hi * 8) * 2); \
              _Pragma("unroll") for (int d0 = 0; d0 < 8; ++d0) { const char* a = kbs[d0 & 3] + (d0 >> 2) * 128; \
                const bf16x8 b0 = *(const bf16x8*)a; const bf16x8 b1 = *(const bf16x8*)(a + 32 * 256); \
                p0 = __builtin_amdgcn_mfma_f32_32x32x16_bf16(b0, qr[d0], p0, 0, 0, 0); p1 = __builtin_amdgcn_mfma_f32_32x32x16_bf16(b1, qr[d0], p1, 0, 0, 0); } } \
            if (c == 0 && kb + 63 > wid * 32) { const float NEG = -__builtin_inff(); const int dq = qm - kb; \
                _Pragma("unroll") for (int r = 0; r < 16; ++r) { const int cc = (r & 3) + 8 * (r >> 2); if (dq - cc < 0) p0[r] = NEG; if (dq - cc - 32 < 0) p1[r] = NEG; } } \
            float pmax = p0[0]; _Pragma("unroll") for (int r = 1; r < 16; ++r) pmax = fmaxf(pmax, p0[r]); _Pragma("unroll") for (int r = 0; r < 16; ++r) pmax = fmaxf(pmax, p1[r]); \
            { auto rr = __builtin_amdgcn_permlane32_swap(__float_as_uint(pmax), __float_as_uint(pmax), false, false); pmax = fmaxf(__uint_as_float(rr[0]), __uint_as_float(rr[1])); } \
            float mn, alpha; \
            if (__builtin_expect(__all((pmax - m_reg) * SCALE <= THR), 1)) { mn = m_reg; alpha = 1.f; } \
            else { mn = fmaxf(m_reg, pmax); alpha = __builtin_amdgcn_exp2f((m_reg - mn) * C2); m_reg = mn; } \
            const float mnL = -mn * C2; \
            _Pragma("unroll") for (int r = 0; r < 16; ++r) { p0[r] = __builtin_amdgcn_exp2f(fmaf(p0[r], C2, mnL)); p1[r] = __builtin_amdgcn_exp2f(fmaf(p1[r], C2, mnL)); } \
            float ps = 0.f; _Pragma("unroll") for (int r = 0; r < 16; ++r) ps += p0[r]; _Pragma("unroll") for (int r = 0; r < 16; ++r) ps += p1[r]; \
            { auto rr = __builtin_amdgcn_permlane32_swap(__float_as_uint(ps), __float_as_uint(ps), false, false); ps = __uint_as_float(rr[0]) + __uint_as_float(rr[1]); } \
            l_reg = l_reg * alpha + ps; \
            if (__any(alpha < 1.f)) { if (hi == 0) al_l[r32] = alpha; LDS_WAIT(); \
                _Pragma("unroll") for (int d_ = 0; d_ < 4; ++d_) _Pragma("unroll") for (int r = 0; r < 16; ++r) o[d_][r] *= al_l[crow(r, hi)]; } \
            bf16x8 pa0, pa1, pa2, pa3; \
            PK4(p0, 0, pa0); PK4(p0, 8, pa1); PK4(p1, 0, pa2); PK4(p1, 8, pa3); \
            SBAR(); pv_tile<TT>(o, vb0, pa0, pa1, pa2, pa3); \
        } } while (0)
    MB_STEP(0); MB_STEP(1); MB_STEP(2); MB_STEP(3);
#undef MB_STEP
#undef PK4
    const int pidx_own = valid ? ((q * NH + h) * 4 + slot) : -1;
    if (hi == 0) { li_l[r32] = l_reg; qi_l[r32] = pidx_own; if (valid) PL[pidx_own] = m_reg * C2 + __builtin_amdgcn_logf(l_reg); }
    LDS_WAIT();
#pragma unroll
    for (int r = 0; r < 16; ++r) { const int orow = crow(r, hi); const int pidx = qi_l[orow]; const float rl = __builtin_amdgcn_rcpf(li_l[orow]);
#pragma unroll
        for (int d0 = 0; d0 < 4; ++d0) { const float v = o[d0][r] * rl; const float vn = __shfl_xor(v, 1);
            if ((r32 & 1) == 0 && pidx >= 0) *(unsigned*)(PO + (size_t)pidx * 128 + d0 * 32 + r32) = cvt_pk_bf16(v, vn); } }
    __syncthreads();
}
}

#define XB_TMO      128
#define XB_XCNT(j)  (256  + 64 * (j))
#define XB_XSUB(j)  (1280 + 64 * (j))
#define XB_XGEN(j)  (2304 + 64 * (j))
#define XB_TOP      3328
#define XB_TOPGEN   3392
#define XCD_BAR_WORDS 3456
#define XB_SPIN_CAP (1u << 18)
__device__ __forceinline__ unsigned xb_ld(unsigned* p)              { return __hip_atomic_load(p, __ATOMIC_RELAXED, __HIP_MEMORY_SCOPE_AGENT); }
__device__ __forceinline__ unsigned xb_add(unsigned* p, unsigned v) { return __hip_atomic_fetch_add(p, v, __ATOMIC_RELAXED, __HIP_MEMORY_SCOPE_AGENT); }
__device__ __forceinline__ unsigned xb_xcc_id() { return (unsigned)__builtin_amdgcn_s_getreg((3 << 11) | 20) & 0xFu; }
#define XB_SPIN(cond, bar) do { unsigned _sp = 0; while (cond) { __builtin_amdgcn_s_sleep(1); \
    if ((++_sp & 255u) == 0u) { if (xb_ld(&(bar)[XB_TMO])) break; if (_sp > XB_SPIN_CAP) { atomicAdd(&(bar)[XB_TMO], 1u); break; } } } } while (0)
struct XcdBarrier { unsigned* bar; unsigned x; volatile LAS unsigned* st; };
__device__ __forceinline__ XcdBarrier xcd_barrier_post(unsigned* bar, volatile LAS unsigned* st, bool t0  ) {
    XcdBarrier b; b.bar = bar; b.x = xb_xcc_id(); b.st = st;
    if (t0) (void)xb_add(&bar[XB_XCNT(b.x)], 1u);
    return b;
}
__device__ __forceinline__ void xcd_barrier_complete(unsigned* bar, unsigned x, unsigned& nloc, unsigned& nx) {
    const unsigned G = gridDim.x * gridDim.y * gridDim.z;
    unsigned sum, cnt, mine, sp = 0u;
    for (;;) {
        sum = 0u; cnt = 0u; mine = 0u;
#pragma unroll
        for (unsigned j = 0; j < 16; ++j) { const unsigned c = xb_ld(&bar[XB_XCNT(j)]); sum += c; cnt += (c > 0u) ? 1u : 0u; mine = (j == x) ? c : mine; }
        if (sum == G) break;
        __builtin_amdgcn_s_sleep(1);
        if ((++sp & 255u) == 0u) { if (xb_ld(&bar[XB_TMO])) break; if (sp > XB_SPIN_CAP) { atomicAdd(&bar[XB_TMO], 1u); break; } }
    }
    nloc = mine > 0u ? mine : 1u; nx = cnt > 0u ? cnt : 1u;
}
__device__ __forceinline__ void xcd_barrier(const XcdBarrier& b, bool t0  ) {
    asm volatile("s_waitcnt vmcnt(0)" ::: "memory");
    __syncthreads();
    if (t0) {
        unsigned* bar = b.bar;
        __builtin_amdgcn_s_waitcnt(0);
        unsigned nloc = b.st[0], nx = b.st[1];
        if (nloc == 0u) { xcd_barrier_complete(bar, b.x, nloc, nx); b.st[0] = nloc; b.st[1] = nx; }
        const unsigned old = xb_add(&bar[XB_XSUB(b.x)], 1u);
        const unsigned gen = old / nloc;
        if (old + 1u == (gen + 1u) * nloc) {
            __builtin_amdgcn_fence(__ATOMIC_RELEASE, "agent");
            asm volatile("s_waitcnt vmcnt(0)" ::: "memory");
            const unsigned og = xb_add(&bar[XB_TOP], 1u);
            const unsigned tg = og / nx;
            if (og + 1u == (tg + 1u) * nx) xb_add(&bar[XB_TOPGEN], 1u);
            else XB_SPIN(xb_ld(&bar[XB_TOPGEN]) == tg, bar);
            __builtin_amdgcn_fence(__ATOMIC_ACQUIRE, "agent");
            xb_add(&bar[XB_XGEN(b.x)], 1u);
            asm volatile("s_waitcnt vmcnt(0)" ::: "memory");
        } else {
            XB_SPIN(xb_ld(&bar[XB_XGEN(b.x)]) == gen, bar);
            __builtin_amdgcn_fence(__ATOMIC_ACQUIRE, "agent");
            asm volatile("s_waitcnt vmcnt(0)" ::: "memory");
        }
    }
    __syncthreads();
}

struct Args;
typedef const __attribute__((address_space(4))) struct Args* KArgsFwd;
struct Args {
    const float* x; const int* pos; const float* w_in; const float* g_q_a; const float* w_q_b; const float* g_kv_a; const float* w_kv_b;
    const float* g_out_mla; const float* g_out_moba; const float* w_o; const float* ln1_g; const float* ln1_b; const float* w_router; const float* b_router;
    const float* w_gate_up; const float* b_gate_up; const float* w_down; const float* b_down; const float* ln2_g; const float* ln2_b;
    float* out; unsigned char* ws; int ph_lo, ph_hi;
};
constexpr int NPHASES = 14;

__device__ __forceinline__ void tr_item(const float* W, int N, bf16* WT, int K, int k0, int n0, int prow0, const float* sc, int lane) {
    float tv[64]; const unsigned off0 = (unsigned)(k0 * N + n0 + lane) * 4u, rb = (unsigned)N * 4u;
#pragma unroll
    for (int i = 0; i < 64; ++i) tv[i] = __builtin_nontemporal_load((const float*)((const char*)W + (off0 + (unsigned)i * rb)));
    if (sc) {
#pragma unroll
        for (int i = 0; i < 64; i += 4) { const f32x4 g4 = *(const f32x4*)(sc + k0 + i); tv[i] *= g4[0]; tv[i + 1] *= g4[1]; tv[i + 2] *= g4[2]; tv[i + 3] *= g4[3]; } }
    bf16* dst = WT + (size_t)(prow0 + lane) * K + k0;
#pragma unroll
    for (int j = 0; j < 8; ++j) { v4u o; o.x = cvt_pk_bf16(tv[8 * j], tv[8 * j + 1]); o.y = cvt_pk_bf16(tv[8 * j + 2], tv[8 * j + 3]); o.z = cvt_pk_bf16(tv[8 * j + 4], tv[8 * j + 5]); o.w = cvt_pk_bf16(tv[8 * j + 6], tv[8 * j + 7]);
        *(v4u*)(dst + 8 * j) = o; }
}
constexpr int BG_ITEMS = NE * 32 * 64 + NE * 32 * 32, BG_ROUNDS = 48;
constexpr int BG_P1 = 6, BG_P6 = 44, BG_P8 = 48;
struct BgItem { const float* W; unsigned char* WT; unsigned rb; int K, k0, n0, prow0; float cs; };
__device__ __forceinline__ BgItem bg_decode(KArgsFwd ka, GAS unsigned char* ws, int it) {
    BgItem b; it = it < BG_ITEMS ? it : BG_ITEMS - 1;
    if (it < NE * 2048) { const int e = it >> 11, q = it & 2047, kb = q >> 6, nb = q & 63, n0 = nb * 64;
        b.W = ((const float*)(GAS const float*)ka->w_gate_up) + (size_t)e * DM * 2 * DFF; b.WT = (unsigned char*)(ws + WS_WGU) + (size_t)e * 2 * DFF * DM; b.rb = 2 * DFF * 4; b.K = DM; b.k0 = kb * 64; b.n0 = n0;
        b.prow0 = n0 < DFF ? (n0 >> 7) * 256 + (n0 & 127) : ((n0 - DFF) >> 7) * 256 + 128 + ((n0 - DFF) & 127); b.cs = SC_WGU; }
    else { it -= NE * 2048; const int e = it >> 10, q = it & 1023, kb = q >> 5, nb = q & 31;
        b.W = ((const float*)(GAS const float*)ka->w_down) + (size_t)e * DFF * DM; b.WT = (unsigned char*)(ws + WS_WD) + (size_t)e * DM * DFF; b.rb = DM * 4; b.K = DFF; b.k0 = kb * 64; b.n0 = nb * 64; b.prow0 = nb * 64; b.cs = SC_WD; }
    return b;
}
#define BG_LOAD(TV, B) do { const unsigned off0_ = (unsigned)((B).k0 + 16 * (lane >> 4)) * (B).rb + (unsigned)((B).n0 + 4 * (lane & 15)) * 4u; \
    _Pragma("unroll") for (int i_ = 0; i_ < 16; ++i_) TV[i_] = __builtin_nontemporal_load((const f32x4*)((const char*)(B).W + (off0_ + (unsigned)i_ * (B).rb))); } while (0)
#define BG_STORE(TV, B) do { unsigned char* dst_ = (B).WT + (size_t)((B).prow0 + 4 * (lane & 15)) * (B).K + (B).k0 + 16 * (lane >> 4); const float cs_ = (B).cs; \
    _Pragma("unroll") for (int c_ = 0; c_ < 4; ++c_) { v4u o_; \
        o_.x = pk4_fp8(TV[0][c_] * cs_, TV[1][c_] * cs_, TV[2][c_] * cs_, TV[3][c_] * cs_); o_.y = pk4_fp8(TV[4][c_] * cs_, TV[5][c_] * cs_, TV[6][c_] * cs_, TV[7][c_] * cs_); \
        o_.z = pk4_fp8(TV[8][c_] * cs_, TV[9][c_] * cs_, TV[10][c_] * cs_, TV[11][c_] * cs_); o_.w = pk4_fp8(TV[12][c_] * cs_, TV[13][c_] * cs_, TV[14][c_] * cs_, TV[15][c_] * cs_); \
        *(v4u*)(dst_ + (size_t)c_ * (B).K) = o_; } } while (0)
__device__ __forceinline__ void bg_run(KArgsFwd ka, GAS unsigned char* ws, int it0, int n, int stride, int lane) {
    if (n <= 0) return;
    f32x4 ta[16], tb[16];
    BgItem A = bg_decode(ka, ws, it0), B = A;
    BG_LOAD(ta, A);
    for (int r = 0; r < n; r += 2) {
        const bool hb = r + 1 < n, ha = r + 2 < n;
        if (hb) { B = bg_decode(ka, ws, it0 + (r + 1) * stride); BG_LOAD(tb, B); }
        BG_STORE(ta, A);
        if (ha) { A = bg_decode(ka, ws, it0 + (r + 2) * stride); BG_LOAD(ta, A); }
        if (hb) BG_STORE(tb, B);
    }
}
__device__ __forceinline__ void bg_rounds(KArgsFwd ka, GAS unsigned char* ws, int r0, int r1, int gw, int NGW, int lane) { bg_run(ka, ws, r0 * NGW + gw, r1 - r0, NGW, lane); }
#undef BG_LOAD
#undef BG_STORE
__device__ __forceinline__ void sincos_d(double x, float& sn, float& cs) {
    const double inv2pi = 0.15915494309189533577, pi2hi = 6.283185307179586232, pi2lo = 2.4492935982947064e-16;
    const double n = rint(x * inv2pi); double r = fma(-n, pi2hi, x); r = fma(-n, pi2lo, r);
    const double r2 = r * r; double s = 1.0, c = 1.0;
    double ts = 0.0, tc = 0.0;
#pragma unroll
    for (int k = 14; k >= 1; --k) { ts = (ts + 1.0) * (-r2 * (1.0 / (double)((2 * k) * (2 * k + 1)))); tc = (tc + 1.0) * (-r2 * (1.0 / (double)((2 * k - 1) * (2 * k)))); }
    s = r * (1.0 + ts); c = 1.0 + tc; sn = (float)s; cs = (float)c;
}

#define XB   ((bf16*)(ws + WS_XB))
#define WIN  ((bf16*)(ws + WS_WIN))
#define WQB  ((bf16*)(ws + WS_WQB))
#define WKVB ((bf16*)(ws + WS_WKVB))
#define WO   ((bf16*)(ws + WS_WO))
#define C128 ((float*)(ws + WS_C128))
#define S128 ((float*)(ws + WS_S128))
#define C64  ((float*)(ws + WS_C64))
#define S64  ((float*)(ws + WS_S64))
#define HQ   ((bf16*)(ws + WS_HQ))
#define HKV  ((bf16*)(ws + WS_HKV))
#define HR   ((bf16*)(ws + WS_HR))
#define KPE  ((bf16*)(ws + WS_KPE))
#define MQ   ((bf16*)(ws + WS_MQ))
#define MK   ((bf16*)(ws + WS_MK))
#define MV   ((bf16*)(ws + WS_MV))
#define RSQ  ((float*)(ws + WS_RSQ))
#define RSKV ((float*)(ws + WS_RSKV))
#define QM   ((bf16*)(ws + WS_QM))
#define KVM  ((bf16*)(ws + WS_KVM))
#define KBAR ((float*)(ws + WS_KBAR))
#define SEL  ((unsigned*)(ws + WS_SEL))
#define MLIST ((int*)(ws + WS_LIST))
#define PO   ((bf16*)(ws + WS_PO))
#define PL   ((float*)(ws + WS_PL))
#define OMIX ((bf16*)(ws + WS_OMIX))
#define X1P  ((float*)(ws + WS_X1P))
#define X1N  ((float*)(ws + WS_X1N))
#define X1B  ((unsigned char*)(ws + WS_X1B))
#define TOPE ((int*)(ws + WS_TOPE))
#define TOPR ((int*)(ws + WS_TOPR))
#define TOPG ((float*)(ws + WS_TOPG))
#define TOPROW ((int*)(ws + WS_TOPROW))
#define RGATE ((float*)(ws + WS_RGATE))
#define XG   ((unsigned char*)(ws + WS_XG))
#define ACT  ((unsigned char*)(ws + WS_ACT))
#define YB   ((bf16*)(ws + WS_Y))
#define WGU  ((unsigned char*)(ws + WS_WGU))
#define WD   ((unsigned char*)(ws + WS_WD))
__device__ __forceinline__ GAS unsigned char* opq(const void* p) { GAS unsigned char* q = (GAS unsigned char*)p; asm volatile("" : "+s"(q)); return q; }
typedef const __attribute__((address_space(4))) struct Args* KArgs;
__device__ __forceinline__ KArgs kargs() { auto p = __builtin_amdgcn_kernarg_segment_ptr(); asm volatile("" : "+s"(p)); return (KArgs)p; }

__global__ void __launch_bounds__(512, 2) fwd(Args a) {
    extern __shared__ __attribute__((aligned(16))) unsigned char lds[];
    LAS unsigned char* L = (LAS unsigned char*)lds;
    const int wave = __builtin_amdgcn_readfirstlane((int)threadIdx.x >> 6);
    const int G = gridDim.x, bid = blockIdx.x;
    const int gw = bid * 8 + wave, NGW = G * 8;
    const int NGT = G * 512;
    gu32* ctl = (gu32*)(a.ws + WS_CTL);
    for (int u = wave * 64 + lane_id(); u < (LDS_BYTES - LDSCTL_OFF) / 4; u += 512) ((LAS unsigned*)(L + LDSCTL_OFF))[u] = 0u;
    __syncthreads();
    XcdBarrier bar; bar.bar = (unsigned*)(ctl + CW_BAR); bar.x = 0; bar.st = nullptr;
    if (MK_N_LAUNCHES == 1) bar = xcd_barrier_post((unsigned*)(ctl + CW_BAR), (volatile LAS unsigned*)(L + LDSCTL_OFF), wave == 0 && lane_id() == 0);
    const int lo = a.ph_lo, hi = a.ph_hi;
#define IN(k) (lo <= (k) && (k) < hi)
#define REPS(k) ((((PROBE_REP_MASK) >> (k)) & 1) + 1)
#define SEAM(k) do { if (IN(k) && IN((k) + 1)) { XcdBarrier b2_ = bar; b2_.bar = (unsigned*)(opq(kargs()->ws) + WS_CTL + (size_t)CW_BAR * 4); xcd_barrier(b2_, wave == 0 && lane_id() == 0); } } while (0)

    if (IN(0)) for (int rep_ = 0; rep_ < REPS(0); ++rep_) { KArgs ka = kargs(); GAS unsigned char* ws = opq(ka->ws); const int lane = lane_id(), tid = wave * 64 + lane, gt = bid * 512 + tid; (void)gt;
        constexpr int I0 = 32 * 61, I1 = 8 * 24, I2 = 4 * 32, I3 = 32 * 32;
        constexpr int NIT = I0 + I1 + I2 + I3;
        for (int it = gw; it < NIT; it += NGW) {
            int r = it;
            if (r < I0) { const int kb = r / 61, nb = r % 61, n0 = nb * 64; tr_item(((const float*)(GAS const float*)ka->w_in), INC, WIN, DM, kb * 64, n0, n0 < 832 ? n0 : n0 + 192, nullptr, lane); continue; } r -= I0;
            if (r < I1) { const int kb = r / 24, nb = r % 24; tr_item(((const float*)(GAS const float*)ka->w_q_b), 1536, WQB, QLORA, kb * 64, nb * 64, nb * 64, ((const float*)(GAS const float*)ka->g_q_a), lane); continue; } r -= I1;
            if (r < I2) { const int kb = r / 32, nb = r % 32; tr_item(((const float*)(GAS const float*)ka->w_kv_b), 2048, WKVB, KVLORA, kb * 64, nb * 64, nb * 64, ((const float*)(GAS const float*)ka->g_kv_a), lane); continue; } r -= I2;
            { const int kb = r / 32, nb = r % 32; tr_item(((const float*)(GAS const float*)ka->w_o), DM, WO, DM, kb * 64, nb * 64, nb * 64, kb < 16 ? ((const float*)(GAS const float*)ka->g_out_mla) : ((const float*)(GAS const float*)ka->g_out_moba) - MW, lane); }
        }
        for (int i = gt; i < 192 * DM / 8; i += NGT) *(v4u*)(WIN + (size_t)832 * DM + (size_t)i * 8) = (v4u){0u, 0u, 0u, 0u};
        for (int i = gt; i < T * DM / 8; i += NGT) { const f32x4 v0 = *(const f32x4*)(((const float*)(GAS const float*)ka->x) + (size_t)i * 8), v1 = *(const f32x4*)(((const float*)(GAS const float*)ka->x) + (size_t)i * 8 + 4);
            v4u w; w.x = cvt_pk_bf16(v0[0], v0[1]); w.y = cvt_pk_bf16(v0[2], v0[3]); w.z = cvt_pk_bf16(v1[0], v1[1]); w.w = cvt_pk_bf16(v1[2], v1[3]); *(v4u*)(XB + (size_t)i * 8) = w; }
        for (int i = gt; i < T * 96; i += NGT) { const int t = i / 96, j = i % 96; const float p = (float)((const int*)(GAS const int*)ka->pos)[t];
            if (j < 64) { const float inv = (float)exp2(-(double)j * (2.0 / 128.0) * 13.287712379549449); float sn, cs; sincos_d((double)(p * inv), sn, cs); C128[t * 64 + j] = cs; S128[t * 64 + j] = sn; }
            else { const int jj = j - 64; const float inv = (float)exp2(-(double)jj * (2.0 / 64.0) * 13.287712379549449); float sn, cs; sincos_d((double)(p * inv), sn, cs); C64[t * 32 + jj] = cs; S64[t * 32 + jj] = sn; } }
    }
    SEAM(0);

    if (IN(1)) for (int rep_ = 0; rep_ < REPS(1); ++rep_) { KArgs ka = kargs(); GAS unsigned char* ws = opq(ka->ws);
        pg8::Gemm g{XB, WIN, DM * 2, DM * 2, DM * 2, 0}; pg8::StaticOrder S; S.init(T, INP, G, bid);
        pg8::EpiInProj E{(unsigned char*)ws};
        const bool bg_first = ((bid >> 3) & 1) == 0;
        if (bg_first) bg_rounds(ka, ws, 0, BG_P1, gw, NGW, lane_id());
        pg8::gemm_phase<pg8::EpiInProj, pg8::StaticOrder>(L, g, S, E, wave);
        if (!bg_first) bg_rounds(ka, ws, 0, BG_P1, gw, NGW, lane_id());
    }
    SEAM(1);

    if (IN(2)) for (int rep_ = 0; rep_ < REPS(2); ++rep_) { KArgs ka = kargs(); GAS unsigned char* ws = opq(ka->ws); const int lane = lane_id(), tid = wave * 64 + lane, gt = bid * 512 + tid; (void)gt;
        for (int r = gw; r < T; r += NGW) {
            { const v4u w = *(const v4u*)(HQ + (size_t)r * QLORA + lane * 8); float s = 0.f;
              s += bflo(w.x) * bflo(w.x) + bfhi(w.x) * bfhi(w.x) + bflo(w.y) * bflo(w.y) + bfhi(w.y) * bfhi(w.y) + bflo(w.z) * bflo(w.z) + bfhi(w.z) * bfhi(w.z) + bflo(w.w) * bflo(w.w) + bfhi(w.w) * bfhi(w.w);
              s = wave_sum(s); if (lane == 0) RSQ[r] = 1.0f / sqrtf(s * (1.0f / QLORA) + RMS_EPS); }
            { const v2u w = *(const v2u*)(HKV + (size_t)r * KVLORA + lane * 4); float s = 0.f;
              s += bflo(w.x) * bflo(w.x) + bfhi(w.x) * bfhi(w.x) + bflo(w.y) * bflo(w.y) + bfhi(w.y) * bfhi(w.y);
              s = wave_sum(s); if (lane == 0) RSKV[r] = 1.0f / sqrtf(s * (1.0f / KVLORA) + RMS_EPS); }
            if (lane < 32) { const float x1 = bf2f(HR[(size_t)r * 256 + lane]), x2 = bf2f(HR[(size_t)r * 256 + 32 + lane]); const float c = C64[r * 32 + lane], s = S64[r * 32 + lane];
                KPE[(size_t)r * ROPE + lane] = f2bf(x1 * c - x2 * s); KPE[(size_t)r * ROPE + 32 + lane] = f2bf(x2 * c + x1 * s); }
            const float c = C128[r * 64 + lane], s = S128[r * 64 + lane];
#pragma unroll
            for (int h = 0; h < NH; ++h) {
                bf16* q = MQ + (size_t)r * MW + h * 128; const float q1 = bf2f(q[lane]), q2 = bf2f(q[64 + lane]); q[lane] = f2bf(q1 * c - q2 * s); q[64 + lane] = f2bf(q2 * c + q1 * s);
                bf16* k = MK + (size_t)r * MW + h * 128; const float k1 = bf2f(k[lane]), k2 = bf2f(k[64 + lane]); k[lane] = f2bf(k1 * c - k2 * s); k[64 + lane] = f2bf(k2 * c + k1 * s); }
        }
    }
    SEAM(2);

    if (IN(3)) for (int rep_ = 0; rep_ < REPS(3); ++rep_) { KArgs ka = kargs(); GAS unsigned char* ws = opq(ka->ws);
        { pg8::Gemm g{HQ, WQB, QLORA * 2, QLORA * 2, QLORA * 2, 0}; pg8::StaticOrder S; S.init(T, 1536, G, bid); pg8::EpiRowScale E{QM, 1536, RSQ};
          pg8::gemm_phase<pg8::EpiRowScale, pg8::StaticOrder>(L, g, S, E, wave); }
        { pg8::Gemm g{HKV, WKVB, KVLORA * 2, KVLORA * 2, KVLORA * 2, 0}; pg8::StaticOrder S; S.init(T, 2048, G, bid); pg8::EpiRowScale E{KVM, 2048, RSKV};
          pg8::gemm_phase<pg8::EpiRowScale, pg8::StaticOrder>(L, g, S, E, wave); }
    }
    SEAM(3);

    if (IN(4)) for (int rep_ = 0; rep_ < REPS(4); ++rep_) { KArgs ka = kargs(); GAS unsigned char* ws = opq(ka->ws); const int lane = lane_id(), tid = wave * 64 + lane, gt = bid * 512 + tid; (void)gt;
        for (int r = gw; r < T; r += NGW) {
#pragma unroll
            for (int j = 0; j < 4; ++j) { const int idx = lane + 64 * j, h = idx >> 5, i = idx & 31; bf16* q = QM + (size_t)r * 1536 + h * QKH + NOPE;
                const float c = C64[r * 32 + i], s = S64[r * 32 + i]; const float x1 = bf2f(q[i]), x2 = bf2f(q[32 + i]); q[i] = f2bf(x1 * c - x2 * s); q[32 + i] = f2bf(x2 * c + x1 * s); }
        }
        for (int it = gw; it < NH * 32; it += NGW) { const int h = it >> 5, blk = it & 31; float s0 = 0.f, s1 = 0.f;
            const bf16* p = MK + (size_t)blk * 256 * MW + h * 128 + 2 * lane;
            for (int rr = 0; rr < 256; ++rr) { const unsigned w = *(const unsigned*)(p + (size_t)rr * MW); s0 += bflo(w); s1 += bfhi(w); }
            KBAR[(h * 32 + blk) * 128 + 2 * lane] = s0 * (1.0f / 256.0f); KBAR[(h * 32 + blk) * 128 + 2 * lane + 1] = s1 * (1.0f / 256.0f); }
    }
    SEAM(4);

    if (IN(5)) for (int rep_ = 0; rep_ < REPS(5); ++rep_) { KArgs ka = kargs(); GAS unsigned char* ws = opq(ka->ws); const int lane = lane_id(), tid = wave * 64 + lane, gt = bid * 512 + tid; (void)gt;
        LAS float* kb = (LAS float*)L;
        for (int i = tid; i < NH * 32 * 128; i += 512) kb[(i >> 7) * 129 + (i & 127)] = KBAR[i];
        LAS unsigned* qs = (LAS unsigned*)(L + 132096 + wave * 2048);
        __syncthreads();
        for (int t = gw; t < T; t += NGW) {
            const int blk = t >> 8;
            { const v4u w0 = *(const v4u*)(MQ + (size_t)t * MW + lane * 8), w1 = *(const v4u*)(MQ + (size_t)t * MW + 512 + lane * 8);
              *(LAS v4u*)(qs + lane * 4) = w0; *(LAS v4u*)(qs + 256 + lane * 4) = w1; }
            LDS_WAIT(); asm volatile("" ::: "memory");
            const int n = lane & 31;
#pragma unroll 1
            for (int hp = 0; hp < 4; ++hp) { const int h = 2 * hp + (lane >> 5);
                const LAS float* kr = kb + (h * 32 + n) * 129; const LAS unsigned* qh = qs + h * 64; float dot = 0.f;
#pragma unroll 8
                for (int d = 0; d < 64; ++d) { const unsigned w = qh[d]; dot = fmaf(bflo(w), kr[2 * d], dot); dot = fmaf(bfhi(w), kr[2 * d + 1], dot); }
                float gate = n < blk ? dot : -__builtin_inff(); unsigned bits = 0u;
#pragma unroll
                for (int k = 0; k < 3; ++k) { float v = gate; int idx = n;
#pragma unroll
                    for (int off = 16; off >= 1; off >>= 1) { const float ov = __shfl_xor(v, off); const int oi = __shfl_xor(idx, off); if (ov > v || (ov == v && oi < idx)) { v = ov; idx = oi; } }
                    if (k < blk && n == 0) { const unsigned pos = __hip_atomic_fetch_add((unsigned*)(ctl + CW_MCNT + (h * 32 + idx) * 64), 1u, RLX_AGENT); MLIST[(size_t)(h * 32 + idx) * 8192 + pos] = t * 4 + k; }
                    (void)bits;
                    if (n == idx) gate = -__builtin_inff(); } }
            LDS_WAIT(); asm volatile("" ::: "memory");
        }
        __syncthreads();
    }
    SEAM(5);

    if (IN(6)) for (int rep_ = 0; rep_ < REPS(6); ++rep_) { KArgs ka = kargs(); GAS unsigned char* ws = opq(ka->ws);
        LAS int* pref = (LAS int*)(L + 143360);
        LAS int* qslot = (LAS int*)(L + LDSCTL_OFF + 32);
        { const int tid = wave * 64 + lane_id();
          if (tid < 256) { const int cn = (int)__hip_atomic_load((unsigned*)(ctl + CW_MCNT + tid * 64), RLX_AGENT); pref[1 + tid] = 1 + ((cn + 255) >> 8); }
          __syncthreads();
          if (tid == 0) { int acc_ = 0; pref[0] = 0; for (int i = 0; i < 256; ++i) { acc_ += pref[1 + i]; pref[1 + i] = acc_; } }
          __syncthreads(); }
        const int NM = __builtin_amdgcn_readfirstlane(pref[256]);
        constexpr int NC = (BG_P6 - BG_P1) * 2048 / 32;
        const int N2 = NM + NC, N = 256 + N2;
        for (int iter = 0;; ++iter) {
            if (wave == 0 && lane_id() == 0) qslot[iter & 1] = (int)__hip_atomic_fetch_add((unsigned*)(ctl + CW_QHEAD), 1u, RLX_AGENT);
            __syncthreads();
            const int p = __builtin_amdgcn_readfirstlane(qslot[iter & 1]);
            if (p >= N) break;
            const int a0 = (p * 256) / N, a1 = ((p + 1) * 256) / N;
            if (a1 > a0) { const int h = a0 & 7, sq = 31 - (a0 >> 3);
                at::attn_unit<true>((const bf16*)QM + h * QKH, 1536, (const bf16*)KVM + h * 256, (const bf16*)KVM + h * 256 + 128, 2048, (const bf16*)KPE, OMIX + h * 128, DM, sq, nullptr, (char*)lds, wave);
            } else { const int q = p - a1; const int b0 = (int)(((long)q * NM) / N2), b1 = (int)(((long)(q + 1) * NM) / N2);
                if (b1 > b0) { int lo_ = 0, hi_ = 255;
                    while (lo_ < hi_) { const int mid = (lo_ + hi_ + 1) >> 1; if (pref[mid] <= b0) lo_ = mid; else hi_ = mid - 1; }
                    const int hj = __builtin_amdgcn_readfirstlane(lo_), c = b0 - __builtin_amdgcn_readfirstlane(pref[lo_]), h = hj >> 5, j = hj & 31;
                    const int cn = (int)__builtin_amdgcn_readfirstlane((int)__hip_atomic_load((unsigned*)(ctl + CW_MCNT + hj * 64), RLX_AGENT));
                    at::moba_unit((const bf16*)MQ + h * 128, (const bf16*)MK + h * 128, (const bf16*)MV + h * 128, MLIST + (size_t)hj * 8192, cn, j, c, h, PO, PL, (char*)lds, wave);
                } else { const int cc = q - b1; bg_run(ka, ws, BG_P1 * 2048 + cc * 32 + wave * 4, 4, 1, lane_id()); }
            }
        }
    }
    SEAM(6);

    if (IN(7)) for (int rep_ = 0; rep_ < REPS(7); ++rep_) { KArgs ka = kargs(); GAS unsigned char* ws = opq(ka->ws); const int lane = lane_id(), tid = wave * 64 + lane, gt = bid * 512 + tid; (void)gt;
        for (int r = gw; r < T; r += NGW) { const int nv = (r >> 8) < 3 ? (r >> 8) : 3;
            float ob[NH][2]; float ssb = 0.f;
#pragma unroll
            for (int h = 0; h < NH; ++h) { const int pb = (r * NH + h) * 4; float Ls[4]; float Lm = PL[pb + 3]; Ls[3] = Lm;
#pragma unroll
                for (int k = 0; k < 3; ++k) { Ls[k] = k < nv ? PL[pb + k] : -__builtin_inff(); Lm = fmaxf(Lm, Ls[k]); }
                float W = 0.f, o0 = 0.f, o1 = 0.f;
#pragma unroll
                for (int k = 0; k < 4; ++k) { if (k == 3 || k < nv) { const float w = __builtin_amdgcn_exp2f(Ls[k] - Lm); const unsigned pv = *(const unsigned*)(PO + (size_t)(pb + k) * 128 + 2 * lane); W += w; o0 = fmaf(w, bflo(pv), o0); o1 = fmaf(w, bfhi(pv), o1); } }
                const float iw = 1.0f / W; ob[h][0] = o0 * iw; ob[h][1] = o1 * iw; ssb += ob[h][0] * ob[h][0] + ob[h][1] * ob[h][1]; }
            v4u w[2]; float ssa = 0.f;
#pragma unroll
            for (int j = 0; j < 2; ++j) { w[j] = *(const v4u*)(OMIX + (size_t)r * DM + j * 512 + lane * 8);
                ssa += bflo(w[j].x) * bflo(w[j].x) + bfhi(w[j].x) * bfhi(w[j].x) + bflo(w[j].y) * bflo(w[j].y) + bfhi(w[j].y) * bfhi(w[j].y) + bflo(w[j].z) * bflo(w[j].z) + bfhi(w[j].z) * bfhi(w[j].z) + bflo(w[j].w) * bflo(w[j].w) + bfhi(w[j].w) * bfhi(w[j].w); }
            const float r0 = 1.0f / sqrtf(wave_sum(ssa) * (1.0f / MW) + RMS_EPS), r1 = 1.0f / sqrtf(wave_sum(ssb) * (1.0f / MW) + RMS_EPS);
#pragma unroll
            for (int j = 0; j < 2; ++j) { v4u o;
                o.x = cvt_pk_bf16(bflo(w[j].x) * r0, bfhi(w[j].x) * r0); o.y = cvt_pk_bf16(bflo(w[j].y) * r0, bfhi(w[j].y) * r0); o.z = cvt_pk_bf16(bflo(w[j].z) * r0, bfhi(w[j].z) * r0); o.w = cvt_pk_bf16(bflo(w[j].w) * r0, bfhi(w[j].w) * r0);
                *(v4u*)(OMIX + (size_t)r * DM + j * 512 + lane * 8) = o; }
#pragma unroll
            for (int h = 0; h < NH; ++h) *(unsigned*)(OMIX + (size_t)r * DM + MW + h * 128 + 2 * lane) = cvt_pk_bf16(ob[h][0] * r1, ob[h][1] * r1); }
    }
    SEAM(7);

    if (IN(8)) for (int rep_ = 0; rep_ < REPS(8); ++rep_) { KArgs ka = kargs(); GAS unsigned char* ws = opq(ka->ws);
        pg8::Gemm g{OMIX, WO, DM * 2, DM * 2, DM * 2, 0}; pg8::StaticOrder S; S.init(T, DM, G, bid); pg8::EpiResF32 E{((const float*)(GAS const float*)ka->x), X1P, DM};
        const bool bg_first = ((bid >> 3) & 1) == 0;
        if (bg_first) bg_rounds(ka, ws, BG_P6, BG_P8, gw, NGW, lane_id());
        pg8::gemm_phase<pg8::EpiResF32, pg8::StaticOrder>(L, g, S, E, wave);
        if (!bg_first) bg_rounds(ka, ws, BG_P6, BG_P8, gw, NGW, lane_id());
    }
    SEAM(8);

    if (IN(9)) for (int rep_ = 0; rep_ < REPS(9); ++rep_) { KArgs ka = kargs(); GAS unsigned char* ws = opq(ka->ws); const int lane = lane_id(), tid = wave * 64 + lane, gt = bid * 512 + tid; (void)gt;
        LAS float* part = (LAS float*)L;
        LAS float* lg = (LAS float*)(L + 32768);
        LAS unsigned* lcnt = (LAS unsigned*)(L + 40960);
        if (tid < 64) lcnt[tid] = 0u;
        for (int rg = bid; rg < T / 32; rg += G) { const int R0 = rg * 32;
            for (int rr = 0; rr < 4; ++rr) { const int r = R0 + wave * 4 + rr; f32x4 v[8]; float s = 0.f;
#pragma unroll
                for (int j = 0; j < 8; ++j) { v[j] = *(const f32x4*)(X1P + (size_t)r * DM + j * 256 + lane * 4); s += (v[j][0] + v[j][1]) + (v[j][2] + v[j][3]); }
                const float mean = wave_sum(s) * (1.0f / DM); float q = 0.f;
#pragma unroll
                for (int j = 0; j < 8; ++j) { v[j] = v[j] - mean; q += (v[j][0] * v[j][0] + v[j][1] * v[j][1]) + (v[j][2] * v[j][2] + v[j][3] * v[j][3]); }
                const float rstd = 1.0f / sqrtf(wave_sum(q) * (1.0f / DM) + LN_EPS);
#pragma unroll
                for (int j = 0; j < 8; ++j) { const int c = j * 256 + lane * 4; const f32x4 gg = *(const f32x4*)(((const float*)(GAS const float*)ka->ln1_g) + c), bb = *(const f32x4*)(((const float*)(GAS const float*)ka->ln1_b) + c);
                    const f32x4 y = v[j] * rstd * gg + bb; *(f32x4*)(X1N + (size_t)r * DM + c) = y;
                    *(unsigned*)(X1B + (size_t)r * DM + c) = pk4_fp8(y[0] * SC_X, y[1] * SC_X, y[2] * SC_X, y[3] * SC_X); } }
            VM_WAIT(); __syncthreads();
            { f32x16 acc = f32x16{}; const int hh = lane >> 5, li = lane & 31;
              const float* ap = X1N + (size_t)(R0 + li) * DM + wave * 256 + 4 * hh; const float* bp = ((const float*)(GAS const float*)ka->w_router) + (size_t)(wave * 256 + 4 * hh) * NE + li;
#pragma unroll 4
              for (int kk = 0; kk < 32; ++kk) { const f32x4 av = *(const f32x4*)(ap + kk * 8); const float* b = bp + (size_t)kk * 8 * NE;
                  acc = __builtin_amdgcn_mfma_f32_32x32x2f32(av[0], b[0], acc, 0, 0, 0); acc = __builtin_amdgcn_mfma_f32_32x32x2f32(av[1], b[NE], acc, 0, 0, 0);
                  acc = __builtin_amdgcn_mfma_f32_32x32x2f32(av[2], b[2 * NE], acc, 0, 0, 0); acc = __builtin_amdgcn_mfma_f32_32x32x2f32(av[3], b[3 * NE], acc, 0, 0, 0); }
#pragma unroll
              for (int r = 0; r < 16; ++r) part[(wave * 32 + at::crow(r, hh)) * 32 + li] = acc[r]; }
            __syncthreads();
            for (int i = tid; i < 1024; i += 512) { float s = ((const float*)(GAS const float*)ka->b_router)[i & 31];
#pragma unroll
                for (int w = 0; w < 8; ++w) s += part[w * 1024 + i];
                lg[(i >> 5) * 33 + (i & 31)] = s; }
            __syncthreads();
            if (tid < 32) { float v[32];
#pragma unroll
                for (int e = 0; e < 32; ++e) v[e] = lg[tid * 33 + e];
                float tv[4]; int ti[4];
#pragma unroll
                for (int k = 0; k < 4; ++k) { float best = -__builtin_inff(); int bi = 0;
#pragma unroll
                    for (int e = 0; e < 32; ++e) { if (v[e] > best) { best = v[e]; bi = e; } }
                    tv[k] = best; ti[k] = bi;
#pragma unroll
                    for (int e = 0; e < 32; ++e) if (e == bi) v[e] = -__builtin_inff(); }
                const float e1 = __expf(tv[1] - tv[0]), e2 = __expf(tv[2] - tv[0]), e3 = __expf(tv[3] - tv[0]); const float inv = 1.0f / (1.0f + e1 + e2 + e3);
                const float gk[4] = {inv, e1 * inv, e2 * inv, e3 * inv}; const int r = R0 + tid;
                unsigned lr[4];
#pragma unroll
                for (int k = 0; k < 4; ++k) { lr[k] = __hip_atomic_fetch_add((LAS unsigned*)&lcnt[ti[k]], 1u, __ATOMIC_RELAXED, __HIP_MEMORY_SCOPE_WORKGROUP);
                    TOPE[r * 4 + k] = ti[k]; TOPG[r * 4 + k] = gk[k]; }
                asm volatile("s_waitcnt lgkmcnt(0)" ::: "memory");
                const unsigned mine = lcnt[tid]; const unsigned base = mine ? __hip_atomic_fetch_add((unsigned*)(ctl + CW_COUNT + tid * 64), mine, RLX_AGENT) : 0u;
                lcnt[32 + tid] = base; lcnt[tid] = 0u;
                asm volatile("s_waitcnt lgkmcnt(0)" ::: "memory");
#pragma unroll
                for (int k = 0; k < 4; ++k) TOPR[r * 4 + k] = (int)(lr[k] + lcnt[32 + ti[k]]); }
            __syncthreads();
        }
    }
    SEAM(9);

    if (IN(10)) for (int rep_ = 0; rep_ < REPS(10); ++rep_) { KArgs ka = kargs(); GAS unsigned char* ws = opq(ka->ws); const int lane = lane_id(), tid = wave * 64 + lane, gt = bid * 512 + tid; (void)gt;
        LAS int* ps = (LAS int*)L;
        if (tid == 0) { int acc_ = 0; for (int e = 0; e < NE; ++e) { const int c = (int)__hip_atomic_load((unsigned*)(ctl + CW_COUNT + e * 64), RLX_AGENT); const int p = (c + 255) & ~255; ps[e] = acc_; ps[32 + e] = c; ps[64 + e] = p; acc_ += p; } ps[96] = acc_; }
        __syncthreads();
        if (bid == 0) { if (tid == 0) __hip_atomic_store((unsigned*)(ctl + CW_NRT), (unsigned)(ps[96] >> 8), RLX_AGENT);
            if (tid < NE) { const int e = tid; for (int rt = ps[e] >> 8; rt < (ps[e] + ps[64 + e]) >> 8; ++rt) __hip_atomic_store((unsigned*)(ctl + CW_TILEE + rt), (unsigned)e, RLX_AGENT); } }
        for (int it = gw; it < T * TOPK; it += NGW) { const int t = it >> 2; const int e = TOPE[it], rk = TOPR[it]; const int row = ps[e] + rk;
            const v4u* src = (const v4u*)(X1B + (size_t)t * DM); v4u* dst = (v4u*)(XG + (size_t)row * DM);
#pragma unroll
            for (int j = 0; j < 2; ++j) dst[j * 64 + lane] = src[j * 64 + lane];
            if (lane == 0) { RGATE[row] = TOPG[it]; TOPROW[it] = row; } }
        for (int it = gw; it < NE * 256; it += NGW) { const int e = it >> 8, i = it & 255; const int rk = ps[32 + e] + i;
            if (rk < ps[64 + e]) { const int row = ps[e] + rk; v4u* dst = (v4u*)(XG + (size_t)row * DM);
#pragma unroll
                for (int j = 0; j < 2; ++j) dst[j * 64 + lane] = (v4u){0u, 0u, 0u, 0u};
                if (lane == 0) RGATE[row] = 0.f; } }
        __syncthreads();
    }
    SEAM(10);

    if (IN(11)) for (int rep_ = 0; rep_ < REPS(11); ++rep_) { KArgs ka = kargs(); GAS unsigned char* ws = opq(ka->ws);
        const int n_rt = (int)__builtin_amdgcn_readfirstlane((int)__hip_atomic_load((unsigned*)(ctl + CW_NRT), RLX_AGENT));
        LAS unsigned* te = (LAS unsigned*)(L + LDSCTL_OFF + 64);
        { const int i_ = wave * 64 + lane_id(); if (i_ < MAXRT) te[i_] = i_ < n_rt ? __hip_atomic_load((unsigned*)(ctl + CW_TILEE + i_), RLX_AGENT) : 0u; }
        __syncthreads();
        pg8::Gemm g{XG, WGU, DM, DM, DM, (size_t)2 * DFF * DM}; pg8::MoeOrder S{te, n_rt, 4, G, bid};
        pg8::EpiSwiglu E{ACT, ((const float*)(GAS const float*)ka->b_gate_up)};
        pg8::gemm_phase<pg8::EpiSwiglu, pg8::MoeOrder, true>(L, g, S, E, wave);
    }
    SEAM(11);

    if (IN(12)) for (int rep_ = 0; rep_ < REPS(12); ++rep_) { KArgs ka = kargs(); GAS unsigned char* ws = opq(ka->ws);
        const int n_rt = (int)__builtin_amdgcn_readfirstlane((int)__hip_atomic_load((unsigned*)(ctl + CW_NRT), RLX_AGENT));
        LAS unsigned* te = (LAS unsigned*)(L + LDSCTL_OFF + 64);
        { const int i_ = wave * 64 + lane_id(); if (i_ < MAXRT) te[i_] = i_ < n_rt ? __hip_atomic_load((unsigned*)(ctl + CW_TILEE + i_), RLX_AGENT) : 0u; }
        __syncthreads();
        pg8::Gemm g{ACT, WD, DFF, DFF, DFF, (size_t)DM * DFF}; pg8::MoeOrder S{te, n_rt, 3, G, bid};
        pg8::EpiDown E{YB, ((const float*)(GAS const float*)ka->b_down), RGATE};
        pg8::gemm_phase<pg8::EpiDown, pg8::MoeOrder, true>(L, g, S, E, wave);
    }
    SEAM(12);

    if (IN(13)) for (int rep_ = 0; rep_ < REPS(13); ++rep_) { KArgs ka = kargs(); GAS unsigned char* ws = opq(ka->ws); const int lane = lane_id(), tid = wave * 64 + lane, gt = bid * 512 + tid; (void)gt;
        for (int t = gw; t < T; t += NGW) { int rows[4];
#pragma unroll
            for (int k = 0; k < 4; ++k) rows[k] = TOPROW[t * 4 + k];
            f32x4 v[8]; float s = 0.f;
#pragma unroll
            for (int j = 0; j < 8; ++j) { const int c = j * 256 + lane * 4; f32x4 y = *(const f32x4*)(X1N + (size_t)t * DM + c) * ALPHA;
#pragma unroll
                for (int k = 0; k < 4; ++k) { const v2u w = *(const v2u*)(YB + (size_t)rows[k] * DM + c); y[0] += bflo(w.x); y[1] += bfhi(w.x); y[2] += bflo(w.y); y[3] += bfhi(w.y); }
                v[j] = y; s += (y[0] + y[1]) + (y[2] + y[3]); }
            const float mean = wave_sum(s) * (1.0f / DM); float q = 0.f;
#pragma unroll
            for (int j = 0; j < 8; ++j) { v[j] = v[j] - mean; q += (v[j][0] * v[j][0] + v[j][1] * v[j][1]) + (v[j][2] * v[j][2] + v[j][3] * v[j][3]); }
            const float rstd = 1.0f / sqrtf(wave_sum(q) * (1.0f / DM) + LN_EPS);
#pragma unroll
            for (int j = 0; j < 8; ++j) { const int c = j * 256 + lane * 4; const f32x4 gg = *(const f32x4*)(((const float*)(GAS const float*)ka->ln2_g) + c), bb = *(const f32x4*)(((const float*)(GAS const float*)ka->ln2_b) + c);
                *(f32x4*)(((float*)(GAS float*)ka->out) + (size_t)t * DM + c) = v[j] * rstd * gg + bb; } }
    }
#undef IN
#undef SEAM
}

extern "C" void kernel_launch(void* const* d_in, const int* in_sizes, int n_in, void* d_out, int out_size, void* d_ws, size_t ws_size, hipStream_t stream) {
    static int grid = 0;
    if (grid == 0) {
        if (n_in != 20 || in_sizes[0] != T * DM || out_size != T * DM || ws_size < WS_END) { fprintf(stderr, "kernel_launch: unexpected shapes (n_in %d, in0 %d, out %d, ws %zu < %zu)\n", n_in, n_in > 0 ? in_sizes[0] : -1, out_size, ws_size, (size_t)WS_END); grid = -1; return; }
        int dev = 0, cus = 0, per_cu = 0;
        if (hipGetDevice(&dev) != hipSuccess || hipDeviceGetAttribute(&cus, hipDeviceAttributeMultiprocessorCount, dev) != hipSuccess) { grid = -1; return; }
        if (hipFuncSetAttribute((const void*)fwd, hipFuncAttributeMaxDynamicSharedMemorySize, LDS_BYTES) != hipSuccess) { fprintf(stderr, "kernel_launch: hipFuncSetAttribute failed\n"); grid = -1; return; }
        if (hipOccupancyMaxActiveBlocksPerMultiprocessor(&per_cu, (const void*)fwd, 512, LDS_BYTES) != hipSuccess || per_cu < 1) fprintf(stderr, "kernel_launch: occupancy query says %d\n", per_cu);
        (void)hipGetLastError();
        grid = cus;
    }
    if (grid < 0) return;
    (void)hipMemsetAsync((char*)d_ws + WS_CTL, 0, CTL_ZERO_BYTES, stream);
    Args a{};
    a.x = (const float*)d_in[0]; a.pos = (const int*)d_in[1]; a.w_in = (const float*)d_in[2]; a.g_q_a = (const float*)d_in[3]; a.w_q_b = (const float*)d_in[4];
    a.g_kv_a = (const float*)d_in[5]; a.w_kv_b = (const float*)d_in[6]; a.g_out_mla = (const float*)d_in[7]; a.g_out_moba = (const float*)d_in[8]; a.w_o = (const float*)d_in[9];
    a.ln1_g = (const float*)d_in[10]; a.ln1_b = (const float*)d_in[11]; a.w_router = (const float*)d_in[12]; a.b_router = (const float*)d_in[13];
    a.w_gate_up = (const float*)d_in[14]; a.b_gate_up = (const float*)d_in[15]; a.w_down = (const float*)d_in[16]; a.b_down = (const float*)d_in[17];
    a.ln2_g = (const float*)d_in[18]; a.ln2_b = (const float*)d_in[19];
    a.out = (float*)d_out; a.ws = (unsigned char*)d_ws;
    if (MK_N_LAUNCHES == 1) { a.ph_lo = 0; a.ph_hi = NPHASES; hipLaunchKernelGGL(fwd, dim3(grid), dim3(512), LDS_BYTES, stream, a); }
    else { for (int p = 0; p < NPHASES; ++p) { a.ph_lo = p; a.ph_hi = p + 1; hipLaunchKernelGGL(fwd, dim3(grid), dim3(512), LDS_BYTES, stream, a); } }
    const hipError_t le = hipPeekAtLastError();
    if (le != hipSuccess) fprintf(stderr, "kernel_launch: launch failed: %s\n", hipGetErrorName(le));
}
```

```cpp
#include <hip/hip_runtime.h>
#include <cstdio>
#include <cstdint>

#ifndef PROBE_REP_MASK
#define PROBE_REP_MASK 0
#endif
#ifndef PROBE_DUP
#define PROBE_DUP 0
#endif
#ifndef PROBE_GEMM
#define PROBE_GEMM 0
#endif
#ifndef MOE_REV12
#define MOE_REV12 1
#endif
#ifndef MOE_GATHER
#define MOE_GATHER 1
#endif
#ifndef PROBE_HOT
#define PROBE_HOT 0
#endif
#ifndef PROBE_NRT
#define PROBE_NRT 0
#endif
#ifndef PROBE_TIME_MASK
#define PROBE_TIME_MASK 0
#endif
#ifndef MK_N_LAUNCHES
#define MK_N_LAUNCHES 1
#endif

constexpr int T = 8192, DM = 2048, NH = 8;
constexpr int QLORA = 512, KVLORA = 256, ROPE = 64, NOPE = 128, VH = 128, QKH = NOPE + ROPE;
constexpr int MW = 1024;
constexpr int INC = 3904, INP = 4096;
constexpr int NE = 32, TOPK = 4, DFF = 2048;
constexpr int ECAP = T;
constexpr int MAXROWS = NE * ECAP;
constexpr int MAXRT_TAB = T * TOPK / 256 + NE;
constexpr float ALPHA = 1.189207115002721f;
constexpr float RMS_EPS = 1e-6f, LN_EPS = 1e-5f;

#define GAS __attribute__((address_space(1)))
#define LAS __attribute__((address_space(3)))
typedef unsigned short bf16;
typedef unsigned v4u __attribute__((ext_vector_type(4)));
typedef unsigned v2u __attribute__((ext_vector_type(2)));
typedef float f32x4 __attribute__((ext_vector_type(4)));
typedef float f32x2 __attribute__((ext_vector_type(2)));
typedef float f32x16 __attribute__((ext_vector_type(16)));
typedef short bf16x8 __attribute__((ext_vector_type(8)));
typedef short s16x4 __attribute__((ext_vector_type(4)));
typedef GAS unsigned gu32;
#define RLX_AGENT __ATOMIC_RELAXED, __HIP_MEMORY_SCOPE_AGENT
#define LDS_WAIT() asm volatile("s_waitcnt lgkmcnt(0)" ::: "memory")
#define VM_WAIT() asm volatile("s_waitcnt vmcnt(0)" ::: "memory")
#define SBAR() __builtin_amdgcn_sched_barrier(0)

__device__ __forceinline__ unsigned cvt_pk_bf16(float lo, float hi) { unsigned r; asm volatile("v_cvt_pk_bf16_f32 %0, %1, %2" : "=v"(r) : "v"(lo), "v"(hi)); return r; }
__device__ __forceinline__ float bf2f(unsigned short b) { return __uint_as_float(((unsigned)b) << 16); }
__device__ __forceinline__ float bflo(unsigned w) { return __uint_as_float(w << 16); }
__device__ __forceinline__ float bfhi(unsigned w) { return __uint_as_float(w & 0xffff0000u); }
__device__ __forceinline__ unsigned short f2bf(float f) { return (unsigned short)(cvt_pk_bf16(f, f) & 0xffffu); }
__device__ __forceinline__ unsigned pk4_fp8(float a, float b, float c, float d) { int w = 0; w = __builtin_amdgcn_cvt_pk_fp8_f32(a, b, w, false); w = __builtin_amdgcn_cvt_pk_fp8_f32(c, d, w, true); return (unsigned)w; }
typedef short v2s_t __attribute__((ext_vector_type(2)));
__device__ __forceinline__ unsigned pk4_fp8s(float a, float b, float c, float d, float sc) { v2s_t w = {0, 0}; w = __builtin_amdgcn_cvt_scalef32_pk_fp8_f32(w, a, b, sc, false); w = __builtin_amdgcn_cvt_scalef32_pk_fp8_f32(w, c, d, sc, true); return __builtin_bit_cast(unsigned, w); }
typedef int v4i __attribute__((ext_vector_type(4)));
typedef int v8i __attribute__((ext_vector_type(8)));
__device__ __forceinline__ v8i cat8(bf16x8 a, bf16x8 b) { const v4i x = __builtin_bit_cast(v4i, a), y = __builtin_bit_cast(v4i, b); return __builtin_shufflevector(x, y, 0, 1, 2, 3, 4, 5, 6, 7); }
__device__ __forceinline__ int lane_id() { int l; asm volatile("v_mbcnt_lo_u32_b32 %0, -1, 0\n\tv_mbcnt_hi_u32_b32 %0, -1, %0" : "=v"(l)); return l; }
__device__ __forceinline__ float wave_sum(float v) {
#pragma unroll
    for (int o = 1; o < 64; o <<= 1) v += __shfl_xor(v, o);
    return v;
}

constexpr size_t MiB = 1u << 20;
constexpr size_t WS_CTL = 0, CTL_ZERO_BYTES = 1 * MiB;
constexpr size_t WS_XB    = 2 * MiB;
constexpr size_t WS_WIN   = WS_XB + 32 * MiB;
constexpr size_t WS_WQB   = WS_WIN + 16 * MiB;
constexpr size_t WS_WKVB  = WS_WQB + 2 * MiB;
constexpr size_t WS_WO    = WS_WKVB + 1 * MiB;
constexpr size_t WS_C128  = WS_WO + 8 * MiB;
constexpr size_t WS_S128  = WS_C128 + 2 * MiB;
constexpr size_t WS_C64   = WS_S128 + 2 * MiB;
constexpr size_t WS_S64   = WS_C64 + 1 * MiB;
constexpr size_t WS_HQ    = WS_S64 + 1 * MiB;
constexpr size_t WS_HKV   = WS_HQ + 8 * MiB;
constexpr size_t WS_HR    = WS_HKV + 4 * MiB;
constexpr size_t WS_KPE   = WS_HR + 4 * MiB;
constexpr size_t WS_MQ    = WS_KPE + 1 * MiB;
constexpr size_t WS_MK    = WS_MQ + 16 * MiB;
constexpr size_t WS_MV    = WS_MK + 16 * MiB;
constexpr size_t WS_RSQ   = WS_MV + 16 * MiB;
constexpr size_t WS_RSKV  = WS_RSQ + 1 * MiB;
constexpr size_t WS_QM    = WS_RSKV + 1 * MiB;
constexpr size_t WS_KVM   = WS_QM + 24 * MiB;
constexpr size_t WS_KBAR  = WS_KVM + 32 * MiB;
constexpr size_t WS_SEL   = WS_KBAR + 1 * MiB;
constexpr size_t WS_OMIX  = WS_SEL + 1 * MiB;
constexpr size_t WS_X1P   = WS_OMIX + 32 * MiB;
constexpr size_t WS_X1N   = WS_X1P + 64 * MiB;
constexpr size_t WS_X1B   = WS_X1N + 64 * MiB;
constexpr size_t WS_TOPE  = WS_X1B + 32 * MiB;
constexpr size_t WS_TOPR  = WS_TOPE + 1 * MiB;
constexpr size_t WS_TOPG  = WS_TOPR + 1 * MiB;
constexpr size_t WS_TOPROW= WS_TOPG + 1 * MiB;
constexpr size_t WS_RGATE = WS_TOPROW + 1 * MiB;
constexpr size_t WS_XG    = WS_RGATE + 1 * MiB;
constexpr size_t WS_ACT   = WS_XG + 512 * MiB;
constexpr size_t WS_Y     = WS_ACT + 512 * MiB;
constexpr size_t WS_WGU   = WS_Y + 512 * MiB;
constexpr size_t WS_WD    = WS_WGU + 256 * MiB;
constexpr size_t WS_LIST  = WS_WD + 128 * MiB;
constexpr size_t WS_PO    = WS_LIST + 8 * MiB;
constexpr size_t WS_PL    = WS_PO + 64 * MiB;
constexpr size_t WS_SSP   = WS_PL + 1 * MiB;
constexpr size_t WS_KSP   = WS_SSP + 1 * MiB;
constexpr size_t WS_END   = WS_KSP + 1 * MiB;
constexpr float SC_X = 16.0f, SC_WGU = 512.0f, SC_ACT = 4.0f, SC_WD = 1024.0f, SC_Y = 32.0f;
constexpr int CW_BAR = 4096;
constexpr int CW_COUNT = 65536;
constexpr int CW_TILEE = 16384 + 64;
constexpr int CW_NRT = 16384 + 64 + 192;
constexpr int CW_MCNT = 32768;
constexpr int CW_QHEAD = 20480;

constexpr int LDS_BYTES = 159744;
constexpr int LDSCTL_OFF = 158720;

namespace pg8 {
constexpr int EB_OFF = 131072, EB_CAP = 12, EG_OFF = EB_OFF + EB_CAP * 1024, EG_CAP = 12;
constexpr int BM = 256, BK = 64, HALF = 128, HTB = HALF * BK * 2, STAGE_BYTES = 8 * HTB, NXCD = 8, WGM = 8;
__host__ __device__ __forceinline__ int lds_byte(int r, int c) { const int st = (r >> 4) * 2 + (c >> 5), rr = r & 15, cc = c & 31, ob = rr * 64 + cc * 2; return st * 1024 + (ob ^ (((ob >> 9) & 1) << 5)); }
__host__ __device__ __forceinline__ void stage_rc(int b, int& R, int& C) { const int st = b / 1024, sb = b % 1024, swz = sb ^ (((sb >> 9) & 1) << 5); R = (st >> 1) * 16 + swz / 64; C = (st & 1) * 32 + (swz % 64) / 2; }
__host__ __device__ __forceinline__ int perm32(int rho) { const int n = rho >> 4, i = rho & 15; return 8 * (i >> 2) + 4 * n + (i & 3); }

struct Unit { int pm, pn, e, i; };
struct Gemm { const void* A; const void* Bt; int Kb, lda, ldb; size_t bes; const LAS unsigned* tk; };

struct StaticOrder {
    int nM, nN, nwg, G, c;
    __device__ void init(int M, int N, int G_, int c_) { nM = M / BM; nN = N / BM; nwg = nM * nN; G = G_; c = c_; }
    __device__ bool next(int i, Unit& u) const {
        const long L = (long)i * G + c; if (L >= nwg) return false;
        int wgid = (int)L; { const int q = nwg / NXCD, r = nwg % NXCD, xcd = wgid % NXCD, off = wgid / NXCD; wgid = (xcd < r ? xcd * (q + 1) : r * (q + 1) + (xcd - r) * q) + off; }
        const int nig = WGM * nN, gid = wgid / nig, fm = gid * WGM, gsz = (nM - fm) < WGM ? (nM - fm) : WGM;
        u.pm = fm + ((wgid % nig) % gsz); u.pn = (wgid % nig) / gsz; u.e = 0; u.i = i; return true;
    }
};
struct MoeOrder {
    const LAS unsigned* tile_e; int n_rt, lnpn, G, c;
    __device__ bool next(int i, Unit& u) const {
        const int L = i * G + c; if (L >= (n_rt << lnpn)) return false;
        const int rt = L >> lnpn; u.pn = L - (rt << lnpn);
        const int ent = (int)__builtin_amdgcn_readfirstlane((int)tile_e[rt]); u.e = ent & 255; u.pm = u.e * (ECAP / 256) + (ent >> 8); u.i = i; return true;
    }
};

typedef f32x4 Acc[2][2][4][2];

__device__ __forceinline__ void rope4(const f32x4 v0, const f32x4 v1, const f32x4 c, const f32x4 s, f32x4& o1, f32x4& o2) {
    o1[0] = v0[0] * c[0] - v0[1] * s[0]; o2[0] = v0[1] * c[0] + v0[0] * s[0];
    o1[1] = v0[2] * c[1] - v0[3] * s[1]; o2[1] = v0[3] * c[1] + v0[2] * s[1];
    o1[2] = v1[0] * c[2] - v1[1] * s[2]; o2[2] = v1[1] * c[2] + v1[0] * s[2];
    o1[3] = v1[2] * c[3] - v1[3] * s[3]; o2[3] = v1[3] * c[3] + v1[2] * s[3];
}
__device__ __forceinline__ v2u pk4_bf16(const f32x4 v) { v2u w; w.x = cvt_pk_bf16(v[0], v[1]); w.y = cvt_pk_bf16(v[2], v[3]); return w; }
struct EpiInProj {
    static constexpr bool PERM = true;
    unsigned char* ws;
    __device__ __forceinline__ void operator()(const Acc& acc, const Unit& u, int wr, int wc, int fr, int fq) const {
        const int pn = u.pn; const int row0 = u.pm * BM + wr * 64 + fr, ct0 = wc * 32 + 8 * fq;
        if (pn < 3) {
            bf16* base = (bf16*)(ws + (pn < 2 ? WS_HQ : WS_HKV)); const int ldc = pn < 2 ? 512 : 256, colt = pn == 1 ? 256 : 0;
            float* ss = (float*)(ws + WS_SSP) + (pn < 2 ? pn * 4 + wc : 8 + wc);
#pragma unroll
            for (int ai = 0; ai < 2; ++ai)
#pragma unroll
                for (int m = 0; m < 4; ++m) { const int row = row0 + ai * HALF + m * 16; bf16* rowp = base + (size_t)row * ldc + colt + ct0; float q = 0.f;
#pragma unroll
                    for (int bj = 0; bj < 2; ++bj) { const f32x4 v0 = acc[ai][bj][m][0], v1 = acc[ai][bj][m][1];
                        q += (v0[0] * v0[0] + v0[1] * v0[1]) + (v0[2] * v0[2] + v0[3] * v0[3]) + (v1[0] * v1[0] + v1[1] * v1[1]) + (v1[2] * v1[2] + v1[3] * v1[3]);
                        v4u w; w.x = cvt_pk_bf16(v0[0], v0[1]); w.y = cvt_pk_bf16(v0[2], v0[3]); w.z = cvt_pk_bf16(v1[0], v1[1]); w.w = cvt_pk_bf16(v1[2], v1[3]);
                        *(v4u*)(rowp + bj * HALF) = w; }
                    q += __shfl_xor(q, 16); q += __shfl_xor(q, 32);
                    if (fq == 0) ss[(size_t)row * 16] = q; }
        } else if (pn == 3) {
            if (ct0 < 64) { bf16* KPEp = (bf16*)(ws + WS_KPE); const float* C = (const float*)(ws + WS_C64); const float* S = (const float*)(ws + WS_S64); const int i0 = ct0 >> 1;
                f32x4 cc[2][4], sc[2][4];
#pragma unroll
                for (int ai = 0; ai < 2; ++ai)
#pragma unroll
                    for (int m = 0; m < 4; ++m) { const int row = row0 + ai * HALF + m * 16; cc[ai][m] = *(const f32x4*)(C + row * 32 + i0); sc[ai][m] = *(const f32x4*)(S + row * 32 + i0); }
#pragma unroll
                for (int ai = 0; ai < 2; ++ai)
#pragma unroll
                    for (int m = 0; m < 4; ++m) { const int row = row0 + ai * HALF + m * 16; f32x4 o1, o2;
                        rope4(acc[ai][0][m][0], acc[ai][0][m][1], cc[ai][m], sc[ai][m], o1, o2);
                        *(v2u*)(KPEp + (size_t)row * ROPE + i0) = pk4_bf16(o1); *(v2u*)(KPEp + (size_t)row * ROPE + 32 + i0) = pk4_bf16(o2); } }
        } else if (pn < 8) {
            bf16* base = (bf16*)(ws + WS_MQ); const float* C = (const float*)(ws + WS_C128); const float* S = (const float*)(ws + WS_S128);
            const int i0 = ct0 >> 1, hd0 = ((pn - 4) & 3) * 2;
            f32x4 cc[2][4], sc[2][4];
#pragma unroll
            for (int ai = 0; ai < 2; ++ai)
#pragma unroll
                for (int m = 0; m < 4; ++m) { const int row = row0 + ai * HALF + m * 16; cc[ai][m] = *(const f32x4*)(C + row * 64 + i0); sc[ai][m] = *(const f32x4*)(S + row * 64 + i0); }
            asm volatile("" ::: "memory");
#pragma unroll
            for (int ai = 0; ai < 2; ++ai)
#pragma unroll
                for (int m = 0; m < 4; ++m) { const int row = row0 + ai * HALF + m * 16; const f32x4 c = cc[ai][m], sn = sc[ai][m];
#pragma unroll
                    for (int bj = 0; bj < 2; ++bj) { f32x4 o1, o2; rope4(acc[ai][bj][m][0], acc[ai][bj][m][1], c, sn, o1, o2);
                        bf16* hp = base + (size_t)row * MW + (hd0 + bj) * 128;
                        *(v2u*)(hp + i0) = pk4_bf16(o1); *(v2u*)(hp + 64 + i0) = pk4_bf16(o2); }
                    asm volatile("" ::: "memory"); }
        } else if (pn < 12) {
            bf16* base = (bf16*)(ws + WS_MK); const float* C = (const float*)(ws + WS_C128); const float* S = (const float*)(ws + WS_S128);
            const int i0 = ct0 >> 1, hd0 = ((pn - 8) & 3) * 2;
            f32x4 cs1[2], cs2[2];
#pragma unroll
            for (int bj = 0; bj < 2; ++bj) { cs1[bj] = (f32x4){0.f, 0.f, 0.f, 0.f}; cs2[bj] = (f32x4){0.f, 0.f, 0.f, 0.f}; }
            f32x4 cc[2][4], sc[2][4];
#pragma unroll
            for (int ai = 0; ai < 2; ++ai)
#pragma unroll
                for (int m = 0; m < 4; ++m) { const int row = row0 + ai * HALF + m * 16; cc[ai][m] = *(const f32x4*)(C + row * 64 + i0); sc[ai][m] = *(const f32x4*)(S + row * 64 + i0); }
            asm volatile("" ::: "memory");
#pragma unroll
            for (int ai = 0; ai < 2; ++ai)
#pragma unroll
                for (int m = 0; m < 4; ++m) { const int row = row0 + ai * HALF + m * 16; const f32x4 c = cc[ai][m], sn = sc[ai][m];
#pragma unroll
                    for (int bj = 0; bj < 2; ++bj) { f32x4 o1, o2; rope4(acc[ai][bj][m][0], acc[ai][bj][m][1], c, sn, o1, o2);
                        bf16* hp = base + (size_t)row * MW + (hd0 + bj) * 128;
                        *(v2u*)(hp + i0) = pk4_bf16(o1); *(v2u*)(hp + 64 + i0) = pk4_bf16(o2);
                        cs1[bj] += o1; cs2[bj] += o2; asm volatile("" : "+v"(cs1[bj]), "+v"(cs2[bj])); }
                    asm volatile("" ::: "memory"); }
            float* ks = (float*)(ws + WS_KSP) + wr * (NH * 32 * 128);
#pragma unroll
            for (int bj = 0; bj < 2; ++bj)
#pragma unroll
                for (int k = 0; k < 4; ++k) { float a = cs1[bj][k], b = cs2[bj][k];
#pragma unroll
                    for (int off = 1; off < 16; off <<= 1) { a += __shfl_xor(a, off); b += __shfl_xor(b, off); }
                    if (fr == 0) { float* kp = ks + ((hd0 + bj) * 32 + u.pm) * 128 + i0 + k; kp[0] = a; kp[64] = b; } }
        } else {
            bf16* base = (bf16*)(ws + WS_MV); const int colt = (pn - 12) * 256;
#pragma unroll
            for (int ai = 0; ai < 2; ++ai)
#pragma unroll
                for (int m = 0; m < 4; ++m) { bf16* rowp = base + (size_t)(row0 + ai * HALF + m * 16) * MW + colt + ct0;
#pragma unroll
                    for (int bj = 0; bj < 2; ++bj) { const f32x4 v0 = acc[ai][bj][m][0], v1 = acc[ai][bj][m][1];
                        v4u w; w.x = cvt_pk_bf16(v0[0], v0[1]); w.y = cvt_pk_bf16(v0[2], v0[3]); w.z = cvt_pk_bf16(v1[0], v1[1]); w.w = cvt_pk_bf16(v1[2], v1[3]);
                        *(v4u*)(rowp + bj * HALF) = w; } }
        }
    }
};
template <bool QROPE> struct EpiRowScale {
    static constexpr bool PERM = true;
    bf16* O; int ldc; const float* ss; float inv_k; const float* C; const float* S;
    __device__ __forceinline__ void operator()(const Acc& acc, const Unit& u, int wr, int wc, int fr, int fq) const {
        const int row0 = u.pm * BM + wr * 64 + fr, col0 = u.pn * BM + wc * 32 + 8 * fq;
        float scs[2][4];
#pragma unroll
        for (int ai = 0; ai < 2; ++ai)
#pragma unroll
            for (int m = 0; m < 4; ++m) { const int row = row0 + ai * HALF + m * 16; float sq; { const f32x4 p0 = *(const f32x4*)(ss + (size_t)row * 16); sq = (p0[0] + p0[1]) + (p0[2] + p0[3]); if (QROPE) { const f32x4 p1 = *(const f32x4*)(ss + (size_t)row * 16 + 4); sq += (p1[0] + p1[1]) + (p1[2] + p1[3]); } }
                scs[ai][m] = 1.0f / sqrtf(sq * inv_k + RMS_EPS); }
        asm volatile("" ::: "memory");
        const int w0_ = col0 % QKH, w1_ = (col0 + HALF) % QKH; const bool rl = QROPE && (w0_ >= NOPE || w1_ >= NOPE); const int ir = ((w0_ >= NOPE ? w0_ : w1_) - NOPE) >> 1;
#pragma unroll
        for (int am = 0; am < 4; ++am) { const int ai = am >> 1;
            f32x4 cc[4], sn[4];
            if (rl) {
#pragma unroll
                for (int m = (am & 1) * 2; m < (am & 1) * 2 + 2; ++m) { const int row = row0 + ai * HALF + m * 16; cc[m] = *(const f32x4*)(C + row * 32 + ir); sn[m] = *(const f32x4*)(S + row * 32 + ir); }
            }
#pragma unroll
            for (int m = (am & 1) * 2; m < (am & 1) * 2 + 2; ++m) { const int row = row0 + ai * HALF + m * 16; const float sc = scs[ai][m]; bf16* rowp = O + (size_t)row * ldc;
#pragma unroll
                for (int bj = 0; bj < 2; ++bj) { const int col = col0 + bj * HALF; const f32x4 v0 = acc[ai][bj][m][0] * sc, v1 = acc[ai][bj][m][1] * sc;
                    const int hd = col / QKH, w = col - hd * QKH;
                    if (QROPE && w >= NOPE) { const int i0 = (w - NOPE) >> 1; f32x4 o1, o2; rope4(v0, v1, cc[m], sn[m], o1, o2);
                        *(v2u*)(rowp + hd * QKH + NOPE + i0) = pk4_bf16(o1); *(v2u*)(rowp + hd * QKH + NOPE + 32 + i0) = pk4_bf16(o2); }
                    else { v4u wv; wv.x = cvt_pk_bf16(v0[0], v0[1]); wv.y = cvt_pk_bf16(v0[2], v0[3]); wv.z = cvt_pk_bf16(v1[0], v1[1]); wv.w = cvt_pk_bf16(v1[2], v1[3]);
                        *(v4u*)(rowp + col) = wv; } } } }
    }
};
struct EpiResBf16 {
    static constexpr bool PERM = true;
    const bf16* X; bf16* O; int ldc;
    __device__ __forceinline__ void operator()(const Acc& acc, const Unit& u, int wr, int wc, int fr, int fq) const {
        const int row0 = u.pm * BM + wr * 64 + fr, col0 = u.pn * BM + wc * 32 + 8 * fq;
        v4u xr[2][4][2];
#pragma unroll
        for (int ai = 0; ai < 2; ++ai)
#pragma unroll
            for (int m = 0; m < 4; ++m) { const size_t off = (size_t)(row0 + ai * HALF + m * 16) * ldc + col0;
#pragma unroll
                for (int bj = 0; bj < 2; ++bj) xr[ai][m][bj] = *(const v4u*)(X + off + bj * HALF); }
        asm volatile("" ::: "memory");
#pragma unroll
        for (int ai = 0; ai < 2; ++ai)
#pragma unroll
            for (int m = 0; m < 4; ++m) { const size_t off = (size_t)(row0 + ai * HALF + m * 16) * ldc + col0;
#pragma unroll
                for (int bj = 0; bj < 2; ++bj) { const v4u xv = xr[ai][m][bj]; const f32x4 v0 = acc[ai][bj][m][0], v1 = acc[ai][bj][m][1];
                    v4u w; w.x = cvt_pk_bf16(bflo(xv.x) * ALPHA + v0[0], bfhi(xv.x) * ALPHA + v0[1]); w.y = cvt_pk_bf16(bflo(xv.y) * ALPHA + v0[2], bfhi(xv.y) * ALPHA + v0[3]);
                    w.z = cvt_pk_bf16(bflo(xv.z) * ALPHA + v1[0], bfhi(xv.z) * ALPHA + v1[1]); w.w = cvt_pk_bf16(bflo(xv.w) * ALPHA + v1[2], bfhi(xv.w) * ALPHA + v1[3]);
                    *(v4u*)(O + off + bj * HALF) = w; }
                asm volatile("" ::: "memory"); }
    }
};
struct EpiSwiglu {
    static constexpr bool PERM = true;
    unsigned char* ACT; const LAS float* eb;
    __device__ __forceinline__ void operator()(const Acc& acc, const Unit& u, int wr, int wc, int fr, int fq) const {
        const int row0 = u.pm * BM + wr * 64 + fr, j0 = u.pn * HALF + wc * 32 + 8 * fq;
        const LAS float* bg = eb + (u.i < EB_CAP ? u.i : EB_CAP - 1) * 256 + wc * 32 + 8 * fq; const LAS float* bu = bg + HALF;
        const f32x4 bg0 = *(const LAS f32x4*)bg, bg1 = *(const LAS f32x4*)(bg + 4), bu0 = *(const LAS f32x4*)bu, bu1 = *(const LAS f32x4*)(bu + 4);
        f32x2 ks = {1.0f / (SC_X * SC_WGU), 1.0f / (SC_X * SC_WGU)}, kc = {-1.702f * 1.4426950408889634f, -1.702f * 1.4426950408889634f}, one = {1.0f, 1.0f}, sa = {SC_ACT, SC_ACT};
        asm volatile("" : "+s"(ks), "+s"(kc), "+s"(one), "+s"(sa));
#pragma unroll
        for (int ai = 0; ai < 2; ++ai)
#pragma unroll
            for (int m = 0; m < 4; ++m) { unsigned char* rowp = ACT + (size_t)(row0 + ai * HALF + m * 16) * DFF + j0;
                f32x2 a[4];
#pragma unroll
                for (int n = 0; n < 2; ++n) { const f32x4 ag = acc[ai][0][m][n], au = acc[ai][1][m][n], bgv = n ? bg1 : bg0, buv = n ? bu1 : bu0;
#pragma unroll
                    for (int p = 0; p < 2; ++p) { const f32x2 gv = (f32x2){ag[2 * p], ag[2 * p + 1]} * ks + (f32x2){bgv[2 * p], bgv[2 * p + 1]}, uv = (f32x2){au[2 * p], au[2 * p + 1]} * ks + (f32x2){buv[2 * p], buv[2 * p + 1]};
                        const f32x2 g = {fminf(gv[0], 7.0f), fminf(gv[1], 7.0f)}, uu = {fminf(fmaxf(uv[0], -7.0f), 7.0f), fminf(fmaxf(uv[1], -7.0f), 7.0f)};
                        const f32x2 t = g * kc; const f32x2 d = (f32x2){__builtin_amdgcn_exp2f(t[0]), __builtin_amdgcn_exp2f(t[1])} + one;
                        const f32x2 sg = {__builtin_amdgcn_rcpf(d[0]), __builtin_amdgcn_rcpf(d[1])};
                        a[n * 2 + p] = (uu * sa + sa) * g * sg; } }
                v2u w; w.x = pk4_fp8(a[0][0], a[0][1], a[1][0], a[1][1]); w.y = pk4_fp8(a[2][0], a[2][1], a[3][0], a[3][1]);
                *(v2u*)rowp = w; }
    }
};
struct EpiDown {
    static constexpr bool PERM = true;
    unsigned char* Y; const LAS float* eb; const LAS float* eg;
    __device__ __forceinline__ void operator()(const Acc& acc, const Unit& u, int wr, int wc, int fr, int fq) const {
        const int row0 = u.pm * BM + wr * 64 + fr, col0 = u.pn * BM + wc * 32 + 8 * fq;
        const int sl = (u.i < EG_CAP ? u.i : EG_CAP - 1) * 256;
        const LAS float* bp = eb + sl + wc * 32 + 8 * fq;
        f32x4 bv[2][2];
#pragma unroll
        for (int bj = 0; bj < 2; ++bj)
#pragma unroll
            for (int n = 0; n < 2; ++n) bv[bj][n] = *(const LAS f32x4*)(bp + bj * HALF + 4 * n);
        float rg[2][4];
#pragma unroll
        for (int ai = 0; ai < 2; ++ai)
#pragma unroll
            for (int m = 0; m < 4; ++m) rg[ai][m] = eg[sl + wr * 64 + fr + ai * HALF + m * 16];
#pragma unroll
        for (int ai = 0; ai < 2; ++ai)
#pragma unroll
            for (int m = 0; m < 4; ++m) { const int row = row0 + ai * HALF + m * 16; const float s = rg[ai][m] * SC_Y; unsigned char* rowp = Y + (size_t)row * DM + col0;
#pragma unroll
                for (int bj = 0; bj < 2; ++bj) { const f32x4 v0 = (acc[ai][bj][m][0] * (1.0f / (SC_ACT * SC_WD)) + bv[bj][0]) * s, v1 = (acc[ai][bj][m][1] * (1.0f / (SC_ACT * SC_WD)) + bv[bj][1]) * s;
                    v2u w; w.x = pk4_fp8(v0[0], v0[1], v0[2], v0[3]); w.y = pk4_fp8(v1[0], v1[1], v1[2], v1[3]);
                    *(v2u*)(rowp + bj * HALF) = w; } }
    }
};

template <class Epi, class Sched, bool F8 = false, bool ALIGN_EPI = true, bool SP2 = true, int PM = 0, bool GA = false>
__device__ __forceinline__ void gemm_phase(LAS unsigned char* lds, const Gemm g, const Sched& S, const Epi& E, const int wid  , unsigned long long& pacc  ) {
    const int lane = lane_id(), tid = wid * 64 + lane, wr = wid >> 2, wc = wid & 3, fr = lane & 15, fq = lane >> 4;
    const int nt = g.Kb / 128;
    const __amdgpu_buffer_rsrc_t rA = __builtin_amdgcn_make_buffer_rsrc((void*)g.A, 0, -1, 0x00020000);
    const __amdgpu_buffer_rsrc_t rB = __builtin_amdgcn_make_buffer_rsrc((void*)g.Bt, 0, -1, 0x00020000);
    unsigned voffA, voffB;
    int Rrow;
    { int R, C; stage_rc(tid * 16, R, C); const int Rb = Epi::PERM ? ((R & ~31) + perm32(R & 31)) : R; Rrow = R;
        voffA = GA ? (unsigned)(C * 2) : (unsigned)(R * g.lda + C * 2); voffB = (unsigned)(Rb * g.ldb + C * 2); }
    const unsigned dA = 64u * (unsigned)g.lda, dB = 64u * (unsigned)g.ldb;
    const unsigned kstep = 128u;
    const unsigned hstepA = (unsigned)HALF * g.lda, hstepB = (unsigned)HALF * g.ldb;
    const unsigned tstepA = 2 * hstepA, tstepB = 2 * hstepB;
    const unsigned ldsw = (unsigned)wid * 1024u;
    const int aoff = lds_byte(wr * 64 + fr, fq * 8), boff = lds_byte(wc * 32 + fr, fq * 8);
#define PG8_SA(b, h) (((b) * 2 + (h)) * HTB)
#define PG8_SB(b, h) ((4 + (b) * 2 + (h)) * HTB)
#define PG8_STAGE(bufoff, rsrc, soff, voff) do { _Pragma("unroll") for (int _i = 0; _i < 2; ++_i) \
        __builtin_amdgcn_raw_ptr_buffer_load_lds(rsrc, (LAS unsigned*)(lds + (bufoff) + ldsw + _i * 8192), 16, (voff), (soff) + _i * (&(voff) == &voffA ? dA : dB), 0, 0); } while (0)
#define PG8_STGA(b, h, soff_full, koff, slot) do { if constexpr (GA) { _Pragma("unroll") for (int _i = 0; _i < 2; ++_i) { const unsigned o_ = g.tk[(slot) + Rrow + 64 * _i + 128 * (h)]; \
        __builtin_amdgcn_raw_ptr_buffer_load_lds(rA, (LAS unsigned*)(lds + PG8_SA(b, h) + ldsw + _i * 8192), 16, o_ + voffA, (koff), 0, 0); } } else PG8_STAGE(PG8_SA(b, h), rA, (soff_full), voffA); } while (0)
    LAS unsigned char* ldsA = lds + aoff; LAS unsigned char* ldsB = lds + 4 * HTB + boff; asm volatile("" : "+v"(ldsA), "+v"(ldsB));
#define PG8_LDA(dst, b, h) do { _Pragma("unroll") for (int m = 0; m < 4; ++m) _Pragma("unroll") for (int k = 0; k < 2; ++k) dst[m][k] = *(const LAS bf16x8*)(ldsA + PG8_SA(b, h) + m * 2048 + k * 1024); } while (0)
#define PG8_LDB(dst, b, h) do { _Pragma("unroll") for (int n = 0; n < 2; ++n) _Pragma("unroll") for (int k = 0; k < 2; ++k) dst[n][k] = *(const LAS bf16x8*)(ldsB + (PG8_SB(b, h) - 4 * HTB) + n * 2048 + k * 1024); } while (0)
#define PG8_MMA(ai, bj, At, Bt) do { __builtin_amdgcn_s_setprio(1); if constexpr (F8) { _Pragma("unroll") for (int m = 0; m < 4; ++m) _Pragma("unroll") for (int n = 0; n < 2; ++n) \
        acc[ai][bj][m][n] = __builtin_amdgcn_mfma_scale_f32_16x16x128_f8f6f4(cat8(Bt[n][0], Bt[n][1]), cat8(At[m][0], At[m][1]), acc[ai][bj][m][n], 0, 0, 0, 0, 0, 0); } \
        else { _Pragma("unroll") for (int m = 0; m < 4; ++m) _Pragma("unroll") for (int n = 0; n < 2; ++n) _Pragma("unroll") for (int k = 0; k < 2; ++k) \
        acc[ai][bj][m][n] = __builtin_amdgcn_mfma_f32_16x16x32_bf16(Bt[n][k], At[m][k], acc[ai][bj][m][n], 0, 0, 0); } __builtin_amdgcn_s_setprio(0); } while (0)
#define PG8_WAIT_V(n) asm volatile("s_waitcnt vmcnt(" #n ")" ::: "memory")
#define PG8_WAIT_L(n) asm volatile("s_waitcnt lgkmcnt(" #n ")" ::: "memory")
#define PG8_BAR __builtin_amdgcn_s_barrier()
#define PG8_SCHED __builtin_amdgcn_sched_barrier(0)
    Unit cur, nxt; int ui = 0;
    if (!S.next(0, cur)) return;
    Acc acc;
#pragma unroll
    for (int a = 0; a < 2; ++a)
#pragma unroll
        for (int b = 0; b < 2; ++b)
#pragma unroll
            for (int m = 0; m < 4; ++m)
#pragma unroll
                for (int n = 0; n < 2; ++n) acc[a][b][m][n] = (f32x4){0.f, 0.f, 0.f, 0.f};
    bf16x8 At[4][2], B0[2][2], B1[2][2];
    unsigned cA = (unsigned)cur.pm * tstepA, cB = (unsigned)((size_t)cur.e * g.bes) + (unsigned)cur.pn * tstepB;
    static_assert(!GA || SP2, "gathered A rows: SP2 schedule only");
    int sA = GA ? cur.i * 256 : 0, snA = 0;
    if constexpr (SP2) {
        PG8_STAGE(PG8_SB(0, 0), rB, cB, voffB); PG8_STAGE(PG8_SB(0, 1), rB, cB + hstepB, voffB); PG8_STGA(0, 0, cA, 0u, sA); PG8_STGA(0, 1, cA + hstepA, 0u, sA);
        if (wr == 1) PG8_BAR;
        PG8_WAIT_V(2); PG8_BAR;
        PG8_STAGE(PG8_SB(1, 0), rB, cB + kstep, voffB); PG8_STGA(1, 0, cA + kstep, kstep, sA); PG8_STAGE(PG8_SB(1, 1), rB, cB + hstepB + kstep, voffB);
        PG8_WAIT_V(6); PG8_BAR;
    } else {
        PG8_STAGE(PG8_SB(0, 0), rB, cB, voffB); PG8_STAGE(PG8_SA(0, 0), rA, cA, voffA); PG8_STAGE(PG8_SB(0, 1), rB, cB + hstepB, voffB); PG8_STAGE(PG8_SA(0, 1), rA, cA + hstepA, voffA);
        if (wr == 1) PG8_BAR;
        PG8_WAIT_V(4); PG8_BAR;
        PG8_STAGE(PG8_SB(1, 0), rB, cB + kstep, voffB); PG8_STAGE(PG8_SA(1, 0), rA, cA + kstep, voffA); PG8_STAGE(PG8_SB(1, 1), rB, cB + hstepB + kstep, voffB);
        PG8_WAIT_V(6); PG8_BAR;
    }
    for (;;) {
        unsigned long long tq0 = 0, tq1 = 0; if constexpr (PM != 0) tq0 = __builtin_amdgcn_s_memrealtime();
        const bool has_next = S.next(ui + 1, nxt);
        if constexpr (GA) snA = has_next ? nxt.i * 256 : sA;
        const unsigned nA = has_next ? (unsigned)nxt.pm * tstepA : cA; const unsigned nB = has_next ? (unsigned)((size_t)nxt.e * g.bes) + (unsigned)nxt.pn * tstepB : cB;
        for (int t = 0; t < nt; t += 2) {
            const bool last = (t == nt - 2);
            const unsigned a1 = cA + (unsigned)(t + 1) * kstep;
            const unsigned a2 = last ? nA : cA + (unsigned)(t + 2) * kstep; const unsigned b2 = last ? nB : cB + (unsigned)(t + 2) * kstep;
            const unsigned a3 = a2 + kstep; const unsigned b3 = b2 + kstep;
            const unsigned k1 = (unsigned)(t + 1) * kstep, k2 = last ? 0u : (unsigned)(t + 2) * kstep, k3 = k2 + kstep; const int sl2 = last ? snA : sA;
            if constexpr (SP2) {
            PG8_LDB(B0, 0, 0); PG8_LDB(B1, 0, 1); PG8_SCHED; PG8_LDA(At, 0, 0); PG8_STGA(1, 1, a1 + hstepA, k1, sA);
            PG8_WAIT_V(8); PG8_WAIT_L(0); PG8_BAR; PG8_MMA(0, 0, At, B0); PG8_MMA(0, 1, At, B1); PG8_BAR; PG8_SCHED;
            PG8_LDA(At, 0, 1); PG8_STAGE(PG8_SB(0, 0), rB, b2, voffB); PG8_STAGE(PG8_SB(0, 1), rB, b2 + hstepB, voffB); PG8_STGA(0, 0, a2, k2, sl2);
            PG8_WAIT_V(8); PG8_WAIT_L(0); PG8_BAR; PG8_MMA(1, 0, At, B0); PG8_MMA(1, 1, At, B1); PG8_BAR; PG8_SCHED;
            PG8_LDB(B0, 1, 0); PG8_LDB(B1, 1, 1); PG8_SCHED; PG8_LDA(At, 1, 0); PG8_STGA(0, 1, a2 + hstepA, k2, sl2);
            PG8_WAIT_V(8); PG8_WAIT_L(0); PG8_BAR; PG8_MMA(0, 0, At, B0); PG8_MMA(0, 1, At, B1); PG8_BAR; PG8_SCHED;
            PG8_LDA(At, 1, 1); PG8_STAGE(PG8_SB(1, 0), rB, b3, voffB); PG8_STAGE(PG8_SB(1, 1), rB, b3 + hstepB, voffB); PG8_STGA(1, 0, a3, k3, sl2);
            PG8_WAIT_V(8); PG8_WAIT_L(0); PG8_BAR; PG8_MMA(1, 0, At, B0); PG8_MMA(1, 1, At, B1); PG8_BAR; PG8_SCHED;
            } else {
            PG8_LDB(B0, 0, 0); PG8_SCHED; PG8_LDA(At, 0, 0); PG8_STAGE(PG8_SA(1, 1), rA, a1 + hstepA, voffA);
            PG8_WAIT_L(8); PG8_BAR; PG8_WAIT_L(0); PG8_MMA(0, 0, At, B0); PG8_BAR; PG8_SCHED;
            PG8_LDB(B1, 0, 1); PG8_STAGE(PG8_SB(0, 0), rB, b2, voffB);
            PG8_BAR; PG8_WAIT_L(0); PG8_MMA(0, 1, At, B1); PG8_BAR;
            PG8_LDA(At, 0, 1); PG8_STAGE(PG8_SA(0, 0), rA, a2, voffA);
            PG8_BAR; PG8_WAIT_L(0); PG8_MMA(1, 0, At, B0); PG8_BAR; PG8_SCHED;
            PG8_STAGE(PG8_SB(0, 1), rB, b2 + hstepB, voffB);
            PG8_WAIT_V(6); PG8_BAR; PG8_MMA(1, 1, At, B1); PG8_BAR;
            PG8_LDB(B0, 1, 0); PG8_SCHED; PG8_LDA(At, 1, 0); PG8_STAGE(PG8_SA(0, 1), rA, a2 + hstepA, voffA);
            PG8_WAIT_L(8); PG8_BAR; PG8_WAIT_L(0); PG8_MMA(0, 0, At, B0); PG8_BAR; PG8_SCHED;
            PG8_LDB(B1, 1, 1); PG8_STAGE(PG8_SB(1, 0), rB, b3, voffB);
            PG8_BAR; PG8_WAIT_L(0); PG8_MMA(0, 1, At, B1); PG8_BAR;
            PG8_LDA(At, 1, 1); PG8_STAGE(PG8_SA(1, 0), rA, a3, voffA);
            PG8_BAR; PG8_WAIT_L(0); PG8_MMA(1, 0, At, B0); PG8_BAR; PG8_SCHED;
            PG8_STAGE(PG8_SB(1, 1), rB, b3 + hstepB, voffB);
            PG8_WAIT_V(6); PG8_BAR; PG8_MMA(1, 1, At, B1); PG8_BAR;
            }
        }
        if constexpr (ALIGN_EPI) { if (wr == 0) PG8_BAR; }
        if constexpr (PM != 0) tq1 = __builtin_amdgcn_s_memrealtime();
        { const int l2 = lane_id(); E(acc, cur, wr, wc, l2 & 15, l2 >> 4); }
        if constexpr (PM != 0) { const unsigned long long tq2 = __builtin_amdgcn_s_memrealtime(); if (PM == 1) pacc += tq1 - tq0; else if (PM == 2) pacc += tq2 - tq1; else if (PM == 3 && ui == 0) pacc += tq2 - tq0; else if (PM == 4 && ui == 1) pacc += tq2 - tq0; }
        if (!has_next) break;
#pragma unroll
        for (int a = 0; a < 2; ++a)
#pragma unroll
            for (int b = 0; b < 2; ++b)
#pragma unroll
                for (int m = 0; m < 4; ++m)
#pragma unroll
                    for (int n = 0; n < 2; ++n) acc[a][b][m][n] = (f32x4){0.f, 0.f, 0.f, 0.f};
        cur = nxt; cA = nA; cB = nB; sA = snA; ++ui;
        if constexpr (ALIGN_EPI) { if (wr == 1) PG8_BAR; }
    }
    PG8_WAIT_V(0);
    if constexpr (!ALIGN_EPI) { if (wr == 0) PG8_BAR; }
    PG8_BAR;
#undef PG8_STGA
#undef PG8_SA
#undef PG8_SB
#undef PG8_STAGE
#undef PG8_LDA
#undef PG8_LDB
#undef PG8_MMA
#undef PG8_WAIT_V
#undef PG8_WAIT_L
#undef PG8_BAR
#undef PG8_SCHED
}
}

namespace at {
constexpr int SHM_V = 16384, SHM_K = 16384, SHM_K2 = 8192;
constexpr int OFF_V = 0, OFF_K = 2 * SHM_V, OFF_K2 = OFF_K + 2 * SHM_K, OFF_WS = OFF_K2 + 2 * SHM_K2, ATTN_LDS = OFF_WS + 8 * 64 * 4;
#define KSWZ(row, colB) ((row) * 256 + ((colB) ^ (((row) & 7) << 4)))
#define KSW4(row, chunk) ((row) * 256 + (((chunk) ^ (((row) & 7) | ((((row) >> 4) & 1) << 3))) << 4))
#define K2SWZ(row, colB) ((row) * 128 + ((colB) ^ ((((row) >> 1) & 7) << 4)))
__device__ __forceinline__ int v_st(int k, int c) { const int kk = (k & ~0xC) | ((k & 4) << 1) | ((k & 8) >> 1); return ((kk >> 3) * 4 + (c >> 5)) * 512 + ((kk & 7) * 32 + (c & 31)) * 2; }
__device__ __forceinline__ int v_rd_base(int lane) { return ((lane & 3) << 3) | (((lane >> 2) & 3) << 6) | (((lane >> 4) & 1) << 5) | (((lane >> 5) & 1) << 8); }
constexpr int v_rd_off(int d0, int ks, int half) { return d0 * 512 + ks * 4096 + half * 2048; }
__device__ __forceinline__ int crow(int r, int hi) { return (r & 3) + 8 * (r >> 2) + 4 * hi; }

template <int VB>
__device__ __forceinline__ void pv_tile(f32x16* o, int vb0, bf16x8 pa0, bf16x8 pa1, bf16x8 pa2, bf16x8 pa3) {
#define TRRD(dst, off) asm volatile("ds_read_b64_tr_b16 %0, %1 offset:%2" : "=&v"(dst) : "v"(vb0), "i"(off) : "memory")
#define PV_D0(d0) do { s16x4 l0, l1, l2, l3, h0, h1, h2, h3; constexpr int b_ = VB * SHM_V + v_rd_off(d0, 0, 0); \
        TRRD(l0, b_); TRRD(h0, b_ + 2048); TRRD(l1, b_ + 4096); TRRD(h1, b_ + 6144); TRRD(l2, b_ + 8192); TRRD(h2, b_ + 10240); TRRD(l3, b_ + 12288); TRRD(h3, b_ + 14336); \
        asm volatile("s_waitcnt lgkmcnt(0)" ::: "memory"); SBAR(); \
        o[d0] = __builtin_amdgcn_mfma_f32_32x32x16_bf16(pa0, (bf16x8){l0[0], l0[1], l0[2], l0[3], h0[0], h0[1], h0[2], h0[3]}, o[d0], 0, 0, 0); \
        o[d0] = __builtin_amdgcn_mfma_f32_32x32x16_bf16(pa1, (bf16x8){l1[0], l1[1], l1[2], l1[3], h1[0], h1[1], h1[2], h1[3]}, o[d0], 0, 0, 0); \
        o[d0] = __builtin_amdgcn_mfma_f32_32x32x16_bf16(pa2, (bf16x8){l2[0], l2[1], l2[2], l2[3], h2[0], h2[1], h2[2], h2[3]}, o[d0], 0, 0, 0); \
        o[d0] = __builtin_amdgcn_mfma_f32_32x32x16_bf16(pa3, (bf16x8){l3[0], l3[1], l3[2], l3[3], h3[0], h3[1], h3[2], h3[3]}, o[d0], 0, 0, 0); } while (0)
    PV_D0(0); PV_D0(1); PV_D0(2); PV_D0(3);
#undef PV_D0
#undef TRRD
}

constexpr int ML_OFF_K = 0, ML_OFF_K2 = 32768, ML_OFF_V = 49152, ML_OFF_WS = 81920, MLA_LDS = ML_OFF_WS + 8 * 64 * 4;
__device__ __forceinline__ void mla_unit(const bf16* Qp, const bf16* KVMp, const bf16* KPEp, int h, bf16* Op, int qb, char* lds, const int wid) {
    constexpr float SCALE = 0.07216878364870322f, C2 = 1.4426950408889634f * SCALE, THR = 8.f;
    const int lane = lane_id(), r32 = lane & 31, hi = lane >> 5;
    const int q0 = qb * 256, qlo = q0 + wid * 32, qrow = qlo + r32, qm = qrow - 4 * hi;
    char* K_lds = lds + ML_OFF_K; char* K2_lds = lds + ML_OFF_K2; char* V_lds = lds + ML_OFF_V;
    float* ws = (float*)(lds + ML_OFF_WS) + wid * 64; float* li_l = ws; float* al_l = ws + 32;
    bf16x8 qr[8], qr2[4];
    { const bf16* Qw = Qp + (size_t)qrow * 1536 + hi * 8;
#pragma unroll
      for (int d0 = 0; d0 < 8; ++d0) qr[d0] = *(const bf16x8*)(Qw + d0 * 16);
#pragma unroll
      for (int d0 = 0; d0 < 4; ++d0) qr2[d0] = *(const bf16x8*)(Qw + 128 + d0 * 16); }
    const __amdgpu_buffer_rsrc_t rKV = __builtin_amdgcn_make_buffer_rsrc((void*)KVMp, 0, -1, 0x00020000);
    const __amdgpu_buffer_rsrc_t rK2 = __builtin_amdgcn_make_buffer_rsrc((void*)KPEp, 0, -1, 0x00020000);
    unsigned vK[2], vV[2], vK2;
#pragma unroll
    for (int i = 0; i < 2; ++i) { const int rowk = 4 * (2 * wid + i) + (lane >> 4), ck = (lane & 15) ^ ((rowk & 7) | (((rowk >> 4) & 1) << 3)); vK[i] = (unsigned)(rowk * 4096 + ck * 16);
        const int sidx = (2 * wid + i) * 2 + (lane >> 5), kk = (sidx >> 2) * 8 + ((lane & 31) >> 2), k = (kk & ~0xC) | ((kk & 4) << 1) | ((kk & 8) >> 1), c = (sidx & 3) * 32 + (lane & 3) * 8;
        vV[i] = (unsigned)(k * 4096 + c * 2); }
    { const int rowk2 = 8 * wid + (lane >> 3), ck2 = (lane & 7) ^ ((rowk2 >> 1) & 7); vK2 = (unsigned)(rowk2 * 128 + ck2 * 16); }
    const unsigned hK = (unsigned)h * 512u, hV = hK + 256u;
    const int kf4 = ((r32 & 7) | (((r32 >> 4) & 1) << 3)) << 4, hi16 = hi << 4;
#define ML_LOADK(t_, buf) do { _Pragma("unroll") for (int i_ = 0; i_ < 2; ++i_) __builtin_amdgcn_raw_ptr_buffer_load_lds(rKV, (LAS unsigned*)(K_lds + (buf) * SHM_K + (2 * wid + i_) * 1024), 16, vK[i_], (unsigned)(t_) * 262144u + hK, 0, 0); \
        __builtin_amdgcn_raw_ptr_buffer_load_lds(rK2, (LAS unsigned*)(K2_lds + (buf) * SHM_K2 + wid * 1024), 16, vK2, (unsigned)(t_) * 8192u, 0, 0); } while (0)
#define ML_LOADV(t_, buf) do { _Pragma("unroll") for (int i_ = 0; i_ < 2; ++i_) __builtin_amdgcn_raw_ptr_buffer_load_lds(rKV, (LAS unsigned*)(V_lds + (buf) * SHM_V + (2 * wid + i_) * 1024), 16, vV[i_], (unsigned)(t_) * 262144u + hV, 0, 0); } while (0)
    const int vb0 = (int)(uintptr_t)V_lds + v_rd_base(lane);
    float m_reg = -1e30f, l_reg = 0.f; f32x16 o[4];
#pragma unroll
    for (int d = 0; d < 4; ++d) o[d] = f32x16{};
    const int NT = 4 * (qb + 1);
#define ML_QK(BF, P0, P1) do { P0 = f32x16{}; P1 = f32x16{}; \
        const char* kb_ = K_lds + (BF) * SHM_K + r32 * 256; const char* k2b_ = K2_lds + (BF) * SHM_K2; int f4_ = kf4; asm volatile("" : "+v"(f4_));   \
        _Pragma("unroll") for (int g_ = 0; g_ < 2; ++g_) { bf16x8 kf_[8]; \
            _Pragma("unroll") for (int dd = 0; dd < 4; ++dd) { const char* a = kb_ + (((((g_ * 4 + dd) * 2) << 4) + hi16) ^ f4_); kf_[2 * dd] = *(const bf16x8*)a; kf_[2 * dd + 1] = *(const bf16x8*)(a + 32 * 256); } \
            LDS_WAIT(); SBAR(); \
            _Pragma("unroll") for (int dd = 0; dd < 4; ++dd) { P0 = __builtin_amdgcn_mfma_f32_32x32x16_bf16(kf_[2 * dd], qr[g_ * 4 + dd], P0, 0, 0, 0); P1 = __builtin_amdgcn_mfma_f32_32x32x16_bf16(kf_[2 * dd + 1], qr[g_ * 4 + dd], P1, 0, 0, 0); } \
            SBAR(); } \
        { bf16x8 kf_[8]; \
            _Pragma("unroll") for (int dd = 0; dd < 4; ++dd) { const char* a = k2b_ + K2SWZ(r32, (dd * 16 + hi * 8) * 2); kf_[2 * dd] = *(const bf16x8*)a; kf_[2 * dd + 1] = *(const bf16x8*)(a + 32 * 128); } \
            LDS_WAIT(); SBAR(); \
            _Pragma("unroll") for (int dd = 0; dd < 4; ++dd) { P0 = __builtin_amdgcn_mfma_f32_32x32x16_bf16(kf_[2 * dd], qr2[dd], P0, 0, 0, 0); P1 = __builtin_amdgcn_mfma_f32_32x32x16_bf16(kf_[2 * dd + 1], qr2[dd], P1, 0, 0, 0); } \
            SBAR(); } } while (0)
#define PK4(P, B_, OUT) do { const unsigned a0 = cvt_pk_bf16(P[B_+0], P[B_+1]), a1 = cvt_pk_bf16(P[B_+2], P[B_+3]); \
        const unsigned b0_ = cvt_pk_bf16(P[B_+4], P[B_+5]), b1_ = cvt_pk_bf16(P[B_+6], P[B_+7]); \
        auto r0 = __builtin_amdgcn_permlane32_swap(a0, b0_, false, false); auto r1 = __builtin_amdgcn_permlane32_swap(a1, b1_, false, false); \
        v4u w = {r0[0], r1[0], r0[1], r1[1]}; OUT = *reinterpret_cast<bf16x8*>(&w); } while (0)
#define ML_SMPV(PB, CUR0, CUR1) do { \
        if (kb + 63 > qlo) { const float NEG = -__builtin_inff(); const int dq = qm - kb; \
            _Pragma("unroll") for (int r = 0; r < 16; ++r) { const int c = (r & 3) + 8 * (r >> 2); if (dq - c < 0) CUR0[r] = NEG; if (dq - c - 32 < 0) CUR1[r] = NEG; } } \
        float pmax = CUR0[0]; _Pragma("unroll") for (int r = 1; r < 16; ++r) pmax = fmaxf(pmax, CUR0[r]); _Pragma("unroll") for (int r = 0; r < 16; ++r) pmax = fmaxf(pmax, CUR1[r]); \
        { auto rr = __builtin_amdgcn_permlane32_swap(__float_as_uint(pmax), __float_as_uint(pmax), false, false); pmax = fmaxf(__uint_as_float(rr[0]), __uint_as_float(rr[1])); } \
        float mn, alpha; \
        if ((pmax - m_reg) * SCALE <= THR) { mn = m_reg; alpha = 1.f; } \
        else { mn = fmaxf(m_reg, pmax); alpha = __builtin_amdgcn_exp2f((m_reg - mn) * C2); m_reg = mn; } \
        const float mnL = -mn * C2; \
        _Pragma("unroll") for (int r = 0; r < 16; ++r) { CUR0[r] = __builtin_amdgcn_exp2f(fmaf(CUR0[r], C2, mnL)); CUR1[r] = __builtin_amdgcn_exp2f(fmaf(CUR1[r], C2, mnL)); } \
        float ps = 0.f; _Pragma("unroll") for (int r = 0; r < 16; ++r) ps += CUR0[r]; _Pragma("unroll") for (int r = 0; r < 16; ++r) ps += CUR1[r]; \
        { auto rr = __builtin_amdgcn_permlane32_swap(__float_as_uint(ps), __float_as_uint(ps), false, false); ps = __uint_as_float(rr[0]) + __uint_as_float(rr[1]); } \
        l_reg = l_reg * alpha + ps; \
        if (__any(alpha < 1.f)) { if (hi == 0) al_l[r32] = alpha; LDS_WAIT(); \
            _Pragma("unroll") for (int d_ = 0; d_ < 4; ++d_) _Pragma("unroll") for (int r = 0; r < 16; ++r) o[d_][r] *= al_l[crow(r, hi)]; } \
        bf16x8 pa0, pa1, pa2, pa3; \
        PK4(CUR0, 0, pa0); PK4(CUR0, 8, pa1); PK4(CUR1, 0, pa2); PK4(CUR1, 8, pa3); \
        SBAR(); pv_tile<PB>(o, vb0, pa0, pa1, pa2, pa3); SBAR(); } while (0)
#define ML_STEP(PB, t_, CUR0, CUR1, NXT0, NXT1) do { const int t = (t_); const int kb = t * 64; \
        if (t + 2 < NT) ML_LOADK(t + 2, PB); \
        if (t + 1 < NT) ML_LOADV(t + 1, (PB) ^ 1); \
        if (wid >= 4) ML_SMPV(PB, CUR0, CUR1); \
        if (t + 1 < NT) ML_QK((PB) ^ 1, NXT0, NXT1); SBAR(); \
        if (wid < 4) ML_SMPV(PB, CUR0, CUR1); \
        VM_WAIT(); __syncthreads(); } while (0)
    ML_LOADK(0, 0); ML_LOADV(0, 0); if (NT > 1) ML_LOADK(1, 1);
    VM_WAIT(); __syncthreads();
    f32x16 pA0, pA1, pB0, pB1;
    ML_QK(0, pA0, pA1);
    asm volatile("s_waitcnt lgkmcnt(0)" ::: "memory"); __syncthreads();
    for (int t2 = 0; t2 < NT; t2 += 2) { ML_STEP(0, t2, pA0, pA1, pB0, pB1); ML_STEP(1, t2 + 1, pB0, pB1, pA0, pA1); }
#undef ML_STEP
#undef ML_SMPV
#undef PK4
#undef ML_QK
#undef ML_LOADK
#undef ML_LOADV
    if (hi == 0) li_l[r32] = l_reg; LDS_WAIT();
    float rli[16];
#pragma unroll
    for (int r = 0; r < 16; ++r) rli[r] = __builtin_amdgcn_rcpf(li_l[crow(r, hi)]);
    bf16* Ow = Op + (size_t)qlo * DM;
#pragma unroll
    for (int r = 0; r < 16; ++r) { const int orow = crow(r, hi);
#pragma unroll
        for (int d0 = 0; d0 < 4; ++d0) { const float v = o[d0][r] * rli[r]; const float vn = __shfl_xor(v, 1);
            if ((r32 & 1) == 0) *(unsigned*)(Ow + (size_t)orow * DM + d0 * 32 + r32) = cvt_pk_bf16(v, vn); } }
    __syncthreads();
}

constexpr int MB_OFF_V = 0, MB_OFF_K = 65536, MB_OFF_WS = 131072, MOBA_LDS = MB_OFF_WS + 8 * 128 * 4;
__device__ __forceinline__ void moba_unit(const bf16* Qh, const bf16* Kh, const bf16* Vh, const int* list, int cnt, int j, int c, int h, bf16* PO, float* PL, char* lds, const int wid) {
    constexpr float SCALE = 0.08838834764831845f, C2 = 1.4426950408889634f * SCALE, THR = 8.f;
    const int lane = lane_id(), tid = wid * 64 + lane, r32 = lane & 31, hi = lane >> 5;
    char* V_lds = lds + MB_OFF_V; char* K_lds = lds + MB_OFF_K;
    float* ws = (float*)(lds + MB_OFF_WS) + wid * 128; float* li_l = ws; float* al_l = ws + 32; int* qi_l = (int*)(ws + 64);
    { const int sr = tid >> 4, sc = (tid & 15) * 8, vst0 = v_st(sr, sc), vst1 = v_st(32 + sr, sc), kws = KSW4(sr, tid & 15);
      const bf16* kp = Kh + (size_t)(256 * j + sr) * MW + sc; const bf16* vp = Vh + (size_t)(256 * j + sr) * MW + sc;
      bf16x8 kk[8], vv[8];
#pragma unroll
      for (int t = 0; t < 4; ++t) { kk[2 * t] = *(const bf16x8*)(kp + (size_t)(64 * t) * MW); kk[2 * t + 1] = *(const bf16x8*)(kp + (size_t)(64 * t + 32) * MW);
          vv[2 * t] = *(const bf16x8*)(vp + (size_t)(64 * t) * MW); vv[2 * t + 1] = *(const bf16x8*)(vp + (size_t)(64 * t + 32) * MW); }
#pragma unroll
      for (int t = 0; t < 4; ++t) { *(bf16x8*)(K_lds + t * SHM_K + kws) = kk[2 * t]; *(bf16x8*)(K_lds + t * SHM_K + kws + 32 * 256) = kk[2 * t + 1];
          *(bf16x8*)(V_lds + t * SHM_V + vst0) = vv[2 * t]; *(bf16x8*)(V_lds + t * SHM_V + vst1) = vv[2 * t + 1]; } }
    const int i = wid * 32 + r32; int q, slot; bool valid = true;
    if (c == 0) { q = 256 * j + i; slot = 3; } else { const int li = (c - 1) * 256 + i; valid = li < cnt; const int e = list[valid ? li : 0]; q = e >> 2; slot = e & 3; }
    bf16x8 qr[8];
    { const bf16* Qw = Qh + (size_t)q * MW + hi * 8;
#pragma unroll
      for (int d0 = 0; d0 < 8; ++d0) qr[d0] = *(const bf16x8*)(Qw + d0 * 16); }
    __syncthreads();
    const int vb0 = (int)(uintptr_t)V_lds + v_rd_base(lane);
    float m_reg = -1e30f, l_reg = 0.f; f32x16 o[4];
#pragma unroll
    for (int d = 0; d < 4; ++d) o[d] = f32x16{};
    const int qm = i - 4 * hi; const int kf4 = ((r32 & 7) | (((r32 >> 4) & 1) << 3)) << 4;
#define PK4(P, B_, OUT) do { const unsigned a0 = cvt_pk_bf16(P[B_+0], P[B_+1]), a1 = cvt_pk_bf16(P[B_+2], P[B_+3]); \
        const unsigned b0_ = cvt_pk_bf16(P[B_+4], P[B_+5]), b1_ = cvt_pk_bf16(P[B_+6], P[B_+7]); \
        auto r0 = __builtin_amdgcn_permlane32_swap(a0, b0_, false, false); auto r1 = __builtin_amdgcn_permlane32_swap(a1, b1_, false, false); \
        v4u w = {r0[0], r1[0], r0[1], r1[1]}; OUT = *reinterpret_cast<bf16x8*>(&w); } while (0)
#define MB_STEP(TT) do { constexpr int kb = 64 * (TT); \
        const bool act = (c != 0) || (kb <= wid * 32 + 31); \
        if (act) { \
            f32x16 p0 = f32x16{}, p1 = f32x16{}; \
            { int f4_ = kf4; asm volatile("" : "+v"(f4_)); _Pragma("unroll") for (int d0 = 0; d0 < 8; ++d0) { const char* a = K_lds + (TT) * SHM_K + r32 * 256 + ((((d0 * 2) << 4) + (hi << 4)) ^ f4_); \
                const bf16x8 b0 = *(const bf16x8*)a; const bf16x8 b1 = *(const bf16x8*)(a + 32 * 256); \
                p0 = __builtin_amdgcn_mfma_f32_32x32x16_bf16(b0, qr[d0], p0, 0, 0, 0); p1 = __builtin_amdgcn_mfma_f32_32x32x16_bf16(b1, qr[d0], p1, 0, 0, 0); } } \
            if (c == 0 && kb + 63 > wid * 32) { const float NEG = -__builtin_inff(); const int dq = qm - kb; \
                _Pragma("unroll") for (int r = 0; r < 16; ++r) { const int cc = (r & 3) + 8 * (r >> 2); if (dq - cc < 0) p0[r] = NEG; if (dq - cc - 32 < 0) p1[r] = NEG; } } \
            float pmax = p0[0]; _Pragma("unroll") for (int r = 1; r < 16; ++r) pmax = fmaxf(pmax, p0[r]); _Pragma("unroll") for (int r = 0; r < 16; ++r) pmax = fmaxf(pmax, p1[r]); \
            { auto rr = __builtin_amdgcn_permlane32_swap(__float_as_uint(pmax), __float_as_uint(pmax), false, false); pmax = fmaxf(__uint_as_float(rr[0]), __uint_as_float(rr[1])); } \
            float mn, alpha; \
            if ((pmax - m_reg) * SCALE <= THR) { mn = m_reg; alpha = 1.f; }        \
            else { mn = fmaxf(m_reg, pmax); alpha = __builtin_amdgcn_exp2f((m_reg - mn) * C2); m_reg = mn; } \
            const float mnL = -mn * C2; \
            _Pragma("unroll") for (int r = 0; r < 16; ++r) { p0[r] = __builtin_amdgcn_exp2f(fmaf(p0[r], C2, mnL)); p1[r] = __builtin_amdgcn_exp2f(fmaf(p1[r], C2, mnL)); } \
            float ps = 0.f; _Pragma("unroll") for (int r = 0; r < 16; ++r) ps += p0[r]; _Pragma("unroll") for (int r = 0; r < 16; ++r) ps += p1[r]; \
            { auto rr = __builtin_amdgcn_permlane32_swap(__float_as_uint(ps), __float_as_uint(ps), false, false); ps = __uint_as_float(rr[0]) + __uint_as_float(rr[1]); } \
            l_reg = l_reg * alpha + ps; \
            if (__any(alpha < 1.f)) { if (hi == 0) al_l[r32] = alpha; LDS_WAIT(); \
                _Pragma("unroll") for (int d_ = 0; d_ < 4; ++d_) _Pragma("unroll") for (int r = 0; r < 16; ++r) o[d_][r] *= al_l[crow(r, hi)]; } \
            bf16x8 pa0, pa1, pa2, pa3; \
            PK4(p0, 0, pa0); PK4(p0, 8, pa1); PK4(p1, 0, pa2); PK4(p1, 8, pa3); \
            SBAR(); pv_tile<TT>(o, vb0, pa0, pa1, pa2, pa3); \
        } } while (0)
    MB_STEP(0); MB_STEP(1); MB_STEP(2); MB_STEP(3);
#undef MB_STEP
#undef PK4
    const int pidx_own = valid ? ((q * NH + h) * 4 + slot) : -1;
    if (hi == 0) { li_l[r32] = l_reg; qi_l[r32] = pidx_own; if (valid) PL[pidx_own] = m_reg * C2 + __builtin_amdgcn_logf(l_reg); }
    LDS_WAIT();
#pragma unroll
    for (int r = 0; r < 16; ++r) { const int orow = crow(r, hi); const int pidx = qi_l[orow]; const float rl = __builtin_amdgcn_rcpf(li_l[orow]);
#pragma unroll
        for (int d0 = 0; d0 < 4; ++d0) { const float v = o[d0][r] * rl; const float vn = __shfl_xor(v, 1);
            if ((r32 & 1) == 0 && pidx >= 0) *(unsigned*)(PO + (size_t)pidx * 128 + d0 * 32 + r32) = cvt_pk_bf16(v, vn); } }
    __syncthreads();
}
}

#define XB_TMO      128
#define XB_XCNT(j)  (256  + 64 * (j))
#define XB_XSUB(j)  (1280 + 64 * (j))
#define XB_XGEN(j)  (2304 + 64 * (j))
#define XB_TOP      3328
#define XB_TOPGEN   3392
#define XCD_BAR_WORDS 3456
#define XB_SPIN_CAP (1u << 18)
__device__ __forceinline__ unsigned xb_ld(unsigned* p)              { return __hip_atomic_load(p, __ATOMIC_RELAXED, __HIP_MEMORY_SCOPE_AGENT); }
__device__ __forceinline__ unsigned xb_add(unsigned* p, unsigned v) { return __hip_atomic_fetch_add(p, v, __ATOMIC_RELAXED, __HIP_MEMORY_SCOPE_AGENT); }
__device__ __forceinline__ unsigned xb_xcc_id() { return (unsigned)__builtin_amdgcn_s_getreg((3 << 11) | 20) & 0xFu; }
#define XB_SPIN(cond, bar) do { unsigned _sp = 0; while (cond) { __builtin_amdgcn_s_sleep(1); \
    if ((++_sp & 255u) == 0u) { if (xb_ld(&(bar)[XB_TMO])) break; if (_sp > XB_SPIN_CAP) { atomicAdd(&(bar)[XB_TMO], 1u); break; } } } } while (0)
struct XcdBarrier { unsigned* bar; unsigned x; volatile LAS unsigned* st; };
__device__ __forceinline__ XcdBarrier xcd_barrier_post(unsigned* bar, volatile LAS unsigned* st, bool t0  ) {
    XcdBarrier b; b.bar = bar; b.x = xb_xcc_id(); b.st = st;
    if (t0) (void)xb_add(&bar[XB_XCNT(b.x)], 1u);
    return b;
}
__device__ __forceinline__ void xcd_barrier_complete(unsigned* bar, unsigned x, unsigned& nloc, unsigned& nx) {
    const unsigned G = gridDim.x * gridDim.y * gridDim.z;
    unsigned sum, cnt, mine, sp = 0u;
    for (;;) {
        sum = 0u; cnt = 0u; mine = 0u;
#pragma unroll
        for (unsigned j = 0; j < 16; ++j) { const unsigned c = xb_ld(&bar[XB_XCNT(j)]); sum += c; cnt += (c > 0u) ? 1u : 0u; mine = (j == x) ? c : mine; }
        if (sum == G) break;
        __builtin_amdgcn_s_sleep(1);
        if ((++sp & 255u) == 0u) { if (xb_ld(&bar[XB_TMO])) break; if (sp > XB_SPIN_CAP) { atomicAdd(&bar[XB_TMO], 1u); break; } }
    }
    nloc = mine > 0u ? mine : 1u; nx = cnt > 0u ? cnt : 1u;
}
__device__ __forceinline__ void xcd_barrier(const XcdBarrier& b, bool t0  ) {
    asm volatile("s_waitcnt vmcnt(0)" ::: "memory");
    __syncthreads();
    if (t0) {
        unsigned* bar = b.bar;
        __builtin_amdgcn_s_waitcnt(0);
        unsigned nloc = b.st[0], nx = b.st[1];
        if (nloc == 0u) { xcd_barrier_complete(bar, b.x, nloc, nx); b.st[0] = nloc; b.st[1] = nx; }
        const unsigned old = xb_add(&bar[XB_XSUB(b.x)], 1u);
        const unsigned gen = old / nloc;
        if (old + 1u == (gen + 1u) * nloc) {
            __builtin_amdgcn_fence(__ATOMIC_RELEASE, "agent");
            asm volatile("s_waitcnt vmcnt(0)" ::: "memory");
            const unsigned og = xb_add(&bar[XB_TOP], 1u);
            const unsigned tg = og / nx;
            if (og + 1u == (tg + 1u) * nx) xb_add(&bar[XB_TOPGEN], 1u);
            else XB_SPIN(xb_ld(&bar[XB_TOPGEN]) == tg, bar);
            __builtin_amdgcn_fence(__ATOMIC_ACQUIRE, "agent");
            xb_add(&bar[XB_XGEN(b.x)], 1u);
            asm volatile("s_waitcnt vmcnt(0)" ::: "memory");
        } else {
            XB_SPIN(xb_ld(&bar[XB_XGEN(b.x)]) == gen, bar);
            __builtin_amdgcn_fence(__ATOMIC_ACQUIRE, "agent");
            asm volatile("s_waitcnt vmcnt(0)" ::: "memory");
        }
    }
    __syncthreads();
}

struct Args;
typedef const __attribute__((address_space(4))) struct Args* KArgsFwd;
struct Args {
    const float* x; const int* pos; const float* w_in; const float* g_q_a; const float* w_q_b; const float* g_kv_a; const float* w_kv_b;
    const float* g_out_mla; const float* g_out_moba; const float* w_o; const float* ln1_g; const float* ln1_b; const float* w_router; const float* b_router;
    const float* w_gate_up; const float* b_gate_up; const float* w_down; const float* b_down; const float* ln2_g; const float* ln2_b;
    float* out; unsigned char* ws; int ph_lo, ph_hi;
};
constexpr int NPHASES = 14;

__device__ __forceinline__ void tr_item(const float* W, int N, bf16* WT, int K, int k0, int n0, int prow0, const float* sc, int lane, int pmode = 0) {
    float tv[64]; const unsigned off0 = (unsigned)(k0 * N + n0 + lane) * 4u, rb = (unsigned)N * 4u;
#pragma unroll
    for (int i = 0; i < 64; ++i) tv[i] = __builtin_nontemporal_load((const float*)((const char*)W + (off0 + (unsigned)i * rb)));
    if (sc) {
#pragma unroll
        for (int i = 0; i < 64; i += 4) { const f32x4 g4 = *(const f32x4*)(sc + k0 + i); tv[i] *= g4[0]; tv[i + 1] *= g4[1]; tv[i + 2] *= g4[2]; tv[i + 3] *= g4[3]; } }
    bf16* dst = WT + (size_t)(prow0 + (pmode == 0 ? lane : (pmode == 1 ? 2 * lane : 2 * (lane & 31) + (lane >> 5)))) * K + k0;
#pragma unroll
    for (int j = 0; j < 8; ++j) { v4u o; o.x = cvt_pk_bf16(tv[8 * j], tv[8 * j + 1]); o.y = cvt_pk_bf16(tv[8 * j + 2], tv[8 * j + 3]); o.z = cvt_pk_bf16(tv[8 * j + 4], tv[8 * j + 5]); o.w = cvt_pk_bf16(tv[8 * j + 6], tv[8 * j + 7]);
        *(v4u*)(dst + 8 * j) = o; }
}
constexpr int BG_ITEMS = NE * 32 * 64 + NE * 32 * 32, BG_ROUNDS = 48;
#ifndef BG_SPLIT
#define BG_SPLIT 0, 6, 6, 44, 48
#endif
constexpr int BG_SPLIT_[5] = {BG_SPLIT};
constexpr int BG_P0 = BG_SPLIT_[0], BG_P1 = BG_SPLIT_[1], BG_P3 = BG_SPLIT_[2], BG_P6 = BG_SPLIT_[3], BG_P8 = BG_SPLIT_[4];
struct BgItem { const float* W; unsigned char* WT; unsigned rb; int K, k0, n0, prow0; float cs; };
__device__ __forceinline__ BgItem bg_decode(KArgsFwd ka, GAS unsigned char* ws, int it) {
    BgItem b; it = it < BG_ITEMS ? it : BG_ITEMS - 1;
    if (it < NE * 2048) { const int e = it >> 11, q = it & 2047, kb = q & 31, nb = q >> 5, n0 = nb * 64;
        b.W = ((const float*)(GAS const float*)ka->w_gate_up) + (size_t)e * DM * 2 * DFF; b.WT = (unsigned char*)(ws + WS_WGU) + (size_t)e * 2 * DFF * DM; b.rb = 2 * DFF * 4; b.K = DM; b.k0 = kb * 64; b.n0 = n0;
        b.prow0 = n0 < DFF ? (n0 >> 7) * 256 + (n0 & 127) : ((n0 - DFF) >> 7) * 256 + 128 + ((n0 - DFF) & 127); b.cs = SC_WGU; }
    else { it -= NE * 2048; const int e = it >> 10, q = it & 1023, kb = q & 31, nb = q >> 5;
        b.W = ((const float*)(GAS const float*)ka->w_down) + (size_t)e * DFF * DM; b.WT = (unsigned char*)(ws + WS_WD) + (size_t)e * DM * DFF; b.rb = DM * 4; b.K = DFF; b.k0 = kb * 64; b.n0 = nb * 64; b.prow0 = nb * 64; b.cs = SC_WD; }
    return b;
}
#define BG_LOAD(TV, B) do { const unsigned off0_ = (unsigned)((B).k0 + 16 * (lane >> 4)) * (B).rb + (unsigned)((B).n0 + 4 * (lane & 15)) * 4u; \
    _Pragma("unroll") for (int i_ = 0; i_ < 16; ++i_) TV[i_] = __builtin_nontemporal_load((const f32x4*)((const char*)(B).W + (off0_ + (unsigned)i_ * (B).rb))); } while (0)
#define BG_STORE(TV, B) do { unsigned char* dst_ = (B).WT + (size_t)((B).prow0 + 4 * (lane & 15)) * (B).K + (B).k0 + 16 * (lane >> 4); const float cs_ = 1.0f / (B).cs; \
    _Pragma("unroll") for (int c_ = 0; c_ < 4; ++c_) { v4u o_; \
        o_.x = pk4_fp8s(TV[0][c_], TV[1][c_], TV[2][c_], TV[3][c_], cs_); o_.y = pk4_fp8s(TV[4][c_], TV[5][c_], TV[6][c_], TV[7][c_], cs_); \
        o_.z = pk4_fp8s(TV[8][c_], TV[9][c_], TV[10][c_], TV[11][c_], cs_); o_.w = pk4_fp8s(TV[12][c_], TV[13][c_], TV[14][c_], TV[15][c_], cs_); \
        *(v4u*)(dst_ + (size_t)c_ * (B).K) = o_; } } while (0)
__device__ __forceinline__ void bg_run(KArgsFwd ka, GAS unsigned char* ws, int it0, int n, int stride, int lane) {
    if (n <= 0) return;
    f32x4 ta[16], tb[16];
    BgItem A = bg_decode(ka, ws, it0), B = A;
    BG_LOAD(ta, A);
    for (int r = 0; r < n; r += 2) {
        const bool hb = r + 1 < n, ha = r + 2 < n;
        if (hb) { B = bg_decode(ka, ws, it0 + (r + 1) * stride); BG_LOAD(tb, B); }
        BG_STORE(ta, A);
        if (ha) { A = bg_decode(ka, ws, it0 + (r + 2) * stride); BG_LOAD(ta, A); }
        if (hb) BG_STORE(tb, B);
    }
}
__device__ __forceinline__ void bg_rounds(KArgsFwd ka, GAS unsigned char* ws, int r0, int r1, int gw, int NGW, int lane) { bg_run(ka, ws, r0 * NGW + gw, r1 - r0, NGW, lane); }
#undef BG_LOAD
#undef BG_STORE
__device__ __forceinline__ void sincos_d(double x, float& sn, float& cs) {
    const double inv2pi = 0.15915494309189533577, pi2hi = 6.283185307179586232, pi2lo = 2.4492935982947064e-16;
    const double n = rint(x * inv2pi); double r = fma(-n, pi2hi, x); r = fma(-n, pi2lo, r);
    const double r2 = r * r; double s = 1.0, c = 1.0;
    double ts = 0.0, tc = 0.0;
#pragma unroll
    for (int k = 14; k >= 1; --k) { ts = (ts + 1.0) * (-r2 * (1.0 / (double)((2 * k) * (2 * k + 1)))); tc = (tc + 1.0) * (-r2 * (1.0 / (double)((2 * k - 1) * (2 * k)))); }
    s = r * (1.0 + ts); c = 1.0 + tc; sn = (float)s; cs = (float)c;
}

#define XB   ((bf16*)(ws + WS_XB))
#define WIN  ((bf16*)(ws + WS_WIN))
#define WQB  ((bf16*)(ws + WS_WQB))
#define WKVB ((bf16*)(ws + WS_WKVB))
#define WO   ((bf16*)(ws + WS_WO))
#define C128 ((float*)(ws + WS_C128))
#define S128 ((float*)(ws + WS_S128))
#define C64  ((float*)(ws + WS_C64))
#define S64  ((float*)(ws + WS_S64))
#define HQ   ((bf16*)(ws + WS_HQ))
#define HKV  ((bf16*)(ws + WS_HKV))
#define KPE  ((bf16*)(ws + WS_KPE))
#define MQ   ((bf16*)(ws + WS_MQ))
#define MK   ((bf16*)(ws + WS_MK))
#define MV   ((bf16*)(ws + WS_MV))
#define RSQ  ((float*)(ws + WS_RSQ))
#define RSKV ((float*)(ws + WS_RSKV))
#define QM   ((bf16*)(ws + WS_QM))
#define KVM  ((bf16*)(ws + WS_KVM))
#define MLIST ((int*)(ws + WS_LIST))
#define PO   ((bf16*)(ws + WS_PO))
#define PL   ((float*)(ws + WS_PL))
#define OMIX ((bf16*)(ws + WS_OMIX))
#define X1P  ((float*)(ws + WS_X1P))
#define X1N  ((bf16*)(ws + WS_X1N))
#define X1B  ((unsigned char*)(ws + WS_X1B))
#define TOPE ((int*)(ws + WS_TOPE))
#define ROWTOK ((int*)(ws + WS_TOPE))
#define TOPR ((int*)(ws + WS_TOPR))
#define TOPG ((float*)(ws + WS_TOPG))
#define TOPROW ((int*)(ws + WS_TOPROW))
#define RGATE ((float*)(ws + WS_RGATE))
#define XG   ((unsigned char*)(ws + WS_XG))
#define ACT  ((unsigned char*)(ws + WS_ACT))
#define YB   ((unsigned char*)(ws + WS_Y))
#define WGU  ((unsigned char*)(ws + WS_WGU))
#define WD   ((unsigned char*)(ws + WS_WD))
__device__ __forceinline__ GAS unsigned char* opq(const void* p) { GAS unsigned char* q = (GAS unsigned char*)p; asm volatile("" : "+s"(q)); return q; }
typedef const __attribute__((address_space(4))) struct Args* KArgs;
__device__ __forceinline__ KArgs kargs() { auto p = __builtin_amdgcn_kernarg_segment_ptr(); asm volatile("" : "+s"(p)); return (KArgs)p; }

__global__ void __launch_bounds__(512, 2) fwd(Args a) {
    extern __shared__ __attribute__((aligned(16))) unsigned char lds[];
    LAS unsigned char* L = (LAS unsigned char*)lds;
    const int wave = __builtin_amdgcn_readfirstlane((int)threadIdx.x >> 6);
    const int G = gridDim.x, bid = blockIdx.x;
    const int gw = bid * 8 + wave, NGW = G * 8;
    const int NGT = G * 512;
    gu32* ctl = (gu32*)(a.ws + WS_CTL);
    for (int u = wave * 64 + lane_id(); u < (LDS_BYTES - LDSCTL_OFF) / 4; u += 512) ((LAS unsigned*)(L + LDSCTL_OFF))[u] = 0u;
    __syncthreads();
    XcdBarrier bar; bar.bar = (unsigned*)(ctl + CW_BAR); bar.x = 0; bar.st = nullptr;
    if (MK_N_LAUNCHES == 1) bar = xcd_barrier_post((unsigned*)(ctl + CW_BAR), (volatile LAS unsigned*)(L + LDSCTL_OFF), wave == 0 && lane_id() == 0);
    const int lo = a.ph_lo, hi = a.ph_hi;
    unsigned long long pt_prev = PROBE_TIME_MASK ? __builtin_amdgcn_s_memrealtime() : 0ull, pt_acc = 0ull;
#define PT_MARK(k) do { if (PROBE_TIME_MASK) { const unsigned long long now_ = __builtin_amdgcn_s_memrealtime(); if ((PROBE_TIME_MASK >> (k)) & 1) pt_acc += now_ - pt_prev; pt_prev = now_; } } while (0)
#define IN(k) (lo <= (k) && (k) < hi)
#define REPS(k) ((((PROBE_REP_MASK) >> (k)) & 1) + 1)
#define SEAM(k) do { if (IN(k) && IN((k) + 1)) { XcdBarrier b2_ = bar; b2_.bar = (unsigned*)(opq(kargs()->ws) + WS_CTL + (size_t)CW_BAR * 4); xcd_barrier(b2_, wave == 0 && lane_id() == 0); } PT_MARK(k); } while (0)

    if (IN(0)) for (int rep_ = 0; rep_ < REPS(0); ++rep_) { KArgs ka = kargs(); GAS unsigned char* ws = opq(ka->ws); const int lane = lane_id(), tid = wave * 64 + lane, gt = bid * 512 + tid; (void)gt;
        constexpr int I0 = 32 * 61, I1 = 8 * 24, I2 = 4 * 32, I3 = 32 * 32;
        constexpr int NIT = I0 + I1 + I2 + I3;
        for (int it = gw; it < NIT; it += NGW) {
            int r = it;
            if (r < I0) { const int kb = r / 61, nb = r % 61, n0 = nb * 64; int prow, pmode;
                if (n0 < 768) { prow = n0; pmode = 0; } else if (n0 == 768) { prow = 768; pmode = 2; }
                else if (n0 < 2880) { const int q = n0 - 832, reg = q >> 10, w = q & 1023; prow = 1024 + reg * 1024 + (w >> 7) * 128 + ((w >> 6) & 1); pmode = 1; }
                else { prow = n0 + 192; pmode = 0; }
                tr_item(((const float*)(GAS const float*)ka->w_in), INC, WIN, DM, kb * 64, n0, prow, nullptr, lane, pmode); continue; } r -= I0;
            if (r < I1) { const int kb = r / 24, nb = r % 24; tr_item(((const float*)(GAS const float*)ka->w_q_b), 1536, WQB, QLORA, kb * 64, nb * 64, nb * 64, ((const float*)(GAS const float*)ka->g_q_a), lane, (nb % 3) == 2 ? 2 : 0); continue; } r -= I1;
            if (r < I2) { const int kb = r / 32, nb = r % 32; tr_item(((const float*)(GAS const float*)ka->w_kv_b), 2048, WKVB, KVLORA, kb * 64, nb * 64, nb * 64, ((const float*)(GAS const float*)ka->g_kv_a), lane); continue; } r -= I2;
            { const int kb = r / 32, nb = r % 32; tr_item(((const float*)(GAS const float*)ka->w_o), DM, WO, DM, kb * 64, nb * 64, nb * 64, kb < 16 ? ((const float*)(GAS const float*)ka->g_out_mla) : ((const float*)(GAS const float*)ka->g_out_moba) - MW, lane); }
        }
        bg_rounds(ka, ws, 0, BG_P0, gw, NGW, lane);
        for (int i = gt; i < 192 * DM / 8; i += NGT) *(v4u*)(WIN + (size_t)832 * DM + (size_t)i * 8) = (v4u){0u, 0u, 0u, 0u};
        for (int i = gt; i < T * DM / 8; i += NGT) { const f32x4 v0 = *(const f32x4*)(((const float*)(GAS const float*)ka->x) + (size_t)i * 8), v1 = *(const f32x4*)(((const float*)(GAS const float*)ka->x) + (size_t)i * 8 + 4);
            v4u w; w.x = cvt_pk_bf16(v0[0], v0[1]); w.y = cvt_pk_bf16(v0[2], v0[3]); w.z = cvt_pk_bf16(v1[0], v1[1]); w.w = cvt_pk_bf16(v1[2], v1[3]); *(v4u*)(XB + (size_t)i * 8) = w; }
        for (int i = gt; i < T * 96; i += NGT) { const int t = i / 96, j = i % 96; const float p = (float)((const int*)(GAS const int*)ka->pos)[t];
            if (j < 64) { const float inv = (float)exp2(-(double)j * (2.0 / 128.0) * 13.287712379549449); float sn, cs; sincos_d((double)(p * inv), sn, cs); C128[t * 64 + j] = cs; S128[t * 64 + j] = sn; }
            else { const int jj = j - 64; const float inv = (float)exp2(-(double)jj * (2.0 / 64.0) * 13.287712379549449); float sn, cs; sincos_d((double)(p * inv), sn, cs); C64[t * 32 + jj] = cs; S64[t * 32 + jj] = sn; } }
    }
    SEAM(0);

    if (IN(1)) for (int rep_ = 0; rep_ < REPS(1); ++rep_) { KArgs ka = kargs(); GAS unsigned char* ws = opq(ka->ws);
        pg8::Gemm g{XB, WIN, DM * 2, DM * 2, DM * 2, 0, nullptr}; pg8::StaticOrder S; S.init(T, INP, G, bid);
        pg8::EpiInProj E{(unsigned char*)ws};
        const bool bg_first = ((bid >> 3) & 1) == 0;
        if (bg_first) bg_rounds(ka, ws, BG_P0, BG_P1, gw, NGW, lane_id());
        pg8::gemm_phase<pg8::EpiInProj, pg8::StaticOrder>(L, g, S, E, wave, pt_acc);
        if (!bg_first) bg_rounds(ka, ws, BG_P0, BG_P1, gw, NGW, lane_id());
    }
    SEAM(1);


    if (IN(3)) for (int rep_ = 0; rep_ < REPS(3); ++rep_) { KArgs ka = kargs(); GAS unsigned char* ws = opq(ka->ws);
        { pg8::Gemm g{HQ, WQB, QLORA * 2, QLORA * 2, QLORA * 2, 0, nullptr}; pg8::StaticOrder S; S.init(T, 1536, G, bid); pg8::EpiRowScale<true> E{QM, 1536, (const float*)(ws + WS_SSP), 1.0f / QLORA, C64, S64};
          pg8::gemm_phase<pg8::EpiRowScale<true>, pg8::StaticOrder>(L, g, S, E, wave, pt_acc); }
        { pg8::Gemm g{HKV, WKVB, KVLORA * 2, KVLORA * 2, KVLORA * 2, 0, nullptr}; pg8::StaticOrder S; S.init(T, 2048, G, bid); pg8::EpiRowScale<false> E{KVM, 2048, (const float*)(ws + WS_SSP) + 8, 1.0f / KVLORA, nullptr, nullptr};
          pg8::gemm_phase<pg8::EpiRowScale<false>, pg8::StaticOrder>(L, g, S, E, wave, pt_acc); }
        bg_rounds(ka, ws, BG_P1, BG_P3, gw, NGW, lane_id());
    }
    if (IN(3)) { KArgs ka = kargs(); GAS unsigned char* ws = opq(ka->ws); const int lane = lane_id();
        LAS unsigned* lc = (LAS unsigned*)L;
        for (int it = bid; it < NH * 32; it += G) { const int h = it & 7, blk = it >> 3;
            const int tk = lane & 31, kh = lane >> 5, t = 256 * blk + 32 * wave + tk;
            if (wave == 0) lc[lane] = 0u;
            const float* ksum = (const float*)(ws + WS_KSP) + (size_t)(h * 32 + tk) * 128 + 64 * kh;
            f32x4 ka4[16];
#pragma unroll
            for (int i = 0; i < 16; ++i) ka4[i] = *(const f32x4*)(ksum + 4 * i) + *(const f32x4*)(ksum + NH * 32 * 128 + 4 * i);
            const bf16* qp = MQ + (size_t)t * MW + h * 128 + 64 * kh;
            v4u qv[8];
#pragma unroll
            for (int i = 0; i < 8; ++i) qv[i] = *(const v4u*)(qp + 8 * i);
            asm volatile("s_waitcnt vmcnt(0)" : "+v"(qv[0]), "+v"(qv[1]), "+v"(qv[2]), "+v"(qv[3]), "+v"(qv[4]), "+v"(qv[5]), "+v"(qv[6]), "+v"(qv[7]) :: "memory");
            f32x16 acc = f32x16{};
#pragma unroll
            for (int i = 0; i < 8; ++i) { const unsigned qw[4] = {qv[i].x, qv[i].y, qv[i].z, qv[i].w};
#pragma unroll
                for (int c = 0; c < 4; ++c) { const f32x4 a0 = ka4[2 * i + (c >> 1)];
                    acc = __builtin_amdgcn_mfma_f32_32x32x2f32(a0[(c & 1) * 2], bflo(qw[c]), acc, 0, 0, 0);
                    acc = __builtin_amdgcn_mfma_f32_32x32x2f32(a0[(c & 1) * 2 + 1], bfhi(qw[c]), acc, 0, 0, 0); } }
            float v[16];
#pragma unroll
            for (int r = 0; r < 16; ++r) v[r] = at::crow(r, kh) < blk ? acc[r] : -__builtin_inff();
            int bsel[3];
#pragma unroll
            for (int k = 0; k < 3; ++k) { float bv = v[0]; int bn = at::crow(0, kh);
#pragma unroll
                for (int r = 1; r < 16; ++r) if (v[r] > bv) { bv = v[r]; bn = at::crow(r, kh); }
                const float ov = __shfl_xor(bv, 32); const int on = __shfl_xor(bn, 32);
                if (ov > bv || (ov == bv && on < bn)) { bv = ov; bn = on; }
                bsel[k] = bn;
#pragma unroll
                for (int r = 0; r < 16; ++r) if (at::crow(r, kh) == bn) v[r] = -__builtin_inff(); }
            __syncthreads();
            unsigned lr[3] = {0u, 0u, 0u};
            if (kh == 0) {
#pragma unroll
                for (int k = 0; k < 3; ++k) if (k < blk) lr[k] = __hip_atomic_fetch_add((LAS unsigned*)&lc[bsel[k]], 1u, __ATOMIC_RELAXED, __HIP_MEMORY_SCOPE_WORKGROUP); }
            asm volatile("s_waitcnt lgkmcnt(0)" ::: "memory"); __syncthreads();
            if (wave == 0 && lane < 32) { const unsigned mine = lc[lane]; lc[32 + lane] = mine ? __hip_atomic_fetch_add((unsigned*)(ctl + CW_MCNT + (h * 32 + lane) * 64), mine, RLX_AGENT) : 0u; }
            asm volatile("s_waitcnt vmcnt(0) lgkmcnt(0)" ::: "memory"); __syncthreads();
            if (kh == 0) {
#pragma unroll
                for (int k = 0; k < 3; ++k) if (k < blk) MLIST[(size_t)(h * 32 + bsel[k]) * 8192 + lc[32 + bsel[k]] + lr[k]] = t * 4 + k; }
            __syncthreads();
        }
    }
    SEAM(3);


    if (IN(6)) for (int rep_ = 0; rep_ < REPS(6); ++rep_) { KArgs ka = kargs(); GAS unsigned char* ws = opq(ka->ws);
        LAS int* pref = (LAS int*)(L + 143360);
        LAS int* qslot = (LAS int*)(L + LDSCTL_OFF + 32);
        { const int tid = wave * 64 + lane_id();
          if (tid < 256) { const int cn = (int)__hip_atomic_load((unsigned*)(ctl + CW_MCNT + tid * 64), RLX_AGENT); pref[1 + tid] = 1 + ((cn + 255) >> 8); }
          __syncthreads();
          if (tid < 64) { int v4_[4]; int sum = 0;
#pragma unroll
              for (int i = 0; i < 4; ++i) { v4_[i] = pref[1 + 4 * tid + i]; sum += v4_[i]; }
              int incl = sum;
#pragma unroll
              for (int off = 1; off < 64; off <<= 1) { const int o_ = __shfl_up(incl, off); if (tid >= off) incl += o_; }
              int run = incl - sum;
#pragma unroll
              for (int i = 0; i < 4; ++i) { run += v4_[i]; pref[1 + 4 * tid + i] = run; }
              if (tid == 0) pref[0] = 0; }
          __syncthreads(); }
        const int NM = __builtin_amdgcn_readfirstlane(pref[256]);
        constexpr int NC = (BG_P6 - BG_P3) * 2048 / 32;
        const int N2 = 3 * NM + (NC > 2 * NM ? NC - 2 * NM : 0), Ntot = (256 + N2) > 4096 ? (256 + N2) : 4096;
        for (int iter = 0;; ++iter) {
            if (wave == 0 && lane_id() == 0) qslot[iter & 1] = (int)__hip_atomic_fetch_add((unsigned*)(ctl + CW_QHEAD), 1u, RLX_AGENT);
            __syncthreads();
            const int p = __builtin_amdgcn_readfirstlane(qslot[iter & 1]);
            if (p >= Ntot) break;
            if (p < 4096 && (p & 15) == 0) { const int a0 = p >> 4, h = a0 & 7, sq = 31 - (a0 >> 3);
                for (int d_ = 0; d_ < (PROBE_DUP == 1 ? 2 : 1); ++d_) at::mla_unit((const bf16*)QM + h * QKH, (const bf16*)KVM, (const bf16*)KPE, h, OMIX + h * 128, sq, (char*)lds, wave);
            } else { const int q = p < 4096 ? p - (p >> 4) - 1 : p - 256;
                int mb = -1, cc = -1;
                if (q < 3 * NM) { const int i3 = q / 3, r3 = q - 3 * i3; if (r3 == 0) mb = i3; else { cc = 2 * i3 + r3 - 1; if (cc >= NC) cc = -1; } }
                else { cc = 2 * NM + (q - 3 * NM); if (cc >= NC) cc = -1; }
                if (mb >= 0) { int lo_ = 0, hi_ = 255;
                    while (lo_ < hi_) { const int mid = (lo_ + hi_ + 1) >> 1; if (pref[mid] <= mb) lo_ = mid; else hi_ = mid - 1; }
                    const int hj = __builtin_amdgcn_readfirstlane(lo_), c = mb - __builtin_amdgcn_readfirstlane(pref[lo_]), h = hj >> 5, j = hj & 31;
                    const int cn = (int)__builtin_amdgcn_readfirstlane((int)__hip_atomic_load((unsigned*)(ctl + CW_MCNT + hj * 64), RLX_AGENT));
                    for (int d_ = 0; d_ < (PROBE_DUP == 2 ? 2 : 1); ++d_) at::moba_unit((const bf16*)MQ + h * 128, (const bf16*)MK + h * 128, (const bf16*)MV + h * 128, MLIST + (size_t)hj * 8192, cn, j, c, h, PO, PL, (char*)lds, wave);
                } else if (cc >= 0) bg_run(ka, ws, BG_P3 * 2048 + cc * 32 + wave * 4, 4, 1, lane_id());
            }
        }
    }
    SEAM(6);

    if (IN(7)) for (int rep_ = 0; rep_ < REPS(7); ++rep_) { KArgs ka = kargs(); GAS unsigned char* ws = opq(ka->ws); const int lane = lane_id();
        const int hl = lane >> 4, col8 = (lane & 15) * 8;
        for (int r = gw; r < T; r += NGW) { const int nv = (r >> 8) < 3 ? (r >> 8) : 3;
            f32x4 oa[2][2]; float ssb = 0.f;
#pragma unroll
            for (int ps = 0; ps < 2; ++ps) { const int h = ps * 4 + hl, pb = (r * NH + h) * 4; const f32x4 L4 = *(const f32x4*)(PL + pb);
                float Ls[4] = {nv > 0 ? L4[0] : -__builtin_inff(), nv > 1 ? L4[1] : -__builtin_inff(), nv > 2 ? L4[2] : -__builtin_inff(), L4[3]};
                const float Lm = fmaxf(fmaxf(Ls[0], Ls[1]), fmaxf(Ls[2], Ls[3])); float W = 0.f; f32x4 a0 = {0.f, 0.f, 0.f, 0.f}, a1 = {0.f, 0.f, 0.f, 0.f};
#pragma unroll
                for (int k = 0; k < 4; ++k) { if (k == 3 || k < nv) { const float w = __builtin_amdgcn_exp2f(Ls[k] - Lm); const v4u pv = *(const v4u*)(PO + (size_t)(pb + k) * 128 + col8); W += w;
                        a0[0] = fmaf(w, bflo(pv.x), a0[0]); a0[1] = fmaf(w, bfhi(pv.x), a0[1]); a0[2] = fmaf(w, bflo(pv.y), a0[2]); a0[3] = fmaf(w, bfhi(pv.y), a0[3]);
                        a1[0] = fmaf(w, bflo(pv.z), a1[0]); a1[1] = fmaf(w, bfhi(pv.z), a1[1]); a1[2] = fmaf(w, bflo(pv.w), a1[2]); a1[3] = fmaf(w, bfhi(pv.w), a1[3]); } }
                const float iw = 1.0f / W; a0 = a0 * iw; a1 = a1 * iw; oa[ps][0] = a0; oa[ps][1] = a1;
                ssb += (a0[0] * a0[0] + a0[1] * a0[1]) + (a0[2] * a0[2] + a0[3] * a0[3]) + (a1[0] * a1[0] + a1[1] * a1[1]) + (a1[2] * a1[2] + a1[3] * a1[3]); }
            v4u w[2]; float ssa = 0.f;
#pragma unroll
            for (int j = 0; j < 2; ++j) { w[j] = *(const v4u*)(OMIX + (size_t)r * DM + j * 512 + lane * 8);
                ssa += bflo(w[j].x) * bflo(w[j].x) + bfhi(w[j].x) * bfhi(w[j].x) + bflo(w[j].y) * bflo(w[j].y) + bfhi(w[j].y) * bfhi(w[j].y) + bflo(w[j].z) * bflo(w[j].z) + bfhi(w[j].z) * bfhi(w[j].z) + bflo(w[j].w) * bflo(w[j].w) + bfhi(w[j].w) * bfhi(w[j].w); }
            const float r0 = 1.0f / sqrtf(wave_sum(ssa) * (1.0f / MW) + RMS_EPS), r1 = 1.0f / sqrtf(wave_sum(ssb) * (1.0f / MW) + RMS_EPS);
#pragma unroll
            for (int j = 0; j < 2; ++j) { v4u o;
                o.x = cvt_pk_bf16(bflo(w[j].x) * r0, bfhi(w[j].x) * r0); o.y = cvt_pk_bf16(bflo(w[j].y) * r0, bfhi(w[j].y) * r0); o.z = cvt_pk_bf16(bflo(w[j].z) * r0, bfhi(w[j].z) * r0); o.w = cvt_pk_bf16(bflo(w[j].w) * r0, bfhi(w[j].w) * r0);
                *(v4u*)(OMIX + (size_t)r * DM + j * 512 + lane * 8) = o; }
#pragma unroll
            for (int ps = 0; ps < 2; ++ps) { const f32x4 a0 = oa[ps][0] * r1, a1 = oa[ps][1] * r1; v4u o; o.x = cvt_pk_bf16(a0[0], a0[1]); o.y = cvt_pk_bf16(a0[2], a0[3]); o.z = cvt_pk_bf16(a1[0], a1[1]); o.w = cvt_pk_bf16(a1[2], a1[3]);
                *(v4u*)(OMIX + (size_t)r * DM + MW + (ps * 4 + hl) * 128 + col8) = o; } }
    }
    SEAM(7);

    if (IN(8)) for (int rep_ = 0; rep_ < REPS(8); ++rep_) { KArgs ka = kargs(); GAS unsigned char* ws = opq(ka->ws);
        pg8::Gemm g{OMIX, WO, DM * 2, DM * 2, DM * 2, 0, nullptr}; pg8::StaticOrder S; S.init(T, DM, G, bid); pg8::EpiResBf16 E{XB, (bf16*)X1P, DM};
        const bool bg_first = ((bid >> 3) & 1) == 0;
        if (bg_first) bg_rounds(ka, ws, BG_P6, BG_P8, gw, NGW, lane_id());
        pg8::gemm_phase<pg8::EpiResBf16, pg8::StaticOrder>(L, g, S, E, wave, pt_acc);
        if (!bg_first) bg_rounds(ka, ws, BG_P6, BG_P8, gw, NGW, lane_id());
    }
    SEAM(8);

    if (IN(9)) for (int rep_ = 0; rep_ < REPS(9); ++rep_) { KArgs ka = kargs(); GAS unsigned char* ws = opq(ka->ws); const int lane = lane_id(), tid = wave * 64 + lane, gt = bid * 512 + tid; (void)gt;
        LAS float* part = (LAS float*)L;
        LAS float* lg = (LAS float*)(L + 32768);
        LAS unsigned* lcnt = (LAS unsigned*)(L + 40960);
        LAS int* rowl = (LAS int*)(L + 41472);
        if (tid < 64) lcnt[tid] = 0u;
        for (int rg = bid; rg < T / 32; rg += G) { const int R0 = rg * 32;
            for (int rr = 0; rr < 4; ++rr) { const int r = R0 + wave * 4 + rr; f32x4 v[8]; float s = 0.f;
#pragma unroll
                for (int j = 0; j < 8; ++j) { const v2u w = *(const v2u*)((const bf16*)X1P + (size_t)r * DM + j * 256 + lane * 4); v[j] = (f32x4){bflo(w.x), bfhi(w.x), bflo(w.y), bfhi(w.y)}; s += (v[j][0] + v[j][1]) + (v[j][2] + v[j][3]); }
                const float mean = wave_sum(s) * (1.0f / DM); float q = 0.f;
#pragma unroll
                for (int j = 0; j < 8; ++j) { v[j] = v[j] - mean; q += (v[j][0] * v[j][0] + v[j][1] * v[j][1]) + (v[j][2] * v[j][2] + v[j][3] * v[j][3]); }
                const float rstd = 1.0f / sqrtf(wave_sum(q) * (1.0f / DM) + LN_EPS);
#pragma unroll
                for (int j = 0; j < 8; ++j) { const int c = j * 256 + lane * 4; const f32x4 gg = *(const f32x4*)(((const float*)(GAS const float*)ka->ln1_g) + c), bb = *(const f32x4*)(((const float*)(GAS const float*)ka->ln1_b) + c);
                    const f32x4 y = v[j] * rstd * gg + bb; *(v2u*)(X1N + (size_t)r * DM + c) = pg8::pk4_bf16(y);
                    *(unsigned*)(X1B + (size_t)r * DM + c) = pk4_fp8(y[0] * SC_X, y[1] * SC_X, y[2] * SC_X, y[3] * SC_X); } }
            VM_WAIT(); __syncthreads();
            { f32x16 acc = f32x16{}; const int hh = lane >> 5, li = lane & 31;
              const bf16* ap = X1N + (size_t)(R0 + li) * DM + wave * 256 + 4 * hh; const float* bp = ((const float*)(GAS const float*)ka->w_router) + (size_t)(wave * 256 + 4 * hh) * NE + li;
#pragma unroll 8
              for (int kk = 0; kk < 32; ++kk) { const v2u aw = *(const v2u*)(ap + kk * 8); const f32x4 av = {bflo(aw.x), bfhi(aw.x), bflo(aw.y), bfhi(aw.y)}; const float* b = bp + (size_t)kk * 8 * NE;
                  acc = __builtin_amdgcn_mfma_f32_32x32x2f32(av[0], b[0], acc, 0, 0, 0); acc = __builtin_amdgcn_mfma_f32_32x32x2f32(av[1], b[NE], acc, 0, 0, 0);
                  acc = __builtin_amdgcn_mfma_f32_32x32x2f32(av[2], b[2 * NE], acc, 0, 0, 0); acc = __builtin_amdgcn_mfma_f32_32x32x2f32(av[3], b[3 * NE], acc, 0, 0, 0); }
#pragma unroll
              for (int r = 0; r < 16; ++r) part[(wave * 32 + at::crow(r, hh)) * 32 + li] = acc[r]; }
            __syncthreads();
            for (int i = tid; i < 1024; i += 512) { float s = ((const float*)(GAS const float*)ka->b_router)[i & 31];
#pragma unroll
                for (int w = 0; w < 8; ++w) s += part[w * 1024 + i];
                lg[(i >> 5) * 33 + (i & 31)] = s; }
            __syncthreads();
            if (tid < 32) { float v[32];
#pragma unroll
                for (int e = 0; e < 32; ++e) v[e] = lg[tid * 33 + e];
                float tv[4]; int ti[4];
#pragma unroll
                for (int k = 0; k < 4; ++k) { float best = -__builtin_inff(); int bi = 0;
#pragma unroll
                    for (int e = 0; e < 32; ++e) { if (v[e] > best) { best = v[e]; bi = e; } }
                    tv[k] = best; ti[k] = bi;
#pragma unroll
                    for (int e = 0; e < 32; ++e) if (e == bi) v[e] = -__builtin_inff(); }
                const float e1 = __expf(tv[1] - tv[0]), e2 = __expf(tv[2] - tv[0]), e3 = __expf(tv[3] - tv[0]); const float inv = 1.0f / (1.0f + e1 + e2 + e3);
                const float gk[4] = {inv, e1 * inv, e2 * inv, e3 * inv}; const int r = R0 + tid;
                unsigned lr[4];
#pragma unroll
                for (int k = 0; k < 4; ++k) { lr[k] = __hip_atomic_fetch_add((LAS unsigned*)&lcnt[ti[k]], 1u, __ATOMIC_RELAXED, __HIP_MEMORY_SCOPE_WORKGROUP);
                    }
                asm volatile("s_waitcnt lgkmcnt(0)" ::: "memory");
                const unsigned mine = lcnt[tid]; const unsigned base = mine ? __hip_atomic_fetch_add((unsigned*)(ctl + CW_COUNT + tid * 64), mine, RLX_AGENT) : 0u;
                lcnt[32 + tid] = base; lcnt[tid] = 0u;
                asm volatile("s_waitcnt lgkmcnt(0)" ::: "memory");
#pragma unroll
                for (int k = 0; k < 4; ++k) { const int row = ti[k] * ECAP + (int)(lr[k] + lcnt[32 + ti[k]]); TOPROW[r * 4 + k] = row; RGATE[row] = gk[k]; rowl[tid * 4 + k] = row; if (MOE_GATHER) ROWTOK[row] = r; } }
            __syncthreads();
#pragma unroll 1
            for (int tt = 0; tt < (MOE_GATHER ? 0 : 4); ++tt) { const int tk = wave * 4 + tt; const v4u* src = (const v4u*)(X1B + (size_t)(R0 + tk) * DM); const v4u s0 = src[lane], s1 = src[64 + lane];
#pragma unroll
                for (int k = 0; k < 4; ++k) { v4u* dst = (v4u*)(XG + (size_t)rowl[tk * 4 + k] * DM); dst[lane] = s0; dst[64 + lane] = s1; } }
            __syncthreads();
        }
    }
    SEAM(9);


    if (IN(11)) for (int rep_ = 0; rep_ < REPS(11); ++rep_) { KArgs ka = kargs(); GAS unsigned char* ws = opq(ka->ws);
        LAS unsigned* te = (LAS unsigned*)(L + LDSCTL_OFF + 64);
        { const int i_ = wave * 64 + lane_id();
          if (i_ < NE) { const int c_ = (int)__hip_atomic_load((unsigned*)(ctl + CW_COUNT + i_ * 64), RLX_AGENT), nt_ = (c_ + 255) >> 8; int incl = nt_;
#pragma unroll
              for (int off = 1; off < 32; off <<= 1) { const int o_ = __shfl_up(incl, off); if (i_ >= off) incl += o_; }
              for (int t_ = 0; t_ < nt_; ++t_) te[incl - nt_ + t_] = (unsigned)i_ | ((unsigned)t_ << 8);
              if (i_ == NE - 1) te[MAXRT_TAB] = (unsigned)incl; } }
        __syncthreads();
        const int n_rt = (int)__builtin_amdgcn_readfirstlane((int)te[MAXRT_TAB]);
        LAS unsigned* tk = (LAS unsigned*)(L + pg8::EG_OFF);
        pg8::Gemm g{MOE_GATHER ? (const void*)X1B : (const void*)XG, WGU, DM, DM, DM, (size_t)2 * DFF * DM, tk}; pg8::MoeOrder S{te, n_rt, 4, G, bid};
        LAS float* eb = (LAS float*)(L + pg8::EB_OFF);
        { const int tid_ = wave * 64 + lane_id(), j_ = tid_ & 255; const float* bgu_ = ((const float*)(GAS const float*)ka->b_gate_up);
          for (int i_ = tid_ >> 8; i_ < pg8::EB_CAP && i_ * G + bid < (n_rt << 4); i_ += 2) { const int L_ = i_ * G + bid, e_ = (int)(te[L_ >> 4] & 255u), pn_ = L_ & 15;
              eb[i_ * 256 + j_] = bgu_[(size_t)e_ * (2 * DFF) + (j_ < 128 ? pn_ * 128 + j_ : DFF + pn_ * 128 + (j_ - 128))];
              if (MOE_GATHER) { const int tl_ = (int)(te[L_ >> 4] >> 8), cnt_ = (int)__hip_atomic_load((unsigned*)(ctl + CW_COUNT + e_ * 64), RLX_AGENT), row_ = tl_ * 256 + j_;
                  tk[i_ * 256 + j_] = row_ < cnt_ ? (unsigned)ROWTOK[e_ * ECAP + row_] * (unsigned)DM : 0u; } } }
        __syncthreads();
        pg8::EpiSwiglu E{ACT, eb};
        pg8::gemm_phase<pg8::EpiSwiglu, pg8::MoeOrder, true, true, true, (PROBE_GEMM / 10 == 11 ? PROBE_GEMM % 10 : 0), (MOE_GATHER != 0)>(L, g, S, E, wave, pt_acc);
        if (PROBE_HOT == 11) { LAS unsigned* te2 = (LAS unsigned*)(L + 155648); for (int i_ = wave * 64 + lane_id(); i_ < MAXRT_TAB; i_ += 512) te2[i_] = 0u; __syncthreads();
            pg8::MoeOrder S2{te2, n_rt, 4, G, bid}; pg8::EpiSwiglu E2{(unsigned char*)ws + WS_END, eb};
            pg8::gemm_phase<pg8::EpiSwiglu, pg8::MoeOrder, true, true, true, 0, (MOE_GATHER != 0)>(L, g, S2, E2, wave, pt_acc); }
    }
    SEAM(11);

    if (IN(12)) for (int rep_ = 0; rep_ < REPS(12); ++rep_) { KArgs ka = kargs(); GAS unsigned char* ws = opq(ka->ws);
        LAS unsigned* te = (LAS unsigned*)(L + LDSCTL_OFF + 64);
        { const int i_ = wave * 64 + lane_id();
          if (i_ < NE) { const int c_ = (int)__hip_atomic_load((unsigned*)(ctl + CW_COUNT + i_ * 64), RLX_AGENT), nt_ = (c_ + 255) >> 8; int incl = nt_;
#pragma unroll
              for (int off = 1; off < 32; off <<= 1) { const int o_ = __shfl_up(incl, off); if (i_ >= off) incl += o_; }
              const int tot_ = __shfl(incl, NE - 1);
              for (int t_ = 0; t_ < nt_; ++t_) te[MOE_REV12 ? tot_ - 1 - (incl - nt_ + t_) : incl - nt_ + t_] = (unsigned)i_ | ((unsigned)t_ << 8);
              if (i_ == NE - 1) te[MAXRT_TAB] = (unsigned)incl; } }
        __syncthreads();
        const int n_rt = (int)__builtin_amdgcn_readfirstlane((int)te[MAXRT_TAB]);
        pg8::Gemm g{ACT, WD, DFF, DFF, DFF, (size_t)DM * DFF, nullptr}; pg8::MoeOrder S{te, n_rt, 3, G, bid};
        LAS float* eb = (LAS float*)(L + pg8::EB_OFF); LAS float* eg = (LAS float*)(L + pg8::EG_OFF);
        { const int tid_ = wave * 64 + lane_id(), j_ = tid_ & 255; const float* bd_ = ((const float*)(GAS const float*)ka->b_down);
          for (int i_ = tid_ >> 8; i_ < pg8::EG_CAP && i_ * G + bid < (n_rt << 3); i_ += 2) { const int L_ = i_ * G + bid, ent_ = (int)te[L_ >> 3], e_ = ent_ & 255, pn_ = L_ & 7, pm_ = e_ * (ECAP / 256) + (ent_ >> 8);
              eb[i_ * 256 + j_] = bd_[(size_t)e_ * DM + pn_ * 256 + j_]; eg[i_ * 256 + j_] = RGATE[(size_t)pm_ * 256 + j_]; } }
        __syncthreads();
        pg8::EpiDown E{YB, eb, eg};
        pg8::gemm_phase<pg8::EpiDown, pg8::MoeOrder, true, true, true, (PROBE_GEMM / 10 == 12 ? PROBE_GEMM % 10 : 0)>(L, g, S, E, wave, pt_acc);
        if (PROBE_HOT == 12) { LAS unsigned* te2 = (LAS unsigned*)(L + 155648); for (int i_ = wave * 64 + lane_id(); i_ < MAXRT_TAB; i_ += 512) te2[i_] = 0u; __syncthreads();
            pg8::MoeOrder S2{te2, n_rt, 3, G, bid}; pg8::EpiDown E2{(unsigned char*)ws + WS_END, eb, eg};
            pg8::gemm_phase<pg8::EpiDown, pg8::MoeOrder, true>(L, g, S2, E2, wave, pt_acc); }
    }
    SEAM(12);

    if (IN(13)) for (int rep_ = 0; rep_ < REPS(13); ++rep_) { KArgs ka = kargs(); GAS unsigned char* ws = opq(ka->ws); const int lane = lane_id(), tid = wave * 64 + lane, gt = bid * 512 + tid; (void)gt;
        for (int t = gw; t < T; t += NGW) { int rows[4];
#pragma unroll
            for (int k = 0; k < 4; ++k) rows[k] = TOPROW[t * 4 + k];
            f32x4 v[2][4]; float s = 0.f;
#pragma unroll
            for (int j = 0; j < 2; ++j) { const int c = j * 1024 + lane * 16;
                { const v4u xa = *(const v4u*)(X1N + (size_t)t * DM + c), xb = *(const v4u*)(X1N + (size_t)t * DM + c + 8);
                  v[j][0] = (f32x4){bflo(xa.x), bfhi(xa.x), bflo(xa.y), bfhi(xa.y)} * ALPHA; v[j][1] = (f32x4){bflo(xa.z), bfhi(xa.z), bflo(xa.w), bfhi(xa.w)} * ALPHA;
                  v[j][2] = (f32x4){bflo(xb.x), bfhi(xb.x), bflo(xb.y), bfhi(xb.y)} * ALPHA; v[j][3] = (f32x4){bflo(xb.z), bfhi(xb.z), bflo(xb.w), bfhi(xb.w)} * ALPHA; }
#pragma unroll
                for (int k = 0; k < 4; ++k) { const v4u w = *(const v4u*)(YB + (size_t)rows[k] * DM + c); const unsigned wd[4] = {w.x, w.y, w.z, w.w};
#pragma unroll
                    for (int i = 0; i < 4; ++i) { const auto lo2 = __builtin_amdgcn_cvt_pk_f32_fp8((int)wd[i], false), hi2 = __builtin_amdgcn_cvt_pk_f32_fp8((int)wd[i], true);
                        v[j][i][0] += lo2[0] * (1.0f / SC_Y); v[j][i][1] += lo2[1] * (1.0f / SC_Y); v[j][i][2] += hi2[0] * (1.0f / SC_Y); v[j][i][3] += hi2[1] * (1.0f / SC_Y); } }
#pragma unroll
                for (int i = 0; i < 4; ++i) s += (v[j][i][0] + v[j][i][1]) + (v[j][i][2] + v[j][i][3]); }
            const float mean = wave_sum(s) * (1.0f / DM); float q = 0.f;
#pragma unroll
            for (int j = 0; j < 2; ++j)
#pragma unroll
                for (int i = 0; i < 4; ++i) { v[j][i] = v[j][i] - mean; q += (v[j][i][0] * v[j][i][0] + v[j][i][1] * v[j][i][1]) + (v[j][i][2] * v[j][i][2] + v[j][i][3] * v[j][i][3]); }
            const float rstd = 1.0f / sqrtf(wave_sum(q) * (1.0f / DM) + LN_EPS);
#pragma unroll
            for (int j = 0; j < 2; ++j)
#pragma unroll
                for (int i = 0; i < 4; ++i) { const int c = j * 1024 + lane * 16 + 4 * i; const f32x4 gg = *(const f32x4*)(((const float*)(GAS const float*)ka->ln2_g) + c), bb = *(const f32x4*)(((const float*)(GAS const float*)ka->ln2_b) + c);
                    *(f32x4*)(((float*)(GAS float*)ka->out) + (size_t)t * DM + c) = v[j][i] * rstd * gg + bb; } }
    }
    PT_MARK(13);
    if (PROBE_NRT && bid == 0) { const int n_ = (int)__builtin_amdgcn_readfirstlane((int)((LAS unsigned*)(L + LDSCTL_OFF + 64))[MAXRT_TAB]); const unsigned long long t_end = __builtin_amdgcn_s_memrealtime() + (unsigned long long)(n_ - 128) * 2000ull; while (__builtin_amdgcn_s_memrealtime() < t_end) __builtin_amdgcn_s_sleep(8); }
    if ((PROBE_TIME_MASK || PROBE_GEMM) && bid == 0) { const unsigned long long t_end = __builtin_amdgcn_s_memrealtime() + pt_acc; while (__builtin_amdgcn_s_memrealtime() < t_end) __builtin_amdgcn_s_sleep(8); }
#undef IN
#undef SEAM
}

extern "C" void kernel_launch(void* const* d_in, const int* in_sizes, int n_in, void* d_out, int out_size, void* d_ws, size_t ws_size, hipStream_t stream) {
    static int grid = 0;
    if (grid == 0) {
        if (n_in != 20 || in_sizes[0] != T * DM || out_size != T * DM || ws_size < WS_END) { fprintf(stderr, "kernel_launch: unexpected shapes (n_in %d, in0 %d, out %d, ws %zu < %zu)\n", n_in, n_in > 0 ? in_sizes[0] : -1, out_size, ws_size, (size_t)WS_END); grid = -1; return; }
        int dev = 0, cus = 0, per_cu = 0;
        if (hipGetDevice(&dev) != hipSuccess || hipDeviceGetAttribute(&cus, hipDeviceAttributeMultiprocessorCount, dev) != hipSuccess) { grid = -1; return; }
        if (hipFuncSetAttribute((const void*)fwd, hipFuncAttributeMaxDynamicSharedMemorySize, LDS_BYTES) != hipSuccess) { fprintf(stderr, "kernel_launch: hipFuncSetAttribute failed\n"); grid = -1; return; }
        if (hipOccupancyMaxActiveBlocksPerMultiprocessor(&per_cu, (const void*)fwd, 512, LDS_BYTES) != hipSuccess || per_cu < 1) fprintf(stderr, "kernel_launch: occupancy query says %d\n", per_cu);
        (void)hipGetLastError();
        grid = cus;
    }
    if (grid < 0) return;
    (void)hipMemsetAsync((char*)d_ws + WS_CTL, 0, CTL_ZERO_BYTES, stream);
    Args a{};
    a.x = (const float*)d_in[0]; a.pos = (const int*)d_in[1]; a.w_in = (const float*)d_in[2]; a.g_q_a = (const float*)d_in[3]; a.w_q_b = (const float*)d_in[4];
    a.g_kv_a = (const float*)d_in[5]; a.w_kv_b = (const float*)d_in[6]; a.g_out_mla = (const float*)d_in[7]; a.g_out_moba = (const float*)d_in[8]; a.w_o = (const float*)d_in[9];
    a.ln1_g = (const float*)d_in[10]; a.ln1_b = (const float*)d_in[11]; a.w_router = (const float*)d_in[12]; a.b_router = (const float*)d_in[13];
    a.w_gate_up = (const float*)d_in[14]; a.b_gate_up = (const float*)d_in[15]; a.w_down = (const float*)d_in[16]; a.b_down = (const float*)d_in[17];
    a.ln2_g = (const float*)d_in[18]; a.ln2_b = (const float*)d_in[19];
    a.out = (float*)d_out; a.ws = (unsigned char*)d_ws;
    if (MK_N_LAUNCHES == 1) { a.ph_lo = 0; a.ph_hi = NPHASES; hipLaunchKernelGGL(fwd, dim3(grid), dim3(512), LDS_BYTES, stream, a); }
    else { for (int p = 0; p < NPHASES; ++p) { a.ph_lo = p; a.ph_hi = p + 1; hipLaunchKernelGGL(fwd, dim3(grid), dim3(512), LDS_BYTES, stream, a); } }
    const hipError_t le = hipPeekAtLastError();
    if (le != hipSuccess) fprintf(stderr, "kernel_launch: launch failed: %s\n", hipGetErrorName(le));
}
```

```cpp
#include <hip/hip_runtime.h>
#include <cstdio>
#include <cstdint>

#ifndef PROBE_REP_MASK
#define PROBE_REP_MASK 0
#endif
#ifndef PROBE_DUP
#define PROBE_DUP 0
#endif
#ifndef PROBE_GEMM
#define PROBE_GEMM 0
#endif
#ifndef MOE_GATHER
#define MOE_GATHER 1
#endif
#ifndef PROBE_HOT
#define PROBE_HOT 0
#endif
#ifndef PROBE_NRT
#define PROBE_NRT 0
#endif
#ifndef PROBE_TIME_MASK
#define PROBE_TIME_MASK 0
#endif
#ifndef MK_N_LAUNCHES
#define MK_N_LAUNCHES 1
#endif

constexpr int T = 8192, DM = 2048, NH = 8;
constexpr int QLORA = 512, KVLORA = 256, ROPE = 64, NOPE = 128, VH = 128, QKH = NOPE + ROPE;
constexpr int MW = 1024;
constexpr int INC = 3904, INP = 4096;
constexpr int NE = 32, TOPK = 4, DFF = 2048;
constexpr int ECAP = T;
constexpr int MAXROWS = NE * ECAP;
constexpr int MAXRT_TAB = T * TOPK / 256 + NE;
constexpr float ALPHA = 1.189207115002721f;
constexpr float RMS_EPS = 1e-6f, LN_EPS = 1e-5f;

#define GAS __attribute__((address_space(1)))
#define LAS __attribute__((address_space(3)))
typedef unsigned short bf16;
typedef unsigned v4u __attribute__((ext_vector_type(4)));
typedef unsigned v2u __attribute__((ext_vector_type(2)));
typedef float f32x4 __attribute__((ext_vector_type(4)));
typedef float f32x2 __attribute__((ext_vector_type(2)));
typedef float f32x16 __attribute__((ext_vector_type(16)));
typedef short bf16x8 __attribute__((ext_vector_type(8)));
typedef short s16x4 __attribute__((ext_vector_type(4)));
typedef GAS unsigned gu32;
#define RLX_AGENT __ATOMIC_RELAXED, __HIP_MEMORY_SCOPE_AGENT
#define LDS_WAIT() asm volatile("s_waitcnt lgkmcnt(0)" ::: "memory")
#define VM_WAIT() asm volatile("s_waitcnt vmcnt(0)" ::: "memory")
#define SBAR() __builtin_amdgcn_sched_barrier(0)

__device__ __forceinline__ unsigned cvt_pk_bf16(float lo, float hi) { unsigned r; asm volatile("v_cvt_pk_bf16_f32 %0, %1, %2" : "=v"(r) : "v"(lo), "v"(hi)); return r; }
__device__ __forceinline__ float bf2f(unsigned short b) { return __uint_as_float(((unsigned)b) << 16); }
__device__ __forceinline__ float bflo(unsigned w) { return __uint_as_float(w << 16); }
__device__ __forceinline__ float bfhi(unsigned w) { return __uint_as_float(w & 0xffff0000u); }
__device__ __forceinline__ unsigned short f2bf(float f) { return (unsigned short)(cvt_pk_bf16(f, f) & 0xffffu); }
__device__ __forceinline__ unsigned pk4_fp8(float a, float b, float c, float d) { int w = 0; w = __builtin_amdgcn_cvt_pk_fp8_f32(a, b, w, false); w = __builtin_amdgcn_cvt_pk_fp8_f32(c, d, w, true); return (unsigned)w; }
typedef short v2s_t __attribute__((ext_vector_type(2)));
__device__ __forceinline__ unsigned pk4_fp8s(float a, float b, float c, float d, float sc) { v2s_t w = {0, 0}; w = __builtin_amdgcn_cvt_scalef32_pk_fp8_f32(w, a, b, sc, false); w = __builtin_amdgcn_cvt_scalef32_pk_fp8_f32(w, c, d, sc, true); return __builtin_bit_cast(unsigned, w); }
typedef int v4i __attribute__((ext_vector_type(4)));
typedef int v8i __attribute__((ext_vector_type(8)));
__device__ __forceinline__ v8i cat8(bf16x8 a, bf16x8 b) { const v4i x = __builtin_bit_cast(v4i, a), y = __builtin_bit_cast(v4i, b); return __builtin_shufflevector(x, y, 0, 1, 2, 3, 4, 5, 6, 7); }
__device__ __forceinline__ int lane_id() { int l; asm volatile("v_mbcnt_lo_u32_b32 %0, -1, 0\n\tv_mbcnt_hi_u32_b32 %0, -1, %0" : "=v"(l)); return l; }
__device__ __forceinline__ float wave_sum(float v) {
#pragma unroll
    for (int o = 1; o < 64; o <<= 1) v += __shfl_xor(v, o);
    return v;
}

constexpr size_t MiB = 1u << 20;
constexpr size_t WS_CTL = 0, CTL_ZERO_BYTES = 1 * MiB;
constexpr size_t WS_XB    = 2 * MiB;
constexpr size_t WS_WIN   = WS_XB + 32 * MiB;
constexpr size_t WS_WQB   = WS_WIN + 16 * MiB;
constexpr size_t WS_WKVB  = WS_WQB + 2 * MiB;
constexpr size_t WS_WO    = WS_WKVB + 1 * MiB;
constexpr size_t WS_C128  = WS_WO + 8 * MiB;
constexpr size_t WS_S128  = WS_C128 + 2 * MiB;
constexpr size_t WS_C64   = WS_S128 + 2 * MiB;
constexpr size_t WS_S64   = WS_C64 + 1 * MiB;
constexpr size_t WS_HQ    = WS_S64 + 1 * MiB;
constexpr size_t WS_HKV   = WS_HQ + 8 * MiB;
constexpr size_t WS_HR    = WS_HKV + 4 * MiB;
constexpr size_t WS_KPE   = WS_HR + 4 * MiB;
constexpr size_t WS_MQ    = WS_KPE + 1 * MiB;
constexpr size_t WS_MK    = WS_MQ + 16 * MiB;
constexpr size_t WS_MV    = WS_MK + 16 * MiB;
constexpr size_t WS_RSQ   = WS_MV + 16 * MiB;
constexpr size_t WS_RSKV  = WS_RSQ + 1 * MiB;
constexpr size_t WS_QM    = WS_RSKV + 1 * MiB;
constexpr size_t WS_KVM   = WS_QM + 24 * MiB;
constexpr size_t WS_KBAR  = WS_KVM + 32 * MiB;
constexpr size_t WS_SEL   = WS_KBAR + 1 * MiB;
constexpr size_t WS_OMIX  = WS_SEL + 1 * MiB;
constexpr size_t WS_X1P   = WS_OMIX + 32 * MiB;
constexpr size_t WS_X1N   = WS_X1P + 64 * MiB;
constexpr size_t WS_X1B   = WS_X1N + 64 * MiB;
constexpr size_t WS_TOPE  = WS_X1B + 32 * MiB;
constexpr size_t WS_TOPR  = WS_TOPE + 1 * MiB;
constexpr size_t WS_TOPG  = WS_TOPR + 1 * MiB;
constexpr size_t WS_TOPROW= WS_TOPG + 1 * MiB;
constexpr size_t WS_RGATE = WS_TOPROW + 1 * MiB;
constexpr size_t WS_XG    = WS_RGATE + 1 * MiB;
constexpr size_t WS_ACT   = WS_XG + 512 * MiB;
constexpr size_t WS_Y     = WS_ACT + 512 * MiB;
constexpr size_t WS_WGU   = WS_Y + 512 * MiB;
constexpr size_t WS_WD    = WS_WGU + 256 * MiB;
constexpr size_t WS_LIST  = WS_WD + 128 * MiB;
constexpr size_t WS_PO    = WS_LIST + 8 * MiB;
constexpr size_t WS_PL    = WS_PO + 64 * MiB;
constexpr size_t WS_SSP   = WS_PL + 1 * MiB;
constexpr size_t WS_KSP   = WS_SSP + 1 * MiB;
constexpr size_t WS_END   = WS_KSP + 1 * MiB;
constexpr float SC_X = 16.0f, SC_WGU = 512.0f, SC_ACT = 4.0f, SC_WD = 1024.0f, SC_Y = 32.0f;
constexpr int CW_BAR = 4096;
constexpr int CW_COUNT = 65536;
constexpr int CW_TILEE = 16384 + 64;
constexpr int CW_NRT = 16384 + 64 + 192;
constexpr int CW_MCNT = 32768;
constexpr int CW_QHEAD = 20480;

constexpr int LDS_BYTES = 159744;
constexpr int LDSCTL_OFF = 158720;

namespace pg8 {
constexpr int EB_OFF = 131072, EB_CAP = 12, EG_OFF = EB_OFF + EB_CAP * 1024, EG_CAP = 12;
constexpr int BM = 256, BK = 64, HALF = 128, HTB = HALF * BK * 2, STAGE_BYTES = 8 * HTB, NXCD = 8, WGM = 8;
__host__ __device__ __forceinline__ int lds_byte(int r, int c) { const int st = (r >> 4) * 2 + (c >> 5), rr = r & 15, cc = c & 31, ob = rr * 64 + cc * 2; return st * 1024 + (ob ^ (((ob >> 9) & 1) << 5)); }
__host__ __device__ __forceinline__ void stage_rc(int b, int& R, int& C) { const int st = b / 1024, sb = b % 1024, swz = sb ^ (((sb >> 9) & 1) << 5); R = (st >> 1) * 16 + swz / 64; C = (st & 1) * 32 + (swz % 64) / 2; }
__host__ __device__ __forceinline__ int perm32(int rho) { const int n = rho >> 4, i = rho & 15; return 8 * (i >> 2) + 4 * n + (i & 3); }

struct Unit { int pm, pn, e, i; };
struct Gemm { const void* A; const void* Bt; int Kb, lda, ldb; size_t bes; const LAS unsigned* tk; };

struct StaticOrder {
    int nM, nN, nwg, G, c;
    __device__ void init(int M, int N, int G_, int c_) { nM = M / BM; nN = N / BM; nwg = nM * nN; G = G_; c = c_; }
    __device__ bool next(int i, Unit& u) const {
        const long L = (long)i * G + c; if (L >= nwg) return false;
        int wgid = (int)L; { const int q = nwg / NXCD, r = nwg % NXCD, xcd = wgid % NXCD, off = wgid / NXCD; wgid = (xcd < r ? xcd * (q + 1) : r * (q + 1) + (xcd - r) * q) + off; }
        const int nig = WGM * nN, gid = wgid / nig, fm = gid * WGM, gsz = (nM - fm) < WGM ? (nM - fm) : WGM;
        u.pm = fm + ((wgid % nig) % gsz); u.pn = (wgid % nig) / gsz; u.e = 0; u.i = i; return true;
    }
};
struct MoeOrder {
    const LAS unsigned* tile_e; int n_rt, lnpn, G, c;
    __device__ bool next(int i, Unit& u) const {
        const int L = i * G + c; if (L >= (n_rt << lnpn)) return false;
        const int rt = L >> lnpn; u.pn = L - (rt << lnpn);
        const int ent = (int)__builtin_amdgcn_readfirstlane((int)tile_e[rt]); u.e = ent & 255; u.pm = u.e * (ECAP / 256) + (ent >> 8); u.i = i; return true;
    }
};

typedef f32x4 Acc[2][2][4][2];

__device__ __forceinline__ void rope4(const f32x4 v0, const f32x4 v1, const f32x4 c, const f32x4 s, f32x4& o1, f32x4& o2) {
    o1[0] = v0[0] * c[0] - v0[1] * s[0]; o2[0] = v0[1] * c[0] + v0[0] * s[0];
    o1[1] = v0[2] * c[1] - v0[3] * s[1]; o2[1] = v0[3] * c[1] + v0[2] * s[1];
    o1[2] = v1[0] * c[2] - v1[1] * s[2]; o2[2] = v1[1] * c[2] + v1[0] * s[2];
    o1[3] = v1[2] * c[3] - v1[3] * s[3]; o2[3] = v1[3] * c[3] + v1[2] * s[3];
}
__device__ __forceinline__ v2u pk4_bf16(const f32x4 v) { v2u w; w.x = cvt_pk_bf16(v[0], v[1]); w.y = cvt_pk_bf16(v[2], v[3]); return w; }
struct EpiInProj {
    static constexpr bool PERM = true;
    unsigned char* ws;
    __device__ __forceinline__ void operator()(const Acc& acc, const Unit& u, int wr, int wc, int fr, int fq) const {
        const int pn = u.pn; const int row0 = u.pm * BM + wr * 64 + fr, ct0 = wc * 32 + 8 * fq;
        if (pn < 3) {
            bf16* base = (bf16*)(ws + (pn < 2 ? WS_HQ : WS_HKV)); const int ldc = pn < 2 ? 512 : 256, colt = pn == 1 ? 256 : 0;
            float* ss = (float*)(ws + WS_SSP) + (pn < 2 ? pn * 4 + wc : 8 + wc);
#pragma unroll
            for (int ai = 0; ai < 2; ++ai)
#pragma unroll
                for (int m = 0; m < 4; ++m) { const int row = row0 + ai * HALF + m * 16; bf16* rowp = base + (size_t)row * ldc + colt + ct0; float q = 0.f;
#pragma unroll
                    for (int bj = 0; bj < 2; ++bj) { const f32x4 v0 = acc[ai][bj][m][0], v1 = acc[ai][bj][m][1];
                        q += (v0[0] * v0[0] + v0[1] * v0[1]) + (v0[2] * v0[2] + v0[3] * v0[3]) + (v1[0] * v1[0] + v1[1] * v1[1]) + (v1[2] * v1[2] + v1[3] * v1[3]);
                        v4u w; w.x = cvt_pk_bf16(v0[0], v0[1]); w.y = cvt_pk_bf16(v0[2], v0[3]); w.z = cvt_pk_bf16(v1[0], v1[1]); w.w = cvt_pk_bf16(v1[2], v1[3]);
                        *(v4u*)(rowp + bj * HALF) = w; }
                    q += __shfl_xor(q, 16); q += __shfl_xor(q, 32);
                    if (fq == 0) ss[(size_t)row * 16] = q; }
        } else if (pn == 3) {
            if (ct0 < 64) { bf16* KPEp = (bf16*)(ws + WS_KPE); const float* C = (const float*)(ws + WS_C64); const float* S = (const float*)(ws + WS_S64); const int i0 = ct0 >> 1;
                f32x4 cc[2][4], sc[2][4];
#pragma unroll
                for (int ai = 0; ai < 2; ++ai)
#pragma unroll
                    for (int m = 0; m < 4; ++m) { const int row = row0 + ai * HALF + m * 16; cc[ai][m] = *(const f32x4*)(C + row * 32 + i0); sc[ai][m] = *(const f32x4*)(S + row * 32 + i0); }
#pragma unroll
                for (int ai = 0; ai < 2; ++ai)
#pragma unroll
                    for (int m = 0; m < 4; ++m) { const int row = row0 + ai * HALF + m * 16; f32x4 o1, o2;
                        rope4(acc[ai][0][m][0], acc[ai][0][m][1], cc[ai][m], sc[ai][m], o1, o2);
                        *(v2u*)(KPEp + (size_t)row * ROPE + i0) = pk4_bf16(o1); *(v2u*)(KPEp + (size_t)row * ROPE + 32 + i0) = pk4_bf16(o2); } }
        } else if (pn < 8) {
            bf16* base = (bf16*)(ws + WS_MQ); const float* C = (const float*)(ws + WS_C128); const float* S = (const float*)(ws + WS_S128);
            const int i0 = ct0 >> 1, hd0 = ((pn - 4) & 3) * 2;
            f32x4 cc[2][4], sc[2][4];
#pragma unroll
            for (int ai = 0; ai < 2; ++ai)
#pragma unroll
                for (int m = 0; m < 4; ++m) { const int row = row0 + ai * HALF + m * 16; cc[ai][m] = *(const f32x4*)(C + row * 64 + i0); sc[ai][m] = *(const f32x4*)(S + row * 64 + i0); }
            asm volatile("" ::: "memory");
#pragma unroll
            for (int ai = 0; ai < 2; ++ai)
#pragma unroll
                for (int m = 0; m < 4; ++m) { const int row = row0 + ai * HALF + m * 16; const f32x4 c = cc[ai][m], sn = sc[ai][m];
#pragma unroll
                    for (int bj = 0; bj < 2; ++bj) { f32x4 o1, o2; rope4(acc[ai][bj][m][0], acc[ai][bj][m][1], c, sn, o1, o2);
                        bf16* hp = base + (size_t)row * MW + (hd0 + bj) * 128;
                        *(v2u*)(hp + i0) = pk4_bf16(o1); *(v2u*)(hp + 64 + i0) = pk4_bf16(o2); }
                    asm volatile("" ::: "memory"); }
        } else if (pn < 12) {
            bf16* base = (bf16*)(ws + WS_MK); const float* C = (const float*)(ws + WS_C128); const float* S = (const float*)(ws + WS_S128);
            const int i0 = ct0 >> 1, hd0 = ((pn - 8) & 3) * 2;
            f32x4 cs1[2], cs2[2];
#pragma unroll
            for (int bj = 0; bj < 2; ++bj) { cs1[bj] = (f32x4){0.f, 0.f, 0.f, 0.f}; cs2[bj] = (f32x4){0.f, 0.f, 0.f, 0.f}; }
            f32x4 cc[2][4], sc[2][4];
#pragma unroll
            for (int ai = 0; ai < 2; ++ai)
#pragma unroll
                for (int m = 0; m < 4; ++m) { const int row = row0 + ai * HALF + m * 16; cc[ai][m] = *(const f32x4*)(C + row * 64 + i0); sc[ai][m] = *(const f32x4*)(S + row * 64 + i0); }
            asm volatile("" ::: "memory");
#pragma unroll
            for (int ai = 0; ai < 2; ++ai)
#pragma unroll
                for (int m = 0; m < 4; ++m) { const int row = row0 + ai * HALF + m * 16; const f32x4 c = cc[ai][m], sn = sc[ai][m];
#pragma unroll
                    for (int bj = 0; bj < 2; ++bj) { f32x4 o1, o2; rope4(acc[ai][bj][m][0], acc[ai][bj][m][1], c, sn, o1, o2);
                        bf16* hp = base + (size_t)row * MW + (hd0 + bj) * 128;
                        *(v2u*)(hp + i0) = pk4_bf16(o1); *(v2u*)(hp + 64 + i0) = pk4_bf16(o2);
                        cs1[bj] += o1; cs2[bj] += o2; asm volatile("" : "+v"(cs1[bj]), "+v"(cs2[bj])); }
                    asm volatile("" ::: "memory"); }
            float* ks = (float*)(ws + WS_KSP) + wr * (NH * 32 * 128);
#pragma unroll
            for (int bj = 0; bj < 2; ++bj)
#pragma unroll
                for (int k = 0; k < 4; ++k) { float a = cs1[bj][k], b = cs2[bj][k];
#pragma unroll
                    for (int off = 1; off < 16; off <<= 1) { a += __shfl_xor(a, off); b += __shfl_xor(b, off); }
                    if (fr == 0) { float* kp = ks + ((hd0 + bj) * 32 + u.pm) * 128 + i0 + k; kp[0] = a; kp[64] = b; } }
        } else {
            bf16* base = (bf16*)(ws + WS_MV); const int colt = (pn - 12) * 256;
#pragma unroll
            for (int ai = 0; ai < 2; ++ai)
#pragma unroll
                for (int m = 0; m < 4; ++m) { bf16* rowp = base + (size_t)(row0 + ai * HALF + m * 16) * MW + colt + ct0;
#pragma unroll
                    for (int bj = 0; bj < 2; ++bj) { const f32x4 v0 = acc[ai][bj][m][0], v1 = acc[ai][bj][m][1];
                        v4u w; w.x = cvt_pk_bf16(v0[0], v0[1]); w.y = cvt_pk_bf16(v0[2], v0[3]); w.z = cvt_pk_bf16(v1[0], v1[1]); w.w = cvt_pk_bf16(v1[2], v1[3]);
                        *(v4u*)(rowp + bj * HALF) = w; } }
        }
    }
};
template <bool QROPE> struct EpiRowScale {
    static constexpr bool PERM = true;
    bf16* O; int ldc; const float* ss; float inv_k; const float* C; const float* S;
    __device__ __forceinline__ void operator()(const Acc& acc, const Unit& u, int wr, int wc, int fr, int fq) const {
        const int row0 = u.pm * BM + wr * 64 + fr, col0 = u.pn * BM + wc * 32 + 8 * fq;
        float scs[2][4];
#pragma unroll
        for (int ai = 0; ai < 2; ++ai)
#pragma unroll
            for (int m = 0; m < 4; ++m) { const int row = row0 + ai * HALF + m * 16; float sq; { const f32x4 p0 = *(const f32x4*)(ss + (size_t)row * 16); sq = (p0[0] + p0[1]) + (p0[2] + p0[3]); if (QROPE) { const f32x4 p1 = *(const f32x4*)(ss + (size_t)row * 16 + 4); sq += (p1[0] + p1[1]) + (p1[2] + p1[3]); } }
                scs[ai][m] = 1.0f / sqrtf(sq * inv_k + RMS_EPS); }
        asm volatile("" ::: "memory");
        const int w0_ = col0 % QKH, w1_ = (col0 + HALF) % QKH; const bool rl = QROPE && (w0_ >= NOPE || w1_ >= NOPE); const int ir = ((w0_ >= NOPE ? w0_ : w1_) - NOPE) >> 1;
#pragma unroll
        for (int am = 0; am < 4; ++am) { const int ai = am >> 1;
            f32x4 cc[4], sn[4];
            if (rl) {
#pragma unroll
                for (int m = (am & 1) * 2; m < (am & 1) * 2 + 2; ++m) { const int row = row0 + ai * HALF + m * 16; cc[m] = *(const f32x4*)(C + row * 32 + ir); sn[m] = *(const f32x4*)(S + row * 32 + ir); }
            }
#pragma unroll
            for (int m = (am & 1) * 2; m < (am & 1) * 2 + 2; ++m) { const int row = row0 + ai * HALF + m * 16; const float sc = scs[ai][m]; bf16* rowp = O + (size_t)row * ldc;
#pragma unroll
                for (int bj = 0; bj < 2; ++bj) { const int col = col0 + bj * HALF; const f32x4 v0 = acc[ai][bj][m][0] * sc, v1 = acc[ai][bj][m][1] * sc;
                    const int hd = col / QKH, w = col - hd * QKH;
                    if (QROPE && w >= NOPE) { const int i0 = (w - NOPE) >> 1; f32x4 o1, o2; rope4(v0, v1, cc[m], sn[m], o1, o2);
                        *(v2u*)(rowp + hd * QKH + NOPE + i0) = pk4_bf16(o1); *(v2u*)(rowp + hd * QKH + NOPE + 32 + i0) = pk4_bf16(o2); }
                    else { v4u wv; wv.x = cvt_pk_bf16(v0[0], v0[1]); wv.y = cvt_pk_bf16(v0[2], v0[3]); wv.z = cvt_pk_bf16(v1[0], v1[1]); wv.w = cvt_pk_bf16(v1[2], v1[3]);
                        *(v4u*)(rowp + col) = wv; } } } }
    }
};
struct EpiResBf16 {
    static constexpr bool PERM = true;
    const bf16* X; bf16* O; int ldc;
    __device__ __forceinline__ void operator()(const Acc& acc, const Unit& u, int wr, int wc, int fr, int fq) const {
        const int row0 = u.pm * BM + wr * 64 + fr, col0 = u.pn * BM + wc * 32 + 8 * fq;
        v4u xr[2][4][2];
#pragma unroll
        for (int ai = 0; ai < 2; ++ai)
#pragma unroll
            for (int m = 0; m < 4; ++m) { const size_t off = (size_t)(row0 + ai * HALF + m * 16) * ldc + col0;
#pragma unroll
                for (int bj = 0; bj < 2; ++bj) xr[ai][m][bj] = *(const v4u*)(X + off + bj * HALF); }
        asm volatile("" ::: "memory");
#pragma unroll
        for (int ai = 0; ai < 2; ++ai)
#pragma unroll
            for (int m = 0; m < 4; ++m) { const size_t off = (size_t)(row0 + ai * HALF + m * 16) * ldc + col0;
#pragma unroll
                for (int bj = 0; bj < 2; ++bj) { const v4u xv = xr[ai][m][bj]; const f32x4 v0 = acc[ai][bj][m][0], v1 = acc[ai][bj][m][1];
                    v4u w; w.x = cvt_pk_bf16(bflo(xv.x) * ALPHA + v0[0], bfhi(xv.x) * ALPHA + v0[1]); w.y = cvt_pk_bf16(bflo(xv.y) * ALPHA + v0[2], bfhi(xv.y) * ALPHA + v0[3]);
                    w.z = cvt_pk_bf16(bflo(xv.z) * ALPHA + v1[0], bfhi(xv.z) * ALPHA + v1[1]); w.w = cvt_pk_bf16(bflo(xv.w) * ALPHA + v1[2], bfhi(xv.w) * ALPHA + v1[3]);
                    *(v4u*)(O + off + bj * HALF) = w; }
                asm volatile("" ::: "memory"); }
    }
};
struct EpiSwiglu {
    static constexpr bool PERM = true;
    unsigned char* ACT; const LAS float* eb;
    __device__ __forceinline__ void operator()(const Acc& acc, const Unit& u, int wr, int wc, int fr, int fq) const {
        const int row0 = u.pm * BM + wr * 64 + fr, j0 = u.pn * HALF + wc * 32 + 8 * fq;
        const LAS float* bg = eb + (u.i < EB_CAP ? u.i : EB_CAP - 1) * 256 + wc * 32 + 8 * fq; const LAS float* bu = bg + HALF;
        const f32x4 bg0 = *(const LAS f32x4*)bg, bg1 = *(const LAS f32x4*)(bg + 4), bu0 = *(const LAS f32x4*)bu, bu1 = *(const LAS f32x4*)(bu + 4);
        f32x2 ks = {1.0f / (SC_X * SC_WGU), 1.0f / (SC_X * SC_WGU)}, kc = {-1.702f * 1.4426950408889634f, -1.702f * 1.4426950408889634f}, one = {1.0f, 1.0f}, sa = {SC_ACT, SC_ACT};
        asm volatile("" : "+s"(ks), "+s"(kc), "+s"(one), "+s"(sa));
#pragma unroll
        for (int ai = 0; ai < 2; ++ai)
#pragma unroll
            for (int m = 0; m < 4; ++m) { unsigned char* rowp = ACT + (size_t)(row0 + ai * HALF + m * 16) * DFF + j0;
                f32x2 a[4];
#pragma unroll
                for (int n = 0; n < 2; ++n) { const f32x4 ag = acc[ai][0][m][n], au = acc[ai][1][m][n], bgv = n ? bg1 : bg0, buv = n ? bu1 : bu0;
#pragma unroll
                    for (int p = 0; p < 2; ++p) { const f32x2 gv = (f32x2){ag[2 * p], ag[2 * p + 1]} * ks + (f32x2){bgv[2 * p], bgv[2 * p + 1]}, uv = (f32x2){au[2 * p], au[2 * p + 1]} * ks + (f32x2){buv[2 * p], buv[2 * p + 1]};
                        const f32x2 g = {fminf(gv[0], 7.0f), fminf(gv[1], 7.0f)}, uu = {fminf(fmaxf(uv[0], -7.0f), 7.0f), fminf(fmaxf(uv[1], -7.0f), 7.0f)};
                        const f32x2 t = g * kc; const f32x2 d = (f32x2){__builtin_amdgcn_exp2f(t[0]), __builtin_amdgcn_exp2f(t[1])} + one;
                        const f32x2 sg = {__builtin_amdgcn_rcpf(d[0]), __builtin_amdgcn_rcpf(d[1])};
                        a[n * 2 + p] = (uu * sa + sa) * g * sg; } }
                v2u w; w.x = pk4_fp8(a[0][0], a[0][1], a[1][0], a[1][1]); w.y = pk4_fp8(a[2][0], a[2][1], a[3][0], a[3][1]);
                *(v2u*)rowp = w; }
    }
};
struct EpiDown {
    static constexpr bool PERM = true;
    unsigned char* Y; const LAS float* eb; const LAS float* eg;
    __device__ __forceinline__ void operator()(const Acc& acc, const Unit& u, int wr, int wc, int fr, int fq) const {
        const int row0 = u.pm * BM + wr * 64 + fr, col0 = u.pn * BM + wc * 32 + 8 * fq;
        const int sl = (u.i < EG_CAP ? u.i : EG_CAP - 1) * 256;
        const LAS float* bp = eb + sl + wc * 32 + 8 * fq;
        f32x4 bv[2][2];
#pragma unroll
        for (int bj = 0; bj < 2; ++bj)
#pragma unroll
            for (int n = 0; n < 2; ++n) bv[bj][n] = *(const LAS f32x4*)(bp + bj * HALF + 4 * n);
        float rg[2][4];
#pragma unroll
        for (int ai = 0; ai < 2; ++ai)
#pragma unroll
            for (int m = 0; m < 4; ++m) rg[ai][m] = eg[sl + wr * 64 + fr + ai * HALF + m * 16];
#pragma unroll
        for (int ai = 0; ai < 2; ++ai)
#pragma unroll
            for (int m = 0; m < 4; ++m) { const int row = row0 + ai * HALF + m * 16; const float s = rg[ai][m] * SC_Y; unsigned char* rowp = Y + (size_t)row * DM + col0;
#pragma unroll
                for (int bj = 0; bj < 2; ++bj) { const f32x4 v0 = (acc[ai][bj][m][0] * (1.0f / (SC_ACT * SC_WD)) + bv[bj][0]) * s, v1 = (acc[ai][bj][m][1] * (1.0f / (SC_ACT * SC_WD)) + bv[bj][1]) * s;
                    v2u w; w.x = pk4_fp8(v0[0], v0[1], v0[2], v0[3]); w.y = pk4_fp8(v1[0], v1[1], v1[2], v1[3]);
                    *(v2u*)(rowp + bj * HALF) = w; } }
    }
};

template <class Epi, class Sched, bool F8 = false, bool ALIGN_EPI = true, bool SP2 = true, int PM = 0, bool GA = false>
__device__ __forceinline__ void gemm_phase(LAS unsigned char* lds, const Gemm g, const Sched& S, const Epi& E, const int wid  , unsigned long long& pacc  ) {
    const int lane = lane_id(), tid = wid * 64 + lane, wr = wid >> 2, wc = wid & 3, fr = lane & 15, fq = lane >> 4;
    const int nt = g.Kb / 128;
    const __amdgpu_buffer_rsrc_t rA = __builtin_amdgcn_make_buffer_rsrc((void*)g.A, 0, -1, 0x00020000);
    const __amdgpu_buffer_rsrc_t rB = __builtin_amdgcn_make_buffer_rsrc((void*)g.Bt, 0, -1, 0x00020000);
    unsigned voffA, voffB;
    int Rrow;
    { int R, C; stage_rc(tid * 16, R, C); const int Rb = Epi::PERM ? ((R & ~31) + perm32(R & 31)) : R; Rrow = R;
        voffA = GA ? (unsigned)(C * 2) : (unsigned)(R * g.lda + C * 2); voffB = (unsigned)(Rb * g.ldb + C * 2); }
    const unsigned dA = 64u * (unsigned)g.lda, dB = 64u * (unsigned)g.ldb;
    const unsigned kstep = 128u;
    const unsigned hstepA = (unsigned)HALF * g.lda, hstepB = (unsigned)HALF * g.ldb;
    const unsigned tstepA = 2 * hstepA, tstepB = 2 * hstepB;
    const unsigned ldsw = (unsigned)wid * 1024u;
    const int aoff = lds_byte(wr * 64 + fr, fq * 8), boff = lds_byte(wc * 32 + fr, fq * 8);
#define PG8_SA(b, h) (((b) * 2 + (h)) * HTB)
#define PG8_SB(b, h) ((4 + (b) * 2 + (h)) * HTB)
#define PG8_STAGE(bufoff, rsrc, soff, voff) do { _Pragma("unroll") for (int _i = 0; _i < 2; ++_i) \
        __builtin_amdgcn_raw_ptr_buffer_load_lds(rsrc, (LAS unsigned*)(lds + (bufoff) + ldsw + _i * 8192), 16, (voff), (soff) + _i * (&(voff) == &voffA ? dA : dB), 0, 0); } while (0)
#define PG8_STGA(b, h, soff_full, koff, slot) do { if constexpr (GA) { _Pragma("unroll") for (int _i = 0; _i < 2; ++_i) { const unsigned o_ = g.tk[(slot) + Rrow + 64 * _i + 128 * (h)]; \
        __builtin_amdgcn_raw_ptr_buffer_load_lds(rA, (LAS unsigned*)(lds + PG8_SA(b, h) + ldsw + _i * 8192), 16, o_ + voffA, (koff), 0, 0); } } else PG8_STAGE(PG8_SA(b, h), rA, (soff_full), voffA); } while (0)
    LAS unsigned char* ldsA = lds + aoff; LAS unsigned char* ldsB = lds + 4 * HTB + boff; asm volatile("" : "+v"(ldsA), "+v"(ldsB));
#define PG8_LDA(dst, b, h) do { _Pragma("unroll") for (int m = 0; m < 4; ++m) _Pragma("unroll") for (int k = 0; k < 2; ++k) dst[m][k] = *(const LAS bf16x8*)(ldsA + PG8_SA(b, h) + m * 2048 + k * 1024); } while (0)
#define PG8_LDB(dst, b, h) do { _Pragma("unroll") for (int n = 0; n < 2; ++n) _Pragma("unroll") for (int k = 0; k < 2; ++k) dst[n][k] = *(const LAS bf16x8*)(ldsB + (PG8_SB(b, h) - 4 * HTB) + n * 2048 + k * 1024); } while (0)
#define PG8_MMA(ai, bj, At, Bt) do { __builtin_amdgcn_s_setprio(1); if constexpr (F8) { _Pragma("unroll") for (int m = 0; m < 4; ++m) _Pragma("unroll") for (int n = 0; n < 2; ++n) \
        acc[ai][bj][m][n] = __builtin_amdgcn_mfma_scale_f32_16x16x128_f8f6f4(cat8(Bt[n][0], Bt[n][1]), cat8(At[m][0], At[m][1]), acc[ai][bj][m][n], 0, 0, 0, 0, 0, 0); } \
        else { _Pragma("unroll") for (int m = 0; m < 4; ++m) _Pragma("unroll") for (int n = 0; n < 2; ++n) _Pragma("unroll") for (int k = 0; k < 2; ++k) \
        acc[ai][bj][m][n] = __builtin_amdgcn_mfma_f32_16x16x32_bf16(Bt[n][k], At[m][k], acc[ai][bj][m][n], 0, 0, 0); } __builtin_amdgcn_s_setprio(0); } while (0)
#define PG8_WAIT_V(n) asm volatile("s_waitcnt vmcnt(" #n ")" ::: "memory")
#define PG8_WAIT_L(n) asm volatile("s_waitcnt lgkmcnt(" #n ")" ::: "memory")
#define PG8_BAR __builtin_amdgcn_s_barrier()
#define PG8_SCHED __builtin_amdgcn_sched_barrier(0)
    Unit cur, nxt; int ui = 0;
    if (!S.next(0, cur)) return;
    Acc acc;
#pragma unroll
    for (int a = 0; a < 2; ++a)
#pragma unroll
        for (int b = 0; b < 2; ++b)
#pragma unroll
            for (int m = 0; m < 4; ++m)
#pragma unroll
                for (int n = 0; n < 2; ++n) acc[a][b][m][n] = (f32x4){0.f, 0.f, 0.f, 0.f};
    bf16x8 At[4][2], B0[2][2], B1[2][2];
    unsigned cA = (unsigned)cur.pm * tstepA, cB = (unsigned)((size_t)cur.e * g.bes) + (unsigned)cur.pn * tstepB;
    static_assert(!GA || SP2, "gathered A rows: SP2 schedule only");
    int sA = GA ? cur.i * 256 : 0, snA = 0;
    if constexpr (SP2) {
        PG8_STAGE(PG8_SB(0, 0), rB, cB, voffB); PG8_STAGE(PG8_SB(0, 1), rB, cB + hstepB, voffB); PG8_STGA(0, 0, cA, 0u, sA); PG8_STGA(0, 1, cA + hstepA, 0u, sA);
        if (wr == 1) PG8_BAR;
        PG8_WAIT_V(2); PG8_BAR;
        PG8_STAGE(PG8_SB(1, 0), rB, cB + kstep, voffB); PG8_STGA(1, 0, cA + kstep, kstep, sA); PG8_STAGE(PG8_SB(1, 1), rB, cB + hstepB + kstep, voffB);
        PG8_WAIT_V(6); PG8_BAR;
    } else {
        PG8_STAGE(PG8_SB(0, 0), rB, cB, voffB); PG8_STAGE(PG8_SA(0, 0), rA, cA, voffA); PG8_STAGE(PG8_SB(0, 1), rB, cB + hstepB, voffB); PG8_STAGE(PG8_SA(0, 1), rA, cA + hstepA, voffA);
        if (wr == 1) PG8_BAR;
        PG8_WAIT_V(4); PG8_BAR;
        PG8_STAGE(PG8_SB(1, 0), rB, cB + kstep, voffB); PG8_STAGE(PG8_SA(1, 0), rA, cA + kstep, voffA); PG8_STAGE(PG8_SB(1, 1), rB, cB + hstepB + kstep, voffB);
        PG8_WAIT_V(6); PG8_BAR;
    }
    for (;;) {
        unsigned long long tq0 = 0, tq1 = 0; if constexpr (PM != 0) tq0 = __builtin_amdgcn_s_memrealtime();
        const bool has_next = S.next(ui + 1, nxt);
        if constexpr (GA) snA = has_next ? nxt.i * 256 : sA;
        const unsigned nA = has_next ? (unsigned)nxt.pm * tstepA : cA; const unsigned nB = has_next ? (unsigned)((size_t)nxt.e * g.bes) + (unsigned)nxt.pn * tstepB : cB;
        for (int t = 0; t < nt; t += 2) {
            const bool last = (t == nt - 2);
            const unsigned a1 = cA + (unsigned)(t + 1) * kstep;
            const unsigned a2 = last ? nA : cA + (unsigned)(t + 2) * kstep; const unsigned b2 = last ? nB : cB + (unsigned)(t + 2) * kstep;
            const unsigned a3 = a2 + kstep; const unsigned b3 = b2 + kstep;
            const unsigned k1 = (unsigned)(t + 1) * kstep, k2 = last ? 0u : (unsigned)(t + 2) * kstep, k3 = k2 + kstep; const int sl2 = last ? snA : sA;
            if constexpr (SP2) {
            PG8_LDB(B0, 0, 0); PG8_LDB(B1, 0, 1); PG8_SCHED; PG8_LDA(At, 0, 0); PG8_STGA(1, 1, a1 + hstepA, k1, sA);
            PG8_WAIT_V(8); PG8_WAIT_L(0); PG8_BAR; PG8_MMA(0, 0, At, B0); PG8_MMA(0, 1, At, B1); PG8_BAR; PG8_SCHED;
            PG8_LDA(At, 0, 1); PG8_STAGE(PG8_SB(0, 0), rB, b2, voffB); PG8_STAGE(PG8_SB(0, 1), rB, b2 + hstepB, voffB); PG8_STGA(0, 0, a2, k2, sl2);
            PG8_WAIT_V(8); PG8_WAIT_L(0); PG8_BAR; PG8_MMA(1, 0, At, B0); PG8_MMA(1, 1, At, B1); PG8_BAR; PG8_SCHED;
            PG8_LDB(B0, 1, 0); PG8_LDB(B1, 1, 1); PG8_SCHED; PG8_LDA(At, 1, 0); PG8_STGA(0, 1, a2 + hstepA, k2, sl2);
            PG8_WAIT_V(8); PG8_WAIT_L(0); PG8_BAR; PG8_MMA(0, 0, At, B0); PG8_MMA(0, 1, At, B1); PG8_BAR; PG8_SCHED;
            PG8_LDA(At, 1, 1); PG8_STAGE(PG8_SB(1, 0), rB, b3, voffB); PG8_STAGE(PG8_SB(1, 1), rB, b3 + hstepB, voffB); PG8_STGA(1, 0, a3, k3, sl2);
            PG8_WAIT_V(8); PG8_WAIT_L(0); PG8_BAR; PG8_MMA(1, 0, At, B0); PG8_MMA(1, 1, At, B1); PG8_BAR; PG8_SCHED;
            } else {
            PG8_LDB(B0, 0, 0); PG8_SCHED; PG8_LDA(At, 0, 0); PG8_STAGE(PG8_SA(1, 1), rA, a1 + hstepA, voffA);
            PG8_WAIT_L(8); PG8_BAR; PG8_WAIT_L(0); PG8_MMA(0, 0, At, B0); PG8_BAR; PG8_SCHED;
            PG8_LDB(B1, 0, 1); PG8_STAGE(PG8_SB(0, 0), rB, b2, voffB);
            PG8_BAR; PG8_WAIT_L(0); PG8_MMA(0, 1, At, B1); PG8_BAR;
            PG8_LDA(At, 0, 1); PG8_STAGE(PG8_SA(0, 0), rA, a2, voffA);
            PG8_BAR; PG8_WAIT_L(0); PG8_MMA(1, 0, At, B0); PG8_BAR; PG8_SCHED;
            PG8_STAGE(PG8_SB(0, 1), rB, b2 + hstepB, voffB);
            PG8_WAIT_V(6); PG8_BAR; PG8_MMA(1, 1, At, B1); PG8_BAR;
            PG8_LDB(B0, 1, 0); PG8_SCHED; PG8_LDA(At, 1, 0); PG8_STAGE(PG8_SA(0, 1), rA, a2 + hstepA, voffA);
            PG8_WAIT_L(8); PG8_BAR; PG8_WAIT_L(0); PG8_MMA(0, 0, At, B0); PG8_BAR; PG8_SCHED;
            PG8_LDB(B1, 1, 1); PG8_STAGE(PG8_SB(1, 0), rB, b3, voffB);
            PG8_BAR; PG8_WAIT_L(0); PG8_MMA(0, 1, At, B1); PG8_BAR;
            PG8_LDA(At, 1, 1); PG8_STAGE(PG8_SA(1, 0), rA, a3, voffA);
            PG8_BAR; PG8_WAIT_L(0); PG8_MMA(1, 0, At, B0); PG8_BAR; PG8_SCHED;
            PG8_STAGE(PG8_SB(1, 1), rB, b3 + hstepB, voffB);
            PG8_WAIT_V(6); PG8_BAR; PG8_MMA(1, 1, At, B1); PG8_BAR;
            }
        }
        if constexpr (ALIGN_EPI) { if (wr == 0) PG8_BAR; }
        if constexpr (PM != 0) tq1 = __builtin_amdgcn_s_memrealtime();
        { const int l2 = lane_id(); E(acc, cur, wr, wc, l2 & 15, l2 >> 4); }
        if constexpr (PM != 0) { const unsigned long long tq2 = __builtin_amdgcn_s_memrealtime(); if (PM == 1) pacc += tq1 - tq0; else if (PM == 2) pacc += tq2 - tq1; else if (PM == 3 && ui == 0) pacc += tq2 - tq0; else if (PM == 4 && ui == 1) pacc += tq2 - tq0; }
        if (!has_next) break;
#pragma unroll
        for (int a = 0; a < 2; ++a)
#pragma unroll
            for (int b = 0; b < 2; ++b)
#pragma unroll
                for (int m = 0; m < 4; ++m)
#pragma unroll
                    for (int n = 0; n < 2; ++n) acc[a][b][m][n] = (f32x4){0.f, 0.f, 0.f, 0.f};
        cur = nxt; cA = nA; cB = nB; sA = snA; ++ui;
        if constexpr (ALIGN_EPI) { if (wr == 1) PG8_BAR; }
    }
    PG8_WAIT_V(0);
    if constexpr (!ALIGN_EPI) { if (wr == 0) PG8_BAR; }
    PG8_BAR;
#undef PG8_STGA
#undef PG8_SA
#undef PG8_SB
#undef PG8_STAGE
#undef PG8_LDA
#undef PG8_LDB
#undef PG8_MMA
#undef PG8_WAIT_V
#undef PG8_WAIT_L
#undef PG8_BAR
#undef PG8_SCHED
}
}

namespace at {
constexpr int SHM_V = 16384, SHM_K = 16384, SHM_K2 = 8192;
constexpr int OFF_V = 0, OFF_K = 2 * SHM_V, OFF_K2 = OFF_K + 2 * SHM_K, OFF_WS = OFF_K2 + 2 * SHM_K2, ATTN_LDS = OFF_WS + 8 * 64 * 4;
#define KSWZ(row, colB) ((row) * 256 + ((colB) ^ (((row) & 7) << 4)))
#define KSW4(row, chunk) ((row) * 256 + (((chunk) ^ (((row) & 7) | ((((row) >> 4) & 1) << 3))) << 4))
#define K2SWZ(row, colB) ((row) * 128 + ((colB) ^ ((((row) >> 1) & 7) << 4)))
__device__ __forceinline__ int v_st(int k, int c) { const int kk = (k & ~0xC) | ((k & 4) << 1) | ((k & 8) >> 1); return ((kk >> 3) * 4 + (c >> 5)) * 512 + ((kk & 7) * 32 + (c & 31)) * 2; }
__device__ __forceinline__ int v_rd_base(int lane) { return ((lane & 3) << 3) | (((lane >> 2) & 3) << 6) | (((lane >> 4) & 1) << 5) | (((lane >> 5) & 1) << 8); }
constexpr int v_rd_off(int d0, int ks, int half) { return d0 * 512 + ks * 4096 + half * 2048; }
__device__ __forceinline__ int crow(int r, int hi) { return (r & 3) + 8 * (r >> 2) + 4 * hi; }

template <int VB>
__device__ __forceinline__ void pv_tile(f32x16* o, int vb0, bf16x8 pa0, bf16x8 pa1, bf16x8 pa2, bf16x8 pa3) {
#define TRRD(dst, off) asm volatile("ds_read_b64_tr_b16 %0, %1 offset:%2" : "=&v"(dst) : "v"(vb0), "i"(off) : "memory")
#define PV_D0(d0) do { s16x4 l0, l1, l2, l3, h0, h1, h2, h3; constexpr int b_ = VB * SHM_V + v_rd_off(d0, 0, 0); \
        TRRD(l0, b_); TRRD(h0, b_ + 2048); TRRD(l1, b_ + 4096); TRRD(h1, b_ + 6144); TRRD(l2, b_ + 8192); TRRD(h2, b_ + 10240); TRRD(l3, b_ + 12288); TRRD(h3, b_ + 14336); \
        asm volatile("s_waitcnt lgkmcnt(0)" ::: "memory"); SBAR(); \
        o[d0] = __builtin_amdgcn_mfma_f32_32x32x16_bf16(pa0, (bf16x8){l0[0], l0[1], l0[2], l0[3], h0[0], h0[1], h0[2], h0[3]}, o[d0], 0, 0, 0); \
        o[d0] = __builtin_amdgcn_mfma_f32_32x32x16_bf16(pa1, (bf16x8){l1[0], l1[1], l1[2], l1[3], h1[0], h1[1], h1[2], h1[3]}, o[d0], 0, 0, 0); \
        o[d0] = __builtin_amdgcn_mfma_f32_32x32x16_bf16(pa2, (bf16x8){l2[0], l2[1], l2[2], l2[3], h2[0], h2[1], h2[2], h2[3]}, o[d0], 0, 0, 0); \
        o[d0] = __builtin_amdgcn_mfma_f32_32x32x16_bf16(pa3, (bf16x8){l3[0], l3[1], l3[2], l3[3], h3[0], h3[1], h3[2], h3[3]}, o[d0], 0, 0, 0); } while (0)
    PV_D0(0); PV_D0(1); PV_D0(2); PV_D0(3);
#undef PV_D0
#undef TRRD
}

constexpr int ML_OFF_K = 0, ML_OFF_K2 = 32768, ML_OFF_V = 49152, ML_OFF_WS = 81920, MLA_LDS = ML_OFF_WS + 8 * 64 * 4;
__device__ __forceinline__ void mla_unit(const bf16* Qp, const bf16* KVMp, const bf16* KPEp, int h, bf16* Op, int qb, char* lds, const int wid) {
    constexpr float SCALE = 0.07216878364870322f, C2 = 1.4426950408889634f * SCALE, THR = 8.f;
    const int lane = lane_id(), r32 = lane & 31, hi = lane >> 5;
    const int q0 = qb * 256, qlo = q0 + wid * 32, qrow = qlo + r32, qm = qrow - 4 * hi;
    char* K_lds = lds + ML_OFF_K; char* K2_lds = lds + ML_OFF_K2; char* V_lds = lds + ML_OFF_V;
    float* ws = (float*)(lds + ML_OFF_WS) + wid * 64; float* li_l = ws; float* al_l = ws + 32;
    bf16x8 qr[8], qr2[4];
    { const bf16* Qw = Qp + (size_t)qrow * 1536 + hi * 8;
#pragma unroll
      for (int d0 = 0; d0 < 8; ++d0) qr[d0] = *(const bf16x8*)(Qw + d0 * 16);
#pragma unroll
      for (int d0 = 0; d0 < 4; ++d0) qr2[d0] = *(const bf16x8*)(Qw + 128 + d0 * 16); }
    const __amdgpu_buffer_rsrc_t rKV = __builtin_amdgcn_make_buffer_rsrc((void*)KVMp, 0, -1, 0x00020000);
    const __amdgpu_buffer_rsrc_t rK2 = __builtin_amdgcn_make_buffer_rsrc((void*)KPEp, 0, -1, 0x00020000);
    unsigned vK[2], vV[2], vK2;
#pragma unroll
    for (int i = 0; i < 2; ++i) { const int rowk = 4 * (2 * wid + i) + (lane >> 4), ck = (lane & 15) ^ ((rowk & 7) | (((rowk >> 4) & 1) << 3)); vK[i] = (unsigned)(rowk * 4096 + ck * 16);
        const int sidx = (2 * wid + i) * 2 + (lane >> 5), kk = (sidx >> 2) * 8 + ((lane & 31) >> 2), k = (kk & ~0xC) | ((kk & 4) << 1) | ((kk & 8) >> 1), c = (sidx & 3) * 32 + (lane & 3) * 8;
        vV[i] = (unsigned)(k * 4096 + c * 2); }
    { const int rowk2 = 8 * wid + (lane >> 3), ck2 = (lane & 7) ^ ((rowk2 >> 1) & 7); vK2 = (unsigned)(rowk2 * 128 + ck2 * 16); }
    const unsigned hK = (unsigned)h * 512u, hV = hK + 256u;
    const int kf4 = ((r32 & 7) | (((r32 >> 4) & 1) << 3)) << 4, hi16 = hi << 4;
#define ML_LOADK(t_, buf) do { _Pragma("unroll") for (int i_ = 0; i_ < 2; ++i_) __builtin_amdgcn_raw_ptr_buffer_load_lds(rKV, (LAS unsigned*)(K_lds + (buf) * SHM_K + (2 * wid + i_) * 1024), 16, vK[i_], (unsigned)(t_) * 262144u + hK, 0, 0); \
        __builtin_amdgcn_raw_ptr_buffer_load_lds(rK2, (LAS unsigned*)(K2_lds + (buf) * SHM_K2 + wid * 1024), 16, vK2, (unsigned)(t_) * 8192u, 0, 0); } while (0)
#define ML_LOADV(t_, buf) do { _Pragma("unroll") for (int i_ = 0; i_ < 2; ++i_) __builtin_amdgcn_raw_ptr_buffer_load_lds(rKV, (LAS unsigned*)(V_lds + (buf) * SHM_V + (2 * wid + i_) * 1024), 16, vV[i_], (unsigned)(t_) * 262144u + hV, 0, 0); } while (0)
    const int vb0 = (int)(uintptr_t)V_lds + v_rd_base(lane);
    float m_reg = -1e30f, l_reg = 0.f; f32x16 o[4];
#pragma unroll
    for (int d = 0; d < 4; ++d) o[d] = f32x16{};
    const int NT = 4 * (qb + 1);
#define ML_QK(BF, P0, P1) do { P0 = f32x16{}; P1 = f32x16{}; \
        const char* kb_ = K_lds + (BF) * SHM_K + r32 * 256; const char* k2b_ = K2_lds + (BF) * SHM_K2; int f4_ = kf4; asm volatile("" : "+v"(f4_));   \
        _Pragma("unroll") for (int g_ = 0; g_ < 2; ++g_) { bf16x8 kf_[8]; \
            _Pragma("unroll") for (int dd = 0; dd < 4; ++dd) { const char* a = kb_ + (((((g_ * 4 + dd) * 2) << 4) + hi16) ^ f4_); kf_[2 * dd] = *(const bf16x8*)a; kf_[2 * dd + 1] = *(const bf16x8*)(a + 32 * 256); } \
            LDS_WAIT(); SBAR(); \
            _Pragma("unroll") for (int dd = 0; dd < 4; ++dd) { P0 = __builtin_amdgcn_mfma_f32_32x32x16_bf16(kf_[2 * dd], qr[g_ * 4 + dd], P0, 0, 0, 0); P1 = __builtin_amdgcn_mfma_f32_32x32x16_bf16(kf_[2 * dd + 1], qr[g_ * 4 + dd], P1, 0, 0, 0); } \
            SBAR(); } \
        { bf16x8 kf_[8]; \
            _Pragma("unroll") for (int dd = 0; dd < 4; ++dd) { const char* a = k2b_ + K2SWZ(r32, (dd * 16 + hi * 8) * 2); kf_[2 * dd] = *(const bf16x8*)a; kf_[2 * dd + 1] = *(const bf16x8*)(a + 32 * 128); } \
            LDS_WAIT(); SBAR(); \
            _Pragma("unroll") for (int dd = 0; dd < 4; ++dd) { P0 = __builtin_amdgcn_mfma_f32_32x32x16_bf16(kf_[2 * dd], qr2[dd], P0, 0, 0, 0); P1 = __builtin_amdgcn_mfma_f32_32x32x16_bf16(kf_[2 * dd + 1], qr2[dd], P1, 0, 0, 0); } \
            SBAR(); } } while (0)
#define PK4(P, B_, OUT) do { const unsigned a0 = cvt_pk_bf16(P[B_+0], P[B_+1]), a1 = cvt_pk_bf16(P[B_+2], P[B_+3]); \
        const unsigned b0_ = cvt_pk_bf16(P[B_+4], P[B_+5]), b1_ = cvt_pk_bf16(P[B_+6], P[B_+7]); \
        auto r0 = __builtin_amdgcn_permlane32_swap(a0, b0_, false, false); auto r1 = __builtin_amdgcn_permlane32_swap(a1, b1_, false, false); \
        v4u w = {r0[0], r1[0], r0[1], r1[1]}; OUT = *reinterpret_cast<bf16x8*>(&w); } while (0)
#define ML_SMPV(PB, CUR0, CUR1) do { \
        if (kb + 63 > qlo) { const float NEG = -__builtin_inff(); const int dq = qm - kb; \
            _Pragma("unroll") for (int r = 0; r < 16; ++r) { const int c = (r & 3) + 8 * (r >> 2); if (dq - c < 0) CUR0[r] = NEG; if (dq - c - 32 < 0) CUR1[r] = NEG; } } \
        float pmax = CUR0[0]; _Pragma("unroll") for (int r = 1; r < 16; ++r) pmax = fmaxf(pmax, CUR0[r]); _Pragma("unroll") for (int r = 0; r < 16; ++r) pmax = fmaxf(pmax, CUR1[r]); \
        { auto rr = __builtin_amdgcn_permlane32_swap(__float_as_uint(pmax), __float_as_uint(pmax), false, false); pmax = fmaxf(__uint_as_float(rr[0]), __uint_as_float(rr[1])); } \
        float mn, alpha; \
        if ((pmax - m_reg) * SCALE <= THR) { mn = m_reg; alpha = 1.f; } \
        else { mn = fmaxf(m_reg, pmax); alpha = __builtin_amdgcn_exp2f((m_reg - mn) * C2); m_reg = mn; } \
        const float mnL = -mn * C2; \
        _Pragma("unroll") for (int r = 0; r < 16; ++r) { CUR0[r] = __builtin_amdgcn_exp2f(fmaf(CUR0[r], C2, mnL)); CUR1[r] = __builtin_amdgcn_exp2f(fmaf(CUR1[r], C2, mnL)); } \
        float ps = 0.f; _Pragma("unroll") for (int r = 0; r < 16; ++r) ps += CUR0[r]; _Pragma("unroll") for (int r = 0; r < 16; ++r) ps += CUR1[r]; \
        { auto rr = __builtin_amdgcn_permlane32_swap(__float_as_uint(ps), __float_as_uint(ps), false, false); ps = __uint_as_float(rr[0]) + __uint_as_float(rr[1]); } \
        l_reg = l_reg * alpha + ps; \
        if (__any(alpha < 1.f)) { if (hi == 0) al_l[r32] = alpha; LDS_WAIT(); \
            _Pragma("unroll") for (int d_ = 0; d_ < 4; ++d_) _Pragma("unroll") for (int r = 0; r < 16; ++r) o[d_][r] *= al_l[crow(r, hi)]; } \
        bf16x8 pa0, pa1, pa2, pa3; \
        PK4(CUR0, 0, pa0); PK4(CUR0, 8, pa1); PK4(CUR1, 0, pa2); PK4(CUR1, 8, pa3); \
        SBAR(); pv_tile<PB>(o, vb0, pa0, pa1, pa2, pa3); SBAR(); } while (0)
#define ML_STEP(PB, t_, CUR0, CUR1, NXT0, NXT1) do { const int t = (t_); const int kb = t * 64; \
        if (t + 2 < NT) ML_LOADK(t + 2, PB); \
        if (t + 1 < NT) ML_LOADV(t + 1, (PB) ^ 1); \
        if (wid >= 4) ML_SMPV(PB, CUR0, CUR1); \
        if (t + 1 < NT) ML_QK((PB) ^ 1, NXT0, NXT1); SBAR(); \
        if (wid < 4) ML_SMPV(PB, CUR0, CUR1); \
        VM_WAIT(); __syncthreads(); } while (0)
    ML_LOADK(0, 0); ML_LOADV(0, 0); if (NT > 1) ML_LOADK(1, 1);
    VM_WAIT(); __syncthreads();
    f32x16 pA0, pA1, pB0, pB1;
    ML_QK(0, pA0, pA1);
    asm volatile("s_waitcnt lgkmcnt(0)" ::: "memory"); __syncthreads();
    for (int t2 = 0; t2 < NT; t2 += 2) { ML_STEP(0, t2, pA0, pA1, pB0, pB1); ML_STEP(1, t2 + 1, pB0, pB1, pA0, pA1); }
#undef ML_STEP
#undef ML_SMPV
#undef PK4
#undef ML_QK
#undef ML_LOADK
#undef ML_LOADV
    if (hi == 0) li_l[r32] = l_reg; LDS_WAIT();
    float rli[16];
#pragma unroll
    for (int r = 0; r < 16; ++r) rli[r] = __builtin_amdgcn_rcpf(li_l[crow(r, hi)]);
    bf16* Ow = Op + (size_t)qlo * DM;
#pragma unroll
    for (int r = 0; r < 16; ++r) { const int orow = crow(r, hi);
#pragma unroll
        for (int d0 = 0; d0 < 4; ++d0) { const float v = o[d0][r] * rli[r]; const float vn = __shfl_xor(v, 1);
            if ((r32 & 1) == 0) *(unsigned*)(Ow + (size_t)orow * DM + d0 * 32 + r32) = cvt_pk_bf16(v, vn); } }
    __syncthreads();
}

constexpr int MB_OFF_V = 0, MB_OFF_K = 65536, MB_OFF_WS = 131072, MOBA_LDS = MB_OFF_WS + 8 * 128 * 4;
__device__ __forceinline__ void moba_unit(const bf16* Qh, const bf16* Kh, const bf16* Vh, const int* list, int cnt, int j, int c, int h, bf16* PO, float* PL, char* lds, const int wid) {
    constexpr float SCALE = 0.08838834764831845f, C2 = 1.4426950408889634f * SCALE, THR = 8.f;
    const int lane = lane_id(), tid = wid * 64 + lane, r32 = lane & 31, hi = lane >> 5;
    char* V_lds = lds + MB_OFF_V; char* K_lds = lds + MB_OFF_K;
    float* ws = (float*)(lds + MB_OFF_WS) + wid * 128; float* li_l = ws; float* al_l = ws + 32; int* qi_l = (int*)(ws + 64);
    { const int sr = tid >> 4, sc = (tid & 15) * 8, vst0 = v_st(sr, sc), vst1 = v_st(32 + sr, sc), kws = KSW4(sr, tid & 15);
      const bf16* kp = Kh + (size_t)(256 * j + sr) * MW + sc; const bf16* vp = Vh + (size_t)(256 * j + sr) * MW + sc;
      bf16x8 kk[8], vv[8];
#pragma unroll
      for (int t = 0; t < 4; ++t) { kk[2 * t] = *(const bf16x8*)(kp + (size_t)(64 * t) * MW); kk[2 * t + 1] = *(const bf16x8*)(kp + (size_t)(64 * t + 32) * MW);
          vv[2 * t] = *(const bf16x8*)(vp + (size_t)(64 * t) * MW); vv[2 * t + 1] = *(const bf16x8*)(vp + (size_t)(64 * t + 32) * MW); }
#pragma unroll
      for (int t = 0; t < 4; ++t) { *(bf16x8*)(K_lds + t * SHM_K + kws) = kk[2 * t]; *(bf16x8*)(K_lds + t * SHM_K + kws + 32 * 256) = kk[2 * t + 1];
          *(bf16x8*)(V_lds + t * SHM_V + vst0) = vv[2 * t]; *(bf16x8*)(V_lds + t * SHM_V + vst1) = vv[2 * t + 1]; } }
    const int i = wid * 32 + r32; int q, slot; bool valid = true;
    if (c == 0) { q = 256 * j + i; slot = 3; } else { const int li = (c - 1) * 256 + i; valid = li < cnt; const int e = list[valid ? li : 0]; q = e >> 2; slot = e & 3; }
    bf16x8 qr[8];
    { const bf16* Qw = Qh + (size_t)q * MW + hi * 8;
#pragma unroll
      for (int d0 = 0; d0 < 8; ++d0) qr[d0] = *(const bf16x8*)(Qw + d0 * 16); }
    __syncthreads();
    const int vb0 = (int)(uintptr_t)V_lds + v_rd_base(lane);
    float m_reg = -1e30f, l_reg = 0.f; f32x16 o[4];
#pragma unroll
    for (int d = 0; d < 4; ++d) o[d] = f32x16{};
    const int qm = i - 4 * hi; const int kf4 = ((r32 & 7) | (((r32 >> 4) & 1) << 3)) << 4;
#define PK4(P, B_, OUT) do { const unsigned a0 = cvt_pk_bf16(P[B_+0], P[B_+1]), a1 = cvt_pk_bf16(P[B_+2], P[B_+3]); \
        const unsigned b0_ = cvt_pk_bf16(P[B_+4], P[B_+5]), b1_ = cvt_pk_bf16(P[B_+6], P[B_+7]); \
        auto r0 = __builtin_amdgcn_permlane32_swap(a0, b0_, false, false); auto r1 = __builtin_amdgcn_permlane32_swap(a1, b1_, false, false); \
        v4u w = {r0[0], r1[0], r0[1], r1[1]}; OUT = *reinterpret_cast<bf16x8*>(&w); } while (0)
#define MB_STEP(TT) do { constexpr int kb = 64 * (TT); \
        const bool act = (c != 0) || (kb <= wid * 32 + 31); \
        if (act) { \
            f32x16 p0 = f32x16{}, p1 = f32x16{}; \
            { int f4_ = kf4; asm volatile("" : "+v"(f4_)); _Pragma("unroll") for (int d0 = 0; d0 < 8; ++d0) { const char* a = K_lds + (TT) * SHM_K + r32 * 256 + ((((d0 * 2) << 4) + (hi << 4)) ^ f4_); \
                const bf16x8 b0 = *(const bf16x8*)a; const bf16x8 b1 = *(const bf16x8*)(a + 32 * 256); \
                p0 = __builtin_amdgcn_mfma_f32_32x32x16_bf16(b0, qr[d0], p0, 0, 0, 0); p1 = __builtin_amdgcn_mfma_f32_32x32x16_bf16(b1, qr[d0], p1, 0, 0, 0); } } \
            if (c == 0 && kb + 63 > wid * 32) { const float NEG = -__builtin_inff(); const int dq = qm - kb; \
                _Pragma("unroll") for (int r = 0; r < 16; ++r) { const int cc = (r & 3) + 8 * (r >> 2); if (dq - cc < 0) p0[r] = NEG; if (dq - cc - 32 < 0) p1[r] = NEG; } } \
            float pmax = p0[0]; _Pragma("unroll") for (int r = 1; r < 16; ++r) pmax = fmaxf(pmax, p0[r]); _Pragma("unroll") for (int r = 0; r < 16; ++r) pmax = fmaxf(pmax, p1[r]); \
            { auto rr = __builtin_amdgcn_permlane32_swap(__float_as_uint(pmax), __float_as_uint(pmax), false, false); pmax = fmaxf(__uint_as_float(rr[0]), __uint_as_float(rr[1])); } \
            float mn, alpha; \
            if ((pmax - m_reg) * SCALE <= THR) { mn = m_reg; alpha = 1.f; }        \
            else { mn = fmaxf(m_reg, pmax); alpha = __builtin_amdgcn_exp2f((m_reg - mn) * C2); m_reg = mn; } \
            const float mnL = -mn * C2; \
            _Pragma("unroll") for (int r = 0; r < 16; ++r) { p0[r] = __builtin_amdgcn_exp2f(fmaf(p0[r], C2, mnL)); p1[r] = __builtin_amdgcn_exp2f(fmaf(p1[r], C2, mnL)); } \
            float ps = 0.f; _Pragma("unroll") for (int r = 0; r < 16; ++r) ps += p0[r]; _Pragma("unroll") for (int r = 0; r < 16; ++r) ps += p1[r]; \
            { auto rr = __builtin_amdgcn_permlane32_swap(__float_as_uint(ps), __float_as_uint(ps), false, false); ps = __uint_as_float(rr[0]) + __uint_as_float(rr[1]); } \
            l_reg = l_reg * alpha + ps; \
            if (__any(alpha < 1.f)) { if (hi == 0) al_l[r32] = alpha; LDS_WAIT(); \
                _Pragma("unroll") for (int d_ = 0; d_ < 4; ++d_) _Pragma("unroll") for (int r = 0; r < 16; ++r) o[d_][r] *= al_l[crow(r, hi)]; } \
            bf16x8 pa0, pa1, pa2, pa3; \
            PK4(p0, 0, pa0); PK4(p0, 8, pa1); PK4(p1, 0, pa2); PK4(p1, 8, pa3); \
            SBAR(); pv_tile<TT>(o, vb0, pa0, pa1, pa2, pa3); \
        } } while (0)
    MB_STEP(0); MB_STEP(1); MB_STEP(2); MB_STEP(3);
#undef MB_STEP
#undef PK4
    const int pidx_own = valid ? ((q * NH + h) * 4 + slot) : -1;
    if (hi == 0) { li_l[r32] = l_reg; qi_l[r32] = pidx_own; if (valid) PL[pidx_own] = m_reg * C2 + __builtin_amdgcn_logf(l_reg); }
    LDS_WAIT();
#pragma unroll
    for (int r = 0; r < 16; ++r) { const int orow = crow(r, hi); const int pidx = qi_l[orow]; const float rl = __builtin_amdgcn_rcpf(li_l[orow]);
#pragma unroll
        for (int d0 = 0; d0 < 4; ++d0) { const float v = o[d0][r] * rl; const float vn = __shfl_xor(v, 1);
            if ((r32 & 1) == 0 && pidx >= 0) *(unsigned*)(PO + (size_t)pidx * 128 + d0 * 32 + r32) = cvt_pk_bf16(v, vn); } }
    __syncthreads();
}
}

#define XB_TMO      128
#define XB_XCNT(j)  (256  + 64 * (j))
#define XB_XSUB(j)  (1280 + 64 * (j))
#define XB_XGEN(j)  (2304 + 64 * (j))
#define XB_TOP      3328
#define XB_TOPGEN   3392
#define XCD_BAR_WORDS 3456
#define XB_SPIN_CAP (1u << 18)
__device__ __forceinline__ unsigned xb_ld(unsigned* p)              { return __hip_atomic_load(p, __ATOMIC_RELAXED, __HIP_MEMORY_SCOPE_AGENT); }
__device__ __forceinline__ unsigned xb_add(unsigned* p, unsigned v) { return __hip_atomic_fetch_add(p, v, __ATOMIC_RELAXED, __HIP_MEMORY_SCOPE_AGENT); }
__device__ __forceinline__ unsigned xb_xcc_id() { return (unsigned)__builtin_amdgcn_s_getreg((3 << 11) | 20) & 0xFu; }
#define XB_SPIN(cond, bar) do { unsigned _sp = 0; while (cond) { __builtin_amdgcn_s_sleep(1); \
    if ((++_sp & 255u) == 0u) { if (xb_ld(&(bar)[XB_TMO])) break; if (_sp > XB_SPIN_CAP) { atomicAdd(&(bar)[XB_TMO], 1u); break; } } } } while (0)
struct XcdBarrier { unsigned* bar; unsigned x; volatile LAS unsigned* st; };
__device__ __forceinline__ XcdBarrier xcd_barrier_post(unsigned* bar, volatile LAS unsigned* st, bool t0  ) {
    XcdBarrier b; b.bar = bar; b.x = xb_xcc_id(); b.st = st;
    if (t0) (void)xb_add(&bar[XB_XCNT(b.x)], 1u);
    return b;
}
__device__ __forceinline__ void xcd_barrier_complete(unsigned* bar, unsigned x, unsigned& nloc, unsigned& nx) {
    const unsigned G = gridDim.x * gridDim.y * gridDim.z;
    unsigned sum, cnt, mine, sp = 0u;
    for (;;) {
        sum = 0u; cnt = 0u; mine = 0u;
#pragma unroll
        for (unsigned j = 0; j < 16; ++j) { const unsigned c = xb_ld(&bar[XB_XCNT(j)]); sum += c; cnt += (c > 0u) ? 1u : 0u; mine = (j == x) ? c : mine; }
        if (sum == G) break;
        __builtin_amdgcn_s_sleep(1);
        if ((++sp & 255u) == 0u) { if (xb_ld(&bar[XB_TMO])) break; if (sp > XB_SPIN_CAP) { atomicAdd(&bar[XB_TMO], 1u); break; } }
    }
    nloc = mine > 0u ? mine : 1u; nx = cnt > 0u ? cnt : 1u;
}
__device__ __forceinline__ void xcd_barrier(const XcdBarrier& b, bool t0  ) {
    asm volatile("s_waitcnt vmcnt(0)" ::: "memory");
    __syncthreads();
    if (t0) {
        unsigned* bar = b.bar;
        __builtin_amdgcn_s_waitcnt(0);
        unsigned nloc = b.st[0], nx = b.st[1];
        if (nloc == 0u) { xcd_barrier_complete(bar, b.x, nloc, nx); b.st[0] = nloc; b.st[1] = nx; }
        const unsigned old = xb_add(&bar[XB_XSUB(b.x)], 1u);
        const unsigned gen = old / nloc;
        if (old + 1u == (gen + 1u) * nloc) {
            __builtin_amdgcn_fence(__ATOMIC_RELEASE, "agent");
            asm volatile("s_waitcnt vmcnt(0)" ::: "memory");
            const unsigned og = xb_add(&bar[XB_TOP], 1u);
            const unsigned tg = og / nx;
            if (og + 1u == (tg + 1u) * nx) xb_add(&bar[XB_TOPGEN], 1u);
            else XB_SPIN(xb_ld(&bar[XB_TOPGEN]) == tg, bar);
            __builtin_amdgcn_fence(__ATOMIC_ACQUIRE, "agent");
            xb_add(&bar[XB_XGEN(b.x)], 1u);
            asm volatile("s_waitcnt vmcnt(0)" ::: "memory");
        } else {
            XB_SPIN(xb_ld(&bar[XB_XGEN(b.x)]) == gen, bar);
            __builtin_amdgcn_fence(__ATOMIC_ACQUIRE, "agent");
            asm volatile("s_waitcnt vmcnt(0)" ::: "memory");
        }
    }
    __syncthreads();
}

struct Args;
typedef const __attribute__((address_space(4))) struct Args* KArgsFwd;
struct Args {
    const float* x; const int* pos; const float* w_in; const float* g_q_a; const float* w_q_b; const float* g_kv_a; const float* w_kv_b;
    const float* g_out_mla; const float* g_out_moba; const float* w_o; const float* ln1_g; const float* ln1_b; const float* w_router; const float* b_router;
    const float* w_gate_up; const float* b_gate_up; const float* w_down; const float* b_down; const float* ln2_g; const float* ln2_b;
    float* out; unsigned char* ws; int ph_lo, ph_hi;
};
constexpr int NPHASES = 14;

__device__ __forceinline__ void tr_item(const float* W, int N, bf16* WT, int K, int k0, int n0, int prow0, const float* sc, int lane, int pmode = 0) {
    float tv[64]; const unsigned off0 = (unsigned)(k0 * N + n0 + lane) * 4u, rb = (unsigned)N * 4u;
#pragma unroll
    for (int i = 0; i < 64; ++i) tv[i] = __builtin_nontemporal_load((const float*)((const char*)W + (off0 + (unsigned)i * rb)));
    if (sc) {
#pragma unroll
        for (int i = 0; i < 64; i += 4) { const f32x4 g4 = *(const f32x4*)(sc + k0 + i); tv[i] *= g4[0]; tv[i + 1] *= g4[1]; tv[i + 2] *= g4[2]; tv[i + 3] *= g4[3]; } }
    bf16* dst = WT + (size_t)(prow0 + (pmode == 0 ? lane : (pmode == 1 ? 2 * lane : 2 * (lane & 31) + (lane >> 5)))) * K + k0;
#pragma unroll
    for (int j = 0; j < 8; ++j) { v4u o; o.x = cvt_pk_bf16(tv[8 * j], tv[8 * j + 1]); o.y = cvt_pk_bf16(tv[8 * j + 2], tv[8 * j + 3]); o.z = cvt_pk_bf16(tv[8 * j + 4], tv[8 * j + 5]); o.w = cvt_pk_bf16(tv[8 * j + 6], tv[8 * j + 7]);
        *(v4u*)(dst + 8 * j) = o; }
}
constexpr int BG_ITEMS = NE * 32 * 64 + NE * 32 * 32, BG_ROUNDS = 48;
#ifndef BG_SPLIT
#define BG_SPLIT 0, 6, 6, 44, 48
#endif
constexpr int BG_SPLIT_[5] = {BG_SPLIT};
constexpr int BG_P0 = BG_SPLIT_[0], BG_P1 = BG_SPLIT_[1], BG_P3 = BG_SPLIT_[2], BG_P6 = BG_SPLIT_[3], BG_P8 = BG_SPLIT_[4];
struct BgItem { const float* W; unsigned char* WT; unsigned rb; int K, k0, n0, prow0; float cs; };
__device__ __forceinline__ BgItem bg_decode(KArgsFwd ka, GAS unsigned char* ws, int it) {
    BgItem b; it = it < BG_ITEMS ? it : BG_ITEMS - 1;
    if (it < NE * 2048) { const int e = it >> 11, q = it & 2047, kb = q & 31, nb = q >> 5, n0 = nb * 64;
        b.W = ((const float*)(GAS const float*)ka->w_gate_up) + (size_t)e * DM * 2 * DFF; b.WT = (unsigned char*)(ws + WS_WGU) + (size_t)e * 2 * DFF * DM; b.rb = 2 * DFF * 4; b.K = DM; b.k0 = kb * 64; b.n0 = n0;
        b.prow0 = n0 < DFF ? (n0 >> 7) * 256 + (n0 & 127) : ((n0 - DFF) >> 7) * 256 + 128 + ((n0 - DFF) & 127); b.cs = SC_WGU; }
    else { it -= NE * 2048; const int e = it >> 10, q = it & 1023, kb = q & 31, nb = q >> 5;
        b.W = ((const float*)(GAS const float*)ka->w_down) + (size_t)e * DFF * DM; b.WT = (unsigned char*)(ws + WS_WD) + (size_t)e * DM * DFF; b.rb = DM * 4; b.K = DFF; b.k0 = kb * 64; b.n0 = nb * 64; b.prow0 = nb * 64; b.cs = SC_WD; }
    return b;
}
#define BG_LOAD(TV, B) do { const unsigned off0_ = (unsigned)((B).k0 + 16 * (lane >> 4)) * (B).rb + (unsigned)((B).n0 + 4 * (lane & 15)) * 4u; \
    _Pragma("unroll") for (int i_ = 0; i_ < 16; ++i_) TV[i_] = __builtin_nontemporal_load((const f32x4*)((const char*)(B).W + (off0_ + (unsigned)i_ * (B).rb))); } while (0)
#define BG_STORE(TV, B) do { unsigned char* dst_ = (B).WT + (size_t)((B).prow0 + 4 * (lane & 15)) * (B).K + (B).k0 + 16 * (lane >> 4); const float cs_ = 1.0f / (B).cs; \
    _Pragma("unroll") for (int c_ = 0; c_ < 4; ++c_) { v4u o_; \
        o_.x = pk4_fp8s(TV[0][c_], TV[1][c_], TV[2][c_], TV[3][c_], cs_); o_.y = pk4_fp8s(TV[4][c_], TV[5][c_], TV[6][c_], TV[7][c_], cs_); \
        o_.z = pk4_fp8s(TV[8][c_], TV[9][c_], TV[10][c_], TV[11][c_], cs_); o_.w = pk4_fp8s(TV[12][c_], TV[13][c_], TV[14][c_], TV[15][c_], cs_); \
        __builtin_nontemporal_store(o_, (v4u*)(dst_ + (size_t)c_ * (B).K)); } } while (0)
__device__ __forceinline__ void bg_run(KArgsFwd ka, GAS unsigned char* ws, int it0, int n, int stride, int lane) {
    if (n <= 0) return;
    f32x4 ta[16], tb[16];
    BgItem A = bg_decode(ka, ws, it0), B = A;
    BG_LOAD(ta, A);
    for (int r = 0; r < n; r += 2) {
        const bool hb = r + 1 < n, ha = r + 2 < n;
        if (hb) { B = bg_decode(ka, ws, it0 + (r + 1) * stride); BG_LOAD(tb, B); }
        BG_STORE(ta, A);
        if (ha) { A = bg_decode(ka, ws, it0 + (r + 2) * stride); BG_LOAD(ta, A); }
        if (hb) BG_STORE(tb, B);
    }
}
__device__ __forceinline__ void bg_rounds(KArgsFwd ka, GAS unsigned char* ws, int r0, int r1, int gw, int NGW, int lane) { bg_run(ka, ws, r0 * NGW + gw, r1 - r0, NGW, lane); }
#undef BG_LOAD
#undef BG_STORE
__device__ __forceinline__ void sincos_d(double x, float& sn, float& cs) {
    const double inv2pi = 0.15915494309189533577, pi2hi = 6.283185307179586232, pi2lo = 2.4492935982947064e-16;
    const double n = rint(x * inv2pi); double r = fma(-n, pi2hi, x); r = fma(-n, pi2lo, r);
    const double r2 = r * r; double s = 1.0, c = 1.0;
    double ts = 0.0, tc = 0.0;
#pragma unroll
    for (int k = 10; k >= 1; --k) { ts = (ts + 1.0) * (-r2 * (1.0 / (double)((2 * k) * (2 * k + 1)))); tc = (tc + 1.0) * (-r2 * (1.0 / (double)((2 * k - 1) * (2 * k)))); }
    s = r * (1.0 + ts); c = 1.0 + tc; sn = (float)s; cs = (float)c;
}

#define XB   ((bf16*)(ws + WS_XB))
#define WIN  ((bf16*)(ws + WS_WIN))
#define WQB  ((bf16*)(ws + WS_WQB))
#define WKVB ((bf16*)(ws + WS_WKVB))
#define WO   ((bf16*)(ws + WS_WO))
#define C128 ((float*)(ws + WS_C128))
#define S128 ((float*)(ws + WS_S128))
#define C64  ((float*)(ws + WS_C64))
#define S64  ((float*)(ws + WS_S64))
#define HQ   ((bf16*)(ws + WS_HQ))
#define HKV  ((bf16*)(ws + WS_HKV))
#define KPE  ((bf16*)(ws + WS_KPE))
#define MQ   ((bf16*)(ws + WS_MQ))
#define MK   ((bf16*)(ws + WS_MK))
#define MV   ((bf16*)(ws + WS_MV))
#define RSQ  ((float*)(ws + WS_RSQ))
#define RSKV ((float*)(ws + WS_RSKV))
#define QM   ((bf16*)(ws + WS_QM))
#define KVM  ((bf16*)(ws + WS_KVM))
#define MLIST ((int*)(ws + WS_LIST))
#define PO   ((bf16*)(ws + WS_PO))
#define PL   ((float*)(ws + WS_PL))
#define OMIX ((bf16*)(ws + WS_OMIX))
#define X1P  ((float*)(ws + WS_X1P))
#define X1N  ((bf16*)(ws + WS_X1N))
#define X1B  ((unsigned char*)(ws + WS_X1B))
#define TOPE ((int*)(ws + WS_TOPE))
#define ROWTOK ((int*)(ws + WS_TOPE))
#define TOPR ((int*)(ws + WS_TOPR))
#define TOPG ((float*)(ws + WS_TOPG))
#define TOPROW ((int*)(ws + WS_TOPROW))
#define RGATE ((float*)(ws + WS_RGATE))
#define XG   ((unsigned char*)(ws + WS_XG))
#define ACT  ((unsigned char*)(ws + WS_ACT))
#define YB   ((unsigned char*)(ws + WS_Y))
#define WGU  ((unsigned char*)(ws + WS_WGU))
#define WD   ((unsigned char*)(ws + WS_WD))
__device__ __forceinline__ GAS unsigned char* opq(const void* p) { GAS unsigned char* q = (GAS unsigned char*)p; asm volatile("" : "+s"(q)); return q; }
typedef const __attribute__((address_space(4))) struct Args* KArgs;
__device__ __forceinline__ KArgs kargs() { auto p = __builtin_amdgcn_kernarg_segment_ptr(); asm volatile("" : "+s"(p)); return (KArgs)p; }

__global__ void __launch_bounds__(512, 2) fwd(Args a) {
    extern __shared__ __attribute__((aligned(16))) unsigned char lds[];
    LAS unsigned char* L = (LAS unsigned char*)lds;
    const int wave = __builtin_amdgcn_readfirstlane((int)threadIdx.x >> 6);
    const int G = gridDim.x, bid = blockIdx.x;
    const int gw = bid * 8 + wave, NGW = G * 8;
    const int NGT = G * 512;
    gu32* ctl = (gu32*)(a.ws + WS_CTL);
    for (int u = wave * 64 + lane_id(); u < (LDS_BYTES - LDSCTL_OFF) / 4; u += 512) ((LAS unsigned*)(L + LDSCTL_OFF))[u] = 0u;
    __syncthreads();
    XcdBarrier bar; bar.bar = (unsigned*)(ctl + CW_BAR); bar.x = 0; bar.st = nullptr;
    if (MK_N_LAUNCHES == 1) bar = xcd_barrier_post((unsigned*)(ctl + CW_BAR), (volatile LAS unsigned*)(L + LDSCTL_OFF), wave == 0 && lane_id() == 0);
    const int lo = a.ph_lo, hi = a.ph_hi;
    unsigned long long pt_prev = PROBE_TIME_MASK ? __builtin_amdgcn_s_memrealtime() : 0ull, pt_acc = 0ull;
#define PT_MARK(k) do { if (PROBE_TIME_MASK) { const unsigned long long now_ = __builtin_amdgcn_s_memrealtime(); if ((PROBE_TIME_MASK >> (k)) & 1) pt_acc += now_ - pt_prev; pt_prev = now_; } } while (0)
#define IN(k) (lo <= (k) && (k) < hi)
#define REPS(k) ((((PROBE_REP_MASK) >> (k)) & 1) + 1)
#define SEAM(k) do { if (IN(k) && IN((k) + 1)) { XcdBarrier b2_ = bar; b2_.bar = (unsigned*)(opq(kargs()->ws) + WS_CTL + (size_t)CW_BAR * 4); xcd_barrier(b2_, wave == 0 && lane_id() == 0); } PT_MARK(k); } while (0)

    if (IN(0)) for (int rep_ = 0; rep_ < REPS(0); ++rep_) { KArgs ka = kargs(); GAS unsigned char* ws = opq(ka->ws); const int lane = lane_id(), tid = wave * 64 + lane, gt = bid * 512 + tid; (void)gt;
        constexpr int I0 = 32 * 61, I1 = 8 * 24, I2 = 4 * 32, I3 = 32 * 32;
        constexpr int NIT = I0 + I1 + I2 + I3;
        for (int it = gw; it < NIT; it += NGW) {
            int r = it;
            if (r < I0) { const int kb = r / 61, nb = r % 61, n0 = nb * 64; int prow, pmode;
                if (n0 < 768) { prow = n0; pmode = 0; } else if (n0 == 768) { prow = 768; pmode = 2; }
                else if (n0 < 2880) { const int q = n0 - 832, reg = q >> 10, w = q & 1023; prow = 1024 + reg * 1024 + (w >> 7) * 128 + ((w >> 6) & 1); pmode = 1; }
                else { prow = n0 + 192; pmode = 0; }
                tr_item(((const float*)(GAS const float*)ka->w_in), INC, WIN, DM, kb * 64, n0, prow, nullptr, lane, pmode); continue; } r -= I0;
            if (r < I1) { const int kb = r / 24, nb = r % 24; tr_item(((const float*)(GAS const float*)ka->w_q_b), 1536, WQB, QLORA, kb * 64, nb * 64, nb * 64, ((const float*)(GAS const float*)ka->g_q_a), lane, (nb % 3) == 2 ? 2 : 0); continue; } r -= I1;
            if (r < I2) { const int kb = r / 32, nb = r % 32; tr_item(((const float*)(GAS const float*)ka->w_kv_b), 2048, WKVB, KVLORA, kb * 64, nb * 64, nb * 64, ((const float*)(GAS const float*)ka->g_kv_a), lane); continue; } r -= I2;
            { const int kb = r / 32, nb = r % 32; tr_item(((const float*)(GAS const float*)ka->w_o), DM, WO, DM, kb * 64, nb * 64, nb * 64, kb < 16 ? ((const float*)(GAS const float*)ka->g_out_mla) : ((const float*)(GAS const float*)ka->g_out_moba) - MW, lane); }
        }
        bg_rounds(ka, ws, 0, BG_P0, gw, NGW, lane);
        for (int i = gt; i < 192 * DM / 8; i += NGT) *(v4u*)(WIN + (size_t)832 * DM + (size_t)i * 8) = (v4u){0u, 0u, 0u, 0u};
#pragma unroll 4
        for (int i = gt; i < T * DM / 8; i += NGT) { const f32x4 v0 = *(const f32x4*)(((const float*)(GAS const float*)ka->x) + (size_t)i * 8), v1 = *(const f32x4*)(((const float*)(GAS const float*)ka->x) + (size_t)i * 8 + 4);
            v4u w; w.x = cvt_pk_bf16(v0[0], v0[1]); w.y = cvt_pk_bf16(v0[2], v0[3]); w.z = cvt_pk_bf16(v1[0], v1[1]); w.w = cvt_pk_bf16(v1[2], v1[3]); *(v4u*)(XB + (size_t)i * 8) = w; }
        if (tid < 384) { const int j = tid % 96, tq = tid / 96; const bool big = j < 64; const int jj = big ? j : j - 64;
            const float inv = (float)exp2(-(double)jj * (big ? 2.0 / 128.0 : 2.0 / 64.0) * 13.287712379549449);
            for (int t = bid * 4 + tq; t < T; t += G * 4) { const float p = (float)((const int*)(GAS const int*)ka->pos)[t]; float sn, cs; sincos_d((double)(p * inv), sn, cs);
                if (big) { C128[t * 64 + jj] = cs; S128[t * 64 + jj] = sn; } else { C64[t * 32 + jj] = cs; S64[t * 32 + jj] = sn; } } }
    }
    SEAM(0);

    if (IN(1)) for (int rep_ = 0; rep_ < REPS(1); ++rep_) { KArgs ka = kargs(); GAS unsigned char* ws = opq(ka->ws);
        pg8::Gemm g{XB, WIN, DM * 2, DM * 2, DM * 2, 0, nullptr}; pg8::StaticOrder S; S.init(T, INP, G, bid);
        pg8::EpiInProj E{(unsigned char*)ws};
        const bool bg_first = ((bid >> 3) & 1) == 0;
        if (bg_first) bg_rounds(ka, ws, BG_P0, BG_P1, gw, NGW, lane_id());
        pg8::gemm_phase<pg8::EpiInProj, pg8::StaticOrder>(L, g, S, E, wave, pt_acc);
        if (!bg_first) bg_rounds(ka, ws, BG_P0, BG_P1, gw, NGW, lane_id());
    }
    SEAM(1);


    if (IN(3)) for (int rep_ = 0; rep_ < REPS(3); ++rep_) { KArgs ka = kargs(); GAS unsigned char* ws = opq(ka->ws);
        { pg8::Gemm g{HQ, WQB, QLORA * 2, QLORA * 2, QLORA * 2, 0, nullptr}; pg8::StaticOrder S; S.init(T, 1536, G, bid); pg8::EpiRowScale<true> E{QM, 1536, (const float*)(ws + WS_SSP), 1.0f / QLORA, C64, S64};
          pg8::gemm_phase<pg8::EpiRowScale<true>, pg8::StaticOrder>(L, g, S, E, wave, pt_acc); }
        { pg8::Gemm g{HKV, WKVB, KVLORA * 2, KVLORA * 2, KVLORA * 2, 0, nullptr}; pg8::StaticOrder S; S.init(T, 2048, G, bid); pg8::EpiRowScale<false> E{KVM, 2048, (const float*)(ws + WS_SSP) + 8, 1.0f / KVLORA, nullptr, nullptr};
          pg8::gemm_phase<pg8::EpiRowScale<false>, pg8::StaticOrder>(L, g, S, E, wave, pt_acc); }
        bg_rounds(ka, ws, BG_P1, BG_P3, gw, NGW, lane_id());
    }
    if (IN(3)) { KArgs ka = kargs(); GAS unsigned char* ws = opq(ka->ws); const int lane = lane_id();
        LAS unsigned* lc = (LAS unsigned*)L;
        for (int it = bid; it < NH * 32; it += G) { const int h = it & 7, blk = it >> 3;
            const int tk = lane & 31, kh = lane >> 5, t = 256 * blk + 32 * wave + tk;
            if (wave == 0) lc[lane] = 0u;
            const float* ksum = (const float*)(ws + WS_KSP) + (size_t)(h * 32 + tk) * 128 + 64 * kh;
            f32x4 ka4[16];
#pragma unroll
            for (int i = 0; i < 16; ++i) ka4[i] = *(const f32x4*)(ksum + 4 * i) + *(const f32x4*)(ksum + NH * 32 * 128 + 4 * i);
            const bf16* qp = MQ + (size_t)t * MW + h * 128 + 64 * kh;
            v4u qv[8];
#pragma unroll
            for (int i = 0; i < 8; ++i) qv[i] = *(const v4u*)(qp + 8 * i);
            asm volatile("s_waitcnt vmcnt(0)" : "+v"(qv[0]), "+v"(qv[1]), "+v"(qv[2]), "+v"(qv[3]), "+v"(qv[4]), "+v"(qv[5]), "+v"(qv[6]), "+v"(qv[7]) :: "memory");
            f32x16 acc = f32x16{};
#pragma unroll
            for (int i = 0; i < 8; ++i) { const unsigned qw[4] = {qv[i].x, qv[i].y, qv[i].z, qv[i].w};
#pragma unroll
                for (int c = 0; c < 4; ++c) { const f32x4 a0 = ka4[2 * i + (c >> 1)];
                    acc = __builtin_amdgcn_mfma_f32_32x32x2f32(a0[(c & 1) * 2], bflo(qw[c]), acc, 0, 0, 0);
                    acc = __builtin_amdgcn_mfma_f32_32x32x2f32(a0[(c & 1) * 2 + 1], bfhi(qw[c]), acc, 0, 0, 0); } }
            float v[16];
#pragma unroll
            for (int r = 0; r < 16; ++r) v[r] = at::crow(r, kh) < blk ? acc[r] : -__builtin_inff();
            int bsel[3];
#pragma unroll
            for (int k = 0; k < 3; ++k) { float bv = v[0]; int bn = at::crow(0, kh);
#pragma unroll
                for (int r = 1; r < 16; ++r) if (v[r] > bv) { bv = v[r]; bn = at::crow(r, kh); }
                const float ov = __shfl_xor(bv, 32); const int on = __shfl_xor(bn, 32);
                if (ov > bv || (ov == bv && on < bn)) { bv = ov; bn = on; }
                bsel[k] = bn;
#pragma unroll
                for (int r = 0; r < 16; ++r) if (at::crow(r, kh) == bn) v[r] = -__builtin_inff(); }
            __syncthreads();
            unsigned lr[3] = {0u, 0u, 0u};
            if (kh == 0) {
#pragma unroll
                for (int k = 0; k < 3; ++k) if (k < blk) lr[k] = __hip_atomic_fetch_add((LAS unsigned*)&lc[bsel[k]], 1u, __ATOMIC_RELAXED, __HIP_MEMORY_SCOPE_WORKGROUP); }
            asm volatile("s_waitcnt lgkmcnt(0)" ::: "memory"); __syncthreads();
            if (wave == 0 && lane < 32) { const unsigned mine = lc[lane]; lc[32 + lane] = mine ? __hip_atomic_fetch_add((unsigned*)(ctl + CW_MCNT + (h * 32 + lane) * 64), mine, RLX_AGENT) : 0u; }
            asm volatile("s_waitcnt vmcnt(0) lgkmcnt(0)" ::: "memory"); __syncthreads();
            if (kh == 0) {
#pragma unroll
                for (int k = 0; k < 3; ++k) if (k < blk) MLIST[(size_t)(h * 32 + bsel[k]) * 8192 + lc[32 + bsel[k]] + lr[k]] = t * 4 + k; }
            __syncthreads();
        }
    }
    SEAM(3);


    if (IN(6)) for (int rep_ = 0; rep_ < REPS(6); ++rep_) { KArgs ka = kargs(); GAS unsigned char* ws = opq(ka->ws);
        LAS int* pref = (LAS int*)(L + 143360);
        LAS int* qslot = (LAS int*)(L + LDSCTL_OFF + 32);
        { const int tid = wave * 64 + lane_id();
          if (tid < 256) { const int cn = (int)__hip_atomic_load((unsigned*)(ctl + CW_MCNT + tid * 64), RLX_AGENT); pref[1 + tid] = 1 + ((cn + 255) >> 8); }
          __syncthreads();
          if (tid < 64) { int v4_[4]; int sum = 0;
#pragma unroll
              for (int i = 0; i < 4; ++i) { v4_[i] = pref[1 + 4 * tid + i]; sum += v4_[i]; }
              int incl = sum;
#pragma unroll
              for (int off = 1; off < 64; off <<= 1) { const int o_ = __shfl_up(incl, off); if (tid >= off) incl += o_; }
              int run = incl - sum;
#pragma unroll
              for (int i = 0; i < 4; ++i) { run += v4_[i]; pref[1 + 4 * tid + i] = run; }
              if (tid == 0) pref[0] = 0; }
          __syncthreads(); }
        const int NM = __builtin_amdgcn_readfirstlane(pref[256]);
        constexpr int NC = (BG_P6 - BG_P3) * 2048 / 32;
        const int N2 = 3 * NM + (NC > 2 * NM ? NC - 2 * NM : 0), Ntot = (256 + N2) > 4096 ? (256 + N2) : 4096;
        for (int iter = 0;; ++iter) {
            if (wave == 0 && lane_id() == 0) qslot[iter & 1] = (int)__hip_atomic_fetch_add((unsigned*)(ctl + CW_QHEAD), 1u, RLX_AGENT);
            __syncthreads();
            const int p = __builtin_amdgcn_readfirstlane(qslot[iter & 1]);
            if (p >= Ntot) break;
            if (p < 4096 && (p & 15) == 0) { const int a0 = p >> 4, h = a0 & 7, sq = 31 - (a0 >> 3);
                for (int d_ = 0; d_ < (PROBE_DUP == 1 ? 2 : 1); ++d_) at::mla_unit((const bf16*)QM + h * QKH, (const bf16*)KVM, (const bf16*)KPE, h, OMIX + h * 128, sq, (char*)lds, wave);
            } else { const int q = p < 4096 ? p - (p >> 4) - 1 : p - 256;
                int mb = -1, cc = -1;
                if (q < 3 * NM) { const int i3 = q / 3, r3 = q - 3 * i3; if (r3 == 0) mb = i3; else { cc = 2 * i3 + r3 - 1; if (cc >= NC) cc = -1; } }
                else { cc = 2 * NM + (q - 3 * NM); if (cc >= NC) cc = -1; }
                if (mb >= 0) { int lo_ = 0, hi_ = 255;
                    while (lo_ < hi_) { const int mid = (lo_ + hi_ + 1) >> 1; if (pref[mid] <= mb) lo_ = mid; else hi_ = mid - 1; }
                    const int hj = __builtin_amdgcn_readfirstlane(lo_), c = mb - __builtin_amdgcn_readfirstlane(pref[lo_]), h = hj >> 5, j = hj & 31;
                    const int cn = (int)__builtin_amdgcn_readfirstlane((int)__hip_atomic_load((unsigned*)(ctl + CW_MCNT + hj * 64), RLX_AGENT));
                    for (int d_ = 0; d_ < (PROBE_DUP == 2 ? 2 : 1); ++d_) at::moba_unit((const bf16*)MQ + h * 128, (const bf16*)MK + h * 128, (const bf16*)MV + h * 128, MLIST + (size_t)hj * 8192, cn, j, c, h, PO, PL, (char*)lds, wave);
                } else if (cc >= 0) bg_run(ka, ws, BG_P3 * 2048 + cc * 32 + wave * 4, 4, 1, lane_id());
            }
        }
    }
    SEAM(6);

    if (IN(7)) for (int rep_ = 0; rep_ < REPS(7); ++rep_) { KArgs ka = kargs(); GAS unsigned char* ws = opq(ka->ws); const int lane = lane_id();
        const int hl = lane >> 4, col8 = (lane & 15) * 8;
        for (int r = gw; r < T; r += NGW) { const int nv = (r >> 8) < 3 ? (r >> 8) : 3;
            f32x4 oa[2][2]; float ssb = 0.f;
#pragma unroll
            for (int ps = 0; ps < 2; ++ps) { const int h = ps * 4 + hl, pb = (r * NH + h) * 4; const f32x4 L4 = *(const f32x4*)(PL + pb);
                float Ls[4] = {nv > 0 ? L4[0] : -__builtin_inff(), nv > 1 ? L4[1] : -__builtin_inff(), nv > 2 ? L4[2] : -__builtin_inff(), L4[3]};
                const float Lm = fmaxf(fmaxf(Ls[0], Ls[1]), fmaxf(Ls[2], Ls[3])); float W = 0.f; f32x4 a0 = {0.f, 0.f, 0.f, 0.f}, a1 = {0.f, 0.f, 0.f, 0.f};
#pragma unroll
                for (int k = 0; k < 4; ++k) { if (k == 3 || k < nv) { const float w = __builtin_amdgcn_exp2f(Ls[k] - Lm); const v4u pv = *(const v4u*)(PO + (size_t)(pb + k) * 128 + col8); W += w;
                        a0[0] = fmaf(w, bflo(pv.x), a0[0]); a0[1] = fmaf(w, bfhi(pv.x), a0[1]); a0[2] = fmaf(w, bflo(pv.y), a0[2]); a0[3] = fmaf(w, bfhi(pv.y), a0[3]);
                        a1[0] = fmaf(w, bflo(pv.z), a1[0]); a1[1] = fmaf(w, bfhi(pv.z), a1[1]); a1[2] = fmaf(w, bflo(pv.w), a1[2]); a1[3] = fmaf(w, bfhi(pv.w), a1[3]); } }
                const float iw = 1.0f / W; a0 = a0 * iw; a1 = a1 * iw; oa[ps][0] = a0; oa[ps][1] = a1;
                ssb += (a0[0] * a0[0] + a0[1] * a0[1]) + (a0[2] * a0[2] + a0[3] * a0[3]) + (a1[0] * a1[0] + a1[1] * a1[1]) + (a1[2] * a1[2] + a1[3] * a1[3]); }
            v4u w[2]; float ssa = 0.f;
#pragma unroll
            for (int j = 0; j < 2; ++j) { w[j] = *(const v4u*)(OMIX + (size_t)r * DM + j * 512 + lane * 8);
                ssa += bflo(w[j].x) * bflo(w[j].x) + bfhi(w[j].x) * bfhi(w[j].x) + bflo(w[j].y) * bflo(w[j].y) + bfhi(w[j].y) * bfhi(w[j].y) + bflo(w[j].z) * bflo(w[j].z) + bfhi(w[j].z) * bfhi(w[j].z) + bflo(w[j].w) * bflo(w[j].w) + bfhi(w[j].w) * bfhi(w[j].w); }
            const float r0 = 1.0f / sqrtf(wave_sum(ssa) * (1.0f / MW) + RMS_EPS), r1 = 1.0f / sqrtf(wave_sum(ssb) * (1.0f / MW) + RMS_EPS);
#pragma unroll
            for (int j = 0; j < 2; ++j) { v4u o;
                o.x = cvt_pk_bf16(bflo(w[j].x) * r0, bfhi(w[j].x) * r0); o.y = cvt_pk_bf16(bflo(w[j].y) * r0, bfhi(w[j].y) * r0); o.z = cvt_pk_bf16(bflo(w[j].z) * r0, bfhi(w[j].z) * r0); o.w = cvt_pk_bf16(bflo(w[j].w) * r0, bfhi(w[j].w) * r0);
                *(v4u*)(OMIX + (size_t)r * DM + j * 512 + lane * 8) = o; }
#pragma unroll
            for (int ps = 0; ps < 2; ++ps) { const f32x4 a0 = oa[ps][0] * r1, a1 = oa[ps][1] * r1; v4u o; o.x = cvt_pk_bf16(a0[0], a0[1]); o.y = cvt_pk_bf16(a0[2], a0[3]); o.z = cvt_pk_bf16(a1[0], a1[1]); o.w = cvt_pk_bf16(a1[2], a1[3]);
                *(v4u*)(OMIX + (size_t)r * DM + MW + (ps * 4 + hl) * 128 + col8) = o; } }
    }
    SEAM(7);

    if (IN(8)) for (int rep_ = 0; rep_ < REPS(8); ++rep_) { KArgs ka = kargs(); GAS unsigned char* ws = opq(ka->ws);
        pg8::Gemm g{OMIX, WO, DM * 2, DM * 2, DM * 2, 0, nullptr}; pg8::StaticOrder S; S.init(T, DM, G, bid); pg8::EpiResBf16 E{XB, (bf16*)X1P, DM};
        const bool bg_first = ((bid >> 3) & 1) == 0;
        if (bg_first) bg_rounds(ka, ws, BG_P6, BG_P8, gw, NGW, lane_id());
        pg8::gemm_phase<pg8::EpiResBf16, pg8::StaticOrder>(L, g, S, E, wave, pt_acc);
        if (!bg_first) bg_rounds(ka, ws, BG_P6, BG_P8, gw, NGW, lane_id());
    }
    SEAM(8);

    if (IN(9)) for (int rep_ = 0; rep_ < REPS(9); ++rep_) { KArgs ka = kargs(); GAS unsigned char* ws = opq(ka->ws); const int lane = lane_id(), tid = wave * 64 + lane, gt = bid * 512 + tid; (void)gt;
        LAS float* part = (LAS float*)L;
        LAS float* lg = (LAS float*)(L + 32768);
        LAS unsigned* lcnt = (LAS unsigned*)(L + 40960);
        LAS int* rowl = (LAS int*)(L + 41472);
        if (tid < 64) lcnt[tid] = 0u;
        for (int rg = bid; rg < T / 32; rg += G) { const int R0 = rg * 32;
            for (int rr = 0; rr < 4; ++rr) { const int r = R0 + wave * 4 + rr; f32x4 v[8]; float s = 0.f;
#pragma unroll
                for (int j = 0; j < 8; ++j) { const v2u w = *(const v2u*)((const bf16*)X1P + (size_t)r * DM + j * 256 + lane * 4); v[j] = (f32x4){bflo(w.x), bfhi(w.x), bflo(w.y), bfhi(w.y)}; s += (v[j][0] + v[j][1]) + (v[j][2] + v[j][3]); }
                const float mean = wave_sum(s) * (1.0f / DM); float q = 0.f;
#pragma unroll
                for (int j = 0; j < 8; ++j) { v[j] = v[j] - mean; q += (v[j][0] * v[j][0] + v[j][1] * v[j][1]) + (v[j][2] * v[j][2] + v[j][3] * v[j][3]); }
                const float rstd = 1.0f / sqrtf(wave_sum(q) * (1.0f / DM) + LN_EPS);
#pragma unroll
                for (int j = 0; j < 8; ++j) { const int c = j * 256 + lane * 4; const f32x4 gg = *(const f32x4*)(((const float*)(GAS const float*)ka->ln1_g) + c), bb = *(const f32x4*)(((const float*)(GAS const float*)ka->ln1_b) + c);
                    const f32x4 y = v[j] * rstd * gg + bb; *(v2u*)(X1N + (size_t)r * DM + c) = pg8::pk4_bf16(y);
                    *(unsigned*)(X1B + (size_t)r * DM + c) = pk4_fp8(y[0] * SC_X, y[1] * SC_X, y[2] * SC_X, y[3] * SC_X); } }
            VM_WAIT(); __syncthreads();
            { f32x16 acc = f32x16{}; const int hh = lane >> 5, li = lane & 31;
              const bf16* ap = X1N + (size_t)(R0 + li) * DM + wave * 256 + 4 * hh; const float* bp = ((const float*)(GAS const float*)ka->w_router) + (size_t)(wave * 256 + 4 * hh) * NE + li;
#pragma unroll 8
              for (int kk = 0; kk < 32; ++kk) { const v2u aw = *(const v2u*)(ap + kk * 8); const f32x4 av = {bflo(aw.x), bfhi(aw.x), bflo(aw.y), bfhi(aw.y)}; const float* b = bp + (size_t)kk * 8 * NE;
                  acc = __builtin_amdgcn_mfma_f32_32x32x2f32(av[0], b[0], acc, 0, 0, 0); acc = __builtin_amdgcn_mfma_f32_32x32x2f32(av[1], b[NE], acc, 0, 0, 0);
                  acc = __builtin_amdgcn_mfma_f32_32x32x2f32(av[2], b[2 * NE], acc, 0, 0, 0); acc = __builtin_amdgcn_mfma_f32_32x32x2f32(av[3], b[3 * NE], acc, 0, 0, 0); }
#pragma unroll
              for (int r = 0; r < 16; ++r) part[(wave * 32 + at::crow(r, hh)) * 32 + li] = acc[r]; }
            __syncthreads();
            for (int i = tid; i < 1024; i += 512) { float s = ((const float*)(GAS const float*)ka->b_router)[i & 31];
#pragma unroll
                for (int w = 0; w < 8; ++w) s += part[w * 1024 + i];
                lg[(i >> 5) * 33 + (i & 31)] = s; }
            __syncthreads();
            if (tid < 32) { float v[32];
#pragma unroll
                for (int e = 0; e < 32; ++e) v[e] = lg[tid * 33 + e];
                float tv[4]; int ti[4];
#pragma unroll
                for (int k = 0; k < 4; ++k) { float best = -__builtin_inff(); int bi = 0;
#pragma unroll
                    for (int e = 0; e < 32; ++e) { if (v[e] > best) { best = v[e]; bi = e; } }
                    tv[k] = best; ti[k] = bi;
#pragma unroll
                    for (int e = 0; e < 32; ++e) if (e == bi) v[e] = -__builtin_inff(); }
                const float e1 = __expf(tv[1] - tv[0]), e2 = __expf(tv[2] - tv[0]), e3 = __expf(tv[3] - tv[0]); const float inv = 1.0f / (1.0f + e1 + e2 + e3);
                const float gk[4] = {inv, e1 * inv, e2 * inv, e3 * inv}; const int r = R0 + tid;
                unsigned lr[4];
#pragma unroll
                for (int k = 0; k < 4; ++k) { lr[k] = __hip_atomic_fetch_add((LAS unsigned*)&lcnt[ti[k]], 1u, __ATOMIC_RELAXED, __HIP_MEMORY_SCOPE_WORKGROUP);
                    }
                asm volatile("s_waitcnt lgkmcnt(0)" ::: "memory");
                const unsigned mine = lcnt[tid]; const unsigned base = mine ? __hip_atomic_fetch_add((unsigned*)(ctl + CW_COUNT + tid * 64), mine, RLX_AGENT) : 0u;
                lcnt[32 + tid] = base; lcnt[tid] = 0u;
                asm volatile("s_waitcnt lgkmcnt(0)" ::: "memory");
#pragma unroll
                for (int k = 0; k < 4; ++k) { const int row = ti[k] * ECAP + (int)(lr[k] + lcnt[32 + ti[k]]); TOPROW[r * 4 + k] = row; RGATE[row] = gk[k]; rowl[tid * 4 + k] = row; if (MOE_GATHER) ROWTOK[row] = r; } }
            __syncthreads();
#pragma unroll 1
            for (int tt = 0; tt < (MOE_GATHER ? 0 : 4); ++tt) { const int tk = wave * 4 + tt; const v4u* src = (const v4u*)(X1B + (size_t)(R0 + tk) * DM); const v4u s0 = src[lane], s1 = src[64 + lane];
#pragma unroll
                for (int k = 0; k < 4; ++k) { v4u* dst = (v4u*)(XG + (size_t)rowl[tk * 4 + k] * DM); dst[lane] = s0; dst[64 + lane] = s1; } }
            __syncthreads();
        }
    }
    SEAM(9);


    if (IN(11)) for (int rep_ = 0; rep_ < REPS(11); ++rep_) { KArgs ka = kargs(); GAS unsigned char* ws = opq(ka->ws);
        LAS unsigned* te = (LAS unsigned*)(L + LDSCTL_OFF + 64);
        { const int i_ = wave * 64 + lane_id();
          if (i_ < NE) { const int c_ = (int)__hip_atomic_load((unsigned*)(ctl + CW_COUNT + i_ * 64), RLX_AGENT), nt_ = (c_ + 255) >> 8; int incl = nt_;
#pragma unroll
              for (int off = 1; off < 32; off <<= 1) { const int o_ = __shfl_up(incl, off); if (i_ >= off) incl += o_; }
              for (int t_ = 0; t_ < nt_; ++t_) te[incl - nt_ + t_] = (unsigned)i_ | ((unsigned)t_ << 8);
              if (i_ == NE - 1) te[MAXRT_TAB] = (unsigned)incl; } }
        __syncthreads();
        const int n_rt = (int)__builtin_amdgcn_readfirstlane((int)te[MAXRT_TAB]);
        LAS unsigned* tk = (LAS unsigned*)(L + pg8::EG_OFF);
        pg8::Gemm g{MOE_GATHER ? (const void*)X1B : (const void*)XG, WGU, DM, DM, DM, (size_t)2 * DFF * DM, tk}; pg8::MoeOrder S{te, n_rt, 4, G, bid};
        LAS float* eb = (LAS float*)(L + pg8::EB_OFF);
        { const int tid_ = wave * 64 + lane_id(), j_ = tid_ & 255; const float* bgu_ = ((const float*)(GAS const float*)ka->b_gate_up);
          for (int i_ = tid_ >> 8; i_ < pg8::EB_CAP && i_ * G + bid < (n_rt << 4); i_ += 2) { const int L_ = i_ * G + bid, e_ = (int)(te[L_ >> 4] & 255u), pn_ = L_ & 15;
              eb[i_ * 256 + j_] = bgu_[(size_t)e_ * (2 * DFF) + (j_ < 128 ? pn_ * 128 + j_ : DFF + pn_ * 128 + (j_ - 128))];
              if (MOE_GATHER) { const int tl_ = (int)(te[L_ >> 4] >> 8), cnt_ = (int)__hip_atomic_load((unsigned*)(ctl + CW_COUNT + e_ * 64), RLX_AGENT), row_ = tl_ * 256 + j_;
                  tk[i_ * 256 + j_] = row_ < cnt_ ? (unsigned)ROWTOK[e_ * ECAP + row_] * (unsigned)DM : 0u; } } }
        __syncthreads();
        pg8::EpiSwiglu E{ACT, eb};
        pg8::gemm_phase<pg8::EpiSwiglu, pg8::MoeOrder, true, true, true, (PROBE_GEMM / 10 == 11 ? PROBE_GEMM % 10 : 0), (MOE_GATHER != 0)>(L, g, S, E, wave, pt_acc);
        if (PROBE_HOT == 11) { LAS unsigned* te2 = (LAS unsigned*)(L + 155648); for (int i_ = wave * 64 + lane_id(); i_ < MAXRT_TAB; i_ += 512) te2[i_] = 0u; __syncthreads();
            pg8::MoeOrder S2{te2, n_rt, 4, G, bid}; pg8::EpiSwiglu E2{(unsigned char*)ws + WS_END, eb};
            pg8::gemm_phase<pg8::EpiSwiglu, pg8::MoeOrder, true, true, true, 0, (MOE_GATHER != 0)>(L, g, S2, E2, wave, pt_acc); }
    }
    SEAM(11);

    if (IN(12)) for (int rep_ = 0; rep_ < REPS(12); ++rep_) { KArgs ka = kargs(); GAS unsigned char* ws = opq(ka->ws);
        LAS unsigned* te = (LAS unsigned*)(L + LDSCTL_OFF + 64);
        { const int i_ = wave * 64 + lane_id();
          if (i_ < NE) { const int c_ = (int)__hip_atomic_load((unsigned*)(ctl + CW_COUNT + i_ * 64), RLX_AGENT), nt_ = (c_ + 255) >> 8; int incl = nt_;
#pragma unroll
              for (int off = 1; off < 32; off <<= 1) { const int o_ = __shfl_up(incl, off); if (i_ >= off) incl += o_; }
              for (int t_ = 0; t_ < nt_; ++t_) te[incl - nt_ + t_] = (unsigned)i_ | ((unsigned)t_ << 8);
              if (i_ == NE - 1) te[MAXRT_TAB] = (unsigned)incl; } }
        __syncthreads();
        const int n_rt = (int)__builtin_amdgcn_readfirstlane((int)te[MAXRT_TAB]);
        pg8::Gemm g{ACT, WD, DFF, DFF, DFF, (size_t)DM * DFF, nullptr}; pg8::MoeOrder S{te, n_rt, 3, G, bid};
        LAS float* eb = (LAS float*)(L + pg8::EB_OFF); LAS float* eg = (LAS float*)(L + pg8::EG_OFF);
        { const int tid_ = wave * 64 + lane_id(), j_ = tid_ & 255; const float* bd_ = ((const float*)(GAS const float*)ka->b_down);
          for (int i_ = tid_ >> 8; i_ < pg8::EG_CAP && i_ * G + bid < (n_rt << 3); i_ += 2) { const int L_ = i_ * G + bid, ent_ = (int)te[L_ >> 3], e_ = ent_ & 255, pn_ = L_ & 7, pm_ = e_ * (ECAP / 256) + (ent_ >> 8);
              eb[i_ * 256 + j_] = bd_[(size_t)e_ * DM + pn_ * 256 + j_]; eg[i_ * 256 + j_] = RGATE[(size_t)pm_ * 256 + j_]; } }
        __syncthreads();
        pg8::EpiDown E{YB, eb, eg};
        pg8::gemm_phase<pg8::EpiDown, pg8::MoeOrder, true, true, true, (PROBE_GEMM / 10 == 12 ? PROBE_GEMM % 10 : 0)>(L, g, S, E, wave, pt_acc);
        if (PROBE_HOT == 12) { LAS unsigned* te2 = (LAS unsigned*)(L + 155648); for (int i_ = wave * 64 + lane_id(); i_ < MAXRT_TAB; i_ += 512) te2[i_] = 0u; __syncthreads();
            pg8::MoeOrder S2{te2, n_rt, 3, G, bid}; pg8::EpiDown E2{(unsigned char*)ws + WS_END, eb, eg};
            pg8::gemm_phase<pg8::EpiDown, pg8::MoeOrder, true>(L, g, S2, E2, wave, pt_acc); }
    }
    SEAM(12);

    if (IN(13)) for (int rep_ = 0; rep_ < REPS(13); ++rep_) { KArgs ka = kargs(); GAS unsigned char* ws = opq(ka->ws); const int lane = lane_id(), tid = wave * 64 + lane, gt = bid * 512 + tid; (void)gt;
        for (int t = gw; t < T; t += NGW) { int rows[4];
#pragma unroll
            for (int k = 0; k < 4; ++k) rows[k] = TOPROW[t * 4 + k];
            f32x4 v[2][4]; float s = 0.f;
#pragma unroll
            for (int j = 0; j < 2; ++j) { const int c = j * 1024 + lane * 16;
                { const v4u xa = *(const v4u*)(X1N + (size_t)t * DM + c), xb = *(const v4u*)(X1N + (size_t)t * DM + c + 8);
                  v[j][0] = (f32x4){bflo(xa.x), bfhi(xa.x), bflo(xa.y), bfhi(xa.y)} * ALPHA; v[j][1] = (f32x4){bflo(xa.z), bfhi(xa.z), bflo(xa.w), bfhi(xa.w)} * ALPHA;
                  v[j][2] = (f32x4){bflo(xb.x), bfhi(xb.x), bflo(xb.y), bfhi(xb.y)} * ALPHA; v[j][3] = (f32x4){bflo(xb.z), bfhi(xb.z), bflo(xb.w), bfhi(xb.w)} * ALPHA; }
#pragma unroll
                for (int k = 0; k < 4; ++k) { const v4u w = *(const v4u*)(YB + (size_t)rows[k] * DM + c); const unsigned wd[4] = {w.x, w.y, w.z, w.w};
#pragma unroll
                    for (int i = 0; i < 4; ++i) { const auto lo2 = __builtin_amdgcn_cvt_pk_f32_fp8((int)wd[i], false), hi2 = __builtin_amdgcn_cvt_pk_f32_fp8((int)wd[i], true);
                        v[j][i][0] += lo2[0] * (1.0f / SC_Y); v[j][i][1] += lo2[1] * (1.0f / SC_Y); v[j][i][2] += hi2[0] * (1.0f / SC_Y); v[j][i][3] += hi2[1] * (1.0f / SC_Y); } }
#pragma unroll
                for (int i = 0; i < 4; ++i) s += (v[j][i][0] + v[j][i][1]) + (v[j][i][2] + v[j][i][3]); }
            const float mean = wave_sum(s) * (1.0f / DM); float q = 0.f;
#pragma unroll
            for (int j = 0; j < 2; ++j)
#pragma unroll
                for (int i = 0; i < 4; ++i) { v[j][i] = v[j][i] - mean; q += (v[j][i][0] * v[j][i][0] + v[j][i][1] * v[j][i][1]) + (v[j][i][2] * v[j][i][2] + v[j][i][3] * v[j][i][3]); }
            const float rstd = 1.0f / sqrtf(wave_sum(q) * (1.0f / DM) + LN_EPS);
#pragma unroll
            for (int j = 0; j < 2; ++j)
#pragma unroll
                for (int i = 0; i < 4; ++i) { const int c = j * 1024 + lane * 16 + 4 * i; const f32x4 gg = *(const f32x4*)(((const float*)(GAS const float*)ka->ln2_g) + c), bb = *(const f32x4*)(((const float*)(GAS const float*)ka->ln2_b) + c);
                    *(f32x4*)(((float*)(GAS float*)ka->out) + (size_t)t * DM + c) = v[j][i] * rstd * gg + bb; } }
    }
    PT_MARK(13);
    if (PROBE_NRT && bid == 0) { const int n_ = (int)__builtin_amdgcn_readfirstlane((int)((LAS unsigned*)(L + LDSCTL_OFF + 64))[MAXRT_TAB]); const unsigned long long t_end = __builtin_amdgcn_s_memrealtime() + (unsigned long long)(n_ - 128) * 2000ull; while (__builtin_amdgcn_s_memrealtime() < t_end) __builtin_amdgcn_s_sleep(8); }
    if ((PROBE_TIME_MASK || PROBE_GEMM) && bid == 0) { const unsigned long long t_end = __builtin_amdgcn_s_memrealtime() + pt_acc; while (__builtin_amdgcn_s_memrealtime() < t_end) __builtin_amdgcn_s_sleep(8); }
#undef IN
#undef SEAM
}

extern "C" void kernel_launch(void* const* d_in, const int* in_sizes, int n_in, void* d_out, int out_size, void* d_ws, size_t ws_size, hipStream_t stream) {
    static int grid = 0;
    if (grid == 0) {
        if (n_in != 20 || in_sizes[0] != T * DM || out_size != T * DM || ws_size < WS_END) { fprintf(stderr, "kernel_launch: unexpected shapes (n_in %d, in0 %d, out %d, ws %zu < %zu)\n", n_in, n_in > 0 ? in_sizes[0] : -1, out_size, ws_size, (size_t)WS_END); grid = -1; return; }
        int dev = 0, cus = 0, per_cu = 0;
        if (hipGetDevice(&dev) != hipSuccess || hipDeviceGetAttribute(&cus, hipDeviceAttributeMultiprocessorCount, dev) != hipSuccess) { grid = -1; return; }
        if (hipFuncSetAttribute((const void*)fwd, hipFuncAttributeMaxDynamicSharedMemorySize, LDS_BYTES) != hipSuccess) { fprintf(stderr, "kernel_launch: hipFuncSetAttribute failed\n"); grid = -1; return; }
        if (hipOccupancyMaxActiveBlocksPerMultiprocessor(&per_cu, (const void*)fwd, 512, LDS_BYTES) != hipSuccess || per_cu < 1) fprintf(stderr, "kernel_launch: occupancy query says %d\n", per_cu);
        (void)hipGetLastError();
        grid = cus;
    }
    if (grid < 0) return;
    (void)hipMemsetAsync((char*)d_ws + WS_CTL, 0, CTL_ZERO_BYTES, stream);
    Args a{};
    a.x = (const float*)d_in[0]; a.pos = (const int*)d_in[1]; a.w_in = (const float*)d_in[2]; a.g_q_a = (const float*)d_in[3]; a.w_q_b = (const float*)d_in[4];
    a.g_kv_a = (const float*)d_in[5]; a.w_kv_b = (const float*)d_in[6]; a.g_out_mla = (const float*)d_in[7]; a.g_out_moba = (const float*)d_in[8]; a.w_o = (const float*)d_in[9];
    a.ln1_g = (const float*)d_in[10]; a.ln1_b = (const float*)d_in[11]; a.w_router = (const float*)d_in[12]; a.b_router = (const float*)d_in[13];
    a.w_gate_up = (const float*)d_in[14]; a.b_gate_up = (const float*)d_in[15]; a.w_down = (const float*)d_in[16]; a.b_down = (const float*)d_in[17];
    a.ln2_g = (const float*)d_in[18]; a.ln2_b = (const float*)d_in[19];
    a.out = (float*)d_out; a.ws = (unsigned char*)d_ws;
    if (MK_N_LAUNCHES == 1) { a.ph_lo = 0; a.ph_hi = NPHASES; hipLaunchKernelGGL(fwd, dim3(grid), dim3(512), LDS_BYTES, stream, a); }
    else { for (int p = 0; p < NPHASES; ++p) { a.ph_lo = p; a.ph_hi = p + 1; hipLaunchKernelGGL(fwd, dim3(grid), dim3(512), LDS_BYTES, stream, a); } }
    const hipError_t le = hipPeekAtLastError();
    if (le != hipSuccess) fprintf(stderr, "kernel_launch: launch failed: %s\n", hipGetErrorName(le));
}
```

```cpp
#include <hip/hip_runtime.h>
#include <cstdio>
#include <cstdint>

#ifndef PROBE_REP_MASK
#define PROBE_REP_MASK 0
#endif
#ifndef PROBE_DUP
#define PROBE_DUP 0
#endif
#ifndef PROBE_GEMM
#define PROBE_GEMM 0
#endif
#ifndef MOE_GATHER
#define MOE_GATHER 1
#endif
#ifndef PROBE_HOT
#define PROBE_HOT 0
#endif
#ifndef PROBE_NRT
#define PROBE_NRT 0
#endif
#ifndef PROBE_TIME_MASK
#define PROBE_TIME_MASK 0
#endif
#ifndef MK_N_LAUNCHES
#define MK_N_LAUNCHES 1
#endif

constexpr int T = 8192, DM = 2048, NH = 8;
constexpr int QLORA = 512, KVLORA = 256, ROPE = 64, NOPE = 128, VH = 128, QKH = NOPE + ROPE;
constexpr int MW = 1024;
constexpr int INC = 3904, INP = 4096;
constexpr int NE = 32, TOPK = 4, DFF = 2048;
constexpr int ECAP = T;
constexpr int MAXROWS = NE * ECAP;
constexpr int MAXRT_TAB = T * TOPK / 256 + NE;
constexpr float ALPHA = 1.189207115002721f;
constexpr float RMS_EPS = 1e-6f, LN_EPS = 1e-5f;

#define GAS __attribute__((address_space(1)))
#define LAS __attribute__((address_space(3)))
typedef unsigned short bf16;
typedef unsigned v4u __attribute__((ext_vector_type(4)));
typedef unsigned v2u __attribute__((ext_vector_type(2)));
typedef float f32x4 __attribute__((ext_vector_type(4)));
typedef float f32x2 __attribute__((ext_vector_type(2)));
typedef float f32x16 __attribute__((ext_vector_type(16)));
typedef short bf16x8 __attribute__((ext_vector_type(8)));
typedef short s16x4 __attribute__((ext_vector_type(4)));
typedef GAS unsigned gu32;
#define RLX_AGENT __ATOMIC_RELAXED, __HIP_MEMORY_SCOPE_AGENT
#define LDS_WAIT() asm volatile("s_waitcnt lgkmcnt(0)" ::: "memory")
#define VM_WAIT() asm volatile("s_waitcnt vmcnt(0)" ::: "memory")
#define SBAR() __builtin_amdgcn_sched_barrier(0)

__device__ __forceinline__ unsigned cvt_pk_bf16(float lo, float hi) { unsigned r; asm volatile("v_cvt_pk_bf16_f32 %0, %1, %2" : "=v"(r) : "v"(lo), "v"(hi)); return r; }
__device__ __forceinline__ float bf2f(unsigned short b) { return __uint_as_float(((unsigned)b) << 16); }
__device__ __forceinline__ float bflo(unsigned w) { return __uint_as_float(w << 16); }
__device__ __forceinline__ float bfhi(unsigned w) { return __uint_as_float(w & 0xffff0000u); }
__device__ __forceinline__ unsigned short f2bf(float f) { return (unsigned short)(cvt_pk_bf16(f, f) & 0xffffu); }
__device__ __forceinline__ unsigned pk4_fp8(float a, float b, float c, float d) { int w = 0; w = __builtin_amdgcn_cvt_pk_fp8_f32(a, b, w, false); w = __builtin_amdgcn_cvt_pk_fp8_f32(c, d, w, true); return (unsigned)w; }
typedef short v2s_t __attribute__((ext_vector_type(2)));
__device__ __forceinline__ unsigned pk4_fp8s(float a, float b, float c, float d, float sc) { v2s_t w = {0, 0}; w = __builtin_amdgcn_cvt_scalef32_pk_fp8_f32(w, a, b, sc, false); w = __builtin_amdgcn_cvt_scalef32_pk_fp8_f32(w, c, d, sc, true); return __builtin_bit_cast(unsigned, w); }
typedef int v4i __attribute__((ext_vector_type(4)));
typedef int v8i __attribute__((ext_vector_type(8)));
__device__ __forceinline__ v8i cat8(bf16x8 a, bf16x8 b) { const v4i x = __builtin_bit_cast(v4i, a), y = __builtin_bit_cast(v4i, b); return __builtin_shufflevector(x, y, 0, 1, 2, 3, 4, 5, 6, 7); }
__device__ __forceinline__ int lane_id() { int l; asm volatile("v_mbcnt_lo_u32_b32 %0, -1, 0\n\tv_mbcnt_hi_u32_b32 %0, -1, %0" : "=v"(l)); return l; }
__device__ __forceinline__ float wave_sum(float v) {
#pragma unroll
    for (int o = 1; o < 64; o <<= 1) v += __shfl_xor(v, o);
    return v;
}

constexpr size_t MiB = 1u << 20;
constexpr size_t WS_CTL = 0, CTL_ZERO_BYTES = 1 * MiB;
constexpr size_t WS_XB    = 2 * MiB;
constexpr size_t WS_WIN   = WS_XB + 32 * MiB;
constexpr size_t WS_WQB   = WS_WIN + 16 * MiB;
constexpr size_t WS_WKVB  = WS_WQB + 2 * MiB;
constexpr size_t WS_WO    = WS_WKVB + 1 * MiB;
constexpr size_t WS_C128  = WS_WO + 8 * MiB;
constexpr size_t WS_S128  = WS_C128 + 2 * MiB;
constexpr size_t WS_C64   = WS_S128 + 2 * MiB;
constexpr size_t WS_S64   = WS_C64 + 1 * MiB;
constexpr size_t WS_HQ    = WS_S64 + 1 * MiB;
constexpr size_t WS_HKV   = WS_HQ + 8 * MiB;
constexpr size_t WS_HR    = WS_HKV + 4 * MiB;
constexpr size_t WS_KPE   = WS_HR + 4 * MiB;
constexpr size_t WS_MQ    = WS_KPE + 1 * MiB;
constexpr size_t WS_MK    = WS_MQ + 16 * MiB;
constexpr size_t WS_MV    = WS_MK + 16 * MiB;
constexpr size_t WS_RSQ   = WS_MV + 16 * MiB;
constexpr size_t WS_RSKV  = WS_RSQ + 1 * MiB;
constexpr size_t WS_QM    = WS_RSKV + 1 * MiB;
constexpr size_t WS_KVM   = WS_QM + 24 * MiB;
constexpr size_t WS_KBAR  = WS_KVM + 32 * MiB;
constexpr size_t WS_SEL   = WS_KBAR + 1 * MiB;
constexpr size_t WS_OMIX  = WS_SEL + 1 * MiB;
constexpr size_t WS_X1P   = WS_OMIX + 32 * MiB;
constexpr size_t WS_X1N   = WS_X1P + 64 * MiB;
constexpr size_t WS_X1B   = WS_X1N + 64 * MiB;
constexpr size_t WS_TOPE  = WS_X1B + 32 * MiB;
constexpr size_t WS_TOPR  = WS_TOPE + 1 * MiB;
constexpr size_t WS_TOPG  = WS_TOPR + 1 * MiB;
constexpr size_t WS_TOPROW= WS_TOPG + 1 * MiB;
constexpr size_t WS_RGATE = WS_TOPROW + 1 * MiB;
constexpr size_t WS_XG    = WS_RGATE + 1 * MiB;
constexpr size_t WS_ACT   = WS_XG + 512 * MiB;
constexpr size_t WS_Y     = WS_ACT + 512 * MiB;
constexpr size_t WS_WGU   = WS_Y + 512 * MiB;
constexpr size_t WS_WD    = WS_WGU + 256 * MiB;
constexpr size_t WS_LIST  = WS_WD + 128 * MiB;
constexpr size_t WS_PO    = WS_LIST + 8 * MiB;
constexpr size_t WS_PL    = WS_PO + 64 * MiB;
constexpr size_t WS_SSP   = WS_PL + 1 * MiB;
constexpr size_t WS_KSP   = WS_SSP + 1 * MiB;
constexpr size_t WS_END   = WS_KSP + 1 * MiB;
constexpr float SC_X = 16.0f, SC_WGU = 512.0f, SC_ACT = 4.0f, SC_WD = 1024.0f, SC_Y = 32.0f;
constexpr int CW_BAR = 4096;
constexpr int CW_COUNT = 65536;
constexpr int CW_TILEE = 16384 + 64;
constexpr int CW_NRT = 16384 + 64 + 192;
constexpr int CW_MCNT = 32768;
constexpr int CW_QHEAD = 20480;

constexpr int LDS_BYTES = 159744;
constexpr int LDSCTL_OFF = 158720;

namespace pg8 {
constexpr int EB_OFF = 131072, EB_CAP = 12, EG_OFF = EB_OFF + EB_CAP * 1024, EG_CAP = 12;
constexpr int BM = 256, BK = 64, HALF = 128, HTB = HALF * BK * 2, STAGE_BYTES = 8 * HTB, NXCD = 8, WGM = 8;
__host__ __device__ __forceinline__ int lds_byte(int r, int c) { const int st = (r >> 4) * 2 + (c >> 5), rr = r & 15, cc = c & 31, ob = rr * 64 + cc * 2; return st * 1024 + (ob ^ (((ob >> 9) & 1) << 5)); }
__host__ __device__ __forceinline__ void stage_rc(int b, int& R, int& C) { const int st = b / 1024, sb = b % 1024, swz = sb ^ (((sb >> 9) & 1) << 5); R = (st >> 1) * 16 + swz / 64; C = (st & 1) * 32 + (swz % 64) / 2; }
__host__ __device__ __forceinline__ int perm32(int rho) { const int n = rho >> 4, i = rho & 15; return 8 * (i >> 2) + 4 * n + (i & 3); }

struct Unit { int pm, pn, e, i; };
struct Gemm { const void* A; const void* Bt; int Kb, lda, ldb; size_t bes; const LAS unsigned* tk; };

struct StaticOrder {
    int nM, nN, nwg, G, c;
    __device__ void init(int M, int N, int G_, int c_) { nM = M / BM; nN = N / BM; nwg = nM * nN; G = G_; c = c_; }
    __device__ bool next(int i, Unit& u) const {
        const long L = (long)i * G + c; if (L >= nwg) return false;
        int wgid = (int)L; { const int q = nwg / NXCD, r = nwg % NXCD, xcd = wgid % NXCD, off = wgid / NXCD; wgid = (xcd < r ? xcd * (q + 1) : r * (q + 1) + (xcd - r) * q) + off; }
        const int nig = WGM * nN, gid = wgid / nig, fm = gid * WGM, gsz = (nM - fm) < WGM ? (nM - fm) : WGM;
        u.pm = fm + ((wgid % nig) % gsz); u.pn = (wgid % nig) / gsz; u.e = 0; u.i = i; return true;
    }
};
struct MoeOrder {
    const LAS unsigned* tile_e; int n_rt, lnpn, G, c;
    __device__ bool next(int i, Unit& u) const {
        const int L = i * G + c; if (L >= (n_rt << lnpn)) return false;
        const int rt = L >> lnpn; u.pn = L - (rt << lnpn);
        const int ent = (int)__builtin_amdgcn_readfirstlane((int)tile_e[rt]); u.e = ent & 255; u.pm = u.e * (ECAP / 256) + (ent >> 8); u.i = i; return true;
    }
};

typedef f32x4 Acc[2][2][4][2];

__device__ __forceinline__ void rope4(const f32x4 v0, const f32x4 v1, const f32x4 c, const f32x4 s, f32x4& o1, f32x4& o2) {
    o1[0] = v0[0] * c[0] - v0[1] * s[0]; o2[0] = v0[1] * c[0] + v0[0] * s[0];
    o1[1] = v0[2] * c[1] - v0[3] * s[1]; o2[1] = v0[3] * c[1] + v0[2] * s[1];
    o1[2] = v1[0] * c[2] - v1[1] * s[2]; o2[2] = v1[1] * c[2] + v1[0] * s[2];
    o1[3] = v1[2] * c[3] - v1[3] * s[3]; o2[3] = v1[3] * c[3] + v1[2] * s[3];
}
__device__ __forceinline__ v2u pk4_bf16(const f32x4 v) { v2u w; w.x = cvt_pk_bf16(v[0], v[1]); w.y = cvt_pk_bf16(v[2], v[3]); return w; }
struct EpiInProj {
    static constexpr bool PERM = true;
    unsigned char* ws;
    __device__ __forceinline__ void operator()(const Acc& acc, const Unit& u, int wr, int wc, int fr, int fq) const {
        const int pn = u.pn; const int row0 = u.pm * BM + wr * 64 + fr, ct0 = wc * 32 + 8 * fq;
        if (pn < 3) {
            bf16* base = (bf16*)(ws + (pn < 2 ? WS_HQ : WS_HKV)); const int ldc = pn < 2 ? 512 : 256, colt = pn == 1 ? 256 : 0;
            float* ss = (float*)(ws + WS_SSP) + (pn < 2 ? pn * 4 + wc : 8 + wc);
#pragma unroll
            for (int ai = 0; ai < 2; ++ai)
#pragma unroll
                for (int m = 0; m < 4; ++m) { const int row = row0 + ai * HALF + m * 16; bf16* rowp = base + (size_t)row * ldc + colt + ct0; float q = 0.f;
#pragma unroll
                    for (int bj = 0; bj < 2; ++bj) { const f32x4 v0 = acc[ai][bj][m][0], v1 = acc[ai][bj][m][1];
                        q += (v0[0] * v0[0] + v0[1] * v0[1]) + (v0[2] * v0[2] + v0[3] * v0[3]) + (v1[0] * v1[0] + v1[1] * v1[1]) + (v1[2] * v1[2] + v1[3] * v1[3]);
                        v4u w; w.x = cvt_pk_bf16(v0[0], v0[1]); w.y = cvt_pk_bf16(v0[2], v0[3]); w.z = cvt_pk_bf16(v1[0], v1[1]); w.w = cvt_pk_bf16(v1[2], v1[3]);
                        *(v4u*)(rowp + bj * HALF) = w; }
                    q += __shfl_xor(q, 16); q += __shfl_xor(q, 32);
                    if (fq == 0) ss[(size_t)row * 16] = q; }
        } else if (pn == 3) {
            if (ct0 < 64) { bf16* KPEp = (bf16*)(ws + WS_KPE); const float* C = (const float*)(ws + WS_C64); const float* S = (const float*)(ws + WS_S64); const int i0 = ct0 >> 1;
                f32x4 cc[2][4], sc[2][4];
#pragma unroll
                for (int ai = 0; ai < 2; ++ai)
#pragma unroll
                    for (int m = 0; m < 4; ++m) { const int row = row0 + ai * HALF + m * 16; cc[ai][m] = *(const f32x4*)(C + row * 32 + i0); sc[ai][m] = *(const f32x4*)(S + row * 32 + i0); }
#pragma unroll
                for (int ai = 0; ai < 2; ++ai)
#pragma unroll
                    for (int m = 0; m < 4; ++m) { const int row = row0 + ai * HALF + m * 16; f32x4 o1, o2;
                        rope4(acc[ai][0][m][0], acc[ai][0][m][1], cc[ai][m], sc[ai][m], o1, o2);
                        *(v2u*)(KPEp + (size_t)row * ROPE + i0) = pk4_bf16(o1); *(v2u*)(KPEp + (size_t)row * ROPE + 32 + i0) = pk4_bf16(o2); } }
        } else if (pn < 8) {
            bf16* base = (bf16*)(ws + WS_MQ); const float* C = (const float*)(ws + WS_C128); const float* S = (const float*)(ws + WS_S128);
            const int i0 = ct0 >> 1, hd0 = ((pn - 4) & 3) * 2;
            f32x4 cc[2][4], sc[2][4];
#pragma unroll
            for (int ai = 0; ai < 2; ++ai)
#pragma unroll
                for (int m = 0; m < 4; ++m) { const int row = row0 + ai * HALF + m * 16; cc[ai][m] = *(const f32x4*)(C + row * 64 + i0); sc[ai][m] = *(const f32x4*)(S + row * 64 + i0); }
            asm volatile("" ::: "memory");
#pragma unroll
            for (int ai = 0; ai < 2; ++ai)
#pragma unroll
                for (int m = 0; m < 4; ++m) { const int row = row0 + ai * HALF + m * 16; const f32x4 c = cc[ai][m], sn = sc[ai][m];
#pragma unroll
                    for (int bj = 0; bj < 2; ++bj) { f32x4 o1, o2; rope4(acc[ai][bj][m][0], acc[ai][bj][m][1], c, sn, o1, o2);
                        bf16* hp = base + (size_t)row * MW + (hd0 + bj) * 128;
                        *(v2u*)(hp + i0) = pk4_bf16(o1); *(v2u*)(hp + 64 + i0) = pk4_bf16(o2); }
                    asm volatile("" ::: "memory"); }
        } else if (pn < 12) {
            bf16* base = (bf16*)(ws + WS_MK); const float* C = (const float*)(ws + WS_C128); const float* S = (const float*)(ws + WS_S128);
            const int i0 = ct0 >> 1, hd0 = ((pn - 8) & 3) * 2;
            f32x4 cs1[2], cs2[2];
#pragma unroll
            for (int bj = 0; bj < 2; ++bj) { cs1[bj] = (f32x4){0.f, 0.f, 0.f, 0.f}; cs2[bj] = (f32x4){0.f, 0.f, 0.f, 0.f}; }
            f32x4 cc[2][4], sc[2][4];
#pragma unroll
            for (int ai = 0; ai < 2; ++ai)
#pragma unroll
                for (int m = 0; m < 4; ++m) { const int row = row0 + ai * HALF + m * 16; cc[ai][m] = *(const f32x4*)(C + row * 64 + i0); sc[ai][m] = *(const f32x4*)(S + row * 64 + i0); }
            asm volatile("" ::: "memory");
#pragma unroll
            for (int ai = 0; ai < 2; ++ai)
#pragma unroll
                for (int m = 0; m < 4; ++m) { const int row = row0 + ai * HALF + m * 16; const f32x4 c = cc[ai][m], sn = sc[ai][m];
#pragma unroll
                    for (int bj = 0; bj < 2; ++bj) { f32x4 o1, o2; rope4(acc[ai][bj][m][0], acc[ai][bj][m][1], c, sn, o1, o2);
                        bf16* hp = base + (size_t)row * MW + (hd0 + bj) * 128;
                        *(v2u*)(hp + i0) = pk4_bf16(o1); *(v2u*)(hp + 64 + i0) = pk4_bf16(o2);
                        cs1[bj] += o1; cs2[bj] += o2; asm volatile("" : "+v"(cs1[bj]), "+v"(cs2[bj])); }
                    asm volatile("" ::: "memory"); }
            float* ks = (float*)(ws + WS_KSP) + wr * (NH * 32 * 128);
#pragma unroll
            for (int bj = 0; bj < 2; ++bj)
#pragma unroll
                for (int k = 0; k < 4; ++k) { float a = cs1[bj][k], b = cs2[bj][k];
#pragma unroll
                    for (int off = 1; off < 16; off <<= 1) { a += __shfl_xor(a, off); b += __shfl_xor(b, off); }
                    if (fr == 0) { float* kp = ks + ((hd0 + bj) * 32 + u.pm) * 128 + i0 + k; kp[0] = a; kp[64] = b; } }
        } else {
            bf16* base = (bf16*)(ws + WS_MV); const int colt = (pn - 12) * 256;
#pragma unroll
            for (int ai = 0; ai < 2; ++ai)
#pragma unroll
                for (int m = 0; m < 4; ++m) { bf16* rowp = base + (size_t)(row0 + ai * HALF + m * 16) * MW + colt + ct0;
#pragma unroll
                    for (int bj = 0; bj < 2; ++bj) { const f32x4 v0 = acc[ai][bj][m][0], v1 = acc[ai][bj][m][1];
                        v4u w; w.x = cvt_pk_bf16(v0[0], v0[1]); w.y = cvt_pk_bf16(v0[2], v0[3]); w.z = cvt_pk_bf16(v1[0], v1[1]); w.w = cvt_pk_bf16(v1[2], v1[3]);
                        *(v4u*)(rowp + bj * HALF) = w; } }
        }
    }
};
template <bool QROPE> struct EpiRowScale {
    static constexpr bool PERM = true;
    bf16* O; int ldc; const float* ss; float inv_k; const float* C; const float* S;
    __device__ __forceinline__ void operator()(const Acc& acc, const Unit& u, int wr, int wc, int fr, int fq) const {
        const int row0 = u.pm * BM + wr * 64 + fr, col0 = u.pn * BM + wc * 32 + 8 * fq;
        float scs[2][4];
#pragma unroll
        for (int ai = 0; ai < 2; ++ai)
#pragma unroll
            for (int m = 0; m < 4; ++m) { const int row = row0 + ai * HALF + m * 16; float sq; { const f32x4 p0 = *(const f32x4*)(ss + (size_t)row * 16); sq = (p0[0] + p0[1]) + (p0[2] + p0[3]); if (QROPE) { const f32x4 p1 = *(const f32x4*)(ss + (size_t)row * 16 + 4); sq += (p1[0] + p1[1]) + (p1[2] + p1[3]); } }
                scs[ai][m] = 1.0f / sqrtf(sq * inv_k + RMS_EPS); }
        asm volatile("" ::: "memory");
        const int w0_ = col0 % QKH, w1_ = (col0 + HALF) % QKH; const bool rl = QROPE && (w0_ >= NOPE || w1_ >= NOPE); const int ir = ((w0_ >= NOPE ? w0_ : w1_) - NOPE) >> 1;
#pragma unroll
        for (int am = 0; am < 4; ++am) { const int ai = am >> 1;
            f32x4 cc[4], sn[4];
            if (rl) {
#pragma unroll
                for (int m = (am & 1) * 2; m < (am & 1) * 2 + 2; ++m) { const int row = row0 + ai * HALF + m * 16; cc[m] = *(const f32x4*)(C + row * 32 + ir); sn[m] = *(const f32x4*)(S + row * 32 + ir); }
            }
#pragma unroll
            for (int m = (am & 1) * 2; m < (am & 1) * 2 + 2; ++m) { const int row = row0 + ai * HALF + m * 16; const float sc = scs[ai][m]; bf16* rowp = O + (size_t)row * ldc;
#pragma unroll
                for (int bj = 0; bj < 2; ++bj) { const int col = col0 + bj * HALF; const f32x4 v0 = acc[ai][bj][m][0] * sc, v1 = acc[ai][bj][m][1] * sc;
                    const int hd = col / QKH, w = col - hd * QKH;
                    if (QROPE && w >= NOPE) { const int i0 = (w - NOPE) >> 1; f32x4 o1, o2; rope4(v0, v1, cc[m], sn[m], o1, o2);
                        *(v2u*)(rowp + hd * QKH + NOPE + i0) = pk4_bf16(o1); *(v2u*)(rowp + hd * QKH + NOPE + 32 + i0) = pk4_bf16(o2); }
                    else { v4u wv; wv.x = cvt_pk_bf16(v0[0], v0[1]); wv.y = cvt_pk_bf16(v0[2], v0[3]); wv.z = cvt_pk_bf16(v1[0], v1[1]); wv.w = cvt_pk_bf16(v1[2], v1[3]);
                        *(v4u*)(rowp + col) = wv; } } } }
    }
};
struct EpiResBf16 {
    static constexpr bool PERM = true;
    const bf16* X; bf16* O; int ldc;
    __device__ __forceinline__ void operator()(const Acc& acc, const Unit& u, int wr, int wc, int fr, int fq) const {
        const int row0 = u.pm * BM + wr * 64 + fr, col0 = u.pn * BM + wc * 32 + 8 * fq;
        v4u xr[2][4][2];
#pragma unroll
        for (int ai = 0; ai < 2; ++ai)
#pragma unroll
            for (int m = 0; m < 4; ++m) { const size_t off = (size_t)(row0 + ai * HALF + m * 16) * ldc + col0;
#pragma unroll
                for (int bj = 0; bj < 2; ++bj) xr[ai][m][bj] = *(const v4u*)(X + off + bj * HALF); }
        asm volatile("" ::: "memory");
#pragma unroll
        for (int ai = 0; ai < 2; ++ai)
#pragma unroll
            for (int m = 0; m < 4; ++m) { const size_t off = (size_t)(row0 + ai * HALF + m * 16) * ldc + col0;
#pragma unroll
                for (int bj = 0; bj < 2; ++bj) { const v4u xv = xr[ai][m][bj]; const f32x4 v0 = acc[ai][bj][m][0], v1 = acc[ai][bj][m][1];
                    v4u w; w.x = cvt_pk_bf16(bflo(xv.x) * ALPHA + v0[0], bfhi(xv.x) * ALPHA + v0[1]); w.y = cvt_pk_bf16(bflo(xv.y) * ALPHA + v0[2], bfhi(xv.y) * ALPHA + v0[3]);
                    w.z = cvt_pk_bf16(bflo(xv.z) * ALPHA + v1[0], bfhi(xv.z) * ALPHA + v1[1]); w.w = cvt_pk_bf16(bflo(xv.w) * ALPHA + v1[2], bfhi(xv.w) * ALPHA + v1[3]);
                    *(v4u*)(O + off + bj * HALF) = w; }
                asm volatile("" ::: "memory"); }
    }
};
struct EpiSwiglu {
    static constexpr bool PERM = true;
    unsigned char* ACT; const LAS float* eb;
    __device__ __forceinline__ void operator()(const Acc& acc, const Unit& u, int wr, int wc, int fr, int fq) const {
        const int row0 = u.pm * BM + wr * 64 + fr, j0 = u.pn * HALF + wc * 32 + 8 * fq;
        const LAS float* bg = eb + (u.i < EB_CAP ? u.i : EB_CAP - 1) * 256 + wc * 32 + 8 * fq; const LAS float* bu = bg + HALF;
        const f32x4 bg0 = *(const LAS f32x4*)bg, bg1 = *(const LAS f32x4*)(bg + 4), bu0 = *(const LAS f32x4*)bu, bu1 = *(const LAS f32x4*)(bu + 4);
        f32x2 ks = {1.0f / (SC_X * SC_WGU), 1.0f / (SC_X * SC_WGU)}, kc = {-1.702f * 1.4426950408889634f, -1.702f * 1.4426950408889634f}, one = {1.0f, 1.0f}, sa = {SC_ACT, SC_ACT};
        asm volatile("" : "+s"(ks), "+s"(kc), "+s"(one), "+s"(sa));
#pragma unroll
        for (int ai = 0; ai < 2; ++ai)
#pragma unroll
            for (int m = 0; m < 4; ++m) { unsigned char* rowp = ACT + (size_t)(row0 + ai * HALF + m * 16) * DFF + j0;
                f32x2 a[4];
#pragma unroll
                for (int n = 0; n < 2; ++n) { const f32x4 ag = acc[ai][0][m][n], au = acc[ai][1][m][n], bgv = n ? bg1 : bg0, buv = n ? bu1 : bu0;
#pragma unroll
                    for (int p = 0; p < 2; ++p) { const f32x2 gv = (f32x2){ag[2 * p], ag[2 * p + 1]} * ks + (f32x2){bgv[2 * p], bgv[2 * p + 1]}, uv = (f32x2){au[2 * p], au[2 * p + 1]} * ks + (f32x2){buv[2 * p], buv[2 * p + 1]};
                        const f32x2 g = {fminf(gv[0], 7.0f), fminf(gv[1], 7.0f)}, uu = {fminf(fmaxf(uv[0], -7.0f), 7.0f), fminf(fmaxf(uv[1], -7.0f), 7.0f)};
                        const f32x2 t = g * kc; const f32x2 d = (f32x2){__builtin_amdgcn_exp2f(t[0]), __builtin_amdgcn_exp2f(t[1])} + one;
                        const f32x2 sg = {__builtin_amdgcn_rcpf(d[0]), __builtin_amdgcn_rcpf(d[1])};
                        a[n * 2 + p] = (uu * sa + sa) * g * sg; } }
                v2u w; w.x = pk4_fp8(a[0][0], a[0][1], a[1][0], a[1][1]); w.y = pk4_fp8(a[2][0], a[2][1], a[3][0], a[3][1]);
                *(v2u*)rowp = w; }
    }
};
struct EpiDown {
    static constexpr bool PERM = true;
    unsigned char* Y; const LAS float* eb; const LAS float* eg;
    __device__ __forceinline__ void operator()(const Acc& acc, const Unit& u, int wr, int wc, int fr, int fq) const {
        const int row0 = u.pm * BM + wr * 64 + fr, col0 = u.pn * BM + wc * 32 + 8 * fq;
        const int sl = (u.i < EG_CAP ? u.i : EG_CAP - 1) * 256;
        const LAS float* bp = eb + sl + wc * 32 + 8 * fq;
        f32x4 bv[2][2];
#pragma unroll
        for (int bj = 0; bj < 2; ++bj)
#pragma unroll
            for (int n = 0; n < 2; ++n) bv[bj][n] = *(const LAS f32x4*)(bp + bj * HALF + 4 * n);
        float rg[2][4];
#pragma unroll
        for (int ai = 0; ai < 2; ++ai)
#pragma unroll
            for (int m = 0; m < 4; ++m) rg[ai][m] = eg[sl + wr * 64 + fr + ai * HALF + m * 16];
#pragma unroll
        for (int ai = 0; ai < 2; ++ai)
#pragma unroll
            for (int m = 0; m < 4; ++m) { const int row = row0 + ai * HALF + m * 16; const float s = rg[ai][m] * SC_Y; unsigned char* rowp = Y + (size_t)row * DM + col0;
#pragma unroll
                for (int bj = 0; bj < 2; ++bj) { const f32x4 v0 = (acc[ai][bj][m][0] * (1.0f / (SC_ACT * SC_WD)) + bv[bj][0]) * s, v1 = (acc[ai][bj][m][1] * (1.0f / (SC_ACT * SC_WD)) + bv[bj][1]) * s;
                    v2u w; w.x = pk4_fp8(v0[0], v0[1], v0[2], v0[3]); w.y = pk4_fp8(v1[0], v1[1], v1[2], v1[3]);
                    *(v2u*)(rowp + bj * HALF) = w; } }
    }
};

template <class Epi, class Sched, bool F8 = false, bool ALIGN_EPI = true, bool SP2 = true, int PM = 0, bool GA = false>
__device__ __forceinline__ void gemm_phase(LAS unsigned char* lds, const Gemm g, const Sched& S, const Epi& E, const int wid  , unsigned long long& pacc  ) {
    const int lane = lane_id(), tid = wid * 64 + lane, wr = wid >> 2, wc = wid & 3, fr = lane & 15, fq = lane >> 4;
    const int nt = g.Kb / 128;
    const __amdgpu_buffer_rsrc_t rA = __builtin_amdgcn_make_buffer_rsrc((void*)g.A, 0, -1, 0x00020000);
    const __amdgpu_buffer_rsrc_t rB = __builtin_amdgcn_make_buffer_rsrc((void*)g.Bt, 0, -1, 0x00020000);
    unsigned voffA, voffB;
    int Rrow;
    { int R, C; stage_rc(tid * 16, R, C); const int Rb = Epi::PERM ? ((R & ~31) + perm32(R & 31)) : R; Rrow = R;
        voffA = GA ? (unsigned)(C * 2) : (unsigned)(R * g.lda + C * 2); voffB = (unsigned)(Rb * g.ldb + C * 2); }
    const unsigned dA = 64u * (unsigned)g.lda, dB = 64u * (unsigned)g.ldb;
    const unsigned kstep = 128u;
    const unsigned hstepA = (unsigned)HALF * g.lda, hstepB = (unsigned)HALF * g.ldb;
    const unsigned tstepA = 2 * hstepA, tstepB = 2 * hstepB;
    const unsigned ldsw = (unsigned)wid * 1024u;
    const int aoff = lds_byte(wr * 64 + fr, fq * 8), boff = lds_byte(wc * 32 + fr, fq * 8);
#define PG8_SA(b, h) (((b) * 2 + (h)) * HTB)
#define PG8_SB(b, h) ((4 + (b) * 2 + (h)) * HTB)
#define PG8_STAGE(bufoff, rsrc, soff, voff) do { _Pragma("unroll") for (int _i = 0; _i < 2; ++_i) \
        __builtin_amdgcn_raw_ptr_buffer_load_lds(rsrc, (LAS unsigned*)(lds + (bufoff) + ldsw + _i * 8192), 16, (voff), (soff) + _i * (&(voff) == &voffA ? dA : dB), 0, 0); } while (0)
#define PG8_STGA(b, h, soff_full, koff, slot) do { if constexpr (GA) { _Pragma("unroll") for (int _i = 0; _i < 2; ++_i) { const unsigned o_ = g.tk[(slot) + Rrow + 64 * _i + 128 * (h)]; \
        __builtin_amdgcn_raw_ptr_buffer_load_lds(rA, (LAS unsigned*)(lds + PG8_SA(b, h) + ldsw + _i * 8192), 16, o_ + voffA, (koff), 0, 0); } } else PG8_STAGE(PG8_SA(b, h), rA, (soff_full), voffA); } while (0)
    LAS unsigned char* ldsA = lds + aoff; LAS unsigned char* ldsB = lds + 4 * HTB + boff; asm volatile("" : "+v"(ldsA), "+v"(ldsB));
#define PG8_LDA(dst, b, h) do { _Pragma("unroll") for (int m = 0; m < 4; ++m) _Pragma("unroll") for (int k = 0; k < 2; ++k) dst[m][k] = *(const LAS bf16x8*)(ldsA + PG8_SA(b, h) + m * 2048 + k * 1024); } while (0)
#define PG8_LDB(dst, b, h) do { _Pragma("unroll") for (int n = 0; n < 2; ++n) _Pragma("unroll") for (int k = 0; k < 2; ++k) dst[n][k] = *(const LAS bf16x8*)(ldsB + (PG8_SB(b, h) - 4 * HTB) + n * 2048 + k * 1024); } while (0)
#define PG8_MMA(ai, bj, At, Bt) do { __builtin_amdgcn_s_setprio(1); if constexpr (F8) { _Pragma("unroll") for (int m = 0; m < 4; ++m) _Pragma("unroll") for (int n = 0; n < 2; ++n) \
        acc[ai][bj][m][n] = __builtin_amdgcn_mfma_scale_f32_16x16x128_f8f6f4(cat8(Bt[n][0], Bt[n][1]), cat8(At[m][0], At[m][1]), acc[ai][bj][m][n], 0, 0, 0, 0, 0, 0); } \
        else { _Pragma("unroll") for (int m = 0; m < 4; ++m) _Pragma("unroll") for (int n = 0; n < 2; ++n) _Pragma("unroll") for (int k = 0; k < 2; ++k) \
        acc[ai][bj][m][n] = __builtin_amdgcn_mfma_f32_16x16x32_bf16(Bt[n][k], At[m][k], acc[ai][bj][m][n], 0, 0, 0); } __builtin_amdgcn_s_setprio(0); } while (0)
#define PG8_WAIT_V(n) asm volatile("s_waitcnt vmcnt(" #n ")" ::: "memory")
#define PG8_WAIT_L(n) asm volatile("s_waitcnt lgkmcnt(" #n ")" ::: "memory")
#define PG8_BAR __builtin_amdgcn_s_barrier()
#define PG8_SCHED __builtin_amdgcn_sched_barrier(0)
    Unit cur, nxt; int ui = 0;
    if (!S.next(0, cur)) return;
    Acc acc;
#pragma unroll
    for (int a = 0; a < 2; ++a)
#pragma unroll
        for (int b = 0; b < 2; ++b)
#pragma unroll
            for (int m = 0; m < 4; ++m)
#pragma unroll
                for (int n = 0; n < 2; ++n) acc[a][b][m][n] = (f32x4){0.f, 0.f, 0.f, 0.f};
    bf16x8 At[4][2], B0[2][2], B1[2][2];
    unsigned cA = (unsigned)cur.pm * tstepA, cB = (unsigned)((size_t)cur.e * g.bes) + (unsigned)cur.pn * tstepB;
    static_assert(!GA || SP2, "gathered A rows: SP2 schedule only");
    int sA = GA ? cur.i * 256 : 0, snA = 0;
    if constexpr (SP2) {
        PG8_STAGE(PG8_SB(0, 0), rB, cB, voffB); PG8_STAGE(PG8_SB(0, 1), rB, cB + hstepB, voffB); PG8_STGA(0, 0, cA, 0u, sA); PG8_STGA(0, 1, cA + hstepA, 0u, sA);
        if (wr == 1) PG8_BAR;
        PG8_WAIT_V(2); PG8_BAR;
        PG8_STAGE(PG8_SB(1, 0), rB, cB + kstep, voffB); PG8_STGA(1, 0, cA + kstep, kstep, sA); PG8_STAGE(PG8_SB(1, 1), rB, cB + hstepB + kstep, voffB);
        PG8_WAIT_V(6); PG8_BAR;
    } else {
        PG8_STAGE(PG8_SB(0, 0), rB, cB, voffB); PG8_STAGE(PG8_SA(0, 0), rA, cA, voffA); PG8_STAGE(PG8_SB(0, 1), rB, cB + hstepB, voffB); PG8_STAGE(PG8_SA(0, 1), rA, cA + hstepA, voffA);
        if (wr == 1) PG8_BAR;
        PG8_WAIT_V(4); PG8_BAR;
        PG8_STAGE(PG8_SB(1, 0), rB, cB + kstep, voffB); PG8_STAGE(PG8_SA(1, 0), rA, cA + kstep, voffA); PG8_STAGE(PG8_SB(1, 1), rB, cB + hstepB + kstep, voffB);
        PG8_WAIT_V(6); PG8_BAR;
    }
    for (;;) {
        unsigned long long tq0 = 0, tq1 = 0; if constexpr (PM != 0) tq0 = __builtin_amdgcn_s_memrealtime();
        const bool has_next = S.next(ui + 1, nxt);
        if constexpr (GA) snA = has_next ? nxt.i * 256 : sA;
        const unsigned nA = has_next ? (unsigned)nxt.pm * tstepA : cA; const unsigned nB = has_next ? (unsigned)((size_t)nxt.e * g.bes) + (unsigned)nxt.pn * tstepB : cB;
        for (int t = 0; t < nt; t += 2) {
            const bool last = (t == nt - 2);
            const unsigned a1 = cA + (unsigned)(t + 1) * kstep;
            const unsigned a2 = last ? nA : cA + (unsigned)(t + 2) * kstep; const unsigned b2 = last ? nB : cB + (unsigned)(t + 2) * kstep;
            const unsigned a3 = a2 + kstep; const unsigned b3 = b2 + kstep;
            const unsigned k1 = (unsigned)(t + 1) * kstep, k2 = last ? 0u : (unsigned)(t + 2) * kstep, k3 = k2 + kstep; const int sl2 = last ? snA : sA;
            if constexpr (SP2) {
            PG8_LDB(B0, 0, 0); PG8_LDB(B1, 0, 1); PG8_SCHED; PG8_LDA(At, 0, 0); PG8_STGA(1, 1, a1 + hstepA, k1, sA);
            PG8_WAIT_V(8); PG8_WAIT_L(0); PG8_BAR; PG8_MMA(0, 0, At, B0); PG8_MMA(0, 1, At, B1); PG8_BAR; PG8_SCHED;
            PG8_LDA(At, 0, 1); PG8_STAGE(PG8_SB(0, 0), rB, b2, voffB); PG8_STAGE(PG8_SB(0, 1), rB, b2 + hstepB, voffB); PG8_STGA(0, 0, a2, k2, sl2);
            PG8_WAIT_V(8); PG8_WAIT_L(0); PG8_BAR; PG8_MMA(1, 0, At, B0); PG8_MMA(1, 1, At, B1); PG8_BAR; PG8_SCHED;
            PG8_LDB(B0, 1, 0); PG8_LDB(B1, 1, 1); PG8_SCHED; PG8_LDA(At, 1, 0); PG8_STGA(0, 1, a2 + hstepA, k2, sl2);
            PG8_WAIT_V(8); PG8_WAIT_L(0); PG8_BAR; PG8_MMA(0, 0, At, B0); PG8_MMA(0, 1, At, B1); PG8_BAR; PG8_SCHED;
            PG8_LDA(At, 1, 1); PG8_STAGE(PG8_SB(1, 0), rB, b3, voffB); PG8_STAGE(PG8_SB(1, 1), rB, b3 + hstepB, voffB); PG8_STGA(1, 0, a3, k3, sl2);
            PG8_WAIT_V(8); PG8_WAIT_L(0); PG8_BAR; PG8_MMA(1, 0, At, B0); PG8_MMA(1, 1, At, B1); PG8_BAR; PG8_SCHED;
            } else {
            PG8_LDB(B0, 0, 0); PG8_SCHED; PG8_LDA(At, 0, 0); PG8_STAGE(PG8_SA(1, 1), rA, a1 + hstepA, voffA);
            PG8_WAIT_L(8); PG8_BAR; PG8_WAIT_L(0); PG8_MMA(0, 0, At, B0); PG8_BAR; PG8_SCHED;
            PG8_LDB(B1, 0, 1); PG8_STAGE(PG8_SB(0, 0), rB, b2, voffB);
            PG8_BAR; PG8_WAIT_L(0); PG8_MMA(0, 1, At, B1); PG8_BAR;
            PG8_LDA(At, 0, 1); PG8_STAGE(PG8_SA(0, 0), rA, a2, voffA);
            PG8_BAR; PG8_WAIT_L(0); PG8_MMA(1, 0, At, B0); PG8_BAR; PG8_SCHED;
            PG8_STAGE(PG8_SB(0, 1), rB, b2 + hstepB, voffB);
            PG8_WAIT_V(6); PG8_BAR; PG8_MMA(1, 1, At, B1); PG8_BAR;
            PG8_LDB(B0, 1, 0); PG8_SCHED; PG8_LDA(At, 1, 0); PG8_STAGE(PG8_SA(0, 1), rA, a2 + hstepA, voffA);
            PG8_WAIT_L(8); PG8_BAR; PG8_WAIT_L(0); PG8_MMA(0, 0, At, B0); PG8_BAR; PG8_SCHED;
            PG8_LDB(B1, 1, 1); PG8_STAGE(PG8_SB(1, 0), rB, b3, voffB);
            PG8_BAR; PG8_WAIT_L(0); PG8_MMA(0, 1, At, B1); PG8_BAR;
            PG8_LDA(At, 1, 1); PG8_STAGE(PG8_SA(1, 0), rA, a3, voffA);
            PG8_BAR; PG8_WAIT_L(0); PG8_MMA(1, 0, At, B0); PG8_BAR; PG8_SCHED;
            PG8_STAGE(PG8_SB(1, 1), rB, b3 + hstepB, voffB);
            PG8_WAIT_V(6); PG8_BAR; PG8_MMA(1, 1, At, B1); PG8_BAR;
            }
        }
        if constexpr (ALIGN_EPI) { if (wr == 0) PG8_BAR; }
        if constexpr (PM != 0) tq1 = __builtin_amdgcn_s_memrealtime();
        { const int l2 = lane_id(); E(acc, cur, wr, wc, l2 & 15, l2 >> 4); }
        if constexpr (PM != 0) { const unsigned long long tq2 = __builtin_amdgcn_s_memrealtime(); if (PM == 1) pacc += tq1 - tq0; else if (PM == 2) pacc += tq2 - tq1; else if (PM == 3 && ui == 0) pacc += tq2 - tq0; else if (PM == 4 && ui == 1) pacc += tq2 - tq0; }
        if (!has_next) break;
#pragma unroll
        for (int a = 0; a < 2; ++a)
#pragma unroll
            for (int b = 0; b < 2; ++b)
#pragma unroll
                for (int m = 0; m < 4; ++m)
#pragma unroll
                    for (int n = 0; n < 2; ++n) acc[a][b][m][n] = (f32x4){0.f, 0.f, 0.f, 0.f};
        cur = nxt; cA = nA; cB = nB; sA = snA; ++ui;
        if constexpr (ALIGN_EPI) { if (wr == 1) PG8_BAR; }
    }
    PG8_WAIT_V(0);
    if constexpr (!ALIGN_EPI) { if (wr == 0) PG8_BAR; }
    PG8_BAR;
#undef PG8_STGA
#undef PG8_SA
#undef PG8_SB
#undef PG8_STAGE
#undef PG8_LDA
#undef PG8_LDB
#undef PG8_MMA
#undef PG8_WAIT_V
#undef PG8_WAIT_L
#undef PG8_BAR
#undef PG8_SCHED
}
}

namespace at {
constexpr int SHM_V = 16384, SHM_K = 16384, SHM_K2 = 8192;
constexpr int OFF_V = 0, OFF_K = 2 * SHM_V, OFF_K2 = OFF_K + 2 * SHM_K, OFF_WS = OFF_K2 + 2 * SHM_K2, ATTN_LDS = OFF_WS + 8 * 64 * 4;
#define KSWZ(row, colB) ((row) * 256 + ((colB) ^ (((row) & 7) << 4)))
#define KSW4(row, chunk) ((row) * 256 + (((chunk) ^ (((row) & 7) | ((((row) >> 4) & 1) << 3))) << 4))
#define K2SWZ(row, colB) ((row) * 128 + ((colB) ^ ((((row) >> 1) & 7) << 4)))
__device__ __forceinline__ int v_st(int k, int c) { const int kk = (k & ~0xC) | ((k & 4) << 1) | ((k & 8) >> 1); return ((kk >> 3) * 4 + (c >> 5)) * 512 + ((kk & 7) * 32 + (c & 31)) * 2; }
__device__ __forceinline__ int v_rd_base(int lane) { return ((lane & 3) << 3) | (((lane >> 2) & 3) << 6) | (((lane >> 4) & 1) << 5) | (((lane >> 5) & 1) << 8); }
constexpr int v_rd_off(int d0, int ks, int half) { return d0 * 512 + ks * 4096 + half * 2048; }
__device__ __forceinline__ int crow(int r, int hi) { return (r & 3) + 8 * (r >> 2) + 4 * hi; }

template <int VB>
__device__ __forceinline__ void pv_tile(f32x16* o, int vb0, bf16x8 pa0, bf16x8 pa1, bf16x8 pa2, bf16x8 pa3) {
#define TRRD(dst, off) asm volatile("ds_read_b64_tr_b16 %0, %1 offset:%2" : "=&v"(dst) : "v"(vb0), "i"(off) : "memory")
#define PV_D0(d0) do { s16x4 l0, l1, l2, l3, h0, h1, h2, h3; constexpr int b_ = VB * SHM_V + v_rd_off(d0, 0, 0); \
        TRRD(l0, b_); TRRD(h0, b_ + 2048); TRRD(l1, b_ + 4096); TRRD(h1, b_ + 6144); TRRD(l2, b_ + 8192); TRRD(h2, b_ + 10240); TRRD(l3, b_ + 12288); TRRD(h3, b_ + 14336); \
        asm volatile("s_waitcnt lgkmcnt(0)" ::: "memory"); SBAR(); \
        o[d0] = __builtin_amdgcn_mfma_f32_32x32x16_bf16(pa0, (bf16x8){l0[0], l0[1], l0[2], l0[3], h0[0], h0[1], h0[2], h0[3]}, o[d0], 0, 0, 0); \
        o[d0] = __builtin_amdgcn_mfma_f32_32x32x16_bf16(pa1, (bf16x8){l1[0], l1[1], l1[2], l1[3], h1[0], h1[1], h1[2], h1[3]}, o[d0], 0, 0, 0); \
        o[d0] = __builtin_amdgcn_mfma_f32_32x32x16_bf16(pa2, (bf16x8){l2[0], l2[1], l2[2], l2[3], h2[0], h2[1], h2[2], h2[3]}, o[d0], 0, 0, 0); \
        o[d0] = __builtin_amdgcn_mfma_f32_32x32x16_bf16(pa3, (bf16x8){l3[0], l3[1], l3[2], l3[3], h3[0], h3[1], h3[2], h3[3]}, o[d0], 0, 0, 0); } while (0)
    PV_D0(0); PV_D0(1); PV_D0(2); PV_D0(3);
#undef PV_D0
#undef TRRD
}

constexpr int ML_OFF_K = 0, ML_OFF_K2 = 32768, ML_OFF_V = 49152, ML_OFF_WS = 81920, MLA_LDS = ML_OFF_WS + 8 * 64 * 4;
__device__ __forceinline__ void mla_unit(const bf16* Qp, const bf16* KVMp, const bf16* KPEp, int h, bf16* Op, int qb, char* lds, const int wid) {
    constexpr float SCALE = 0.07216878364870322f, C2 = 1.4426950408889634f * SCALE, THR = 8.f;
    const int lane = lane_id(), r32 = lane & 31, hi = lane >> 5;
    const int q0 = qb * 256, qlo = q0 + wid * 32, qrow = qlo + r32, qm = qrow - 4 * hi;
    char* K_lds = lds + ML_OFF_K; char* K2_lds = lds + ML_OFF_K2; char* V_lds = lds + ML_OFF_V;
    float* ws = (float*)(lds + ML_OFF_WS) + wid * 64; float* li_l = ws; float* al_l = ws + 32;
    bf16x8 qr[8], qr2[4];
    { const bf16* Qw = Qp + (size_t)qrow * 1536 + hi * 8;
#pragma unroll
      for (int d0 = 0; d0 < 8; ++d0) qr[d0] = *(const bf16x8*)(Qw + d0 * 16);
#pragma unroll
      for (int d0 = 0; d0 < 4; ++d0) qr2[d0] = *(const bf16x8*)(Qw + 128 + d0 * 16); }
    const __amdgpu_buffer_rsrc_t rKV = __builtin_amdgcn_make_buffer_rsrc((void*)KVMp, 0, -1, 0x00020000);
    const __amdgpu_buffer_rsrc_t rK2 = __builtin_amdgcn_make_buffer_rsrc((void*)KPEp, 0, -1, 0x00020000);
    unsigned vK[2], vV[2], vK2;
#pragma unroll
    for (int i = 0; i < 2; ++i) { const int rowk = 4 * (2 * wid + i) + (lane >> 4), ck = (lane & 15) ^ ((rowk & 7) | (((rowk >> 4) & 1) << 3)); vK[i] = (unsigned)(rowk * 4096 + ck * 16);
        const int sidx = (2 * wid + i) * 2 + (lane >> 5), kk = (sidx >> 2) * 8 + ((lane & 31) >> 2), k = (kk & ~0xC) | ((kk & 4) << 1) | ((kk & 8) >> 1), c = (sidx & 3) * 32 + (lane & 3) * 8;
        vV[i] = (unsigned)(k * 4096 + c * 2); }
    { const int rowk2 = 8 * wid + (lane >> 3), ck2 = (lane & 7) ^ ((rowk2 >> 1) & 7); vK2 = (unsigned)(rowk2 * 128 + ck2 * 16); }
    const unsigned hK = (unsigned)h * 512u, hV = hK + 256u;
    const int kf4 = ((r32 & 7) | (((r32 >> 4) & 1) << 3)) << 4, hi16 = hi << 4;
#define ML_LOADK(t_, buf) do { _Pragma("unroll") for (int i_ = 0; i_ < 2; ++i_) __builtin_amdgcn_raw_ptr_buffer_load_lds(rKV, (LAS unsigned*)(K_lds + (buf) * SHM_K + (2 * wid + i_) * 1024), 16, vK[i_], (unsigned)(t_) * 262144u + hK, 0, 0); \
        __builtin_amdgcn_raw_ptr_buffer_load_lds(rK2, (LAS unsigned*)(K2_lds + (buf) * SHM_K2 + wid * 1024), 16, vK2, (unsigned)(t_) * 8192u, 0, 0); } while (0)
#define ML_LOADV(t_, buf) do { _Pragma("unroll") for (int i_ = 0; i_ < 2; ++i_) __builtin_amdgcn_raw_ptr_buffer_load_lds(rKV, (LAS unsigned*)(V_lds + (buf) * SHM_V + (2 * wid + i_) * 1024), 16, vV[i_], (unsigned)(t_) * 262144u + hV, 0, 0); } while (0)
    const int vb0 = (int)(uintptr_t)V_lds + v_rd_base(lane);
    float m_reg = -1e30f, l_reg = 0.f; f32x16 o[4];
#pragma unroll
    for (int d = 0; d < 4; ++d) o[d] = f32x16{};
    const int NT = 4 * (qb + 1);
#define ML_QK(BF, P0, P1) do { P0 = f32x16{}; P1 = f32x16{}; \
        const char* kb_ = K_lds + (BF) * SHM_K + r32 * 256; const char* k2b_ = K2_lds + (BF) * SHM_K2; int f4_ = kf4; asm volatile("" : "+v"(f4_));   \
        _Pragma("unroll") for (int g_ = 0; g_ < 2; ++g_) { bf16x8 kf_[8]; \
            _Pragma("unroll") for (int dd = 0; dd < 4; ++dd) { const char* a = kb_ + (((((g_ * 4 + dd) * 2) << 4) + hi16) ^ f4_); kf_[2 * dd] = *(const bf16x8*)a; kf_[2 * dd + 1] = *(const bf16x8*)(a + 32 * 256); } \
            LDS_WAIT(); SBAR(); \
            _Pragma("unroll") for (int dd = 0; dd < 4; ++dd) { P0 = __builtin_amdgcn_mfma_f32_32x32x16_bf16(kf_[2 * dd], qr[g_ * 4 + dd], P0, 0, 0, 0); P1 = __builtin_amdgcn_mfma_f32_32x32x16_bf16(kf_[2 * dd + 1], qr[g_ * 4 + dd], P1, 0, 0, 0); } \
            SBAR(); } \
        { bf16x8 kf_[8]; \
            _Pragma("unroll") for (int dd = 0; dd < 4; ++dd) { const char* a = k2b_ + K2SWZ(r32, (dd * 16 + hi * 8) * 2); kf_[2 * dd] = *(const bf16x8*)a; kf_[2 * dd + 1] = *(const bf16x8*)(a + 32 * 128); } \
            LDS_WAIT(); SBAR(); \
            _Pragma("unroll") for (int dd = 0; dd < 4; ++dd) { P0 = __builtin_amdgcn_mfma_f32_32x32x16_bf16(kf_[2 * dd], qr2[dd], P0, 0, 0, 0); P1 = __builtin_amdgcn_mfma_f32_32x32x16_bf16(kf_[2 * dd + 1], qr2[dd], P1, 0, 0, 0); } \
            SBAR(); } } while (0)
#define PK4(P, B_, OUT) do { const unsigned a0 = cvt_pk_bf16(P[B_+0], P[B_+1]), a1 = cvt_pk_bf16(P[B_+2], P[B_+3]); \
        const unsigned b0_ = cvt_pk_bf16(P[B_+4], P[B_+5]), b1_ = cvt_pk_bf16(P[B_+6], P[B_+7]); \
        auto r0 = __builtin_amdgcn_permlane32_swap(a0, b0_, false, false); auto r1 = __builtin_amdgcn_permlane32_swap(a1, b1_, false, false); \
        v4u w = {r0[0], r1[0], r0[1], r1[1]}; OUT = *reinterpret_cast<bf16x8*>(&w); } while (0)
#define ML_SMPV(PB, CUR0, CUR1) do { \
        if (kb + 63 > qlo) { const float NEG = -__builtin_inff(); const int dq = qm - kb; \
            _Pragma("unroll") for (int r = 0; r < 16; ++r) { const int c = (r & 3) + 8 * (r >> 2); if (dq - c < 0) CUR0[r] = NEG; if (dq - c - 32 < 0) CUR1[r] = NEG; } } \
        float pmax = CUR0[0]; _Pragma("unroll") for (int r = 1; r < 16; ++r) pmax = fmaxf(pmax, CUR0[r]); _Pragma("unroll") for (int r = 0; r < 16; ++r) pmax = fmaxf(pmax, CUR1[r]); \
        { auto rr = __builtin_amdgcn_permlane32_swap(__float_as_uint(pmax), __float_as_uint(pmax), false, false); pmax = fmaxf(__uint_as_float(rr[0]), __uint_as_float(rr[1])); } \
        float mn, alpha; \
        if ((pmax - m_reg) * SCALE <= THR) { mn = m_reg; alpha = 1.f; } \
        else { mn = fmaxf(m_reg, pmax); alpha = __builtin_amdgcn_exp2f((m_reg - mn) * C2); m_reg = mn; } \
        const float mnL = -mn * C2; \
        _Pragma("unroll") for (int r = 0; r < 16; ++r) { CUR0[r] = __builtin_amdgcn_exp2f(fmaf(CUR0[r], C2, mnL)); CUR1[r] = __builtin_amdgcn_exp2f(fmaf(CUR1[r], C2, mnL)); } \
        float ps = 0.f; _Pragma("unroll") for (int r = 0; r < 16; ++r) ps += CUR0[r]; _Pragma("unroll") for (int r = 0; r < 16; ++r) ps += CUR1[r]; \
        { auto rr = __builtin_amdgcn_permlane32_swap(__float_as_uint(ps), __float_as_uint(ps), false, false); ps = __uint_as_float(rr[0]) + __uint_as_float(rr[1]); } \
        l_reg = l_reg * alpha + ps; \
        if (__any(alpha < 1.f)) { if (hi == 0) al_l[r32] = alpha; LDS_WAIT(); \
            _Pragma("unroll") for (int d_ = 0; d_ < 4; ++d_) _Pragma("unroll") for (int r = 0; r < 16; ++r) o[d_][r] *= al_l[crow(r, hi)]; } \
        bf16x8 pa0, pa1, pa2, pa3; \
        PK4(CUR0, 0, pa0); PK4(CUR0, 8, pa1); PK4(CUR1, 0, pa2); PK4(CUR1, 8, pa3); \
        SBAR(); pv_tile<PB>(o, vb0, pa0, pa1, pa2, pa3); SBAR(); } while (0)
#define ML_STEP(PB, t_, CUR0, CUR1, NXT0, NXT1) do { const int t = (t_); const int kb = t * 64; \
        if (t + 2 < NT) ML_LOADK(t + 2, PB); \
        if (t + 1 < NT) ML_LOADV(t + 1, (PB) ^ 1); \
        if (wid >= 4) ML_SMPV(PB, CUR0, CUR1); \
        if (t + 1 < NT) ML_QK((PB) ^ 1, NXT0, NXT1); SBAR(); \
        if (wid < 4) ML_SMPV(PB, CUR0, CUR1); \
        VM_WAIT(); __syncthreads(); } while (0)
    ML_LOADK(0, 0); ML_LOADV(0, 0); if (NT > 1) ML_LOADK(1, 1);
    VM_WAIT(); __syncthreads();
    f32x16 pA0, pA1, pB0, pB1;
    ML_QK(0, pA0, pA1);
    asm volatile("s_waitcnt lgkmcnt(0)" ::: "memory"); __syncthreads();
    for (int t2 = 0; t2 < NT; t2 += 2) { ML_STEP(0, t2, pA0, pA1, pB0, pB1); ML_STEP(1, t2 + 1, pB0, pB1, pA0, pA1); }
#undef ML_STEP
#undef ML_SMPV
#undef PK4
#undef ML_QK
#undef ML_LOADK
#undef ML_LOADV
    if (hi == 0) li_l[r32] = l_reg; LDS_WAIT();
    float rli[16];
#pragma unroll
    for (int r = 0; r < 16; ++r) rli[r] = __builtin_amdgcn_rcpf(li_l[crow(r, hi)]);
    bf16* Ow = Op + (size_t)qlo * DM;
#pragma unroll
    for (int r = 0; r < 16; ++r) { const int orow = crow(r, hi);
#pragma unroll
        for (int d0 = 0; d0 < 4; ++d0) { const float v = o[d0][r] * rli[r]; const float vn = __shfl_xor(v, 1);
            if ((r32 & 1) == 0) *(unsigned*)(Ow + (size_t)orow * DM + d0 * 32 + r32) = cvt_pk_bf16(v, vn); } }
    __syncthreads();
}

constexpr int MB_OFF_V = 0, MB_OFF_K = 65536, MB_OFF_WS = 131072, MOBA_LDS = MB_OFF_WS + 8 * 128 * 4;
__device__ __forceinline__ void moba_unit(const bf16* Qh, const bf16* Kh, const bf16* Vh, const int* list, int cnt, int j, int c, int h, bf16* PO, float* PL, char* lds, const int wid) {
    constexpr float SCALE = 0.08838834764831845f, C2 = 1.4426950408889634f * SCALE, THR = 8.f;
    const int lane = lane_id(), tid = wid * 64 + lane, r32 = lane & 31, hi = lane >> 5;
    char* V_lds = lds + MB_OFF_V; char* K_lds = lds + MB_OFF_K;
    float* ws = (float*)(lds + MB_OFF_WS) + wid * 128; float* li_l = ws; float* al_l = ws + 32; int* qi_l = (int*)(ws + 64);
    { const int sr = tid >> 4, sc = (tid & 15) * 8, vst0 = v_st(sr, sc), vst1 = v_st(32 + sr, sc), kws = KSW4(sr, tid & 15);
      const bf16* kp = Kh + (size_t)(256 * j + sr) * MW + sc; const bf16* vp = Vh + (size_t)(256 * j + sr) * MW + sc;
      bf16x8 kk[8], vv[8];
#pragma unroll
      for (int t = 0; t < 4; ++t) { kk[2 * t] = *(const bf16x8*)(kp + (size_t)(64 * t) * MW); kk[2 * t + 1] = *(const bf16x8*)(kp + (size_t)(64 * t + 32) * MW);
          vv[2 * t] = *(const bf16x8*)(vp + (size_t)(64 * t) * MW); vv[2 * t + 1] = *(const bf16x8*)(vp + (size_t)(64 * t + 32) * MW); }
#pragma unroll
      for (int t = 0; t < 4; ++t) { *(bf16x8*)(K_lds + t * SHM_K + kws) = kk[2 * t]; *(bf16x8*)(K_lds + t * SHM_K + kws + 32 * 256) = kk[2 * t + 1];
          *(bf16x8*)(V_lds + t * SHM_V + vst0) = vv[2 * t]; *(bf16x8*)(V_lds + t * SHM_V + vst1) = vv[2 * t + 1]; } }
    const int i = wid * 32 + r32; int q, slot; bool valid = true;
    if (c == 0) { q = 256 * j + i; slot = 3; } else { const int li = (c - 1) * 256 + i; valid = li < cnt; const int e = list[valid ? li : 0]; q = e >> 2; slot = e & 3; }
    bf16x8 qr[8];
    { const bf16* Qw = Qh + (size_t)q * MW + hi * 8;
#pragma unroll
      for (int d0 = 0; d0 < 8; ++d0) qr[d0] = *(const bf16x8*)(Qw + d0 * 16); }
    __syncthreads();
    const int vb0 = (int)(uintptr_t)V_lds + v_rd_base(lane);
    float m_reg = -1e30f, l_reg = 0.f; f32x16 o[4];
#pragma unroll
    for (int d = 0; d < 4; ++d) o[d] = f32x16{};
    const int qm = i - 4 * hi; const int kf4 = ((r32 & 7) | (((r32 >> 4) & 1) << 3)) << 4;
#define PK4(P, B_, OUT) do { const unsigned a0 = cvt_pk_bf16(P[B_+0], P[B_+1]), a1 = cvt_pk_bf16(P[B_+2], P[B_+3]); \
        const unsigned b0_ = cvt_pk_bf16(P[B_+4], P[B_+5]), b1_ = cvt_pk_bf16(P[B_+6], P[B_+7]); \
        auto r0 = __builtin_amdgcn_permlane32_swap(a0, b0_, false, false); auto r1 = __builtin_amdgcn_permlane32_swap(a1, b1_, false, false); \
        v4u w = {r0[0], r1[0], r0[1], r1[1]}; OUT = *reinterpret_cast<bf16x8*>(&w); } while (0)
#define MB_STEP(TT) do { constexpr int kb = 64 * (TT); \
        const bool act = (c != 0) || (kb <= wid * 32 + 31); \
        if (act) { \
            f32x16 p0 = f32x16{}, p1 = f32x16{}; \
            { int f4_ = kf4; asm volatile("" : "+v"(f4_)); _Pragma("unroll") for (int d0 = 0; d0 < 8; ++d0) { const char* a = K_lds + (TT) * SHM_K + r32 * 256 + ((((d0 * 2) << 4) + (hi << 4)) ^ f4_); \
                const bf16x8 b0 = *(const bf16x8*)a; const bf16x8 b1 = *(const bf16x8*)(a + 32 * 256); \
                p0 = __builtin_amdgcn_mfma_f32_32x32x16_bf16(b0, qr[d0], p0, 0, 0, 0); p1 = __builtin_amdgcn_mfma_f32_32x32x16_bf16(b1, qr[d0], p1, 0, 0, 0); } } \
            if (c == 0 && kb + 63 > wid * 32) { const float NEG = -__builtin_inff(); const int dq = qm - kb; \
                _Pragma("unroll") for (int r = 0; r < 16; ++r) { const int cc = (r & 3) + 8 * (r >> 2); if (dq - cc < 0) p0[r] = NEG; if (dq - cc - 32 < 0) p1[r] = NEG; } } \
            float pmax = p0[0]; _Pragma("unroll") for (int r = 1; r < 16; ++r) pmax = fmaxf(pmax, p0[r]); _Pragma("unroll") for (int r = 0; r < 16; ++r) pmax = fmaxf(pmax, p1[r]); \
            { auto rr = __builtin_amdgcn_permlane32_swap(__float_as_uint(pmax), __float_as_uint(pmax), false, false); pmax = fmaxf(__uint_as_float(rr[0]), __uint_as_float(rr[1])); } \
            float mn, alpha; \
            if ((pmax - m_reg) * SCALE <= THR) { mn = m_reg; alpha = 1.f; }        \
            else { mn = fmaxf(m_reg, pmax); alpha = __builtin_amdgcn_exp2f((m_reg - mn) * C2); m_reg = mn; } \
            const float mnL = -mn * C2; \
            _Pragma("unroll") for (int r = 0; r < 16; ++r) { p0[r] = __builtin_amdgcn_exp2f(fmaf(p0[r], C2, mnL)); p1[r] = __builtin_amdgcn_exp2f(fmaf(p1[r], C2, mnL)); } \
            float ps = 0.f; _Pragma("unroll") for (int r = 0; r < 16; ++r) ps += p0[r]; _Pragma("unroll") for (int r = 0; r < 16; ++r) ps += p1[r]; \
            { auto rr = __builtin_amdgcn_permlane32_swap(__float_as_uint(ps), __float_as_uint(ps), false, false); ps = __uint_as_float(rr[0]) + __uint_as_float(rr[1]); } \
            l_reg = l_reg * alpha + ps; \
            if (__any(alpha < 1.f)) { if (hi == 0) al_l[r32] = alpha; LDS_WAIT(); \
                _Pragma("unroll") for (int d_ = 0; d_ < 4; ++d_) _Pragma("unroll") for (int r = 0; r < 16; ++r) o[d_][r] *= al_l[crow(r, hi)]; } \
            bf16x8 pa0, pa1, pa2, pa3; \
            PK4(p0, 0, pa0); PK4(p0, 8, pa1); PK4(p1, 0, pa2); PK4(p1, 8, pa3); \
            SBAR(); pv_tile<TT>(o, vb0, pa0, pa1, pa2, pa3); \
        } } while (0)
    MB_STEP(0); MB_STEP(1); MB_STEP(2); MB_STEP(3);
#undef MB_STEP
#undef PK4
    const int pidx_own = valid ? ((q * NH + h) * 4 + slot) : -1;
    if (hi == 0) { li_l[r32] = l_reg; qi_l[r32] = pidx_own; if (valid) PL[pidx_own] = m_reg * C2 + __builtin_amdgcn_logf(l_reg); }
    LDS_WAIT();
#pragma unroll
    for (int r = 0; r < 16; ++r) { const int orow = crow(r, hi); const int pidx = qi_l[orow]; const float rl = __builtin_amdgcn_rcpf(li_l[orow]);
#pragma unroll
        for (int d0 = 0; d0 < 4; ++d0) { const float v = o[d0][r] * rl; const float vn = __shfl_xor(v, 1);
            if ((r32 & 1) == 0 && pidx >= 0) *(unsigned*)(PO + (size_t)pidx * 128 + d0 * 32 + r32) = cvt_pk_bf16(v, vn); } }
    __syncthreads();
}
}

#define XB_TMO      128
#define XB_XCNT(j)  (256  + 64 * (j))
#define XB_XSUB(j)  (1280 + 64 * (j))
#define XB_XGEN(j)  (2304 + 64 * (j))
#define XB_TOP      3328
#define XB_TOPGEN   3392
#define XCD_BAR_WORDS 3456
#define XB_SPIN_CAP (1u << 18)
__device__ __forceinline__ unsigned xb_ld(unsigned* p)              { return __hip_atomic_load(p, __ATOMIC_RELAXED, __HIP_MEMORY_SCOPE_AGENT); }
__device__ __forceinline__ unsigned xb_add(unsigned* p, unsigned v) { return __hip_atomic_fetch_add(p, v, __ATOMIC_RELAXED, __HIP_MEMORY_SCOPE_AGENT); }
__device__ __forceinline__ unsigned xb_xcc_id() { return (unsigned)__builtin_amdgcn_s_getreg((3 << 11) | 20) & 0xFu; }
#define XB_SPIN(cond, bar) do { unsigned _sp = 0; while (cond) { __builtin_amdgcn_s_sleep(1); \
    if ((++_sp & 255u) == 0u) { if (xb_ld(&(bar)[XB_TMO])) break; if (_sp > XB_SPIN_CAP) { atomicAdd(&(bar)[XB_TMO], 1u); break; } } } } while (0)
struct XcdBarrier { unsigned* bar; unsigned x; volatile LAS unsigned* st; };
__device__ __forceinline__ XcdBarrier xcd_barrier_post(unsigned* bar, volatile LAS unsigned* st, bool t0  ) {
    XcdBarrier b; b.bar = bar; b.x = xb_xcc_id(); b.st = st;
    if (t0) (void)xb_add(&bar[XB_XCNT(b.x)], 1u);
    return b;
}
__device__ __forceinline__ void xcd_barrier_complete(unsigned* bar, unsigned x, unsigned& nloc, unsigned& nx) {
    const unsigned G = gridDim.x * gridDim.y * gridDim.z;
    unsigned sum, cnt, mine, sp = 0u;
    for (;;) {
        sum = 0u; cnt = 0u; mine = 0u;
#pragma unroll
        for (unsigned j = 0; j < 16; ++j) { const unsigned c = xb_ld(&bar[XB_XCNT(j)]); sum += c; cnt += (c > 0u) ? 1u : 0u; mine = (j == x) ? c : mine; }
        if (sum == G) break;
        __builtin_amdgcn_s_sleep(1);
        if ((++sp & 255u) == 0u) { if (xb_ld(&bar[XB_TMO])) break; if (sp > XB_SPIN_CAP) { atomicAdd(&bar[XB_TMO], 1u); break; } }
    }
    nloc = mine > 0u ? mine : 1u; nx = cnt > 0u ? cnt : 1u;
}
__device__ __forceinline__ void xcd_barrier(const XcdBarrier& b, bool t0  ) {
    asm volatile("s_waitcnt vmcnt(0)" ::: "memory");
    __syncthreads();
    if (t0) {
        unsigned* bar = b.bar;
        __builtin_amdgcn_s_waitcnt(0);
        unsigned nloc = b.st[0], nx = b.st[1];
        if (nloc == 0u) { xcd_barrier_complete(bar, b.x, nloc, nx); b.st[0] = nloc; b.st[1] = nx; }
        const unsigned old = xb_add(&bar[XB_XSUB(b.x)], 1u);
        const unsigned gen = old / nloc;
        if (old + 1u == (gen + 1u) * nloc) {
            __builtin_amdgcn_fence(__ATOMIC_RELEASE, "agent");
            asm volatile("s_waitcnt vmcnt(0)" ::: "memory");
            const unsigned og = xb_add(&bar[XB_TOP], 1u);
            const unsigned tg = og / nx;
            if (og + 1u == (tg + 1u) * nx) xb_add(&bar[XB_TOPGEN], 1u);
            else XB_SPIN(xb_ld(&bar[XB_TOPGEN]) == tg, bar);
            __builtin_amdgcn_fence(__ATOMIC_ACQUIRE, "agent");
            xb_add(&bar[XB_XGEN(b.x)], 1u);
            asm volatile("s_waitcnt vmcnt(0)" ::: "memory");
        } else {
            XB_SPIN(xb_ld(&bar[XB_XGEN(b.x)]) == gen, bar);
            __builtin_amdgcn_fence(__ATOMIC_ACQUIRE, "agent");
            asm volatile("s_waitcnt vmcnt(0)" ::: "memory");
        }
    }
    __syncthreads();
}

struct Args;
typedef const __attribute__((address_space(4))) struct Args* KArgsFwd;
struct Args {
    const float* x; const int* pos; const float* w_in; const float* g_q_a; const float* w_q_b; const float* g_kv_a; const float* w_kv_b;
    const float* g_out_mla; const float* g_out_moba; const float* w_o; const float* ln1_g; const float* ln1_b; const float* w_router; const float* b_router;
    const float* w_gate_up; const float* b_gate_up; const float* w_down; const float* b_down; const float* ln2_g; const float* ln2_b;
    float* out; unsigned char* ws; int ph_lo, ph_hi;
};
constexpr int NPHASES = 14;

__device__ __forceinline__ void tr_item(const float* W, int N, bf16* WT, int K, int k0, int n0, int prow0, const float* sc, int lane, int pmode = 0) {
    float tv[64]; const unsigned off0 = (unsigned)(k0 * N + n0 + lane) * 4u, rb = (unsigned)N * 4u;
#pragma unroll
    for (int i = 0; i < 64; ++i) tv[i] = __builtin_nontemporal_load((const float*)((const char*)W + (off0 + (unsigned)i * rb)));
    if (sc) {
#pragma unroll
        for (int i = 0; i < 64; i += 4) { const f32x4 g4 = *(const f32x4*)(sc + k0 + i); tv[i] *= g4[0]; tv[i + 1] *= g4[1]; tv[i + 2] *= g4[2]; tv[i + 3] *= g4[3]; } }
    bf16* dst = WT + (size_t)(prow0 + (pmode == 0 ? lane : (pmode == 1 ? 2 * lane : 2 * (lane & 31) + (lane >> 5)))) * K + k0;
#pragma unroll
    for (int j = 0; j < 8; ++j) { v4u o; o.x = cvt_pk_bf16(tv[8 * j], tv[8 * j + 1]); o.y = cvt_pk_bf16(tv[8 * j + 2], tv[8 * j + 3]); o.z = cvt_pk_bf16(tv[8 * j + 4], tv[8 * j + 5]); o.w = cvt_pk_bf16(tv[8 * j + 6], tv[8 * j + 7]);
        *(v4u*)(dst + 8 * j) = o; }
}
constexpr int BG_ITEMS = NE * 32 * 64 + NE * 32 * 32, BG_ROUNDS = 48;
#ifndef BG_SPLIT
#define BG_SPLIT 0, 6, 6, 44, 48
#endif
constexpr int BG_SPLIT_[5] = {BG_SPLIT};
constexpr int BG_P0 = BG_SPLIT_[0], BG_P1 = BG_SPLIT_[1], BG_P3 = BG_SPLIT_[2], BG_P6 = BG_SPLIT_[3], BG_P8 = BG_SPLIT_[4];
struct BgItem { const float* W; unsigned char* WT; unsigned rb; int K, k0, n0, prow0; float cs; };
__device__ __forceinline__ BgItem bg_decode(KArgsFwd ka, GAS unsigned char* ws, int it) {
    BgItem b; it = it < BG_ITEMS ? it : BG_ITEMS - 1;
    if (it < NE * 2048) { const int e = it >> 11, q = it & 2047, kb = q & 31, nb = q >> 5, n0 = nb * 64;
        b.W = ((const float*)(GAS const float*)ka->w_gate_up) + (size_t)e * DM * 2 * DFF; b.WT = (unsigned char*)(ws + WS_WGU) + (size_t)e * 2 * DFF * DM; b.rb = 2 * DFF * 4; b.K = DM; b.k0 = kb * 64; b.n0 = n0;
        b.prow0 = n0 < DFF ? (n0 >> 7) * 256 + (n0 & 127) : ((n0 - DFF) >> 7) * 256 + 128 + ((n0 - DFF) & 127); b.cs = SC_WGU; }
    else { it -= NE * 2048; const int e = it >> 10, q = it & 1023, kb = q & 31, nb = q >> 5;
        b.W = ((const float*)(GAS const float*)ka->w_down) + (size_t)e * DFF * DM; b.WT = (unsigned char*)(ws + WS_WD) + (size_t)e * DM * DFF; b.rb = DM * 4; b.K = DFF; b.k0 = kb * 64; b.n0 = nb * 64; b.prow0 = nb * 64; b.cs = SC_WD; }
    return b;
}
#define BG_LOAD(TV, B) do { const unsigned off0_ = (unsigned)((B).k0 + 16 * (lane >> 4)) * (B).rb + (unsigned)((B).n0 + 4 * (lane & 15)) * 4u; \
    _Pragma("unroll") for (int i_ = 0; i_ < 16; ++i_) TV[i_] = __builtin_nontemporal_load((const f32x4*)((const char*)(B).W + (off0_ + (unsigned)i_ * (B).rb))); } while (0)
#define BG_STORE(TV, B) do { unsigned char* dst_ = (B).WT + (size_t)((B).prow0 + 4 * (lane & 15)) * (B).K + (B).k0 + 16 * (lane >> 4); const float cs_ = 1.0f / (B).cs; \
    _Pragma("unroll") for (int c_ = 0; c_ < 4; ++c_) { v4u o_; \
        o_.x = pk4_fp8s(TV[0][c_], TV[1][c_], TV[2][c_], TV[3][c_], cs_); o_.y = pk4_fp8s(TV[4][c_], TV[5][c_], TV[6][c_], TV[7][c_], cs_); \
        o_.z = pk4_fp8s(TV[8][c_], TV[9][c_], TV[10][c_], TV[11][c_], cs_); o_.w = pk4_fp8s(TV[12][c_], TV[13][c_], TV[14][c_], TV[15][c_], cs_); \
        __builtin_nontemporal_store(o_, (v4u*)(dst_ + (size_t)c_ * (B).K)); } } while (0)
__device__ __forceinline__ void bg_run(KArgsFwd ka, GAS unsigned char* ws, int it0, int n, int stride, int lane) {
    if (n <= 0) return;
    f32x4 ta[16], tb[16];
    BgItem A = bg_decode(ka, ws, it0), B = A;
    BG_LOAD(ta, A);
    for (int r = 0; r < n; r += 2) {
        const bool hb = r + 1 < n, ha = r + 2 < n;
        if (hb) { B = bg_decode(ka, ws, it0 + (r + 1) * stride); BG_LOAD(tb, B); }
        BG_STORE(ta, A);
        if (ha) { A = bg_decode(ka, ws, it0 + (r + 2) * stride); BG_LOAD(ta, A); }
        if (hb) BG_STORE(tb, B);
    }
}
__device__ __forceinline__ void bg_rounds(KArgsFwd ka, GAS unsigned char* ws, int r0, int r1, int gw, int NGW, int lane) { bg_run(ka, ws, r0 * NGW + gw, r1 - r0, NGW, lane); }
#undef BG_LOAD
#undef BG_STORE
__device__ __forceinline__ void sincos_d(double x, float& sn, float& cs) {
    const double inv2pi = 0.15915494309189533577, pi2hi = 6.283185307179586232, pi2lo = 2.4492935982947064e-16;
    const double n = rint(x * inv2pi); double r = fma(-n, pi2hi, x); r = fma(-n, pi2lo, r);
    const double r2 = r * r; double s = 1.0, c = 1.0;
    double ts = 0.0, tc = 0.0;
#pragma unroll
    for (int k = 10; k >= 1; --k) { ts = (ts + 1.0) * (-r2 * (1.0 / (double)((2 * k) * (2 * k + 1)))); tc = (tc + 1.0) * (-r2 * (1.0 / (double)((2 * k - 1) * (2 * k)))); }
    s = r * (1.0 + ts); c = 1.0 + tc; sn = (float)s; cs = (float)c;
}

#define XB   ((bf16*)(ws + WS_XB))
#define WIN  ((bf16*)(ws + WS_WIN))
#define WQB  ((bf16*)(ws + WS_WQB))
#define WKVB ((bf16*)(ws + WS_WKVB))
#define WO   ((bf16*)(ws + WS_WO))
#define C128 ((float*)(ws + WS_C128))
#define S128 ((float*)(ws + WS_S128))
#define C64  ((float*)(ws + WS_C64))
#define S64  ((float*)(ws + WS_S64))
#define HQ   ((bf16*)(ws + WS_HQ))
#define HKV  ((bf16*)(ws + WS_HKV))
#define KPE  ((bf16*)(ws + WS_KPE))
#define MQ   ((bf16*)(ws + WS_MQ))
#define MK   ((bf16*)(ws + WS_MK))
#define MV   ((bf16*)(ws + WS_MV))
#define RSQ  ((float*)(ws + WS_RSQ))
#define RSKV ((float*)(ws + WS_RSKV))
#define QM   ((bf16*)(ws + WS_QM))
#define KVM  ((bf16*)(ws + WS_KVM))
#define MLIST ((int*)(ws + WS_LIST))
#define PO   ((bf16*)(ws + WS_PO))
#define PL   ((float*)(ws + WS_PL))
#define OMIX ((bf16*)(ws + WS_OMIX))
#define X1P  ((float*)(ws + WS_X1P))
#define X1N  ((bf16*)(ws + WS_X1N))
#define X1B  ((unsigned char*)(ws + WS_X1B))
#define TOPE ((int*)(ws + WS_TOPE))
#define ROWTOK ((int*)(ws + WS_TOPE))
#define TOPR ((int*)(ws + WS_TOPR))
#define TOPG ((float*)(ws + WS_TOPG))
#define TOPROW ((int*)(ws + WS_TOPROW))
#define RGATE ((float*)(ws + WS_RGATE))
#define XG   ((unsigned char*)(ws + WS_XG))
#define ACT  ((unsigned char*)(ws + WS_ACT))
#define YB   ((unsigned char*)(ws + WS_Y))
#define WGU  ((unsigned char*)(ws + WS_WGU))
#define WD   ((unsigned char*)(ws + WS_WD))
__device__ __forceinline__ GAS unsigned char* opq(const void* p) { GAS unsigned char* q = (GAS unsigned char*)p; asm volatile("" : "+s"(q)); return q; }
typedef const __attribute__((address_space(4))) struct Args* KArgs;
__device__ __forceinline__ KArgs kargs() { auto p = __builtin_amdgcn_kernarg_segment_ptr(); asm volatile("" : "+s"(p)); return (KArgs)p; }

__global__ void __launch_bounds__(512, 2) fwd(Args a) {
    extern __shared__ __attribute__((aligned(16))) unsigned char lds[];
    LAS unsigned char* L = (LAS unsigned char*)lds;
    const int wave = __builtin_amdgcn_readfirstlane((int)threadIdx.x >> 6);
    const int G = gridDim.x, bid = blockIdx.x;
    const int gw = bid * 8 + wave, NGW = G * 8;
    const int NGT = G * 512;
    gu32* ctl = (gu32*)(a.ws + WS_CTL);
    for (int u = wave * 64 + lane_id(); u < (LDS_BYTES - LDSCTL_OFF) / 4; u += 512) ((LAS unsigned*)(L + LDSCTL_OFF))[u] = 0u;
    __syncthreads();
    XcdBarrier bar; bar.bar = (unsigned*)(ctl + CW_BAR); bar.x = 0; bar.st = nullptr;
    if (MK_N_LAUNCHES == 1) bar = xcd_barrier_post((unsigned*)(ctl + CW_BAR), (volatile LAS unsigned*)(L + LDSCTL_OFF), wave == 0 && lane_id() == 0);
    const int lo = a.ph_lo, hi = a.ph_hi;
    unsigned long long pt_prev = PROBE_TIME_MASK ? __builtin_amdgcn_s_memrealtime() : 0ull, pt_acc = 0ull;
#define PT_MARK(k) do { if (PROBE_TIME_MASK) { const unsigned long long now_ = __builtin_amdgcn_s_memrealtime(); if ((PROBE_TIME_MASK >> (k)) & 1) pt_acc += now_ - pt_prev; pt_prev = now_; } } while (0)
#define IN(k) (lo <= (k) && (k) < hi)
#define REPS(k) ((((PROBE_REP_MASK) >> (k)) & 1) + 1)
#define SEAM(k) do { if (IN(k) && IN((k) + 1)) { XcdBarrier b2_ = bar; b2_.bar = (unsigned*)(opq(kargs()->ws) + WS_CTL + (size_t)CW_BAR * 4); xcd_barrier(b2_, wave == 0 && lane_id() == 0); } PT_MARK(k); } while (0)

    if (IN(0)) for (int rep_ = 0; rep_ < REPS(0); ++rep_) { KArgs ka = kargs(); GAS unsigned char* ws = opq(ka->ws); const int lane = lane_id(), tid = wave * 64 + lane, gt = bid * 512 + tid; (void)gt;
        constexpr int I0 = 32 * 61, I1 = 8 * 24, I2 = 4 * 32, I3 = 32 * 32;
        constexpr int NIT = I0 + I1 + I2 + I3;
        for (int it = gw; it < NIT; it += NGW) {
            int r = it;
            if (r < I0) { const int kb = r / 61, nb = r % 61, n0 = nb * 64; int prow, pmode;
                if (n0 < 768) { prow = n0; pmode = 0; } else if (n0 == 768) { prow = 768; pmode = 2; }
                else if (n0 < 2880) { const int q = n0 - 832, reg = q >> 10, w = q & 1023; prow = 1024 + reg * 1024 + (w >> 7) * 128 + ((w >> 6) & 1); pmode = 1; }
                else { prow = n0 + 192; pmode = 0; }
                tr_item(((const float*)(GAS const float*)ka->w_in), INC, WIN, DM, kb * 64, n0, prow, nullptr, lane, pmode); continue; } r -= I0;
            if (r < I1) { const int kb = r / 24, nb = r % 24; tr_item(((const float*)(GAS const float*)ka->w_q_b), 1536, WQB, QLORA, kb * 64, nb * 64, nb * 64, ((const float*)(GAS const float*)ka->g_q_a), lane, (nb % 3) == 2 ? 2 : 0); continue; } r -= I1;
            if (r < I2) { const int kb = r / 32, nb = r % 32; tr_item(((const float*)(GAS const float*)ka->w_kv_b), 2048, WKVB, KVLORA, kb * 64, nb * 64, nb * 64, ((const float*)(GAS const float*)ka->g_kv_a), lane); continue; } r -= I2;
            { const int kb = r / 32, nb = r % 32; tr_item(((const float*)(GAS const float*)ka->w_o), DM, WO, DM, kb * 64, nb * 64, nb * 64, kb < 16 ? ((const float*)(GAS const float*)ka->g_out_mla) : ((const float*)(GAS const float*)ka->g_out_moba) - MW, lane); }
        }
        bg_rounds(ka, ws, 0, BG_P0, gw, NGW, lane);
        for (int i = gt; i < 192 * DM / 8; i += NGT) *(v4u*)(WIN + (size_t)832 * DM + (size_t)i * 8) = (v4u){0u, 0u, 0u, 0u};
#pragma unroll 4
        for (int i = gt; i < T * DM / 8; i += NGT) { const f32x4 v0 = __builtin_nontemporal_load((const f32x4*)(((const float*)(GAS const float*)ka->x) + (size_t)i * 8)), v1 = __builtin_nontemporal_load((const f32x4*)(((const float*)(GAS const float*)ka->x) + (size_t)i * 8 + 4));
            v4u w; w.x = cvt_pk_bf16(v0[0], v0[1]); w.y = cvt_pk_bf16(v0[2], v0[3]); w.z = cvt_pk_bf16(v1[0], v1[1]); w.w = cvt_pk_bf16(v1[2], v1[3]); *(v4u*)(XB + (size_t)i * 8) = w; }
        if (tid < 384) { const int j = tid % 96, tq = tid / 96; const bool big = j < 64; const int jj = big ? j : j - 64;
            const float inv = (float)exp2(-(double)jj * (big ? 2.0 / 128.0 : 2.0 / 64.0) * 13.287712379549449);
            for (int t = bid * 4 + tq; t < T; t += G * 4) { const float p = (float)((const int*)(GAS const int*)ka->pos)[t]; float sn, cs; sincos_d((double)(p * inv), sn, cs);
                if (big) { C128[t * 64 + jj] = cs; S128[t * 64 + jj] = sn; } else { C64[t * 32 + jj] = cs; S64[t * 32 + jj] = sn; } } }
    }
    SEAM(0);

    if (IN(1)) for (int rep_ = 0; rep_ < REPS(1); ++rep_) { KArgs ka = kargs(); GAS unsigned char* ws = opq(ka->ws);
        pg8::Gemm g{XB, WIN, DM * 2, DM * 2, DM * 2, 0, nullptr}; pg8::StaticOrder S; S.init(T, INP, G, bid);
        pg8::EpiInProj E{(unsigned char*)ws};
        const bool bg_first = ((bid >> 3) & 1) == 0;
        if (bg_first) bg_rounds(ka, ws, BG_P0, BG_P1, gw, NGW, lane_id());
        pg8::gemm_phase<pg8::EpiInProj, pg8::StaticOrder>(L, g, S, E, wave, pt_acc);
        if (!bg_first) bg_rounds(ka, ws, BG_P0, BG_P1, gw, NGW, lane_id());
    }
    SEAM(1);


    if (IN(3)) for (int rep_ = 0; rep_ < REPS(3); ++rep_) { KArgs ka = kargs(); GAS unsigned char* ws = opq(ka->ws);
        { pg8::Gemm g{HQ, WQB, QLORA * 2, QLORA * 2, QLORA * 2, 0, nullptr}; pg8::StaticOrder S; S.init(T, 1536, G, bid); pg8::EpiRowScale<true> E{QM, 1536, (const float*)(ws + WS_SSP), 1.0f / QLORA, C64, S64};
          pg8::gemm_phase<pg8::EpiRowScale<true>, pg8::StaticOrder>(L, g, S, E, wave, pt_acc); }
        { pg8::Gemm g{HKV, WKVB, KVLORA * 2, KVLORA * 2, KVLORA * 2, 0, nullptr}; pg8::StaticOrder S; S.init(T, 2048, G, bid); pg8::EpiRowScale<false> E{KVM, 2048, (const float*)(ws + WS_SSP) + 8, 1.0f / KVLORA, nullptr, nullptr};
          pg8::gemm_phase<pg8::EpiRowScale<false>, pg8::StaticOrder>(L, g, S, E, wave, pt_acc); }
        bg_rounds(ka, ws, BG_P1, BG_P3, gw, NGW, lane_id());
    }
    if (IN(3)) { KArgs ka = kargs(); GAS unsigned char* ws = opq(ka->ws); const int lane = lane_id();
        LAS unsigned* lc = (LAS unsigned*)L;
        for (int it = bid; it < NH * 32; it += G) { const int h = it & 7, blk = it >> 3;
            const int tk = lane & 31, kh = lane >> 5, t = 256 * blk + 32 * wave + tk;
            if (wave == 0) lc[lane] = 0u;
            const float* ksum = (const float*)(ws + WS_KSP) + (size_t)(h * 32 + tk) * 128 + 64 * kh;
            f32x4 ka4[16];
#pragma unroll
            for (int i = 0; i < 16; ++i) ka4[i] = *(const f32x4*)(ksum + 4 * i) + *(const f32x4*)(ksum + NH * 32 * 128 + 4 * i);
            const bf16* qp = MQ + (size_t)t * MW + h * 128 + 64 * kh;
            v4u qv[8];
#pragma unroll
            for (int i = 0; i < 8; ++i) qv[i] = *(const v4u*)(qp + 8 * i);
            asm volatile("s_waitcnt vmcnt(0)" : "+v"(qv[0]), "+v"(qv[1]), "+v"(qv[2]), "+v"(qv[3]), "+v"(qv[4]), "+v"(qv[5]), "+v"(qv[6]), "+v"(qv[7]) :: "memory");
            f32x16 acc = f32x16{};
#pragma unroll
            for (int i = 0; i < 8; ++i) { const unsigned qw[4] = {qv[i].x, qv[i].y, qv[i].z, qv[i].w};
#pragma unroll
                for (int c = 0; c < 4; ++c) { const f32x4 a0 = ka4[2 * i + (c >> 1)];
                    acc = __builtin_amdgcn_mfma_f32_32x32x2f32(a0[(c & 1) * 2], bflo(qw[c]), acc, 0, 0, 0);
                    acc = __builtin_amdgcn_mfma_f32_32x32x2f32(a0[(c & 1) * 2 + 1], bfhi(qw[c]), acc, 0, 0, 0); } }
            float v[16];
#pragma unroll
            for (int r = 0; r < 16; ++r) v[r] = at::crow(r, kh) < blk ? acc[r] : -__builtin_inff();
            int bsel[3];
#pragma unroll
            for (int k = 0; k < 3; ++k) { float bv = v[0]; int bn = at::crow(0, kh);
#pragma unroll
                for (int r = 1; r < 16; ++r) if (v[r] > bv) { bv = v[r]; bn = at::crow(r, kh); }
                const float ov = __shfl_xor(bv, 32); const int on = __shfl_xor(bn, 32);
                if (ov > bv || (ov == bv && on < bn)) { bv = ov; bn = on; }
                bsel[k] = bn;
#pragma unroll
                for (int r = 0; r < 16; ++r) if (at::crow(r, kh) == bn) v[r] = -__builtin_inff(); }
            __syncthreads();
            unsigned lr[3] = {0u, 0u, 0u};
            if (kh == 0) {
#pragma unroll
                for (int k = 0; k < 3; ++k) if (k < blk) lr[k] = __hip_atomic_fetch_add((LAS unsigned*)&lc[bsel[k]], 1u, __ATOMIC_RELAXED, __HIP_MEMORY_SCOPE_WORKGROUP); }
            asm volatile("s_waitcnt lgkmcnt(0)" ::: "memory"); __syncthreads();
            if (wave == 0 && lane < 32) { const unsigned mine = lc[lane]; lc[32 + lane] = mine ? __hip_atomic_fetch_add((unsigned*)(ctl + CW_MCNT + (h * 32 + lane) * 64), mine, RLX_AGENT) : 0u; }
            asm volatile("s_waitcnt vmcnt(0) lgkmcnt(0)" ::: "memory"); __syncthreads();
            if (kh == 0) {
#pragma unroll
                for (int k = 0; k < 3; ++k) if (k < blk) MLIST[(size_t)(h * 32 + bsel[k]) * 8192 + lc[32 + bsel[k]] + lr[k]] = t * 4 + k; }
            __syncthreads();
        }
    }
    SEAM(3);


    if (IN(6)) for (int rep_ = 0; rep_ < REPS(6); ++rep_) { KArgs ka = kargs(); GAS unsigned char* ws = opq(ka->ws);
        LAS int* pref = (LAS int*)(L + 143360);
        LAS int* qslot = (LAS int*)(L + LDSCTL_OFF + 32);
        { const int tid = wave * 64 + lane_id();
          if (tid < 256) { const int cn = (int)__hip_atomic_load((unsigned*)(ctl + CW_MCNT + tid * 64), RLX_AGENT); pref[1 + tid] = 1 + ((cn + 255) >> 8); }
          __syncthreads();
          if (tid < 64) { int v4_[4]; int sum = 0;
#pragma unroll
              for (int i = 0; i < 4; ++i) { v4_[i] = pref[1 + 4 * tid + i]; sum += v4_[i]; }
              int incl = sum;
#pragma unroll
              for (int off = 1; off < 64; off <<= 1) { const int o_ = __shfl_up(incl, off); if (tid >= off) incl += o_; }
              int run = incl - sum;
#pragma unroll
              for (int i = 0; i < 4; ++i) { run += v4_[i]; pref[1 + 4 * tid + i] = run; }
              if (tid == 0) pref[0] = 0; }
          __syncthreads(); }
        const int NM = __builtin_amdgcn_readfirstlane(pref[256]);
        constexpr int NC = (BG_P6 - BG_P3) * 2048 / 32;
        const int N2 = 3 * NM + (NC > 2 * NM ? NC - 2 * NM : 0), Ntot = (256 + N2) > 4096 ? (256 + N2) : 4096;
        for (int iter = 0;; ++iter) {
            if (wave == 0 && lane_id() == 0) qslot[iter & 1] = (int)__hip_atomic_fetch_add((unsigned*)(ctl + CW_QHEAD), 1u, RLX_AGENT);
            __syncthreads();
            const int p = __builtin_amdgcn_readfirstlane(qslot[iter & 1]);
            if (p >= Ntot) break;
            if (p < 4096 && (p & 15) == 0) { const int a0 = p >> 4, h = a0 & 7, sq = 31 - (a0 >> 3);
                for (int d_ = 0; d_ < (PROBE_DUP == 1 ? 2 : 1); ++d_) at::mla_unit((const bf16*)QM + h * QKH, (const bf16*)KVM, (const bf16*)KPE, h, OMIX + h * 128, sq, (char*)lds, wave);
            } else { const int q = p < 4096 ? p - (p >> 4) - 1 : p - 256;
                int mb = -1, cc = -1;
                if (q < 3 * NM) { const int i3 = q / 3, r3 = q - 3 * i3; if (r3 == 0) mb = i3; else { cc = 2 * i3 + r3 - 1; if (cc >= NC) cc = -1; } }
                else { cc = 2 * NM + (q - 3 * NM); if (cc >= NC) cc = -1; }
                if (mb >= 0) { int lo_ = 0, hi_ = 255;
                    while (lo_ < hi_) { const int mid = (lo_ + hi_ + 1) >> 1; if (pref[mid] <= mb) lo_ = mid; else hi_ = mid - 1; }
                    const int hj = __builtin_amdgcn_readfirstlane(lo_), c = mb - __builtin_amdgcn_readfirstlane(pref[lo_]), h = hj >> 5, j = hj & 31;
                    const int cn = (int)__builtin_amdgcn_readfirstlane((int)__hip_atomic_load((unsigned*)(ctl + CW_MCNT + hj * 64), RLX_AGENT));
                    for (int d_ = 0; d_ < (PROBE_DUP == 2 ? 2 : 1); ++d_) at::moba_unit((const bf16*)MQ + h * 128, (const bf16*)MK + h * 128, (const bf16*)MV + h * 128, MLIST + (size_t)hj * 8192, cn, j, c, h, PO, PL, (char*)lds, wave);
                } else if (cc >= 0) bg_run(ka, ws, BG_P3 * 2048 + cc * 32 + wave * 4, 4, 1, lane_id());
            }
        }
    }
    SEAM(6);

    if (IN(7)) for (int rep_ = 0; rep_ < REPS(7); ++rep_) { KArgs ka = kargs(); GAS unsigned char* ws = opq(ka->ws); const int lane = lane_id();
        const int hl = lane >> 4, col8 = (lane & 15) * 8;
        for (int r = gw; r < T; r += NGW) { const int nv = (r >> 8) < 3 ? (r >> 8) : 3;
            f32x4 oa[2][2]; float ssb = 0.f;
#pragma unroll
            for (int ps = 0; ps < 2; ++ps) { const int h = ps * 4 + hl, pb = (r * NH + h) * 4; const f32x4 L4 = *(const f32x4*)(PL + pb);
                float Ls[4] = {nv > 0 ? L4[0] : -__builtin_inff(), nv > 1 ? L4[1] : -__builtin_inff(), nv > 2 ? L4[2] : -__builtin_inff(), L4[3]};
                const float Lm = fmaxf(fmaxf(Ls[0], Ls[1]), fmaxf(Ls[2], Ls[3])); float W = 0.f; f32x4 a0 = {0.f, 0.f, 0.f, 0.f}, a1 = {0.f, 0.f, 0.f, 0.f};
#pragma unroll
                for (int k = 0; k < 4; ++k) { if (k == 3 || k < nv) { const float w = __builtin_amdgcn_exp2f(Ls[k] - Lm); const v4u pv = *(const v4u*)(PO + (size_t)(pb + k) * 128 + col8); W += w;
                        a0[0] = fmaf(w, bflo(pv.x), a0[0]); a0[1] = fmaf(w, bfhi(pv.x), a0[1]); a0[2] = fmaf(w, bflo(pv.y), a0[2]); a0[3] = fmaf(w, bfhi(pv.y), a0[3]);
                        a1[0] = fmaf(w, bflo(pv.z), a1[0]); a1[1] = fmaf(w, bfhi(pv.z), a1[1]); a1[2] = fmaf(w, bflo(pv.w), a1[2]); a1[3] = fmaf(w, bfhi(pv.w), a1[3]); } }
                const float iw = 1.0f / W; a0 = a0 * iw; a1 = a1 * iw; oa[ps][0] = a0; oa[ps][1] = a1;
                ssb += (a0[0] * a0[0] + a0[1] * a0[1]) + (a0[2] * a0[2] + a0[3] * a0[3]) + (a1[0] * a1[0] + a1[1] * a1[1]) + (a1[2] * a1[2] + a1[3] * a1[3]); }
            v4u w[2]; float ssa = 0.f;
#pragma unroll
            for (int j = 0; j < 2; ++j) { w[j] = *(const v4u*)(OMIX + (size_t)r * DM + j * 512 + lane * 8);
                ssa += bflo(w[j].x) * bflo(w[j].x) + bfhi(w[j].x) * bfhi(w[j].x) + bflo(w[j].y) * bflo(w[j].y) + bfhi(w[j].y) * bfhi(w[j].y) + bflo(w[j].z) * bflo(w[j].z) + bfhi(w[j].z) * bfhi(w[j].z) + bflo(w[j].w) * bflo(w[j].w) + bfhi(w[j].w) * bfhi(w[j].w); }
            const float r0 = 1.0f / sqrtf(wave_sum(ssa) * (1.0f / MW) + RMS_EPS), r1 = 1.0f / sqrtf(wave_sum(ssb) * (1.0f / MW) + RMS_EPS);
#pragma unroll
            for (int j = 0; j < 2; ++j) { v4u o;
                o.x = cvt_pk_bf16(bflo(w[j].x) * r0, bfhi(w[j].x) * r0); o.y = cvt_pk_bf16(bflo(w[j].y) * r0, bfhi(w[j].y) * r0); o.z = cvt_pk_bf16(bflo(w[j].z) * r0, bfhi(w[j].z) * r0); o.w = cvt_pk_bf16(bflo(w[j].w) * r0, bfhi(w[j].w) * r0);
                *(v4u*)(OMIX + (size_t)r * DM + j * 512 + lane * 8) = o; }
#pragma unroll
            for (int ps = 0; ps < 2; ++ps) { const f32x4 a0 = oa[ps][0] * r1, a1 = oa[ps][1] * r1; v4u o; o.x = cvt_pk_bf16(a0[0], a0[1]); o.y = cvt_pk_bf16(a0[2], a0[3]); o.z = cvt_pk_bf16(a1[0], a1[1]); o.w = cvt_pk_bf16(a1[2], a1[3]);
                *(v4u*)(OMIX + (size_t)r * DM + MW + (ps * 4 + hl) * 128 + col8) = o; } }
    }
    SEAM(7);

    if (IN(8)) for (int rep_ = 0; rep_ < REPS(8); ++rep_) { KArgs ka = kargs(); GAS unsigned char* ws = opq(ka->ws);
        pg8::Gemm g{OMIX, WO, DM * 2, DM * 2, DM * 2, 0, nullptr}; pg8::StaticOrder S; S.init(T, DM, G, bid); pg8::EpiResBf16 E{XB, (bf16*)X1P, DM};
        const bool bg_first = ((bid >> 3) & 1) == 0;
        if (bg_first) bg_rounds(ka, ws, BG_P6, BG_P8, gw, NGW, lane_id());
        pg8::gemm_phase<pg8::EpiResBf16, pg8::StaticOrder>(L, g, S, E, wave, pt_acc);
        if (!bg_first) bg_rounds(ka, ws, BG_P6, BG_P8, gw, NGW, lane_id());
    }
    SEAM(8);

    if (IN(9)) for (int rep_ = 0; rep_ < REPS(9); ++rep_) { KArgs ka = kargs(); GAS unsigned char* ws = opq(ka->ws); const int lane = lane_id(), tid = wave * 64 + lane, gt = bid * 512 + tid; (void)gt;
        LAS float* part = (LAS float*)L;
        LAS float* lg = (LAS float*)(L + 32768);
        LAS unsigned* lcnt = (LAS unsigned*)(L + 40960);
        LAS int* rowl = (LAS int*)(L + 41472);
        if (tid < 64) lcnt[tid] = 0u;
        for (int rg = bid; rg < T / 32; rg += G) { const int R0 = rg * 32;
            for (int rr = 0; rr < 4; ++rr) { const int r = R0 + wave * 4 + rr; f32x4 v[8]; float s = 0.f;
#pragma unroll
                for (int j = 0; j < 8; ++j) { const v2u w = *(const v2u*)((const bf16*)X1P + (size_t)r * DM + j * 256 + lane * 4); v[j] = (f32x4){bflo(w.x), bfhi(w.x), bflo(w.y), bfhi(w.y)}; s += (v[j][0] + v[j][1]) + (v[j][2] + v[j][3]); }
                const float mean = wave_sum(s) * (1.0f / DM); float q = 0.f;
#pragma unroll
                for (int j = 0; j < 8; ++j) { v[j] = v[j] - mean; q += (v[j][0] * v[j][0] + v[j][1] * v[j][1]) + (v[j][2] * v[j][2] + v[j][3] * v[j][3]); }
                const float rstd = 1.0f / sqrtf(wave_sum(q) * (1.0f / DM) + LN_EPS);
#pragma unroll
                for (int j = 0; j < 8; ++j) { const int c = j * 256 + lane * 4; const f32x4 gg = *(const f32x4*)(((const float*)(GAS const float*)ka->ln1_g) + c), bb = *(const f32x4*)(((const float*)(GAS const float*)ka->ln1_b) + c);
                    const f32x4 y = v[j] * rstd * gg + bb; *(v2u*)(X1N + (size_t)r * DM + c) = pg8::pk4_bf16(y);
                    *(unsigned*)(X1B + (size_t)r * DM + c) = pk4_fp8(y[0] * SC_X, y[1] * SC_X, y[2] * SC_X, y[3] * SC_X); } }
            VM_WAIT(); __syncthreads();
            { f32x16 acc = f32x16{}; const int hh = lane >> 5, li = lane & 31;
              const bf16* ap = X1N + (size_t)(R0 + li) * DM + wave * 256 + 4 * hh; const float* bp = ((const float*)(GAS const float*)ka->w_router) + (size_t)(wave * 256 + 4 * hh) * NE + li;
#pragma unroll 8
              for (int kk = 0; kk < 32; ++kk) { const v2u aw = *(const v2u*)(ap + kk * 8); const f32x4 av = {bflo(aw.x), bfhi(aw.x), bflo(aw.y), bfhi(aw.y)}; const float* b = bp + (size_t)kk * 8 * NE;
                  acc = __builtin_amdgcn_mfma_f32_32x32x2f32(av[0], b[0], acc, 0, 0, 0); acc = __builtin_amdgcn_mfma_f32_32x32x2f32(av[1], b[NE], acc, 0, 0, 0);
                  acc = __builtin_amdgcn_mfma_f32_32x32x2f32(av[2], b[2 * NE], acc, 0, 0, 0); acc = __builtin_amdgcn_mfma_f32_32x32x2f32(av[3], b[3 * NE], acc, 0, 0, 0); }
#pragma unroll
              for (int r = 0; r < 16; ++r) part[(wave * 32 + at::crow(r, hh)) * 32 + li] = acc[r]; }
            __syncthreads();
            for (int i = tid; i < 1024; i += 512) { float s = ((const float*)(GAS const float*)ka->b_router)[i & 31];
#pragma unroll
                for (int w = 0; w < 8; ++w) s += part[w * 1024 + i];
                lg[(i >> 5) * 33 + (i & 31)] = s; }
            __syncthreads();
            if (tid < 32) { float v[32];
#pragma unroll
                for (int e = 0; e < 32; ++e) v[e] = lg[tid * 33 + e];
                float tv[4]; int ti[4];
#pragma unroll
                for (int k = 0; k < 4; ++k) { float best = -__builtin_inff(); int bi = 0;
#pragma unroll
                    for (int e = 0; e < 32; ++e) { if (v[e] > best) { best = v[e]; bi = e; } }
                    tv[k] = best; ti[k] = bi;
#pragma unroll
                    for (int e = 0; e < 32; ++e) if (e == bi) v[e] = -__builtin_inff(); }
                const float e1 = __expf(tv[1] - tv[0]), e2 = __expf(tv[2] - tv[0]), e3 = __expf(tv[3] - tv[0]); const float inv = 1.0f / (1.0f + e1 + e2 + e3);
                const float gk[4] = {inv, e1 * inv, e2 * inv, e3 * inv}; const int r = R0 + tid;
                unsigned lr[4];
#pragma unroll
                for (int k = 0; k < 4; ++k) { lr[k] = __hip_atomic_fetch_add((LAS unsigned*)&lcnt[ti[k]], 1u, __ATOMIC_RELAXED, __HIP_MEMORY_SCOPE_WORKGROUP);
                    }
                asm volatile("s_waitcnt lgkmcnt(0)" ::: "memory");
                const unsigned mine = lcnt[tid]; const unsigned base = mine ? __hip_atomic_fetch_add((unsigned*)(ctl + CW_COUNT + tid * 64), mine, RLX_AGENT) : 0u;
                lcnt[32 + tid] = base; lcnt[tid] = 0u;
                asm volatile("s_waitcnt lgkmcnt(0)" ::: "memory");
#pragma unroll
                for (int k = 0; k < 4; ++k) { const int row = ti[k] * ECAP + (int)(lr[k] + lcnt[32 + ti[k]]); TOPROW[r * 4 + k] = row; RGATE[row] = gk[k]; rowl[tid * 4 + k] = row; if (MOE_GATHER) ROWTOK[row] = r; } }
            __syncthreads();
#pragma unroll 1
            for (int tt = 0; tt < (MOE_GATHER ? 0 : 4); ++tt) { const int tk = wave * 4 + tt; const v4u* src = (const v4u*)(X1B + (size_t)(R0 + tk) * DM); const v4u s0 = src[lane], s1 = src[64 + lane];
#pragma unroll
                for (int k = 0; k < 4; ++k) { v4u* dst = (v4u*)(XG + (size_t)rowl[tk * 4 + k] * DM); dst[lane] = s0; dst[64 + lane] = s1; } }
            __syncthreads();
        }
    }
    SEAM(9);


    if (IN(11)) for (int rep_ = 0; rep_ < REPS(11); ++rep_) { KArgs ka = kargs(); GAS unsigned char* ws = opq(ka->ws);
        LAS unsigned* te = (LAS unsigned*)(L + LDSCTL_OFF + 64);
        { const int i_ = wave * 64 + lane_id();
          if (i_ < NE) { const int c_ = (int)__hip_atomic_load((unsigned*)(ctl + CW_COUNT + i_ * 64), RLX_AGENT), nt_ = (c_ + 255) >> 8; int incl = nt_;
#pragma unroll
              for (int off = 1; off < 32; off <<= 1) { const int o_ = __shfl_up(incl, off); if (i_ >= off) incl += o_; }
              for (int t_ = 0; t_ < nt_; ++t_) te[incl - nt_ + t_] = (unsigned)i_ | ((unsigned)t_ << 8);
              if (i_ == NE - 1) te[MAXRT_TAB] = (unsigned)incl; } }
        __syncthreads();
        const int n_rt = (int)__builtin_amdgcn_readfirstlane((int)te[MAXRT_TAB]);
        LAS unsigned* tk = (LAS unsigned*)(L + pg8::EG_OFF);
        pg8::Gemm g{MOE_GATHER ? (const void*)X1B : (const void*)XG, WGU, DM, DM, DM, (size_t)2 * DFF * DM, tk}; pg8::MoeOrder S{te, n_rt, 4, G, bid};
        LAS float* eb = (LAS float*)(L + pg8::EB_OFF);
        { const int tid_ = wave * 64 + lane_id(), j_ = tid_ & 255; const float* bgu_ = ((const float*)(GAS const float*)ka->b_gate_up);
          for (int i_ = tid_ >> 8; i_ < pg8::EB_CAP && i_ * G + bid < (n_rt << 4); i_ += 2) { const int L_ = i_ * G + bid, e_ = (int)(te[L_ >> 4] & 255u), pn_ = L_ & 15;
              eb[i_ * 256 + j_] = bgu_[(size_t)e_ * (2 * DFF) + (j_ < 128 ? pn_ * 128 + j_ : DFF + pn_ * 128 + (j_ - 128))];
              if (MOE_GATHER) { const int tl_ = (int)(te[L_ >> 4] >> 8), cnt_ = (int)__hip_atomic_load((unsigned*)(ctl + CW_COUNT + e_ * 64), RLX_AGENT), row_ = tl_ * 256 + j_;
                  tk[i_ * 256 + j_] = row_ < cnt_ ? (unsigned)ROWTOK[e_ * ECAP + row_] * (unsigned)DM : 0u; } } }
        __syncthreads();
        pg8::EpiSwiglu E{ACT, eb};
        pg8::gemm_phase<pg8::EpiSwiglu, pg8::MoeOrder, true, true, true, (PROBE_GEMM / 10 == 11 ? PROBE_GEMM % 10 : 0), (MOE_GATHER != 0)>(L, g, S, E, wave, pt_acc);
        if (PROBE_HOT == 11) { LAS unsigned* te2 = (LAS unsigned*)(L + 155648); for (int i_ = wave * 64 + lane_id(); i_ < MAXRT_TAB; i_ += 512) te2[i_] = 0u; __syncthreads();
            pg8::MoeOrder S2{te2, n_rt, 4, G, bid}; pg8::EpiSwiglu E2{(unsigned char*)ws + WS_END, eb};
            pg8::gemm_phase<pg8::EpiSwiglu, pg8::MoeOrder, true, true, true, 0, (MOE_GATHER != 0)>(L, g, S2, E2, wave, pt_acc); }
    }
    SEAM(11);

    if (IN(12)) for (int rep_ = 0; rep_ < REPS(12); ++rep_) { KArgs ka = kargs(); GAS unsigned char* ws = opq(ka->ws);
        LAS unsigned* te = (LAS unsigned*)(L + LDSCTL_OFF + 64);
        { const int i_ = wave * 64 + lane_id();
          if (i_ < NE) { const int c_ = (int)__hip_atomic_load((unsigned*)(ctl + CW_COUNT + i_ * 64), RLX_AGENT), nt_ = (c_ + 255) >> 8; int incl = nt_;
#pragma unroll
              for (int off = 1; off < 32; off <<= 1) { const int o_ = __shfl_up(incl, off); if (i_ >= off) incl += o_; }
              for (int t_ = 0; t_ < nt_; ++t_) te[incl - nt_ + t_] = (unsigned)i_ | ((unsigned)t_ << 8);
              if (i_ == NE - 1) te[MAXRT_TAB] = (unsigned)incl; } }
        __syncthreads();
        const int n_rt = (int)__builtin_amdgcn_readfirstlane((int)te[MAXRT_TAB]);
        pg8::Gemm g{ACT, WD, DFF, DFF, DFF, (size_t)DM * DFF, nullptr}; pg8::MoeOrder S{te, n_rt, 3, G, bid};
        LAS float* eb = (LAS float*)(L + pg8::EB_OFF); LAS float* eg = (LAS float*)(L + pg8::EG_OFF);
        { const int tid_ = wave * 64 + lane_id(), j_ = tid_ & 255; const float* bd_ = ((const float*)(GAS const float*)ka->b_down);
          for (int i_ = tid_ >> 8; i_ < pg8::EG_CAP && i_ * G + bid < (n_rt << 3); i_ += 2) { const int L_ = i_ * G + bid, ent_ = (int)te[L_ >> 3], e_ = ent_ & 255, pn_ = L_ & 7, pm_ = e_ * (ECAP / 256) + (ent_ >> 8);
              eb[i_ * 256 + j_] = bd_[(size_t)e_ * DM + pn_ * 256 + j_]; eg[i_ * 256 + j_] = RGATE[(size_t)pm_ * 256 + j_]; } }
        __syncthreads();
        pg8::EpiDown E{YB, eb, eg};
        pg8::gemm_phase<pg8::EpiDown, pg8::MoeOrder, true, true, true, (PROBE_GEMM / 10 == 12 ? PROBE_GEMM % 10 : 0)>(L, g, S, E, wave, pt_acc);
        if (PROBE_HOT == 12) { LAS unsigned* te2 = (LAS unsigned*)(L + 155648); for (int i_ = wave * 64 + lane_id(); i_ < MAXRT_TAB; i_ += 512) te2[i_] = 0u; __syncthreads();
            pg8::MoeOrder S2{te2, n_rt, 3, G, bid}; pg8::EpiDown E2{(unsigned char*)ws + WS_END, eb, eg};
            pg8::gemm_phase<pg8::EpiDown, pg8::MoeOrder, true>(L, g, S2, E2, wave, pt_acc); }
    }
    SEAM(12);

    if (IN(13)) for (int rep_ = 0; rep_ < REPS(13); ++rep_) { KArgs ka = kargs(); GAS unsigned char* ws = opq(ka->ws); const int lane = lane_id(), tid = wave * 64 + lane, gt = bid * 512 + tid; (void)gt;
        for (int t = gw; t < T; t += NGW) { int rows[4];
#pragma unroll
            for (int k = 0; k < 4; ++k) rows[k] = TOPROW[t * 4 + k];
            f32x4 v[2][4]; float s = 0.f;
#pragma unroll
            for (int j = 0; j < 2; ++j) { const int c = j * 1024 + lane * 16;
                { const v4u xa = *(const v4u*)(X1N + (size_t)t * DM + c), xb = *(const v4u*)(X1N + (size_t)t * DM + c + 8);
                  v[j][0] = (f32x4){bflo(xa.x), bfhi(xa.x), bflo(xa.y), bfhi(xa.y)} * ALPHA; v[j][1] = (f32x4){bflo(xa.z), bfhi(xa.z), bflo(xa.w), bfhi(xa.w)} * ALPHA;
                  v[j][2] = (f32x4){bflo(xb.x), bfhi(xb.x), bflo(xb.y), bfhi(xb.y)} * ALPHA; v[j][3] = (f32x4){bflo(xb.z), bfhi(xb.z), bflo(xb.w), bfhi(xb.w)} * ALPHA; }
#pragma unroll
                for (int k = 0; k < 4; ++k) { const v4u w = *(const v4u*)(YB + (size_t)rows[k] * DM + c); const unsigned wd[4] = {w.x, w.y, w.z, w.w};
#pragma unroll
                    for (int i = 0; i < 4; ++i) { const auto lo2 = __builtin_amdgcn_cvt_pk_f32_fp8((int)wd[i], false), hi2 = __builtin_amdgcn_cvt_pk_f32_fp8((int)wd[i], true);
                        v[j][i][0] += lo2[0] * (1.0f / SC_Y); v[j][i][1] += lo2[1] * (1.0f / SC_Y); v[j][i][2] += hi2[0] * (1.0f / SC_Y); v[j][i][3] += hi2[1] * (1.0f / SC_Y); } }
#pragma unroll
                for (int i = 0; i < 4; ++i) s += (v[j][i][0] + v[j][i][1]) + (v[j][i][2] + v[j][i][3]); }
            const float mean = wave_sum(s) * (1.0f / DM); float q = 0.f;
#pragma unroll
            for (int j = 0; j < 2; ++j)
#pragma unroll
                for (int i = 0; i < 4; ++i) { v[j][i] = v[j][i] - mean; q += (v[j][i][0] * v[j][i][0] + v[j][i][1] * v[j][i][1]) + (v[j][i][2] * v[j][i][2] + v[j][i][3] * v[j][i][3]); }
            const float rstd = 1.0f / sqrtf(wave_sum(q) * (1.0f / DM) + LN_EPS);
#pragma unroll
            for (int j = 0; j < 2; ++j)
#pragma unroll
                for (int i = 0; i < 4; ++i) { const int c = j * 1024 + lane * 16 + 4 * i; const f32x4 gg = *(const f32x4*)(((const float*)(GAS const float*)ka->ln2_g) + c), bb = *(const f32x4*)(((const float*)(GAS const float*)ka->ln2_b) + c);
                    *(f32x4*)(((float*)(GAS float*)ka->out) + (size_t)t * DM + c) = v[j][i] * rstd * gg + bb; } }
    }
    PT_MARK(13);
    if (PROBE_NRT && bid == 0) { const int n_ = (int)__builtin_amdgcn_readfirstlane((int)((LAS unsigned*)(L + LDSCTL_OFF + 64))[MAXRT_TAB]); const unsigned long long t_end = __builtin_amdgcn_s_memrealtime() + (unsigned long long)(n_ - 128) * 2000ull; while (__builtin_amdgcn_s_memrealtime() < t_end) __builtin_amdgcn_s_sleep(8); }
    if ((PROBE_TIME_MASK || PROBE_GEMM) && bid == 0) { const unsigned long long t_end = __builtin_amdgcn_s_memrealtime() + pt_acc; while (__builtin_amdgcn_s_memrealtime() < t_end) __builtin_amdgcn_s_sleep(8); }
#undef IN
#undef SEAM
}

extern "C" void kernel_launch(void* const* d_in, const int* in_sizes, int n_in, void* d_out, int out_size, void* d_ws, size_t ws_size, hipStream_t stream) {
    static int grid = 0;
    if (grid == 0) {
        if (n_in != 20 || in_sizes[0] != T * DM || out_size != T * DM || ws_size < WS_END) { fprintf(stderr, "kernel_launch: unexpected shapes (n_in %d, in0 %d, out %d, ws %zu < %zu)\n", n_in, n_in > 0 ? in_sizes[0] : -1, out_size, ws_size, (size_t)WS_END); grid = -1; return; }
        int dev = 0, cus = 0, per_cu = 0;
        if (hipGetDevice(&dev) != hipSuccess || hipDeviceGetAttribute(&cus, hipDeviceAttributeMultiprocessorCount, dev) != hipSuccess) { grid = -1; return; }
        if (hipFuncSetAttribute((const void*)fwd, hipFuncAttributeMaxDynamicSharedMemorySize, LDS_BYTES) != hipSuccess) { fprintf(stderr, "kernel_launch: hipFuncSetAttribute failed\n"); grid = -1; return; }
        if (hipOccupancyMaxActiveBlocksPerMultiprocessor(&per_cu, (const void*)fwd, 512, LDS_BYTES) != hipSuccess || per_cu < 1) fprintf(stderr, "kernel_launch: occupancy query says %d\n", per_cu);
        (void)hipGetLastError();
        grid = cus;
    }
    if (grid < 0) return;
    (void)hipMemsetAsync((char*)d_ws + WS_CTL, 0, CTL_ZERO_BYTES, stream);
    Args a{};
    a.x = (const float*)d_in[0]; a.pos = (const int*)d_in[1]; a.w_in = (const float*)d_in[2]; a.g_q_a = (const float*)d_in[3]; a.w_q_b = (const float*)d_in[4];
    a.g_kv_a = (const float*)d_in[5]; a.w_kv_b = (const float*)d_in[6]; a.g_out_mla = (const float*)d_in[7]; a.g_out_moba = (const float*)d_in[8]; a.w_o = (const float*)d_in[9];
    a.ln1_g = (const float*)d_in[10]; a.ln1_b = (const float*)d_in[11]; a.w_router = (const float*)d_in[12]; a.b_router = (const float*)d_in[13];
    a.w_gate_up = (const float*)d_in[14]; a.b_gate_up = (const float*)d_in[15]; a.w_down = (const float*)d_in[16]; a.b_down = (const float*)d_in[17];
    a.ln2_g = (const float*)d_in[18]; a.ln2_b = (const float*)d_in[19];
    a.out = (float*)d_out; a.ws = (unsigned char*)d_ws;
    if (MK_N_LAUNCHES == 1) { a.ph_lo = 0; a.ph_hi = NPHASES; hipLaunchKernelGGL(fwd, dim3(grid), dim3(512), LDS_BYTES, stream, a); }
    else { for (int p = 0; p < NPHASES; ++p) { a.ph_lo = p; a.ph_hi = p + 1; hipLaunchKernelGGL(fwd, dim3(grid), dim3(512), LDS_BYTES, stream, a); } }
    const hipError_t le = hipPeekAtLastError();
    if (le != hipSuccess) fprintf(stderr, "kernel_launch: launch failed: %s\n", hipGetErrorName(le));
}
```
